# Optimizing an MI355X kernel written in HIP

```python
import math
import jax, jax.numpy as jnp
from jax import lax
import numpy as np

D_MODEL = 1024
BATCH = 8
SEQ = 2048
DEPTH = 1
DEC_BATCH = 128
DEC_SEQ = 8
PAST_LEN = 16384
PAGE_SIZE = 128

MIX_DIM = D_MODEL
SSM_DIM = MIX_DIM // 2
CONV_DIM = MIX_DIM - SSM_DIM
SSM_GROUP_CH = 16
SSM_GROUPS = SSM_DIM // SSM_GROUP_CH
SSM_STATE = 64
CONV_WIDTH = 31
N_MEM = 256
MEM_HEADS = 4
MEM_HEAD_DIM = D_MODEL // MEM_HEADS
D_FF = ((8 * D_MODEL // 3 + 127) // 128) * 128
EPS = 1e-6
DT_MIN = 1e-3
DT_MAX = 1e-1

kernel_name = "hymba_s5_conformer_macaron_memxattn_step"


def rms_norm(x, g):
    xf = x.astype(jnp.float32)
    y = xf * lax.rsqrt(jnp.mean(xf * xf, axis=-1, keepdims=True) + EPS)
    return (y * g.astype(jnp.float32)).astype(x.dtype)


def layer_norm(x, g, b):
    xf = x.astype(jnp.float32)
    mu = jnp.mean(xf, axis=-1, keepdims=True)
    var = jnp.mean(jnp.square(xf - mu), axis=-1, keepdims=True)
    y = (xf - mu) * lax.rsqrt(var + EPS) * g.astype(jnp.float32) + b.astype(jnp.float32)
    return y.astype(x.dtype)


def swiglu_ffn(x, w_gate, w_up, w_down):
    return (jax.nn.silu(x @ w_gate) * (x @ w_up)) @ w_down


def s5_mixer(u, h0_re, h0_im, a_re, a_im, log_dt, b_re, b_im, c_re, c_im, d_skip, w_glu):
    f32 = jnp.float32
    bsz, t_len, _ = u.shape
    dt = jnp.exp(log_dt.astype(f32))[:, None]
    lr, li = a_re.astype(f32), a_im.astype(f32)
    mag = jnp.exp(lr * dt)
    ab_re, ab_im = mag * jnp.cos(li * dt), mag * jnp.sin(li * dt)
    den = lr * lr + li * li
    nr, ni = ab_re - 1.0, ab_im
    coef_re = (nr * lr + ni * li) / den
    coef_im = (ni * lr - nr * li) / den
    uf = u.astype(f32)
    ug = uf.reshape(bsz, t_len, SSM_GROUPS, SSM_GROUP_CH)
    bu_re = jnp.einsum('btgc,gnc->btgn', ug, b_re.astype(f32))
    bu_im = jnp.einsum('btgc,gnc->btgn', ug, b_im.astype(f32))
    x_re = coef_re * bu_re - coef_im * bu_im
    x_im = coef_re * bu_im + coef_im * bu_re
    a_re_t = jnp.broadcast_to(ab_re, x_re.shape)
    a_im_t = jnp.broadcast_to(ab_im, x_re.shape)

    def combine(e1, e2):
        a1r, a1i, b1r, b1i = e1
        a2r, a2i, b2r, b2i = e2
        return (a1r * a2r - a1i * a2i,
                a1r * a2i + a1i * a2r,
                a2r * b1r - a2i * b1i + b2r,
                a2r * b1i + a2i * b1r + b2i)

    p_re, p_im, s_re, s_im = lax.associative_scan(combine, (a_re_t, a_im_t, x_re, x_im), axis=1)
    h0r = h0_re.astype(f32)[:, None]
    h0i = h0_im.astype(f32)[:, None]
    h_re = s_re + p_re * h0r - p_im * h0i
    h_im = s_im + p_re * h0i + p_im * h0r
    y = (jnp.einsum('btgn,gcn->btgc', h_re, c_re.astype(f32))
         - jnp.einsum('btgn,gcn->btgc', h_im, c_im.astype(f32)))
    y = y.reshape(bsz, t_len, SSM_DIM) + d_skip.astype(f32) * uf
    g = jax.nn.gelu(y)
    out = g * jax.nn.sigmoid(g @ w_glu.astype(f32))
    return out.astype(u.dtype), h_re[:, -1], h_im[:, -1]


def conformer_conv_mixer(val, gate, buf, w_dw, b_dw, ln_g, ln_b):
    v = val * jax.nn.sigmoid(gate)
    xp = jnp.concatenate([buf.astype(v.dtype), v], axis=1)
    y = lax.conv_general_dilated(xp, w_dw[:, None, :].astype(v.dtype), window_strides=(1,),
                                 padding='VALID', dimension_numbers=('NWC', 'WIO', 'NWC'),
                                 feature_group_count=CONV_DIM) + b_dw
    y = jax.nn.silu(layer_norm(y, ln_g, ln_b))
    return y, xp[:, -(CONV_WIDTH - 1):]


def mem_kv(mem, g_mem, w_k, w_v):
    bsz = mem.shape[0]
    m = rms_norm(mem, g_mem)
    k = (m @ w_k).reshape(bsz, N_MEM, MEM_HEADS, MEM_HEAD_DIM)
    v = (m @ w_v).reshape(bsz, N_MEM, MEM_HEADS, MEM_HEAD_DIM)
    return k, v


def mem_attend(h, k, v, w_q, w_o):
    bsz, t_len, _ = h.shape
    q = (h @ w_q).reshape(bsz, t_len, MEM_HEADS, MEM_HEAD_DIM)
    s = jnp.einsum('bthd,bmhd->bhtm', q, k.astype(q.dtype)).astype(jnp.float32) * (MEM_HEAD_DIM ** -0.5)
    p = jax.nn.softmax(s, axis=-1).astype(h.dtype)
    o = jnp.einsum('bhtm,bmhd->bthd', p, v.astype(h.dtype)).reshape(bsz, t_len, MEM_HEADS * MEM_HEAD_DIM)
    return o @ w_o


def decoder_layer(x, mk, mv, h0_re, h0_im, conv_buf,
                  g_ffn1, w_ffn1_gate, w_ffn1_up, w_ffn1_down,
                  g_mix, w_in,
                  ssm_a_re, ssm_a_im, ssm_log_dt, ssm_b_re, ssm_b_im, ssm_c_re, ssm_c_im, ssm_d, w_ssm_glu,
                  conv_w, conv_b, conv_ln_g, conv_ln_b,
                  w_out, g_xattn, w_mem_q, w_mem_o,
                  g_ffn2, w_ffn2_gate, w_ffn2_up, w_ffn2_down):
    x = x + 0.5 * swiglu_ffn(rms_norm(x, g_ffn1), w_ffn1_gate, w_ffn1_up, w_ffn1_down)
    h = rms_norm(x, g_mix)
    z = h @ w_in
    u_ssm = z[..., :SSM_DIM]
    c_val = z[..., SSM_DIM:SSM_DIM + CONV_DIM]
    c_gate = z[..., SSM_DIM + CONV_DIM:]
    s_out, h_re, h_im = s5_mixer(u_ssm, h0_re, h0_im, ssm_a_re, ssm_a_im, ssm_log_dt,
                                 ssm_b_re, ssm_b_im, ssm_c_re, ssm_c_im, ssm_d, w_ssm_glu)
    c_out, new_buf = conformer_conv_mixer(c_val, c_gate, conv_buf, conv_w, conv_b, conv_ln_g, conv_ln_b)
    x = x + jnp.concatenate([s_out, c_out], axis=-1) @ w_out
    x = x + mem_attend(rms_norm(x, g_xattn), mk, mv, w_mem_q, w_mem_o)
    x = x + 0.5 * swiglu_ffn(rms_norm(x, g_ffn2), w_ffn2_gate, w_ffn2_up, w_ffn2_down)
    return x, h_re.astype(x.dtype), h_im.astype(x.dtype), new_buf


def setup_inputs(seed: int = 0) -> dict:
    key = jax.random.key(seed)
    ks = iter(jax.random.split(key, 64))
    f32 = jnp.float32

    def nrm(shape, scale):
        return jax.random.normal(next(ks), shape, f32) * scale

    def gain(shape):
        return 1.0 + 0.02 * jax.random.normal(next(ks), shape, f32)

    L = DEPTH
    n_idx = jnp.arange(SSM_STATE, dtype=f32)
    inp = {}
    inp['x_prompt'] = nrm((BATCH, SEQ, D_MODEL), 1.0)
    inp['x_sample'] = nrm((DEC_BATCH, DEC_SEQ, D_MODEL), 1.0)
    inp['state_ssm_re'] = nrm((L, DEC_BATCH, SSM_GROUPS, SSM_STATE), 0.5)
    inp['state_ssm_im'] = nrm((L, DEC_BATCH, SSM_GROUPS, SSM_STATE), 0.5)
    inp['cache_conv'] = nrm((L, DEC_BATCH, CONV_WIDTH - 1, CONV_DIM), 0.5)
    inp['cache_mem_k'] = nrm((L, DEC_BATCH, N_MEM, MEM_HEADS, MEM_HEAD_DIM), 1.0)
    inp['cache_mem_v'] = nrm((L, DEC_BATCH, N_MEM, MEM_HEADS, MEM_HEAD_DIM), 1.0)
    inp['mem_prompt'] = nrm((BATCH, N_MEM, D_MODEL), 1.0)
    inp['g_mem'] = gain((L, D_MODEL))
    inp['w_mem_k'] = nrm((L, D_MODEL, MEM_HEADS * MEM_HEAD_DIM), D_MODEL ** -0.5)
    inp['w_mem_v'] = nrm((L, D_MODEL, MEM_HEADS * MEM_HEAD_DIM), D_MODEL ** -0.5)
    inp['g_ffn1'] = gain((L, D_MODEL))
    inp['w_ffn1_gate'] = nrm((L, D_MODEL, D_FF), D_MODEL ** -0.5)
    inp['w_ffn1_up'] = nrm((L, D_MODEL, D_FF), D_MODEL ** -0.5)
    inp['w_ffn1_down'] = nrm((L, D_FF, D_MODEL), D_FF ** -0.5)
    inp['g_mix'] = gain((L, D_MODEL))
    inp['w_in'] = nrm((L, D_MODEL, SSM_DIM + 2 * CONV_DIM), D_MODEL ** -0.5)
    inp['ssm_a_re'] = -0.5 + 0.01 * jax.random.normal(next(ks), (L, SSM_GROUPS, SSM_STATE), f32)
    inp['ssm_a_im'] = math.pi * n_idx + 0.01 * jax.random.normal(next(ks), (L, SSM_GROUPS, SSM_STATE), f32)
    inp['ssm_log_dt'] = jax.random.uniform(next(ks), (L, SSM_GROUPS), f32,
                                           minval=math.log(DT_MIN), maxval=math.log(DT_MAX))
    inp['ssm_b_re'] = nrm((L, SSM_GROUPS, SSM_STATE, SSM_GROUP_CH), (2 * SSM_GROUP_CH) ** -0.5)
    inp['ssm_b_im'] = nrm((L, SSM_GROUPS, SSM_STATE, SSM_GROUP_CH), (2 * SSM_GROUP_CH) ** -0.5)
    inp['ssm_c_re'] = nrm((L, SSM_GROUPS, SSM_GROUP_CH, SSM_STATE), (2 * SSM_STATE) ** -0.5)
    inp['ssm_c_im'] = nrm((L, SSM_GROUPS, SSM_GROUP_CH, SSM_STATE), (2 * SSM_STATE) ** -0.5)
    inp['ssm_d'] = nrm((L, SSM_DIM), 1.0)
    inp['w_ssm_glu'] = nrm((L, SSM_DIM, SSM_DIM), SSM_DIM ** -0.5)
    inp['conv_w'] = nrm((L, CONV_WIDTH, CONV_DIM), CONV_WIDTH ** -0.5)
    inp['conv_b'] = nrm((L, CONV_DIM), 0.02)
    inp['conv_ln_g'] = gain((L, CONV_DIM))
    inp['conv_ln_b'] = nrm((L, CONV_DIM), 0.02)
    inp['w_out'] = nrm((L, MIX_DIM, D_MODEL), MIX_DIM ** -0.5)
    inp['g_xattn'] = gain((L, D_MODEL))
    inp['w_mem_q'] = nrm((L, D_MODEL, MEM_HEADS * MEM_HEAD_DIM), D_MODEL ** -0.5)
    inp['w_mem_o'] = nrm((L, MEM_HEADS * MEM_HEAD_DIM, D_MODEL), D_MODEL ** -0.5)
    inp['g_ffn2'] = gain((L, D_MODEL))
    inp['w_ffn2_gate'] = nrm((L, D_MODEL, D_FF), D_MODEL ** -0.5)
    inp['w_ffn2_up'] = nrm((L, D_MODEL, D_FF), D_MODEL ** -0.5)
    inp['w_ffn2_down'] = nrm((L, D_FF, D_MODEL), D_FF ** -0.5)
    inp['g_final'] = gain((D_MODEL,))
    return inp


def reference(x_prompt, x_sample, state_ssm_re, state_ssm_im, cache_conv, cache_mem_k, cache_mem_v,
              mem_prompt, g_mem, w_mem_k, w_mem_v,
              g_ffn1, w_ffn1_gate, w_ffn1_up, w_ffn1_down,
              g_mix, w_in,
              ssm_a_re, ssm_a_im, ssm_log_dt, ssm_b_re, ssm_b_im, ssm_c_re, ssm_c_im, ssm_d, w_ssm_glu,
              conv_w, conv_b, conv_ln_g, conv_ln_b,
              w_out, g_xattn, w_mem_q, w_mem_o,
              g_ffn2, w_ffn2_gate, w_ffn2_up, w_ffn2_down,
              g_final):
    bp = x_prompt.shape[0]
    yp, ys = x_prompt, x_sample
    p_re, p_im, p_conv, p_mk, p_mv = [], [], [], [], []
    s_re, s_im, s_conv = [], [], []
    for l in range(DEPTH):
        lw = (g_ffn1[l], w_ffn1_gate[l], w_ffn1_up[l], w_ffn1_down[l],
              g_mix[l], w_in[l],
              ssm_a_re[l], ssm_a_im[l], ssm_log_dt[l], ssm_b_re[l], ssm_b_im[l],
              ssm_c_re[l], ssm_c_im[l], ssm_d[l], w_ssm_glu[l],
              conv_w[l], conv_b[l], conv_ln_g[l], conv_ln_b[l],
              w_out[l], g_xattn[l], w_mem_q[l], w_mem_o[l],
              g_ffn2[l], w_ffn2_gate[l], w_ffn2_up[l], w_ffn2_down[l])
        mk, mv = mem_kv(mem_prompt, g_mem[l], w_mem_k[l], w_mem_v[l])
        h0 = jnp.zeros((bp, SSM_GROUPS, SSM_STATE), jnp.float32)
        buf0 = jnp.zeros((bp, CONV_WIDTH - 1, CONV_DIM), yp.dtype)
        yp, hr, hi, nb = decoder_layer(yp, mk, mv, h0, h0, buf0, *lw)
        p_re.append(hr); p_im.append(hi); p_conv.append(nb); p_mk.append(mk); p_mv.append(mv)
        ys, hr, hi, nb = decoder_layer(ys, cache_mem_k[l], cache_mem_v[l], state_ssm_re[l],
                                       state_ssm_im[l], cache_conv[l], *lw)
        s_re.append(hr); s_im.append(hi); s_conv.append(nb)
    y_prompt = rms_norm(yp, g_final)
    y_sample = rms_norm(ys, g_final)
    return (y_prompt, y_sample,
            jnp.stack(p_re), jnp.stack(p_im), jnp.stack(p_conv), jnp.stack(p_mk), jnp.stack(p_mv),
            jnp.stack(s_re), jnp.stack(s_im), jnp.stack(s_conv))
```

```cpp
#include <hip/hip_runtime.h>
#include <cstdint>
#include <cstdio>

typedef unsigned short bf16_t;
typedef float f32x4 __attribute__((ext_vector_type(4)));

constexpr int D = 1024, FF = 2816, MP = 16384, MS = 1024, M = MP + MS;
constexpr int SEQ = 2048, DECB = 128, DECS = 8, NBATCH = 8;
constexpr int SSM = 512, CONVD = 512, NG = 32, GC = 16, NST = 64, CWID = 31, NMEM = 256, NH = 4, HD = 256;
constexpr int MMEM = NBATCH * NMEM;
constexpr float EPS = 1e-6f;
constexpr float QSCALE = 0.0625f * 1.4426950408889634f;

constexpr size_t O_Y = 0;
constexpr size_t O_SRP = (size_t)M * D;
constexpr size_t O_SIP = O_SRP + 16384;
constexpr size_t O_CVP = O_SIP + 16384;
constexpr size_t O_MKP = O_CVP + 122880;
constexpr size_t O_MVP = O_MKP + 2097152;
constexpr size_t O_SRS = O_MVP + 2097152;
constexpr size_t O_SIS = O_SRS + 262144;
constexpr size_t O_CVS = O_SIS + 262144;
constexpr size_t O_END = O_CVS + 1966080;

constexpr size_t MiB = 1u << 20;
constexpr size_t WS_CTL = 0;
constexpr size_t WS_WGU1 = 2 * MiB, WS_WGU2 = 13 * MiB, WS_WD1 = 24 * MiB, WS_WD2 = 30 * MiB, WS_WIN = 36 * MiB, WS_WGLU = 39 * MiB,
                 WS_WOUT = 40 * MiB, WS_WQ = 42 * MiB, WS_WO = 44 * MiB, WS_WKV = 46 * MiB;
constexpr size_t WS_TAB = 50 * MiB;
constexpr size_t WS_XB = 72 * MiB, WS_MEMB = 106 * MiB, WS_KB = 110 * MiB, WS_VB2 = 114 * MiB;
constexpr size_t WS_SS0 = 118 * MiB, WS_SS1 = 120 * MiB, WS_SS2 = 122 * MiB, WS_SS3 = 124 * MiB, WS_SS4 = 126 * MiB, WS_SSM = 127 * MiB + 512 * 1024;
constexpr size_t WS_XRES = 128 * MiB, WS_H = 196 * MiB, WS_UG = 290 * MiB, WS_VB = 307 * MiB, WS_GB = 324 * MiB, WS_MIXB = 342 * MiB,
                 WS_QB = 376 * MiB, WS_OB = 410 * MiB, WS_END = 444 * MiB;

__device__ __forceinline__ unsigned f2bf(float f) { unsigned u = __builtin_bit_cast(unsigned, f); return (u + 0x7fffu + ((u >> 16) & 1u)) >> 16; }
__device__ __forceinline__ float bf2f(bf16_t b) { return __builtin_bit_cast(float, (unsigned)b << 16); }
__device__ __forceinline__ float sigmoidf_(float x) { return 1.f / (1.f + __expf(-x)); }
__device__ __forceinline__ float siluf_(float x) { return x * sigmoidf_(x); }
__device__ __forceinline__ float gelu_tanh(float x) { const float u = 0.7978845608028654f * (x + 0.044715f * x * x * x); return 0.5f * x * (1.f + tanhf(u)); }
__device__ __forceinline__ float wave_sum(float v) {
#pragma unroll
    for (int o = 1; o < 64; o <<= 1) v += __shfl_xor(v, o);
    return v;
}
__device__ __forceinline__ float rstd_from_ss(const float* ss, int row) {
    float s = 0.f;
#pragma unroll
    for (int i = 0; i < 16; ++i) s += ss[(size_t)row * 16 + i];
    return rsqrtf(s * (1.f / D) + EPS);
}

template <int MAP>
__global__ void k_wt(const float* W0, const float* W1, const float* gain, bf16_t* WT, int K, int N, int ldw) {
    __shared__ float tile[32][33];
    const int n0 = blockIdx.x * 32, k0 = blockIdx.y * 32, tx = threadIdx.x & 31, ty = threadIdx.x >> 5;
    const float* W = W0; int c0 = n0;
    if (MAP == 1) { const int pn = n0 / 256, half = (n0 % 256) / 128, jj = n0 % 128; W = half ? W1 : W0; c0 = pn * 128 + jj; }
    if (MAP == 2) { if (n0 >= 512) { const int m = n0 - 512, pc = m / 256, half = (m % 256) / 128, jj = m % 128; c0 = 512 + half * 512 + pc * 128 + jj; } }
    if (MAP == 3) { if (n0 >= 1024) { W = W1; c0 = n0 - 1024; } }
    for (int i = ty; i < 32; i += 8) { const int k = k0 + i; tile[i][tx] = W[(size_t)k * ldw + c0 + tx] * (gain ? gain[k] : 1.f); }
    __syncthreads();
    for (int i = ty; i < 32; i += 8) WT[(size_t)(n0 + i) * K + k0 + tx] = (bf16_t)f2bf(tile[tx][i]);
}
__global__ void k_rows_bf16_ss(const float* x0, int rows0, const float* x1, int rows1, bf16_t* xb, float* ss) {
    const int row = blockIdx.x * 4 + (threadIdx.x >> 6), lane = threadIdx.x & 63;
    if (row >= rows0 + rows1) return;
    const float* xr = row < rows0 ? x0 + (size_t)row * D : x1 + (size_t)(row - rows0) * D;
    float s = 0.f;
    for (int j = 0; j < 4; ++j) { const f32x4 v = *(const f32x4*)(xr + j * 256 + lane * 4); s += v.x * v.x + v.y * v.y + v.z * v.z + v.w * v.w;
        uint2 o; o.x = f2bf(v.x) | (f2bf(v.y) << 16); o.y = f2bf(v.z) | (f2bf(v.w) << 16); *(uint2*)(xb + (size_t)row * D + j * 256 + lane * 4) = o; }
    s = wave_sum(s);
    if (lane < 16) ss[(size_t)row * 16 + lane] = lane == 0 ? s : 0.f;
}
__global__ void k_rows_ss(const float* x, int rows, float* ss) {
    const int row = blockIdx.x * 4 + (threadIdx.x >> 6), lane = threadIdx.x & 63;
    if (row >= rows) return;
    float s = 0.f;
    for (int j = 0; j < 4; ++j) { const f32x4 v = *(const f32x4*)(x + (size_t)row * D + j * 256 + lane * 4); s += v.x * v.x + v.y * v.y + v.z * v.z + v.w * v.w; }
    s = wave_sum(s);
    if (lane < 16) ss[(size_t)row * 16 + lane] = lane == 0 ? s : 0.f;
}

enum { E_KV = 1, E_SWIGLU = 2, E_RES = 3, E_U = 4, E_V = 5, E_GLU = 6, E_Q = 7 };
struct EpiP {
    const float* ss;
    const float* resin;
    float* resout;
    bf16_t* ob;
    bf16_t* ob2;
    const bf16_t* gb;
    float* out;
    float alpha;
    int pad;
};
template <int MODE>
__device__ __forceinline__ void epi_elem(const EpiP& P, int row, int c, float a0, float a1, float rstd) {
    if (MODE == E_KV) {
        const float v = a0 * rstd;
        if (c < 1024) { P.out[O_MKP + (size_t)row * 1024 + c] = v; P.ob[(size_t)row * 1024 + c] = (bf16_t)f2bf(v); }
        else { P.out[O_MVP + (size_t)row * 1024 + c - 1024] = v; P.ob2[(size_t)row * 1024 + c - 1024] = (bf16_t)f2bf(v); }
    } else if (MODE == E_SWIGLU) {
        const float g = a0 * rstd, u = a1 * rstd; P.ob[(size_t)row * FF + c] = (bf16_t)f2bf(siluf_(g) * u);
    } else if (MODE == E_RES) {
        const float v = P.resin[(size_t)row * D + c] + P.alpha * a0; P.resout[(size_t)row * D + c] = v; if (P.ob) P.ob[(size_t)row * D + c] = (bf16_t)f2bf(v);
    } else if (MODE == E_U) {
        P.ob[((size_t)(c >> 4) * M + row) * 16 + (c & 15)] = (bf16_t)f2bf(a0 * rstd);
    } else if (MODE == E_V) {
        const float v = (a0 * rstd) * sigmoidf_(a1 * rstd); P.ob[(size_t)row * CONVD + c] = (bf16_t)f2bf(v);
        if (row < MP) { const int b = row / SEQ, t = row % SEQ; if (t >= SEQ - 30) P.out[O_CVP + ((size_t)b * 30 + (t - (SEQ - 30))) * CONVD + c] = v; }
        else { const int rs = row - MP, b = rs / DECS, t = rs % DECS; P.out[O_CVS + ((size_t)b * 30 + 22 + t) * CONVD + c] = v; }
    } else if (MODE == E_GLU) {
        const float g = bf2f(P.gb[(size_t)row * SSM + c]); P.ob[(size_t)row * D + c] = (bf16_t)f2bf(g * sigmoidf_(a0));
    } else if (MODE == E_Q) {
        P.ob[(size_t)row * D + c] = (bf16_t)f2bf(a0 * rstd * QSCALE);
    }
}
template <int MODE> struct ModeTraits { static constexpr bool PAIRED = (MODE == E_SWIGLU || MODE == E_V); static constexpr bool RSTD = (MODE == E_KV || MODE == E_SWIGLU || MODE == E_U || MODE == E_V || MODE == E_Q); };

template <int MODE>
__global__ void __launch_bounds__(256) k_ref_gemm(const bf16_t* A, const bf16_t* BT, int K, EpiP P) {
    constexpr bool PAIRED = ModeTraits<MODE>::PAIRED;
    __shared__ float As[32][65], B0[32][65], B1[PAIRED ? 32 : 1][65];
    const int tid = threadIdx.x, tx = tid & 15, ty = tid >> 4;
    const int m0 = blockIdx.y * 64, p0 = blockIdx.x * 64;
    const int cb0 = PAIRED ? (p0 / 128) * 256 + (p0 % 128) : p0;
    float acc0[4][4], acc1[4][4];
    for (int i = 0; i < 4; ++i) for (int j = 0; j < 4; ++j) { acc0[i][j] = 0.f; acc1[i][j] = 0.f; }
    for (int k0 = 0; k0 < K; k0 += 32) {
        for (int e = tid; e < 64 * 32; e += 256) { const int r = e >> 5, k = e & 31;
            As[k][r] = bf2f(A[(size_t)(m0 + r) * K + k0 + k]); B0[k][r] = bf2f(BT[(size_t)(cb0 + r) * K + k0 + k]);
            if (PAIRED) B1[k][r] = bf2f(BT[(size_t)(cb0 + 128 + r) * K + k0 + k]); }
        __syncthreads();
        for (int k = 0; k < 32; ++k) {
            float a[4], b0[4], b1[4];
            for (int i = 0; i < 4; ++i) a[i] = As[k][ty * 4 + i];
            for (int j = 0; j < 4; ++j) { b0[j] = B0[k][tx * 4 + j]; b1[j] = PAIRED ? B1[k][tx * 4 + j] : 0.f; }
            for (int i = 0; i < 4; ++i) for (int j = 0; j < 4; ++j) { acc0[i][j] += a[i] * b0[j]; if (PAIRED) acc1[i][j] += a[i] * b1[j]; }
        }
        __syncthreads();
    }
    for (int i = 0; i < 4; ++i) { const int row = m0 + ty * 4 + i; const float rstd = ModeTraits<MODE>::RSTD ? rstd_from_ss(P.ss, row) : 1.f;
        for (int j = 0; j < 4; ++j) epi_elem<MODE>(P, row, p0 + tx * 4 + j, acc0[i][j], acc1[i][j], rstd); }
}

__global__ void __launch_bounds__(64) k_ref_s5(const bf16_t* ug, const float* h0re, const float* h0im, const float* a_re, const float* a_im, const float* log_dt,
                                               const float* b_re, const float* b_im, const float* c_re, const float* c_im, const float* dskip, bf16_t* gb, float* out) {
    const int g = blockIdx.x % NG, sq = blockIdx.x / NG, n = threadIdx.x;
    const bool prompt = sq < NBATCH; const int b = prompt ? sq : sq - NBATCH, T = prompt ? SEQ : DECS, row0 = prompt ? b * SEQ : MP + b * DECS;
    const float dt = expf(log_dt[g]), lr = a_re[g * NST + n], li = a_im[g * NST + n];
    const float mag = expf(lr * dt), abr = mag * cosf(li * dt), abi = mag * sinf(li * dt);
    const float den = lr * lr + li * li, nr = abr - 1.f, ni = abi, cr = (nr * lr + ni * li) / den, ci = (ni * lr - nr * li) / den;
    float Br[16], Bi[16], Cr[16], Ci[16];
    for (int c = 0; c < 16; ++c) { const float br = b_re[((size_t)g * NST + n) * 16 + c], bi = b_im[((size_t)g * NST + n) * 16 + c];
        Br[c] = cr * br - ci * bi; Bi[c] = cr * bi + ci * br; Cr[c] = c_re[((size_t)g * 16 + c) * NST + n]; Ci[c] = c_im[((size_t)g * 16 + c) * NST + n]; }
    float hr = 0.f, hi = 0.f;
    if (!prompt) { hr = h0re[((size_t)b * NG + g) * NST + n]; hi = h0im[((size_t)b * NG + g) * NST + n]; }
    const float dsk = dskip[g * 16 + (n & 15)];
    for (int t = 0; t < T; ++t) {
        const bf16_t* up = ug + ((size_t)g * M + row0 + t) * 16;
        float u[16], xr = 0.f, xi = 0.f;
#pragma unroll
        for (int c = 0; c < 16; ++c) { u[c] = bf2f(up[c]); xr += Br[c] * u[c]; xi += Bi[c] * u[c]; }
        const float nhr = abr * hr - abi * hi + xr, nhi = abr * hi + abi * hr + xi; hr = nhr; hi = nhi;
        float ymine = 0.f;
#pragma unroll
        for (int c = 0; c < 16; ++c) { const float y = wave_sum(Cr[c] * hr - Ci[c] * hi); if ((n & 15) == c) ymine = y + dsk * u[c]; }
        if (n < 16) gb[(size_t)(row0 + t) * SSM + g * 16 + n] = (bf16_t)f2bf(gelu_tanh(ymine));
    }
    if (prompt) { out[O_SRP + ((size_t)b * NG + g) * NST + n] = hr; out[O_SIP + ((size_t)b * NG + g) * NST + n] = hi; }
    else { out[O_SRS + ((size_t)b * NG + g) * NST + n] = hr; out[O_SIS + ((size_t)b * NG + g) * NST + n] = hi; }
}

__global__ void __launch_bounds__(512) k_ref_conv(const bf16_t* vb, const float* cache, const float* w, const float* bias, const float* lg, const float* lb, bf16_t* mixb, float* out) {
    __shared__ float red[2][8];
    const int row = blockIdx.x, c = threadIdx.x;
    float y = bias[c];
    if (row < MP) { const int t = row % SEQ;
        for (int k = 0; k < CWID; ++k) { const int tt = t - 30 + k; if (tt >= 0) y += w[k * CONVD + c] * bf2f(vb[(size_t)(row - 30 + k) * CONVD + c]); }
    } else { const int rs = row - MP, b = rs / DECS, t = rs % DECS;
        for (int k = 0; k < CWID; ++k) { const int idx = t + k; const float xv = idx < 30 ? cache[((size_t)b * 30 + idx) * CONVD + c] : bf2f(vb[(size_t)(MP + b * DECS + idx - 30) * CONVD + c]); y += w[k * CONVD + c] * xv; }
        if (t == 0) for (int j = 0; j < 22; ++j) out[O_CVS + ((size_t)b * 30 + j) * CONVD + c] = cache[((size_t)b * 30 + j + 8) * CONVD + c];
    }
    float s = wave_sum(y); if ((c & 63) == 0) red[0][c >> 6] = s; __syncthreads();
    float mu = 0.f; for (int i = 0; i < 8; ++i) mu += red[0][i]; mu *= (1.f / CONVD);
    const float d = y - mu; float q = wave_sum(d * d); if ((c & 63) == 0) red[1][c >> 6] = q; __syncthreads();
    float var = 0.f; for (int i = 0; i < 8; ++i) var += red[1][i]; var *= (1.f / CONVD);
    const float z = d * rsqrtf(var + EPS) * lg[c] + lb[c];
    mixb[(size_t)row * D + SSM + c] = (bf16_t)f2bf(siluf_(z));
}

__global__ void __launch_bounds__(256) k_ref_attn(const bf16_t* qb, const bf16_t* kb, const bf16_t* vb2, const float* ck, const float* cv, bf16_t* ob) {
    __shared__ float q[256], p[256], red[4];
    const int row = blockIdx.x >> 2, h = blockIdx.x & 3, tid = threadIdx.x;
    q[tid] = bf2f(qb[(size_t)row * D + h * HD + tid]);
    __syncthreads();
    float s = 0.f;
    if (row < MP) { const int b = row / SEQ; const bf16_t* kr = kb + ((size_t)b * NMEM + tid) * D + h * HD; for (int d = 0; d < HD; ++d) s += q[d] * bf2f(kr[d]); }
    else { const int b = (row - MP) / DECS; const float* kr = ck + ((size_t)b * NMEM + tid) * D + h * HD; for (int d = 0; d < HD; ++d) s += q[d] * kr[d]; }
    float mx = s; for (int o = 1; o < 64; o <<= 1) mx = fmaxf(mx, __shfl_xor(mx, o));
    if ((tid & 63) == 0) red[tid >> 6] = mx; __syncthreads();
    mx = fmaxf(fmaxf(red[0], red[1]), fmaxf(red[2], red[3])); __syncthreads();
    const float e = exp2f(s - mx); float sm = wave_sum(e);
    if ((tid & 63) == 0) red[tid >> 6] = sm; __syncthreads();
    sm = red[0] + red[1] + red[2] + red[3];
    p[tid] = e / sm; __syncthreads();
    float o = 0.f;
    if (row < MP) { const int b = row / SEQ; const bf16_t* vr = vb2 + (size_t)b * NMEM * D + h * HD + tid; for (int m = 0; m < NMEM; ++m) o += p[m] * bf2f(vr[(size_t)m * D]); }
    else { const int b = (row - MP) / DECS; const float* vr = cv + (size_t)b * NMEM * D + h * HD + tid; for (int m = 0; m < NMEM; ++m) o += p[m] * vr[(size_t)m * D]; }
    ob[(size_t)row * D + h * HD + tid] = (bf16_t)f2bf(o);
}

__global__ void k_final(float* y, const float* ss, const float* g) {
    const int row = blockIdx.x * 4 + (threadIdx.x >> 6), lane = threadIdx.x & 63;
    const float r = rstd_from_ss(ss, row);
    for (int j = 0; j < 4; ++j) { f32x4* p = (f32x4*)(y + (size_t)row * D + j * 256 + lane * 4); const f32x4 gg = *(const f32x4*)(g + j * 256 + lane * 4); f32x4 v = *p; v = v * r * gg; *p = v; }
}

extern "C" void kernel_launch(void* const* d_in, const int* in_sizes, int n_in, void* d_out, int out_size, void* d_ws, size_t ws_size, hipStream_t stream) {
    if (n_in != 39 || out_size != (int)O_END || ws_size < WS_END) { fprintf(stderr, "kernel_launch: unexpected shapes n_in %d out %d ws %zu\n", n_in, out_size, ws_size); return; }
    const float* const* in = (const float* const*)d_in;
    const float *x_p = in[0], *x_s = in[1], *st_re = in[2], *st_im = in[3], *cconv = in[4], *cmk = in[5], *cmv = in[6], *memp = in[7], *g_mem = in[8], *w_k = in[9], *w_v = in[10],
                *g_ffn1 = in[11], *w1g = in[12], *w1u = in[13], *w1d = in[14], *g_mix = in[15], *w_in = in[16], *a_re = in[17], *a_im = in[18], *log_dt = in[19], *b_re = in[20], *b_im = in[21],
                *c_re = in[22], *c_im = in[23], *ssm_d = in[24], *w_glu = in[25], *conv_w = in[26], *conv_b = in[27], *ln_g = in[28], *ln_b = in[29], *w_out = in[30], *g_xattn = in[31],
                *w_q = in[32], *w_o = in[33], *g_ffn2 = in[34], *w2g = in[35], *w2u = in[36], *w2d = in[37], *g_final = in[38];
    unsigned char* ws = (unsigned char*)d_ws; float* out = (float*)d_out;
    bf16_t *Wgu1 = (bf16_t*)(ws + WS_WGU1), *Wgu2 = (bf16_t*)(ws + WS_WGU2), *Wd1 = (bf16_t*)(ws + WS_WD1), *Wd2 = (bf16_t*)(ws + WS_WD2), *Win = (bf16_t*)(ws + WS_WIN), *Wglu = (bf16_t*)(ws + WS_WGLU),
           *Wout = (bf16_t*)(ws + WS_WOUT), *Wq = (bf16_t*)(ws + WS_WQ), *Wo = (bf16_t*)(ws + WS_WO), *Wkv = (bf16_t*)(ws + WS_WKV);
    bf16_t *xb = (bf16_t*)(ws + WS_XB), *memb = (bf16_t*)(ws + WS_MEMB), *kb = (bf16_t*)(ws + WS_KB), *vb2 = (bf16_t*)(ws + WS_VB2), *hb = (bf16_t*)(ws + WS_H), *ug = (bf16_t*)(ws + WS_UG),
           *vb = (bf16_t*)(ws + WS_VB), *gb = (bf16_t*)(ws + WS_GB), *mixb = (bf16_t*)(ws + WS_MIXB), *qb = (bf16_t*)(ws + WS_QB), *ob = (bf16_t*)(ws + WS_OB);
    float *ss0 = (float*)(ws + WS_SS0), *ss1 = (float*)(ws + WS_SS1), *ss2 = (float*)(ws + WS_SS2), *ss3 = (float*)(ws + WS_SS3), *ss4 = (float*)(ws + WS_SS4), *ssm = (float*)(ws + WS_SSM), *xres = (float*)(ws + WS_XRES);

    k_wt<1><<<dim3(2 * FF / 32, D / 32), 256, 0, stream>>>(w1g, w1u, g_ffn1, Wgu1, D, 2 * FF, FF);
    k_wt<1><<<dim3(2 * FF / 32, D / 32), 256, 0, stream>>>(w2g, w2u, g_ffn2, Wgu2, D, 2 * FF, FF);
    k_wt<0><<<dim3(D / 32, FF / 32), 256, 0, stream>>>(w1d, nullptr, nullptr, Wd1, FF, D, D);
    k_wt<0><<<dim3(D / 32, FF / 32), 256, 0, stream>>>(w2d, nullptr, nullptr, Wd2, FF, D, D);
    k_wt<2><<<dim3(1536 / 32, D / 32), 256, 0, stream>>>(w_in, nullptr, g_mix, Win, D, 1536, 1536);
    k_wt<0><<<dim3(SSM / 32, SSM / 32), 256, 0, stream>>>(w_glu, nullptr, nullptr, Wglu, SSM, SSM, SSM);
    k_wt<0><<<dim3(D / 32, D / 32), 256, 0, stream>>>(w_out, nullptr, nullptr, Wout, D, D, D);
    k_wt<0><<<dim3(D / 32, D / 32), 256, 0, stream>>>(w_q, nullptr, g_xattn, Wq, D, D, D);
    k_wt<0><<<dim3(D / 32, D / 32), 256, 0, stream>>>(w_o, nullptr, nullptr, Wo, D, D, D);
    k_wt<3><<<dim3(2048 / 32, D / 32), 256, 0, stream>>>(w_k, w_v, g_mem, Wkv, D, 2048, D);
    k_rows_bf16_ss<<<M / 4, 256, 0, stream>>>(x_p, MP, x_s, MS, xb, ss0);
    k_rows_bf16_ss<<<MMEM / 4, 256, 0, stream>>>(memp, MMEM, nullptr, 0, memb, ssm);

    EpiP P{};
    P = EpiP{}; P.ss = ssm; P.ob = kb; P.ob2 = vb2; P.out = out;
    k_ref_gemm<E_KV><<<dim3(2048 / 64, MMEM / 64), 256, 0, stream>>>(memb, Wkv, D, P);
    P = EpiP{}; P.ss = ss0; P.ob = hb;
    k_ref_gemm<E_SWIGLU><<<dim3(FF / 64, M / 64), 256, 0, stream>>>(xb, Wgu1, D, P);
    hipMemcpyAsync(xres, x_p, (size_t)MP * D * 4, hipMemcpyDeviceToDevice, stream);
    hipMemcpyAsync(xres + (size_t)MP * D, x_s, (size_t)MS * D * 4, hipMemcpyDeviceToDevice, stream);
    P = EpiP{}; P.resin = xres; P.resout = xres; P.ob = xb; P.alpha = 0.5f;
    k_ref_gemm<E_RES><<<dim3(D / 64, M / 64), 256, 0, stream>>>(hb, Wd1, FF, P);
    k_rows_ss<<<M / 4, 256, 0, stream>>>(xres, M, ss1);
    P = EpiP{}; P.ss = ss1; P.ob = ug;
    k_ref_gemm<E_U><<<dim3(SSM / 64, M / 64), 256, 0, stream>>>(xb, Win, D, P);
    P = EpiP{}; P.ss = ss1; P.ob = vb; P.out = out;
    k_ref_gemm<E_V><<<dim3(CONVD / 64, M / 64), 256, 0, stream>>>(xb, Win + (size_t)512 * D, D, P);
    k_ref_s5<<<(NBATCH + DECB) * NG, 64, 0, stream>>>(ug, st_re, st_im, a_re, a_im, log_dt, b_re, b_im, c_re, c_im, ssm_d, gb, out);
    k_ref_conv<<<M, 512, 0, stream>>>(vb, cconv, conv_w, conv_b, ln_g, ln_b, mixb, out);
    P = EpiP{}; P.ob = mixb; P.gb = gb;
    k_ref_gemm<E_GLU><<<dim3(SSM / 64, M / 64), 256, 0, stream>>>(gb, Wglu, SSM, P);
    P = EpiP{}; P.resin = xres; P.resout = xres; P.ob = xb; P.alpha = 1.f;
    k_ref_gemm<E_RES><<<dim3(D / 64, M / 64), 256, 0, stream>>>(mixb, Wout, D, P);
    k_rows_ss<<<M / 4, 256, 0, stream>>>(xres, M, ss2);
    P = EpiP{}; P.ss = ss2; P.ob = qb;
    k_ref_gemm<E_Q><<<dim3(D / 64, M / 64), 256, 0, stream>>>(xb, Wq, D, P);
    k_ref_attn<<<M * NH, 256, 0, stream>>>(qb, kb, vb2, cmk, cmv, ob);
    P = EpiP{}; P.resin = xres; P.resout = xres; P.ob = xb; P.alpha = 1.f;
    k_ref_gemm<E_RES><<<dim3(D / 64, M / 64), 256, 0, stream>>>(ob, Wo, D, P);
    k_rows_ss<<<M / 4, 256, 0, stream>>>(xres, M, ss3);
    P = EpiP{}; P.ss = ss3; P.ob = hb;
    k_ref_gemm<E_SWIGLU><<<dim3(FF / 64, M / 64), 256, 0, stream>>>(xb, Wgu2, D, P);
    P = EpiP{}; P.resin = xres; P.resout = out + O_Y; P.ob = nullptr; P.alpha = 0.5f;
    k_ref_gemm<E_RES><<<dim3(D / 64, M / 64), 256, 0, stream>>>(hb, Wd2, FF, P);
    k_rows_ss<<<M / 4, 256, 0, stream>>>(out + O_Y, M, ss4);
    k_final<<<M / 4, 256, 0, stream>>>(out + O_Y, ss4, g_final);
}
```

```cpp
#include <hip/hip_runtime.h>
#include <cstdint>
#include <cstdio>

typedef unsigned short bf16_t;
typedef float f32x4 __attribute__((ext_vector_type(4)));

constexpr int D = 1024, FF = 2816, MP = 16384, MS = 1024, M = MP + MS;
constexpr int SEQ = 2048, DECB = 128, DECS = 8, NBATCH = 8;
constexpr int SSM = 512, CONVD = 512, NG = 32, GC = 16, NST = 64, CWID = 31, NMEM = 256, NH = 4, HD = 256;
constexpr int MMEM = NBATCH * NMEM;
constexpr float EPS = 1e-6f;
constexpr float QSCALE = 0.0625f * 1.4426950408889634f;

constexpr size_t O_Y = 0;
constexpr size_t O_SRP = (size_t)M * D;
constexpr size_t O_SIP = O_SRP + 16384;
constexpr size_t O_CVP = O_SIP + 16384;
constexpr size_t O_MKP = O_CVP + 122880;
constexpr size_t O_MVP = O_MKP + 2097152;
constexpr size_t O_SRS = O_MVP + 2097152;
constexpr size_t O_SIS = O_SRS + 262144;
constexpr size_t O_CVS = O_SIS + 262144;
constexpr size_t O_END = O_CVS + 1966080;

constexpr size_t MiB = 1u << 20;
constexpr size_t WS_CTL = 0;
constexpr size_t WS_WGU1 = 2 * MiB, WS_WGU2 = 13 * MiB, WS_WD1 = 24 * MiB, WS_WD2 = 30 * MiB, WS_WIN = 36 * MiB, WS_WGLU = 39 * MiB,
                 WS_WOUT = 40 * MiB, WS_WQ = 42 * MiB, WS_WO = 44 * MiB, WS_WKV = 46 * MiB;
constexpr size_t WS_TAB = 50 * MiB;
constexpr size_t WS_XB = 72 * MiB, WS_MEMB = 106 * MiB, WS_KB = 110 * MiB, WS_VB2 = 114 * MiB;
constexpr size_t WS_SS0 = 118 * MiB, WS_SS1 = 120 * MiB, WS_SS2 = 122 * MiB, WS_SS3 = 124 * MiB, WS_SS4 = 126 * MiB, WS_SSM = 127 * MiB + 512 * 1024;
constexpr size_t WS_XRES = 128 * MiB, WS_H = 196 * MiB, WS_UG = 290 * MiB, WS_VB = 307 * MiB, WS_GB = 324 * MiB, WS_MIXB = 342 * MiB,
                 WS_QB = 376 * MiB, WS_OB = 410 * MiB, WS_END = 444 * MiB;

__device__ __forceinline__ unsigned f2bf(float f) { unsigned u = __builtin_bit_cast(unsigned, f); return (u + 0x7fffu + ((u >> 16) & 1u)) >> 16; }
__device__ __forceinline__ float bf2f(bf16_t b) { return __builtin_bit_cast(float, (unsigned)b << 16); }
__device__ __forceinline__ float sigmoidf_(float x) { return 1.f / (1.f + __expf(-x)); }
__device__ __forceinline__ float siluf_(float x) { return x * sigmoidf_(x); }
__device__ __forceinline__ float gelu_tanh(float x) { const float u = 0.7978845608028654f * (x + 0.044715f * x * x * x); return 0.5f * x * (1.f + tanhf(u)); }
__device__ __forceinline__ float wave_sum(float v) {
#pragma unroll
    for (int o = 1; o < 64; o <<= 1) v += __shfl_xor(v, o);
    return v;
}
__device__ __forceinline__ float rstd_from_ss(const float* ss, int row) {
    float s = 0.f;
#pragma unroll
    for (int i = 0; i < 16; ++i) s += ss[(size_t)row * 16 + i];
    return rsqrtf(s * (1.f / D) + EPS);
}

template <int MAP>
__global__ void k_wt(const float* W0, const float* W1, const float* gain, bf16_t* WT, int K, int N, int ldw) {
    __shared__ float tile[32][33];
    const int n0 = blockIdx.x * 32, k0 = blockIdx.y * 32, tx = threadIdx.x & 31, ty = threadIdx.x >> 5;
    const float* W = W0; int c0 = n0;
    if (MAP == 1) { const int pn = n0 / 256, half = (n0 % 256) / 128, jj = n0 % 128; W = half ? W1 : W0; c0 = pn * 128 + jj; }
    if (MAP == 2) { if (n0 >= 512) { const int m = n0 - 512, pc = m / 256, half = (m % 256) / 128, jj = m % 128; c0 = 512 + half * 512 + pc * 128 + jj; } }
    if (MAP == 3) { if (n0 >= 1024) { W = W1; c0 = n0 - 1024; } }
    for (int i = ty; i < 32; i += 8) { const int k = k0 + i; tile[i][tx] = W[(size_t)k * ldw + c0 + tx] * (gain ? gain[k] : 1.f); }
    __syncthreads();
    for (int i = ty; i < 32; i += 8) WT[(size_t)(n0 + i) * K + k0 + tx] = (bf16_t)f2bf(tile[tx][i]);
}
__global__ void k_rows_bf16_ss(const float* x0, int rows0, const float* x1, int rows1, bf16_t* xb, float* ss) {
    const int row = blockIdx.x * 4 + (threadIdx.x >> 6), lane = threadIdx.x & 63;
    if (row >= rows0 + rows1) return;
    const float* xr = row < rows0 ? x0 + (size_t)row * D : x1 + (size_t)(row - rows0) * D;
    float s = 0.f;
    for (int j = 0; j < 4; ++j) { const f32x4 v = *(const f32x4*)(xr + j * 256 + lane * 4); s += v.x * v.x + v.y * v.y + v.z * v.z + v.w * v.w;
        uint2 o; o.x = f2bf(v.x) | (f2bf(v.y) << 16); o.y = f2bf(v.z) | (f2bf(v.w) << 16); *(uint2*)(xb + (size_t)row * D + j * 256 + lane * 4) = o; }
    s = wave_sum(s);
    if (lane < 16) ss[(size_t)row * 16 + lane] = lane == 0 ? s : 0.f;
}
__global__ void k_rows_ss(const float* x, int rows, float* ss) {
    const int row = blockIdx.x * 4 + (threadIdx.x >> 6), lane = threadIdx.x & 63;
    if (row >= rows) return;
    float s = 0.f;
    for (int j = 0; j < 4; ++j) { const f32x4 v = *(const f32x4*)(x + (size_t)row * D + j * 256 + lane * 4); s += v.x * v.x + v.y * v.y + v.z * v.z + v.w * v.w; }
    s = wave_sum(s);
    if (lane < 16) ss[(size_t)row * 16 + lane] = lane == 0 ? s : 0.f;
}

enum { E_KV = 1, E_SWIGLU = 2, E_RES = 3, E_U = 4, E_V = 5, E_GLU = 6, E_Q = 7 };
struct EpiP {
    const float* ss;
    const float* resin;
    float* resout;
    bf16_t* ob;
    bf16_t* ob2;
    const bf16_t* gb;
    float* out;
    float alpha;
    int pad;
};
template <int MODE>
__device__ __forceinline__ void epi_elem(const EpiP& P, int row, int c, float a0, float a1, float rstd) {
    if (MODE == E_KV) {
        const float v = a0 * rstd;
        if (c < 1024) { P.out[O_MKP + (size_t)row * 1024 + c] = v; P.ob[(size_t)row * 1024 + c] = (bf16_t)f2bf(v); }
        else { P.out[O_MVP + (size_t)row * 1024 + c - 1024] = v; P.ob2[(size_t)row * 1024 + c - 1024] = (bf16_t)f2bf(v); }
    } else if (MODE == E_SWIGLU) {
        const float g = a0 * rstd, u = a1 * rstd; P.ob[(size_t)row * FF + c] = (bf16_t)f2bf(siluf_(g) * u);
    } else if (MODE == E_RES) {
        const float v = P.resin[(size_t)row * D + c] + P.alpha * a0; P.resout[(size_t)row * D + c] = v; if (P.ob) P.ob[(size_t)row * D + c] = (bf16_t)f2bf(v);
    } else if (MODE == E_U) {
        P.ob[((size_t)(c >> 4) * M + row) * 16 + (c & 15)] = (bf16_t)f2bf(a0 * rstd);
    } else if (MODE == E_V) {
        const float v = (a0 * rstd) * sigmoidf_(a1 * rstd); P.ob[(size_t)row * CONVD + c] = (bf16_t)f2bf(v);
        if (row < MP) { const int b = row / SEQ, t = row % SEQ; if (t >= SEQ - 30) P.out[O_CVP + ((size_t)b * 30 + (t - (SEQ - 30))) * CONVD + c] = v; }
        else { const int rs = row - MP, b = rs / DECS, t = rs % DECS; P.out[O_CVS + ((size_t)b * 30 + 22 + t) * CONVD + c] = v; }
    } else if (MODE == E_GLU) {
        const float g = bf2f(P.gb[(size_t)row * SSM + c]); P.ob[(size_t)row * D + c] = (bf16_t)f2bf(g * sigmoidf_(a0));
    } else if (MODE == E_Q) {
        P.ob[(size_t)row * D + c] = (bf16_t)f2bf(a0 * rstd * QSCALE);
    }
}
template <int MODE> struct ModeTraits { static constexpr bool PAIRED = (MODE == E_SWIGLU || MODE == E_V); static constexpr bool RSTD = (MODE == E_KV || MODE == E_SWIGLU || MODE == E_U || MODE == E_V || MODE == E_Q); };

template <int MODE>
__global__ void __launch_bounds__(256) k_ref_gemm(const bf16_t* A, const bf16_t* BT, int K, EpiP P) {
    constexpr bool PAIRED = ModeTraits<MODE>::PAIRED;
    __shared__ float As[32][65], B0[32][65], B1[PAIRED ? 32 : 1][65];
    const int tid = threadIdx.x, tx = tid & 15, ty = tid >> 4;
    const int m0 = blockIdx.y * 64, p0 = blockIdx.x * 64;
    const int cb0 = PAIRED ? (p0 / 128) * 256 + (p0 % 128) : p0;
    float acc0[4][4], acc1[4][4];
    for (int i = 0; i < 4; ++i) for (int j = 0; j < 4; ++j) { acc0[i][j] = 0.f; acc1[i][j] = 0.f; }
    for (int k0 = 0; k0 < K; k0 += 32) {
        for (int e = tid; e < 64 * 32; e += 256) { const int r = e >> 5, k = e & 31;
            As[k][r] = bf2f(A[(size_t)(m0 + r) * K + k0 + k]); B0[k][r] = bf2f(BT[(size_t)(cb0 + r) * K + k0 + k]);
            if (PAIRED) B1[k][r] = bf2f(BT[(size_t)(cb0 + 128 + r) * K + k0 + k]); }
        __syncthreads();
        for (int k = 0; k < 32; ++k) {
            float a[4], b0[4], b1[4];
            for (int i = 0; i < 4; ++i) a[i] = As[k][ty * 4 + i];
            for (int j = 0; j < 4; ++j) { b0[j] = B0[k][tx * 4 + j]; b1[j] = PAIRED ? B1[k][tx * 4 + j] : 0.f; }
            for (int i = 0; i < 4; ++i) for (int j = 0; j < 4; ++j) { acc0[i][j] += a[i] * b0[j]; if (PAIRED) acc1[i][j] += a[i] * b1[j]; }
        }
        __syncthreads();
    }
    for (int i = 0; i < 4; ++i) { const int row = m0 + ty * 4 + i; const float rstd = ModeTraits<MODE>::RSTD ? rstd_from_ss(P.ss, row) : 1.f;
        for (int j = 0; j < 4; ++j) epi_elem<MODE>(P, row, p0 + tx * 4 + j, acc0[i][j], acc1[i][j], rstd); }
}

__global__ void __launch_bounds__(64) k_ref_s5(const bf16_t* ug, const float* h0re, const float* h0im, const float* a_re, const float* a_im, const float* log_dt,
                                               const float* b_re, const float* b_im, const float* c_re, const float* c_im, const float* dskip, bf16_t* gb, float* out) {
    const int g = blockIdx.x % NG, sq = blockIdx.x / NG, n = threadIdx.x;
    const bool prompt = sq < NBATCH; const int b = prompt ? sq : sq - NBATCH, T = prompt ? SEQ : DECS, row0 = prompt ? b * SEQ : MP + b * DECS;
    const float dt = expf(log_dt[g]), lr = a_re[g * NST + n], li = a_im[g * NST + n];
    const float mag = expf(lr * dt), abr = mag * cosf(li * dt), abi = mag * sinf(li * dt);
    const float den = lr * lr + li * li, nr = abr - 1.f, ni = abi, cr = (nr * lr + ni * li) / den, ci = (ni * lr - nr * li) / den;
    float Br[16], Bi[16], Cr[16], Ci[16];
    for (int c = 0; c < 16; ++c) { const float br = b_re[((size_t)g * NST + n) * 16 + c], bi = b_im[((size_t)g * NST + n) * 16 + c];
        Br[c] = cr * br - ci * bi; Bi[c] = cr * bi + ci * br; Cr[c] = c_re[((size_t)g * 16 + c) * NST + n]; Ci[c] = c_im[((size_t)g * 16 + c) * NST + n]; }
    float hr = 0.f, hi = 0.f;
    if (!prompt) { hr = h0re[((size_t)b * NG + g) * NST + n]; hi = h0im[((size_t)b * NG + g) * NST + n]; }
    const float dsk = dskip[g * 16 + (n & 15)];
    for (int t = 0; t < T; ++t) {
        const bf16_t* up = ug + ((size_t)g * M + row0 + t) * 16;
        float u[16], xr = 0.f, xi = 0.f;
#pragma unroll
        for (int c = 0; c < 16; ++c) { u[c] = bf2f(up[c]); xr += Br[c] * u[c]; xi += Bi[c] * u[c]; }
        const float nhr = abr * hr - abi * hi + xr, nhi = abr * hi + abi * hr + xi; hr = nhr; hi = nhi;
        float ymine = 0.f;
#pragma unroll
        for (int c = 0; c < 16; ++c) { const float y = wave_sum(Cr[c] * hr - Ci[c] * hi); if ((n & 15) == c) ymine = y + dsk * u[c]; }
        if (n < 16) gb[(size_t)(row0 + t) * SSM + g * 16 + n] = (bf16_t)f2bf(gelu_tanh(ymine));
    }
    if (prompt) { out[O_SRP + ((size_t)b * NG + g) * NST + n] = hr; out[O_SIP + ((size_t)b * NG + g) * NST + n] = hi; }
    else { out[O_SRS + ((size_t)b * NG + g) * NST + n] = hr; out[O_SIS + ((size_t)b * NG + g) * NST + n] = hi; }
}

__global__ void __launch_bounds__(512) k_ref_conv(const bf16_t* vb, const float* cache, const float* w, const float* bias, const float* lg, const float* lb, bf16_t* mixb, float* out) {
    __shared__ float red[2][8];
    const int row = blockIdx.x, c = threadIdx.x;
    float y = bias[c];
    if (row < MP) { const int t = row % SEQ;
        for (int k = 0; k < CWID; ++k) { const int tt = t - 30 + k; if (tt >= 0) y += w[k * CONVD + c] * bf2f(vb[(size_t)(row - 30 + k) * CONVD + c]); }
    } else { const int rs = row - MP, b = rs / DECS, t = rs % DECS;
        for (int k = 0; k < CWID; ++k) { const int idx = t + k; const float xv = idx < 30 ? cache[((size_t)b * 30 + idx) * CONVD + c] : bf2f(vb[(size_t)(MP + b * DECS + idx - 30) * CONVD + c]); y += w[k * CONVD + c] * xv; }
        if (t == 0) for (int j = 0; j < 22; ++j) out[O_CVS + ((size_t)b * 30 + j) * CONVD + c] = cache[((size_t)b * 30 + j + 8) * CONVD + c];
    }
    float s = wave_sum(y); if ((c & 63) == 0) red[0][c >> 6] = s; __syncthreads();
    float mu = 0.f; for (int i = 0; i < 8; ++i) mu += red[0][i]; mu *= (1.f / CONVD);
    const float d = y - mu; float q = wave_sum(d * d); if ((c & 63) == 0) red[1][c >> 6] = q; __syncthreads();
    float var = 0.f; for (int i = 0; i < 8; ++i) var += red[1][i]; var *= (1.f / CONVD);
    const float z = d * rsqrtf(var + EPS) * lg[c] + lb[c];
    mixb[(size_t)row * D + SSM + c] = (bf16_t)f2bf(siluf_(z));
}

__global__ void __launch_bounds__(256) k_ref_attn(const bf16_t* qb, const bf16_t* kb, const bf16_t* vb2, const float* ck, const float* cv, bf16_t* ob) {
    __shared__ float q[256], p[256], red[4];
    const int row = blockIdx.x >> 2, h = blockIdx.x & 3, tid = threadIdx.x;
    q[tid] = bf2f(qb[(size_t)row * D + h * HD + tid]);
    __syncthreads();
    float s = 0.f;
    if (row < MP) { const int b = row / SEQ; const bf16_t* kr = kb + ((size_t)b * NMEM + tid) * D + h * HD; for (int d = 0; d < HD; ++d) s += q[d] * bf2f(kr[d]); }
    else { const int b = (row - MP) / DECS; const float* kr = ck + ((size_t)b * NMEM + tid) * D + h * HD; for (int d = 0; d < HD; ++d) s += q[d] * kr[d]; }
    float mx = s; for (int o = 1; o < 64; o <<= 1) mx = fmaxf(mx, __shfl_xor(mx, o));
    if ((tid & 63) == 0) red[tid >> 6] = mx; __syncthreads();
    mx = fmaxf(fmaxf(red[0], red[1]), fmaxf(red[2], red[3])); __syncthreads();
    const float e = exp2f(s - mx); float sm = wave_sum(e);
    if ((tid & 63) == 0) red[tid >> 6] = sm; __syncthreads();
    sm = red[0] + red[1] + red[2] + red[3];
    p[tid] = e / sm; __syncthreads();
    float o = 0.f;
    if (row < MP) { const int b = row / SEQ; const bf16_t* vr = vb2 + (size_t)b * NMEM * D + h * HD + tid; for (int m = 0; m < NMEM; ++m) o += p[m] * bf2f(vr[(size_t)m * D]); }
    else { const int b = (row - MP) / DECS; const float* vr = cv + (size_t)b * NMEM * D + h * HD + tid; for (int m = 0; m < NMEM; ++m) o += p[m] * vr[(size_t)m * D]; }
    ob[(size_t)row * D + h * HD + tid] = (bf16_t)f2bf(o);
}

__global__ void k_final(float* y, const float* ss, const float* g) {
    const int row = blockIdx.x * 4 + (threadIdx.x >> 6), lane = threadIdx.x & 63;
    const float r = rstd_from_ss(ss, row);
    for (int j = 0; j < 4; ++j) { f32x4* p = (f32x4*)(y + (size_t)row * D + j * 256 + lane * 4); const f32x4 gg = *(const f32x4*)(g + j * 256 + lane * 4); f32x4 v = *p; v = v * r * gg; *p = v; }
}


namespace pg8 {
#define PG8_LAS __attribute__((address_space(3)))
typedef unsigned short bf16_t;
typedef short bf16x8 __attribute__((ext_vector_type(8)));
typedef float f32x4 __attribute__((ext_vector_type(4)));
typedef unsigned u32x4 __attribute__((ext_vector_type(4)));
constexpr int BM = 256, BK = 64, HALF = 128, HTB = HALF * BK * 2  , STAGE_BYTES = 8 * HTB, NXCD = 8, WGM = 8;

__host__ __device__ __forceinline__ int lds_byte(int r, int c) { const int st = (r >> 4) * 2 + (c >> 5), rr = r & 15, cc = c & 31, ob = rr * 64 + cc * 2; return st * 1024 + (ob ^ (((ob >> 9) & 1) << 5)); }
__host__ __device__ __forceinline__ void stage_rc(int b, int& R, int& C) { const int st = b / 1024, sb = b % 1024, swz = sb ^ (((sb >> 9) & 1) << 5); R = (st >> 1) * 16 + swz / 64; C = (st & 1) * 32 + (swz % 64) / 2; }
__host__ __device__ __forceinline__ int perm32(int rho) { const int n = rho >> 4, i = rho & 15; return 8 * (i >> 2) + 4 * n + (i & 3); }

struct Unit { int pm, pn; };
struct Gemm { const bf16_t* A; const bf16_t* Bt; int M, N, K; };

struct StaticOrder {
    int nM, nN, nwg, G, c;
    __host__ __device__ void init(int M, int N, int G_, int c_) { nM = M / BM; nN = N / BM; nwg = nM * nN; G = G_; c = c_; }
    __host__ __device__ bool next(int i, Unit& u) const {
        const long L = (long)i * G + c; if (L >= nwg) return false;
        int wgid = (int)L; { const int q = nwg / NXCD, r = nwg % NXCD, xcd = wgid % NXCD, off = wgid / NXCD; wgid = (xcd < r ? xcd * (q + 1) : r * (q + 1) + (xcd - r) * q) + off; }
        const int nig = WGM * nN, gid = wgid / nig, fm = gid * WGM, gsz = (nM - fm) < WGM ? (nM - fm) : WGM;
        u.pm = fm + ((wgid % nig) % gsz); u.pn = (wgid % nig) / gsz; return true;
    }
    __device__ __forceinline__ void a_ready(const Unit&) const {}
    __device__ __forceinline__ void done(const Unit&) const {}
};
__device__ __forceinline__ unsigned cvt_pk_bf16(float lo, float hi) { unsigned r; asm volatile("v_cvt_pk_bf16_f32 %0, %1, %2" : "=v"(r) : "v"(lo), "v"(hi)); return r; }
typedef float f32x2 __attribute__((ext_vector_type(2)));
template <class Epi, class Sched, bool ALIGN_EPI = false, bool SP2 = false>
__device__ __forceinline__ void gemm_phase(PG8_LAS unsigned char* lds, const Gemm g, const Sched& S, const Epi& E) {
    const int tid = threadIdx.x, wid = __builtin_amdgcn_readfirstlane(tid >> 6), lane = tid & 63, wr = wid >> 2, wc = wid & 3, fr = lane & 15, fq = lane >> 4;
    const int K = g.K, nt = K / BK;
    unsigned voffA[2], voffB[2];
#pragma unroll
    for (int i = 0; i < 2; ++i) { int R, C; stage_rc(tid * 16 + i * 8192, R, C); const int Rb = Epi::PERM ? ((R & ~31) + perm32(R & 31)) : R;
        voffA[i] = (unsigned)(R * K + C) * 2u; voffB[i] = (unsigned)(Rb * K + C) * 2u; }
    const size_t kstep = (size_t)(BK * 2);
    const size_t hstep = (size_t)HALF * K * 2;
    const size_t tstep = 2 * hstep;
    const unsigned ldsw = (unsigned)wid * 1024u;
    const int aoff = lds_byte(wr * 64 + fr, fq * 8), boff = lds_byte(wc * 32 + fr, fq * 8);
#define PG8_SA(b, h) (((b) * 2 + (h)) * HTB)
#define PG8_SB(b, h) ((4 + (b) * 2 + (h)) * HTB)
#define PG8_STAGE(bufoff, gbase, voff) do { _Pragma("unroll") for (int _i = 0; _i < 2; ++_i) \
        __builtin_amdgcn_global_load_lds((const unsigned*)((const char*)(gbase) + (voff)[_i]), (PG8_LAS unsigned*)(lds + (bufoff) + ldsw + _i * 8192), 16, 0, 0); } while (0)
#define PG8_LDA(dst, b, h) do { _Pragma("unroll") for (int m = 0; m < 4; ++m) _Pragma("unroll") for (int k = 0; k < 2; ++k) dst[m][k] = *(const PG8_LAS bf16x8*)(lds + PG8_SA(b, h) + aoff + m * 2048 + k * 1024); } while (0)
#define PG8_LDB(dst, b, h) do { _Pragma("unroll") for (int n = 0; n < 2; ++n) _Pragma("unroll") for (int k = 0; k < 2; ++k) dst[n][k] = *(const PG8_LAS bf16x8*)(lds + PG8_SB(b, h) + boff + n * 2048 + k * 1024); } while (0)
#define PG8_MMA(ai, bj, At, Bt) do { __builtin_amdgcn_s_setprio(1); _Pragma("unroll") for (int m = 0; m < 4; ++m) _Pragma("unroll") for (int n = 0; n < 2; ++n) _Pragma("unroll") for (int k = 0; k < 2; ++k) \
        acc[ai][bj][m][n] = __builtin_amdgcn_mfma_f32_16x16x32_bf16(Bt[n][k], At[m][k], acc[ai][bj][m][n], 0, 0, 0); __builtin_amdgcn_s_setprio(0); } while (0)
#define PG8_WAIT_V(n) asm volatile("s_waitcnt vmcnt(" #n ")" ::: "memory")
#define PG8_WAIT_L(n) asm volatile("s_waitcnt lgkmcnt(" #n ")" ::: "memory")
#define PG8_BAR __builtin_amdgcn_s_barrier()
#define PG8_SCHED __builtin_amdgcn_sched_barrier(0)
    Unit cur, nxt; int ui = 0;
    if (!S.next(0, cur)) return;
    f32x4 acc[2][2][4][2];
#pragma unroll
    for (int a = 0; a < 2; ++a)
#pragma unroll
        for (int b = 0; b < 2; ++b)
#pragma unroll
            for (int m = 0; m < 4; ++m)
#pragma unroll
                for (int n = 0; n < 2; ++n) acc[a][b][m][n] = (f32x4){0.f, 0.f, 0.f, 0.f};
    bf16x8 At[4][2], B0[2][2], B1[2][2];
    const char* cA = (const char*)g.A + (size_t)cur.pm * tstep; const char* cB = (const char*)g.Bt + (size_t)cur.pn * tstep;
    S.a_ready(cur);
    if constexpr (SP2) {
        PG8_STAGE(PG8_SB(0, 0), cB, voffB); PG8_STAGE(PG8_SB(0, 1), cB + hstep, voffB); PG8_STAGE(PG8_SA(0, 0), cA, voffA); PG8_STAGE(PG8_SA(0, 1), cA + hstep, voffA);
        if (wr == 1) PG8_BAR;
        PG8_WAIT_V(2); PG8_BAR;
        PG8_STAGE(PG8_SB(1, 0), cB + kstep, voffB); PG8_STAGE(PG8_SA(1, 0), cA + kstep, voffA); PG8_STAGE(PG8_SB(1, 1), cB + hstep + kstep, voffB);
        PG8_WAIT_V(6); PG8_BAR;
    } else {
        PG8_STAGE(PG8_SB(0, 0), cB, voffB); PG8_STAGE(PG8_SA(0, 0), cA, voffA); PG8_STAGE(PG8_SB(0, 1), cB + hstep, voffB); PG8_STAGE(PG8_SA(0, 1), cA + hstep, voffA);
        if (wr == 1) PG8_BAR;
        PG8_WAIT_V(4); PG8_BAR;
        PG8_STAGE(PG8_SB(1, 0), cB + kstep, voffB); PG8_STAGE(PG8_SA(1, 0), cA + kstep, voffA); PG8_STAGE(PG8_SB(1, 1), cB + hstep + kstep, voffB);
        PG8_WAIT_V(6); PG8_BAR;
    }
    for (;;) {
        const bool has_next = S.next(ui + 1, nxt);
        const char* nA = has_next ? (const char*)g.A + (size_t)nxt.pm * tstep : cA; const char* nB = has_next ? (const char*)g.Bt + (size_t)nxt.pn * tstep : cB;
        for (int t = 0; t < nt; t += 2) {
            const bool last = (t == nt - 2);
            const char* a1 = cA + (size_t)(t + 1) * kstep;
            const char* a2 = last ? nA : cA + (size_t)(t + 2) * kstep; const char* b2 = last ? nB : cB + (size_t)(t + 2) * kstep;
            const char* a3 = a2 + kstep; const char* b3 = b2 + kstep;
            if (last && has_next) S.a_ready(nxt);
            if constexpr (SP2) {
            PG8_LDB(B0, 0, 0); PG8_LDB(B1, 0, 1); PG8_SCHED; PG8_LDA(At, 0, 0); PG8_STAGE(PG8_SA(1, 1), a1 + hstep, voffA);
            PG8_WAIT_V(8); PG8_WAIT_L(0); PG8_BAR; PG8_MMA(0, 0, At, B0); PG8_MMA(0, 1, At, B1); PG8_BAR; PG8_SCHED;
            PG8_LDA(At, 0, 1); PG8_STAGE(PG8_SB(0, 0), b2, voffB); PG8_STAGE(PG8_SB(0, 1), b2 + hstep, voffB); PG8_STAGE(PG8_SA(0, 0), a2, voffA);
            PG8_WAIT_V(8); PG8_WAIT_L(0); PG8_BAR; PG8_MMA(1, 0, At, B0); PG8_MMA(1, 1, At, B1); PG8_BAR; PG8_SCHED;
            PG8_LDB(B0, 1, 0); PG8_LDB(B1, 1, 1); PG8_SCHED; PG8_LDA(At, 1, 0); PG8_STAGE(PG8_SA(0, 1), a2 + hstep, voffA);
            PG8_WAIT_V(8); PG8_WAIT_L(0); PG8_BAR; PG8_MMA(0, 0, At, B0); PG8_MMA(0, 1, At, B1); PG8_BAR; PG8_SCHED;
            PG8_LDA(At, 1, 1); PG8_STAGE(PG8_SB(1, 0), b3, voffB); PG8_STAGE(PG8_SB(1, 1), b3 + hstep, voffB); PG8_STAGE(PG8_SA(1, 0), a3, voffA);
            PG8_WAIT_V(8); PG8_WAIT_L(0); PG8_BAR; PG8_MMA(1, 0, At, B0); PG8_MMA(1, 1, At, B1); PG8_BAR; PG8_SCHED;
            } else {
            PG8_LDB(B0, 0, 0); PG8_SCHED; PG8_LDA(At, 0, 0); PG8_STAGE(PG8_SA(1, 1), a1 + hstep, voffA);
            PG8_WAIT_L(8); PG8_BAR; PG8_WAIT_L(0); PG8_MMA(0, 0, At, B0); PG8_BAR; PG8_SCHED;
            PG8_LDB(B1, 0, 1); PG8_STAGE(PG8_SB(0, 0), b2, voffB);
            PG8_BAR; PG8_WAIT_L(0); PG8_MMA(0, 1, At, B1); PG8_BAR;
            PG8_LDA(At, 0, 1); PG8_STAGE(PG8_SA(0, 0), a2, voffA);
            PG8_BAR; PG8_WAIT_L(0); PG8_MMA(1, 0, At, B0); PG8_BAR; PG8_SCHED;
            PG8_STAGE(PG8_SB(0, 1), b2 + hstep, voffB);
            PG8_WAIT_V(6); PG8_BAR; PG8_MMA(1, 1, At, B1); PG8_BAR;
            PG8_LDB(B0, 1, 0); PG8_SCHED; PG8_LDA(At, 1, 0); PG8_STAGE(PG8_SA(0, 1), a2 + hstep, voffA);
            PG8_WAIT_L(8); PG8_BAR; PG8_WAIT_L(0); PG8_MMA(0, 0, At, B0); PG8_BAR; PG8_SCHED;
            PG8_LDB(B1, 1, 1); PG8_STAGE(PG8_SB(1, 0), b3, voffB);
            PG8_BAR; PG8_WAIT_L(0); PG8_MMA(0, 1, At, B1); PG8_BAR;
            PG8_LDA(At, 1, 1); PG8_STAGE(PG8_SA(1, 0), a3, voffA);
            PG8_BAR; PG8_WAIT_L(0); PG8_MMA(1, 0, At, B0); PG8_BAR; PG8_SCHED;
            PG8_STAGE(PG8_SB(1, 1), b3 + hstep, voffB);
            PG8_WAIT_V(6); PG8_BAR; PG8_MMA(1, 1, At, B1); PG8_BAR;
            }
        }
        if constexpr (ALIGN_EPI) { if (wr == 0) PG8_BAR; }
        if constexpr (!Epi::AFTER_DRAIN) { E(acc, cur, wr, wc, fr, fq); S.done(cur); }
        if (!has_next) break;
#pragma unroll
        for (int a = 0; a < 2; ++a)
#pragma unroll
            for (int b = 0; b < 2; ++b)
#pragma unroll
                for (int m = 0; m < 4; ++m)
#pragma unroll
                    for (int n = 0; n < 2; ++n) acc[a][b][m][n] = (f32x4){0.f, 0.f, 0.f, 0.f};
        cur = nxt; cA = nA; cB = nB; ++ui;
        if constexpr (ALIGN_EPI) { if (wr == 1) PG8_BAR; }
    }
    PG8_WAIT_V(0);
    if constexpr (!ALIGN_EPI) { if (wr == 0) PG8_BAR; }
    PG8_BAR;
    if constexpr (Epi::AFTER_DRAIN) { E.fused(acc, cur, wr, wc, fr, fq, lds, wid, lane); S.done(cur); }
#undef PG8_SA
#undef PG8_SB
#undef PG8_STAGE
#undef PG8_LDA
#undef PG8_LDB
#undef PG8_MMA
#undef PG8_WAIT_V
#undef PG8_WAIT_L
#undef PG8_BAR
#undef PG8_SCHED
}
}

namespace fx {
using pg8::f32x4; using pg8::u32x4; using pg8::Unit; using pg8::HALF; using pg8::BM; using pg8::cvt_pk_bf16;
__device__ __forceinline__ float rstd_row(const float* ss, int row) {
    const f32x4* p = (const f32x4*)(ss + (size_t)row * 16); const f32x4 a = p[0], b = p[1], c = p[2], d = p[3];
    const float s = ((a.x + a.y) + (a.z + a.w)) + ((b.x + b.y) + (b.z + b.w)) + ((c.x + c.y) + (c.z + c.w)) + ((d.x + d.y) + (d.z + d.w));
    return rsqrtf(s * (1.f / D) + EPS);
}
__device__ __forceinline__ float fsig(float x) { return __builtin_amdgcn_rcpf(1.f + __builtin_amdgcn_exp2f(-1.4426950408889634f * x)); }
__device__ __forceinline__ u32x4 pack8(const f32x4 a, const f32x4 b) { u32x4 w; w.x = cvt_pk_bf16(a[0], a[1]); w.y = cvt_pk_bf16(a[2], a[3]); w.z = cvt_pk_bf16(b[0], b[1]); w.w = cvt_pk_bf16(b[2], b[3]); return w; }
__device__ __forceinline__ f32x4 sig4(const f32x4 x) { return (f32x4){fsig(x[0]), fsig(x[1]), fsig(x[2]), fsig(x[3])}; }

struct EpiKV { static constexpr bool PERM = true, AFTER_DRAIN = false; const float* ss; bf16_t* kb; bf16_t* vb2; float* out;
    __device__ __forceinline__ void operator()(const f32x4 (&acc)[2][2][4][2], const Unit& u, int wr, int wc, int fr, int fq) const {
        const int row0 = u.pm * BM + wr * 64 + fr; const bool isv = u.pn >= 4; const int colt = (isv ? u.pn - 4 : u.pn) * BM + wc * 32 + 8 * fq;
        float* of = out + (isv ? O_MVP : O_MKP); bf16_t* ob = isv ? vb2 : kb;
#pragma unroll
        for (int ai = 0; ai < 2; ++ai)
#pragma unroll
            for (int m = 0; m < 4; ++m) { const int row = row0 + ai * HALF + m * 16; const float r = rstd_row(ss, row);
#pragma unroll
                for (int bj = 0; bj < 2; ++bj) { const f32x4 v0 = acc[ai][bj][m][0] * r, v1 = acc[ai][bj][m][1] * r; const size_t o = (size_t)row * D + colt + bj * HALF;
                    *(f32x4*)(of + o) = v0; *(f32x4*)(of + o + 4) = v1; *(u32x4*)(ob + o) = pack8(v0, v1); } }
    }
};
struct EpiSwiglu { static constexpr bool PERM = true, AFTER_DRAIN = false; const float* ss; bf16_t* H;
    __device__ __forceinline__ void operator()(const f32x4 (&acc)[2][2][4][2], const Unit& u, int wr, int wc, int fr, int fq) const {
        const int row0 = u.pm * BM + wr * 64 + fr, col0 = u.pn * HALF + wc * 32 + 8 * fq;
#pragma unroll
        for (int ai = 0; ai < 2; ++ai)
#pragma unroll
            for (int m = 0; m < 4; ++m) { const int row = row0 + ai * HALF + m * 16; const float r = rstd_row(ss, row);
                const f32x4 g0 = acc[ai][0][m][0] * r, g1 = acc[ai][0][m][1] * r, u0 = acc[ai][1][m][0] * r, u1 = acc[ai][1][m][1] * r;
                *(u32x4*)(H + (size_t)row * FF + col0) = pack8(g0 * sig4(g0) * u0, g1 * sig4(g1) * u1); }
    }
};
struct EpiRes { static constexpr bool PERM = true, AFTER_DRAIN = false; const float* rin0; const float* rin1; float* rout; bf16_t* xb; float* ss; float alpha;
    __device__ __forceinline__ void operator()(const f32x4 (&acc)[2][2][4][2], const Unit& u, int wr, int wc, int fr, int fq) const {
        const int row0 = u.pm * BM + wr * 64 + fr, col0 = u.pn * BM + wc * 32 + 8 * fq; const float* rin = u.pm >= MP / BM ? rin1 : rin0;
#pragma unroll
        for (int ai = 0; ai < 2; ++ai)
#pragma unroll
            for (int m = 0; m < 4; ++m) { const int row = row0 + ai * HALF + m * 16; float sq = 0.f;
#pragma unroll
                for (int bj = 0; bj < 2; ++bj) { const size_t o = (size_t)row * D + col0 + bj * HALF;
                    const f32x4 v0 = *(const f32x4*)(rin + o) + acc[ai][bj][m][0] * alpha, v1 = *(const f32x4*)(rin + o + 4) + acc[ai][bj][m][1] * alpha;
                    *(f32x4*)(rout + o) = v0; *(f32x4*)(rout + o + 4) = v1; if (xb) *(u32x4*)(xb + o) = pack8(v0, v1);
                    sq += (v0[0] * v0[0] + v0[1] * v0[1]) + (v0[2] * v0[2] + v0[3] * v0[3]) + (v1[0] * v1[0] + v1[1] * v1[1]) + (v1[2] * v1[2] + v1[3] * v1[3]); }
                sq += __shfl_xor(sq, 16); sq += __shfl_xor(sq, 32);
                if (fq == 0) ss[(size_t)row * 16 + u.pn * 4 + wc] = sq;
                if (m & 1) asm volatile("" ::: "memory"); }
    }
};
struct EpiIn { static constexpr bool PERM = true, AFTER_DRAIN = false; const float* ss; bf16_t* ug; bf16_t* vb; float* out;
    __device__ __forceinline__ void operator()(const f32x4 (&acc)[2][2][4][2], const Unit& u, int wr, int wc, int fr, int fq) const {
        const int row0 = u.pm * BM + wr * 64 + fr;
        if (u.pn < 2) {
#pragma unroll
            for (int ai = 0; ai < 2; ++ai)
#pragma unroll
                for (int m = 0; m < 4; ++m) { const int row = row0 + ai * HALF + m * 16; const float r = rstd_row(ss, row);
#pragma unroll
                    for (int bj = 0; bj < 2; ++bj) { const int c0 = u.pn * BM + bj * HALF + wc * 32 + 8 * fq;
                        *(u32x4*)(ug + ((size_t)(c0 >> 4) * M + row) * 16 + (c0 & 15)) = pack8(acc[ai][bj][m][0] * r, acc[ai][bj][m][1] * r); } }
        } else {
            const int p0 = (u.pn - 2) * HALF + wc * 32 + 8 * fq;
#pragma unroll
            for (int ai = 0; ai < 2; ++ai)
#pragma unroll
                for (int m = 0; m < 4; ++m) { const int row = row0 + ai * HALF + m * 16; const float r = rstd_row(ss, row);
                    const f32x4 a0 = acc[ai][0][m][0] * r, a1 = acc[ai][0][m][1] * r, g0 = acc[ai][1][m][0] * r, g1 = acc[ai][1][m][1] * r;
                    const f32x4 v0 = a0 * sig4(g0), v1 = a1 * sig4(g1);
                    *(u32x4*)(vb + (size_t)row * CONVD + p0) = pack8(v0, v1);
                    float* o = nullptr;
                    if (row >= MP) { const int rs = row - MP; o = out + O_CVS + ((size_t)(rs >> 3) * 30 + 22 + (rs & 7)) * CONVD + p0; }
                    else { const int t = row & (SEQ - 1); if (t >= SEQ - 30) o = out + O_CVP + ((size_t)(row >> 11) * 30 + (t - (SEQ - 30))) * CONVD + p0; }
                    if (o) { *(f32x4*)o = v0; *(f32x4*)(o + 4) = v1; } }
        }
    }
};
struct EpiGlu { static constexpr bool PERM = true, AFTER_DRAIN = false; const bf16_t* gb; bf16_t* mixb;
    __device__ __forceinline__ void operator()(const f32x4 (&acc)[2][2][4][2], const Unit& u, int wr, int wc, int fr, int fq) const {
        const int row0 = u.pm * BM + wr * 64 + fr, col0 = u.pn * BM + wc * 32 + 8 * fq;
#pragma unroll
        for (int ai = 0; ai < 2; ++ai)
#pragma unroll
            for (int m = 0; m < 4; ++m) { const int row = row0 + ai * HALF + m * 16;
#pragma unroll
                for (int bj = 0; bj < 2; ++bj) { const int c0 = col0 + bj * HALF; const u32x4 gw = *(const u32x4*)(gb + (size_t)row * SSM + c0);
                    const f32x4 ga = {__builtin_bit_cast(float, gw.x << 16), __builtin_bit_cast(float, gw.x & 0xffff0000u), __builtin_bit_cast(float, gw.y << 16), __builtin_bit_cast(float, gw.y & 0xffff0000u)};
                    const f32x4 gc = {__builtin_bit_cast(float, gw.z << 16), __builtin_bit_cast(float, gw.z & 0xffff0000u), __builtin_bit_cast(float, gw.w << 16), __builtin_bit_cast(float, gw.w & 0xffff0000u)};
                    *(u32x4*)(mixb + (size_t)row * D + c0) = pack8(ga * sig4(acc[ai][bj][m][0]), gc * sig4(acc[ai][bj][m][1])); } }
    }
};
struct EpiQ { static constexpr bool PERM = true, AFTER_DRAIN = false; const float* ss; bf16_t* qb;
    __device__ __forceinline__ void operator()(const f32x4 (&acc)[2][2][4][2], const Unit& u, int wr, int wc, int fr, int fq) const {
        const int row0 = u.pm * BM + wr * 64 + fr, col0 = u.pn * BM + wc * 32 + 8 * fq;
#pragma unroll
        for (int ai = 0; ai < 2; ++ai)
#pragma unroll
            for (int m = 0; m < 4; ++m) { const int row = row0 + ai * HALF + m * 16; const float r = rstd_row(ss, row) * QSCALE;
#pragma unroll
                for (int bj = 0; bj < 2; ++bj) *(u32x4*)(qb + (size_t)row * D + col0 + bj * HALF) = pack8(acc[ai][bj][m][0] * r, acc[ai][bj][m][1] * r); }
    }
};
}

#define GAS __attribute__((address_space(1)))
#define LAS __attribute__((address_space(3)))
typedef unsigned v4u __attribute__((ext_vector_type(4)));
typedef float f32x4 __attribute__((ext_vector_type(4)));
typedef short bf16x8 __attribute__((ext_vector_type(8)));
typedef GAS unsigned gu32;
typedef GAS unsigned long long gu64;
#define RLX_AGENT __ATOMIC_RELAXED, __HIP_MEMORY_SCOPE_AGENT
#define LDS_WAIT() asm volatile("s_waitcnt lgkmcnt(0)" ::: "memory")
#define VM_WAIT() asm volatile("s_waitcnt vmcnt(0)" ::: "memory")
__device__ __forceinline__ unsigned long long rt() { return __builtin_amdgcn_s_memrealtime(); }
__device__ __forceinline__ unsigned pk2(float lo, float hi) { return f2bf(lo) | (f2bf(hi) << 16); }

#define XB_TMO      128
#define XB_XCNT(j)  (256  + 64 * (j))
#define XB_XSUB(j)  (1280 + 64 * (j))
#define XB_XGEN(j)  (2304 + 64 * (j))
#define XB_TOP      3328
#define XB_TOPGEN   3392
#define XCD_BAR_WORDS 3456
#define XB_SPIN_CAP (1u << 18)

__device__ __forceinline__ unsigned xb_ld(unsigned* p)              { return __hip_atomic_load(p, __ATOMIC_RELAXED, __HIP_MEMORY_SCOPE_AGENT); }
__device__ __forceinline__ unsigned xb_add(unsigned* p, unsigned v) { return __hip_atomic_fetch_add(p, v, __ATOMIC_RELAXED, __HIP_MEMORY_SCOPE_AGENT); }
__device__ __forceinline__ unsigned xb_xcc_id() { return (unsigned)__builtin_amdgcn_s_getreg((3 << 11) | 20) & 0xFu; }
#define XB_SPIN(cond, bar) do { unsigned _sp = 0; while (cond) { __builtin_amdgcn_s_sleep(1); \
    if ((++_sp & 255u) == 0u) { if (xb_ld(&(bar)[XB_TMO])) break; if (_sp > XB_SPIN_CAP) { atomicAdd(&(bar)[XB_TMO], 1u); break; } } } } while (0)

struct XcdBarrier {
    unsigned* bar; unsigned x;
    volatile LAS unsigned* st;
};

__device__ __forceinline__ XcdBarrier xcd_barrier_post(unsigned* bar, volatile LAS unsigned* st) {
    XcdBarrier b; b.bar = bar; b.x = xb_xcc_id(); b.st = st;
    if (threadIdx.x == 0) (void)xb_add(&bar[XB_XCNT(b.x)], 1u);
    return b;
}
__device__ __forceinline__ void xcd_barrier_complete(unsigned* bar, unsigned x, unsigned& nloc, unsigned& nx) {
    const unsigned G = gridDim.x * gridDim.y * gridDim.z;
    unsigned sum, cnt, mine, sp = 0u;
    for (;;) {
        sum = 0u; cnt = 0u; mine = 0u;
#pragma unroll
        for (unsigned j = 0; j < 16; ++j) { const unsigned c = xb_ld(&bar[XB_XCNT(j)]); sum += c; cnt += (c > 0u) ? 1u : 0u; mine = (j == x) ? c : mine; }
        if (sum == G) break;
        __builtin_amdgcn_s_sleep(1);
        if ((++sp & 255u) == 0u) { if (xb_ld(&bar[XB_TMO])) break; if (sp > XB_SPIN_CAP) { atomicAdd(&bar[XB_TMO], 1u); break; } }
    }
    nloc = mine > 0u ? mine : 1u; nx = cnt > 0u ? cnt : 1u;
}

__device__ __forceinline__ void xcd_barrier(const XcdBarrier& b) {
    asm volatile("s_waitcnt vmcnt(0)" ::: "memory");
    __syncthreads();
    if (threadIdx.x == 0) {
        unsigned* bar = b.bar;
        __builtin_amdgcn_s_waitcnt(0);
        unsigned nloc = b.st[0], nx = b.st[1];
        if (nloc == 0u) { xcd_barrier_complete(bar, b.x, nloc, nx); b.st[0] = nloc; b.st[1] = nx; }
        const unsigned old = xb_add(&bar[XB_XSUB(b.x)], 1u);
        const unsigned gen = old / nloc;
        if (old + 1u == (gen + 1u) * nloc) {
            __builtin_amdgcn_fence(__ATOMIC_RELEASE, "agent");
            asm volatile("s_waitcnt vmcnt(0)" ::: "memory");
            const unsigned og = xb_add(&bar[XB_TOP], 1u);
            const unsigned tg = og / nx;
            if (og + 1u == (tg + 1u) * nx) xb_add(&bar[XB_TOPGEN], 1u);
            else XB_SPIN(xb_ld(&bar[XB_TOPGEN]) == tg, bar);
            __builtin_amdgcn_fence(__ATOMIC_ACQUIRE, "agent");
            xb_add(&bar[XB_XGEN(b.x)], 1u);
            asm volatile("s_waitcnt vmcnt(0)" ::: "memory");
        } else {
            XB_SPIN(xb_ld(&bar[XB_XGEN(b.x)]) == gen, bar);
            __builtin_amdgcn_fence(__ATOMIC_ACQUIRE, "agent");
            asm volatile("s_waitcnt vmcnt(0)" ::: "memory");
        }
    }
    __syncthreads();
}

constexpr int NWAVES = 8;
constexpr int RING_OFF = 0, RING_BYTES = 131072;
constexpr int LDSCTL_OFF = RING_BYTES, MISC_OFF = LDSCTL_OFF + 320;
constexpr int LDS_BYTES = 147456;
constexpr size_t CTL_ZERO_BYTES = 1 * MiB;
constexpr int CW_TMO = 0, CW_CODE = 1, CW_BAR = 4096;
constexpr int MAX_LAUNCHES = 8;
static_assert((CW_BAR + MAX_LAUNCHES * XCD_BAR_WORDS) * 4 <= (int)CTL_ZERO_BYTES, "barrier words inside the memset region");

enum Phase { PH_PRO = 0, PH_GU1 = 1, PH_D1 = 2, PH_IN = 3, PH_MIX = 4, PH_GLU = 5, PH_OUT = 6, PH_Q = 7, PH_ATT = 8, PH_O = 9, PH_GU2 = 10, PH_D2 = 11, PH_FIN = 12, PH_N = 13 };

struct Args { const float* in[39]; float* out; unsigned char* ws; int ph_lo, ph_hi, li, pad; };

__global__ void __launch_bounds__(NWAVES * 64, 2) mk_fwd(Args args) {
    extern __shared__ __attribute__((aligned(16))) unsigned char lds[];
    LAS unsigned char* L = (LAS unsigned char*)lds;
    volatile LAS unsigned* MISC = (volatile LAS unsigned*)(L + MISC_OFF);
    const int tid = threadIdx.x;
    const int G = gridDim.x, bx = blockIdx.x;
    unsigned char* ws = args.ws; float* out = args.out;
    gu32* ctl = (gu32*)(ws + WS_CTL);
    for (int u = tid; u < (LDS_BYTES - LDSCTL_OFF) / 4; u += NWAVES * 64) ((LAS unsigned*)(L + LDSCTL_OFF))[u] = 0u;
    __syncthreads();
    XcdBarrier bar = xcd_barrier_post((unsigned*)(ctl + CW_BAR) + args.li * XCD_BAR_WORDS, MISC + 8);
    const int lo = args.ph_lo, hi = args.ph_hi;
#define IN(k) (lo <= (k) && (k) < hi)
#define BOTH(k) (IN(k) && IN((k) + 1))
#define GRID_BAR() xcd_barrier(bar)
    bf16_t *Wgu1 = (bf16_t*)(ws + WS_WGU1), *Wgu2 = (bf16_t*)(ws + WS_WGU2), *Wd1 = (bf16_t*)(ws + WS_WD1), *Wd2 = (bf16_t*)(ws + WS_WD2), *Win = (bf16_t*)(ws + WS_WIN), *Wglu = (bf16_t*)(ws + WS_WGLU),
           *Wout = (bf16_t*)(ws + WS_WOUT), *Wq = (bf16_t*)(ws + WS_WQ), *Wo = (bf16_t*)(ws + WS_WO), *Wkv = (bf16_t*)(ws + WS_WKV);
    bf16_t *xb = (bf16_t*)(ws + WS_XB), *memb = (bf16_t*)(ws + WS_MEMB), *kb = (bf16_t*)(ws + WS_KB), *vb2 = (bf16_t*)(ws + WS_VB2), *hb = (bf16_t*)(ws + WS_H), *ug = (bf16_t*)(ws + WS_UG),
           *vb = (bf16_t*)(ws + WS_VB), *gb = (bf16_t*)(ws + WS_GB), *mixb = (bf16_t*)(ws + WS_MIXB), *qb = (bf16_t*)(ws + WS_QB), *ob = (bf16_t*)(ws + WS_OB);
    float *ss0 = (float*)(ws + WS_SS0), *ss1 = (float*)(ws + WS_SS1), *ss2 = (float*)(ws + WS_SS2), *ss3 = (float*)(ws + WS_SS3), *ss4 = (float*)(ws + WS_SS4), *ssm = (float*)(ws + WS_SSM), *xres = (float*)(ws + WS_XRES);

    if (IN(PH_GU1)) {
        { pg8::Gemm g{memb, Wkv, MMEM, 2048, D}; pg8::StaticOrder S; S.init(MMEM, 2048, G, bx); fx::EpiKV E{ssm, kb, vb2, out};
          pg8::gemm_phase<fx::EpiKV, pg8::StaticOrder, true, true>(L + RING_OFF, g, S, E); }
        { pg8::Gemm g{xb, Wgu1, M, 2 * FF, D}; pg8::StaticOrder S; S.init(M, 2 * FF, G, bx); fx::EpiSwiglu E{ss0, hb};
          pg8::gemm_phase<fx::EpiSwiglu, pg8::StaticOrder, true, true>(L + RING_OFF, g, S, E); }
        if (BOTH(PH_GU1)) GRID_BAR();
    }
    if (IN(PH_D1)) {
        pg8::Gemm g{hb, Wd1, M, D, FF}; pg8::StaticOrder S; S.init(M, D, G, bx); fx::EpiRes E{args.in[0], args.in[1] - (size_t)MP * D, xres, xb, ss1, 0.5f};
        pg8::gemm_phase<fx::EpiRes, pg8::StaticOrder, true, true>(L + RING_OFF, g, S, E);
        if (BOTH(PH_D1)) GRID_BAR();
    }
    if (IN(PH_IN)) {
        pg8::Gemm g{xb, Win, M, 1536, D}; pg8::StaticOrder S; S.init(M, 1536, G, bx); fx::EpiIn E{ss1, ug, vb, out};
        pg8::gemm_phase<fx::EpiIn, pg8::StaticOrder, true, true>(L + RING_OFF, g, S, E);
        if (BOTH(PH_IN)) GRID_BAR();
    }
    if (IN(PH_GLU)) {
        pg8::Gemm g{gb, Wglu, M, SSM, SSM}; pg8::StaticOrder S; S.init(M, SSM, G, bx); fx::EpiGlu E{gb, mixb};
        pg8::gemm_phase<fx::EpiGlu, pg8::StaticOrder, true, true>(L + RING_OFF, g, S, E);
        if (BOTH(PH_GLU)) GRID_BAR();
    }
    if (IN(PH_OUT)) {
        pg8::Gemm g{mixb, Wout, M, D, D}; pg8::StaticOrder S; S.init(M, D, G, bx); fx::EpiRes E{xres, xres, xres, xb, ss2, 1.f};
        pg8::gemm_phase<fx::EpiRes, pg8::StaticOrder, true, true>(L + RING_OFF, g, S, E);
        if (BOTH(PH_OUT)) GRID_BAR();
    }
    if (IN(PH_Q)) {
        pg8::Gemm g{xb, Wq, M, D, D}; pg8::StaticOrder S; S.init(M, D, G, bx); fx::EpiQ E{ss2, qb};
        pg8::gemm_phase<fx::EpiQ, pg8::StaticOrder, true, true>(L + RING_OFF, g, S, E);
        if (BOTH(PH_Q)) GRID_BAR();
    }
    if (IN(PH_O)) {
        pg8::Gemm g{ob, Wo, M, D, D}; pg8::StaticOrder S; S.init(M, D, G, bx); fx::EpiRes E{xres, xres, xres, xb, ss3, 1.f};
        pg8::gemm_phase<fx::EpiRes, pg8::StaticOrder, true, true>(L + RING_OFF, g, S, E);
        if (BOTH(PH_O)) GRID_BAR();
    }
    if (IN(PH_GU2)) {
        pg8::Gemm g{xb, Wgu2, M, 2 * FF, D}; pg8::StaticOrder S; S.init(M, 2 * FF, G, bx); fx::EpiSwiglu E{ss3, hb};
        pg8::gemm_phase<fx::EpiSwiglu, pg8::StaticOrder, true, true>(L + RING_OFF, g, S, E);
        if (BOTH(PH_GU2)) GRID_BAR();
    }
    if (IN(PH_D2)) {
        pg8::Gemm g{hb, Wd2, M, D, FF}; pg8::StaticOrder S; S.init(M, D, G, bx); fx::EpiRes E{xres, xres, out + O_Y, nullptr, ss4, 0.5f};
        pg8::gemm_phase<fx::EpiRes, pg8::StaticOrder, true, true>(L + RING_OFF, g, S, E);
        if (BOTH(PH_D2)) GRID_BAR();
    }
#undef IN
#undef BOTH
#undef GRID_BAR
}

#ifndef FAST_MERGE
#define FAST_MERGE 1
#endif
extern "C" void kernel_launch(void* const* d_in, const int* in_sizes, int n_in, void* d_out, int out_size, void* d_ws, size_t ws_size, hipStream_t stream) {
    if (n_in != 39 || out_size != (int)O_END || ws_size < WS_END) { fprintf(stderr, "kernel_launch: unexpected shapes n_in %d out %d ws %zu\n", n_in, out_size, ws_size); return; }
    static int grid = 0;
    if (grid == 0) {
        int dev = 0, cus = 0;
        if (hipGetDevice(&dev) != hipSuccess || hipDeviceGetAttribute(&cus, hipDeviceAttributeMultiprocessorCount, dev) != hipSuccess) { grid = -1; return; }
        if (hipFuncSetAttribute((const void*)mk_fwd, hipFuncAttributeMaxDynamicSharedMemorySize, LDS_BYTES) != hipSuccess) { fprintf(stderr, "kernel_launch: hipFuncSetAttribute failed\n"); grid = -1; return; }
        int per_cu = 0;
        if (hipOccupancyMaxActiveBlocksPerMultiprocessor(&per_cu, (const void*)mk_fwd, NWAVES * 64, LDS_BYTES) != hipSuccess || per_cu < 1) { fprintf(stderr, "kernel_launch: occupancy query says %d\n", per_cu); }
        (void)hipGetLastError();
        grid = cus;
    }
    if (grid < 0) return;
    const float* const* in = (const float* const*)d_in;
    const float *x_p = in[0], *x_s = in[1], *st_re = in[2], *st_im = in[3], *cconv = in[4], *cmk = in[5], *cmv = in[6], *memp = in[7], *g_mem = in[8], *w_k = in[9], *w_v = in[10],
                *g_ffn1 = in[11], *w1g = in[12], *w1u = in[13], *w1d = in[14], *g_mix = in[15], *w_in = in[16], *a_re = in[17], *a_im = in[18], *log_dt = in[19], *b_re = in[20], *b_im = in[21],
                *c_re = in[22], *c_im = in[23], *ssm_d = in[24], *w_glu = in[25], *conv_w = in[26], *conv_b = in[27], *ln_g = in[28], *ln_b = in[29], *w_out = in[30], *g_xattn = in[31],
                *w_q = in[32], *w_o = in[33], *g_ffn2 = in[34], *w2g = in[35], *w2u = in[36], *w2d = in[37], *g_final = in[38];
    (void)x_p; (void)x_s;
    unsigned char* ws = (unsigned char*)d_ws; float* out = (float*)d_out;
    bf16_t *Wgu1 = (bf16_t*)(ws + WS_WGU1), *Wgu2 = (bf16_t*)(ws + WS_WGU2), *Wd1 = (bf16_t*)(ws + WS_WD1), *Wd2 = (bf16_t*)(ws + WS_WD2), *Win = (bf16_t*)(ws + WS_WIN), *Wglu = (bf16_t*)(ws + WS_WGLU),
           *Wout = (bf16_t*)(ws + WS_WOUT), *Wq = (bf16_t*)(ws + WS_WQ), *Wo = (bf16_t*)(ws + WS_WO), *Wkv = (bf16_t*)(ws + WS_WKV);
    bf16_t *xb = (bf16_t*)(ws + WS_XB), *memb = (bf16_t*)(ws + WS_MEMB), *kb = (bf16_t*)(ws + WS_KB), *vb2 = (bf16_t*)(ws + WS_VB2), *ug = (bf16_t*)(ws + WS_UG),
           *vb = (bf16_t*)(ws + WS_VB), *gb = (bf16_t*)(ws + WS_GB), *mixb = (bf16_t*)(ws + WS_MIXB), *qb = (bf16_t*)(ws + WS_QB), *ob = (bf16_t*)(ws + WS_OB);
    float *ss0 = (float*)(ws + WS_SS0), *ss4 = (float*)(ws + WS_SS4), *ssm = (float*)(ws + WS_SSM);

    if (hipMemsetAsync(ws + WS_CTL, 0, CTL_ZERO_BYTES, stream) != hipSuccess) return;
    Args a{};
    for (int i = 0; i < 39; ++i) a.in[i] = in[i];
    a.out = out; a.ws = ws;
    int li = 0;
    auto run = [&](int lo, int hi) {
        if (FAST_MERGE) { a.ph_lo = lo; a.ph_hi = hi; a.li = li++; hipLaunchKernelGGL(mk_fwd, dim3(grid), dim3(NWAVES * 64), LDS_BYTES, stream, a); }
        else for (int p = lo; p < hi; ++p) { a.ph_lo = p; a.ph_hi = p + 1; a.li = li; hipLaunchKernelGGL(mk_fwd, dim3(grid), dim3(NWAVES * 64), LDS_BYTES, stream, a); }
    };

    k_wt<1><<<dim3(2 * FF / 32, D / 32), 256, 0, stream>>>(w1g, w1u, g_ffn1, Wgu1, D, 2 * FF, FF);
    k_wt<1><<<dim3(2 * FF / 32, D / 32), 256, 0, stream>>>(w2g, w2u, g_ffn2, Wgu2, D, 2 * FF, FF);
    k_wt<0><<<dim3(D / 32, FF / 32), 256, 0, stream>>>(w1d, nullptr, nullptr, Wd1, FF, D, D);
    k_wt<0><<<dim3(D / 32, FF / 32), 256, 0, stream>>>(w2d, nullptr, nullptr, Wd2, FF, D, D);
    k_wt<2><<<dim3(1536 / 32, D / 32), 256, 0, stream>>>(w_in, nullptr, g_mix, Win, D, 1536, 1536);
    k_wt<0><<<dim3(SSM / 32, SSM / 32), 256, 0, stream>>>(w_glu, nullptr, nullptr, Wglu, SSM, SSM, SSM);
    k_wt<0><<<dim3(D / 32, D / 32), 256, 0, stream>>>(w_out, nullptr, nullptr, Wout, D, D, D);
    k_wt<0><<<dim3(D / 32, D / 32), 256, 0, stream>>>(w_q, nullptr, g_xattn, Wq, D, D, D);
    k_wt<0><<<dim3(D / 32, D / 32), 256, 0, stream>>>(w_o, nullptr, nullptr, Wo, D, D, D);
    k_wt<3><<<dim3(2048 / 32, D / 32), 256, 0, stream>>>(w_k, w_v, g_mem, Wkv, D, 2048, D);
    k_rows_bf16_ss<<<M / 4, 256, 0, stream>>>(x_p, MP, x_s, MS, xb, ss0);
    k_rows_bf16_ss<<<MMEM / 4, 256, 0, stream>>>(memp, MMEM, nullptr, 0, memb, ssm);

    run(PH_GU1, PH_IN + 1);
    k_ref_s5<<<(NBATCH + DECB) * NG, 64, 0, stream>>>(ug, st_re, st_im, a_re, a_im, log_dt, b_re, b_im, c_re, c_im, ssm_d, gb, out);
    k_ref_conv<<<M, 512, 0, stream>>>(vb, cconv, conv_w, conv_b, ln_g, ln_b, mixb, out);
    run(PH_GLU, PH_Q + 1);
    k_ref_attn<<<M * NH, 256, 0, stream>>>(qb, kb, vb2, cmk, cmv, ob);
    run(PH_O, PH_D2 + 1);
    k_final<<<M / 4, 256, 0, stream>>>(out + O_Y, ss4, g_final);
}
```

```cpp
#include <hip/hip_runtime.h>
#include <cstdint>
#include <cstdio>

typedef unsigned short bf16_t;
typedef float f32x4 __attribute__((ext_vector_type(4)));

constexpr int D = 1024, FF = 2816, MP = 16384, MS = 1024, M = MP + MS;
constexpr int SEQ = 2048, DECB = 128, DECS = 8, NBATCH = 8;
constexpr int SSM = 512, CONVD = 512, NG = 32, GC = 16, NST = 64, CWID = 31, NMEM = 256, NH = 4, HD = 256;
constexpr int MMEM = NBATCH * NMEM;
constexpr float EPS = 1e-6f;
constexpr float QSCALE = 0.0625f * 1.4426950408889634f;

constexpr size_t O_Y = 0;
constexpr size_t O_SRP = (size_t)M * D;
constexpr size_t O_SIP = O_SRP + 16384;
constexpr size_t O_CVP = O_SIP + 16384;
constexpr size_t O_MKP = O_CVP + 122880;
constexpr size_t O_MVP = O_MKP + 2097152;
constexpr size_t O_SRS = O_MVP + 2097152;
constexpr size_t O_SIS = O_SRS + 262144;
constexpr size_t O_CVS = O_SIS + 262144;
constexpr size_t O_END = O_CVS + 1966080;

constexpr size_t MiB = 1u << 20;
constexpr size_t WS_CTL = 0;
constexpr size_t WS_WGU1 = 2 * MiB, WS_WGU2 = 13 * MiB, WS_WD1 = 24 * MiB, WS_WD2 = 30 * MiB, WS_WIN = 36 * MiB, WS_WGLU = 39 * MiB,
                 WS_WOUT = 40 * MiB, WS_WQ = 42 * MiB, WS_WO = 44 * MiB, WS_WKV = 46 * MiB;
constexpr size_t WS_TAB = 50 * MiB;
constexpr size_t WS_XB = 72 * MiB, WS_MEMB = 106 * MiB, WS_KB = 110 * MiB, WS_VB2 = 114 * MiB;
constexpr size_t WS_SS0 = 118 * MiB, WS_SS1 = 120 * MiB, WS_SS2 = 122 * MiB, WS_SS3 = 124 * MiB, WS_SS4 = 126 * MiB, WS_SSM = 127 * MiB + 512 * 1024;
constexpr size_t WS_XRES = 128 * MiB, WS_H = 196 * MiB, WS_UG = 290 * MiB, WS_VB = 307 * MiB, WS_GB = 324 * MiB, WS_MIXB = 342 * MiB,
                 WS_QB = 376 * MiB, WS_OB = 410 * MiB, WS_END = 444 * MiB;

__device__ __forceinline__ unsigned f2bf(float f) { unsigned u = __builtin_bit_cast(unsigned, f); return (u + 0x7fffu + ((u >> 16) & 1u)) >> 16; }
__device__ __forceinline__ float bf2f(bf16_t b) { return __builtin_bit_cast(float, (unsigned)b << 16); }
__device__ __forceinline__ float sigmoidf_(float x) { return 1.f / (1.f + __expf(-x)); }
__device__ __forceinline__ float siluf_(float x) { return x * sigmoidf_(x); }
__device__ __forceinline__ float gelu_tanh(float x) { const float u = 0.7978845608028654f * (x + 0.044715f * x * x * x); return 0.5f * x * (1.f + tanhf(u)); }
__device__ __forceinline__ float wave_sum(float v) {
#pragma unroll
    for (int o = 1; o < 64; o <<= 1) v += __shfl_xor(v, o);
    return v;
}
__device__ __forceinline__ float rstd_from_ss(const float* ss, int row) {
    float s = 0.f;
#pragma unroll
    for (int i = 0; i < 16; ++i) s += ss[(size_t)row * 16 + i];
    return rsqrtf(s * (1.f / D) + EPS);
}

template <int MAP>
__global__ void k_wt(const float* W0, const float* W1, const float* gain, bf16_t* WT, int K, int N, int ldw) {
    __shared__ float tile[32][33];
    const int n0 = blockIdx.x * 32, k0 = blockIdx.y * 32, tx = threadIdx.x & 31, ty = threadIdx.x >> 5;
    const float* W = W0; int c0 = n0;
    if (MAP == 1) { const int pn = n0 / 256, half = (n0 % 256) / 128, jj = n0 % 128; W = half ? W1 : W0; c0 = pn * 128 + jj; }
    if (MAP == 2) { if (n0 >= 512) { const int m = n0 - 512, pc = m / 256, half = (m % 256) / 128, jj = m % 128; c0 = 512 + half * 512 + pc * 128 + jj; } }
    if (MAP == 3) { if (n0 >= 1024) { W = W1; c0 = n0 - 1024; } }
    for (int i = ty; i < 32; i += 8) { const int k = k0 + i; tile[i][tx] = W[(size_t)k * ldw + c0 + tx] * (gain ? gain[k] : 1.f); }
    __syncthreads();
    for (int i = ty; i < 32; i += 8) WT[(size_t)(n0 + i) * K + k0 + tx] = (bf16_t)f2bf(tile[tx][i]);
}
__global__ void k_rows_bf16_ss(const float* x0, int rows0, const float* x1, int rows1, bf16_t* xb, float* ss) {
    const int row = blockIdx.x * 4 + (threadIdx.x >> 6), lane = threadIdx.x & 63;
    if (row >= rows0 + rows1) return;
    const float* xr = row < rows0 ? x0 + (size_t)row * D : x1 + (size_t)(row - rows0) * D;
    float s = 0.f;
    for (int j = 0; j < 4; ++j) { const f32x4 v = *(const f32x4*)(xr + j * 256 + lane * 4); s += v.x * v.x + v.y * v.y + v.z * v.z + v.w * v.w;
        uint2 o; o.x = f2bf(v.x) | (f2bf(v.y) << 16); o.y = f2bf(v.z) | (f2bf(v.w) << 16); *(uint2*)(xb + (size_t)row * D + j * 256 + lane * 4) = o; }
    s = wave_sum(s);
    if (lane < 16) ss[(size_t)row * 16 + lane] = lane == 0 ? s : 0.f;
}
__global__ void k_rows_ss(const float* x, int rows, float* ss) {
    const int row = blockIdx.x * 4 + (threadIdx.x >> 6), lane = threadIdx.x & 63;
    if (row >= rows) return;
    float s = 0.f;
    for (int j = 0; j < 4; ++j) { const f32x4 v = *(const f32x4*)(x + (size_t)row * D + j * 256 + lane * 4); s += v.x * v.x + v.y * v.y + v.z * v.z + v.w * v.w; }
    s = wave_sum(s);
    if (lane < 16) ss[(size_t)row * 16 + lane] = lane == 0 ? s : 0.f;
}

enum { E_KV = 1, E_SWIGLU = 2, E_RES = 3, E_U = 4, E_V = 5, E_GLU = 6, E_Q = 7 };
struct EpiP {
    const float* ss;
    const float* resin;
    float* resout;
    bf16_t* ob;
    bf16_t* ob2;
    const bf16_t* gb;
    float* out;
    float alpha;
    int pad;
};
template <int MODE>
__device__ __forceinline__ void epi_elem(const EpiP& P, int row, int c, float a0, float a1, float rstd) {
    if (MODE == E_KV) {
        const float v = a0 * rstd;
        if (c < 1024) { P.out[O_MKP + (size_t)row * 1024 + c] = v; P.ob[(size_t)row * 1024 + c] = (bf16_t)f2bf(v); }
        else { P.out[O_MVP + (size_t)row * 1024 + c - 1024] = v; P.ob2[(size_t)row * 1024 + c - 1024] = (bf16_t)f2bf(v); }
    } else if (MODE == E_SWIGLU) {
        const float g = a0 * rstd, u = a1 * rstd; P.ob[(size_t)row * FF + c] = (bf16_t)f2bf(siluf_(g) * u);
    } else if (MODE == E_RES) {
        const float v = P.resin[(size_t)row * D + c] + P.alpha * a0; P.resout[(size_t)row * D + c] = v; if (P.ob) P.ob[(size_t)row * D + c] = (bf16_t)f2bf(v);
    } else if (MODE == E_U) {
        P.ob[((size_t)(c >> 4) * M + row) * 16 + (c & 15)] = (bf16_t)f2bf(a0 * rstd);
    } else if (MODE == E_V) {
        const float v = (a0 * rstd) * sigmoidf_(a1 * rstd); P.ob[(size_t)row * CONVD + c] = (bf16_t)f2bf(v);
        if (row < MP) { const int b = row / SEQ, t = row % SEQ; if (t >= SEQ - 30) P.out[O_CVP + ((size_t)b * 30 + (t - (SEQ - 30))) * CONVD + c] = v; }
        else { const int rs = row - MP, b = rs / DECS, t = rs % DECS; P.out[O_CVS + ((size_t)b * 30 + 22 + t) * CONVD + c] = v; }
    } else if (MODE == E_GLU) {
        const float g = bf2f(P.gb[(size_t)row * SSM + c]); P.ob[(size_t)row * D + c] = (bf16_t)f2bf(g * sigmoidf_(a0));
    } else if (MODE == E_Q) {
        P.ob[(size_t)row * D + c] = (bf16_t)f2bf(a0 * rstd * QSCALE);
    }
}
template <int MODE> struct ModeTraits { static constexpr bool PAIRED = (MODE == E_SWIGLU || MODE == E_V); static constexpr bool RSTD = (MODE == E_KV || MODE == E_SWIGLU || MODE == E_U || MODE == E_V || MODE == E_Q); };

template <int MODE>
__global__ void __launch_bounds__(256) k_ref_gemm(const bf16_t* A, const bf16_t* BT, int K, EpiP P) {
    constexpr bool PAIRED = ModeTraits<MODE>::PAIRED;
    __shared__ float As[32][65], B0[32][65], B1[PAIRED ? 32 : 1][65];
    const int tid = threadIdx.x, tx = tid & 15, ty = tid >> 4;
    const int m0 = blockIdx.y * 64, p0 = blockIdx.x * 64;
    const int cb0 = PAIRED ? (p0 / 128) * 256 + (p0 % 128) : p0;
    float acc0[4][4], acc1[4][4];
    for (int i = 0; i < 4; ++i) for (int j = 0; j < 4; ++j) { acc0[i][j] = 0.f; acc1[i][j] = 0.f; }
    for (int k0 = 0; k0 < K; k0 += 32) {
        for (int e = tid; e < 64 * 32; e += 256) { const int r = e >> 5, k = e & 31;
            As[k][r] = bf2f(A[(size_t)(m0 + r) * K + k0 + k]); B0[k][r] = bf2f(BT[(size_t)(cb0 + r) * K + k0 + k]);
            if (PAIRED) B1[k][r] = bf2f(BT[(size_t)(cb0 + 128 + r) * K + k0 + k]); }
        __syncthreads();
        for (int k = 0; k < 32; ++k) {
            float a[4], b0[4], b1[4];
            for (int i = 0; i < 4; ++i) a[i] = As[k][ty * 4 + i];
            for (int j = 0; j < 4; ++j) { b0[j] = B0[k][tx * 4 + j]; b1[j] = PAIRED ? B1[k][tx * 4 + j] : 0.f; }
            for (int i = 0; i < 4; ++i) for (int j = 0; j < 4; ++j) { acc0[i][j] += a[i] * b0[j]; if (PAIRED) acc1[i][j] += a[i] * b1[j]; }
        }
        __syncthreads();
    }
    for (int i = 0; i < 4; ++i) { const int row = m0 + ty * 4 + i; const float rstd = ModeTraits<MODE>::RSTD ? rstd_from_ss(P.ss, row) : 1.f;
        for (int j = 0; j < 4; ++j) epi_elem<MODE>(P, row, p0 + tx * 4 + j, acc0[i][j], acc1[i][j], rstd); }
}

__global__ void __launch_bounds__(64) k_ref_s5(const bf16_t* ug, const float* h0re, const float* h0im, const float* a_re, const float* a_im, const float* log_dt,
                                               const float* b_re, const float* b_im, const float* c_re, const float* c_im, const float* dskip, bf16_t* gb, float* out) {
    const int g = blockIdx.x % NG, sq = blockIdx.x / NG, n = threadIdx.x;
    const bool prompt = sq < NBATCH; const int b = prompt ? sq : sq - NBATCH, T = prompt ? SEQ : DECS, row0 = prompt ? b * SEQ : MP + b * DECS;
    const float dt = expf(log_dt[g]), lr = a_re[g * NST + n], li = a_im[g * NST + n];
    const float mag = expf(lr * dt), abr = mag * cosf(li * dt), abi = mag * sinf(li * dt);
    const float den = lr * lr + li * li, nr = abr - 1.f, ni = abi, cr = (nr * lr + ni * li) / den, ci = (ni * lr - nr * li) / den;
    float Br[16], Bi[16], Cr[16], Ci[16];
    for (int c = 0; c < 16; ++c) { const float br = b_re[((size_t)g * NST + n) * 16 + c], bi = b_im[((size_t)g * NST + n) * 16 + c];
        Br[c] = cr * br - ci * bi; Bi[c] = cr * bi + ci * br; Cr[c] = c_re[((size_t)g * 16 + c) * NST + n]; Ci[c] = c_im[((size_t)g * 16 + c) * NST + n]; }
    float hr = 0.f, hi = 0.f;
    if (!prompt) { hr = h0re[((size_t)b * NG + g) * NST + n]; hi = h0im[((size_t)b * NG + g) * NST + n]; }
    const float dsk = dskip[g * 16 + (n & 15)];
    for (int t = 0; t < T; ++t) {
        const bf16_t* up = ug + ((size_t)g * M + row0 + t) * 16;
        float u[16], xr = 0.f, xi = 0.f;
#pragma unroll
        for (int c = 0; c < 16; ++c) { u[c] = bf2f(up[c]); xr += Br[c] * u[c]; xi += Bi[c] * u[c]; }
        const float nhr = abr * hr - abi * hi + xr, nhi = abr * hi + abi * hr + xi; hr = nhr; hi = nhi;
        float ymine = 0.f;
#pragma unroll
        for (int c = 0; c < 16; ++c) { const float y = wave_sum(Cr[c] * hr - Ci[c] * hi); if ((n & 15) == c) ymine = y + dsk * u[c]; }
        if (n < 16) gb[(size_t)(row0 + t) * SSM + g * 16 + n] = (bf16_t)f2bf(gelu_tanh(ymine));
    }
    if (prompt) { out[O_SRP + ((size_t)b * NG + g) * NST + n] = hr; out[O_SIP + ((size_t)b * NG + g) * NST + n] = hi; }
    else { out[O_SRS + ((size_t)b * NG + g) * NST + n] = hr; out[O_SIS + ((size_t)b * NG + g) * NST + n] = hi; }
}

__global__ void __launch_bounds__(512) k_ref_conv(const bf16_t* vb, const float* cache, const float* w, const float* bias, const float* lg, const float* lb, bf16_t* mixb, float* out) {
    __shared__ float red[2][8];
    const int row = blockIdx.x, c = threadIdx.x;
    float y = bias[c];
    if (row < MP) { const int t = row % SEQ;
        for (int k = 0; k < CWID; ++k) { const int tt = t - 30 + k; if (tt >= 0) y += w[k * CONVD + c] * bf2f(vb[(size_t)(row - 30 + k) * CONVD + c]); }
    } else { const int rs = row - MP, b = rs / DECS, t = rs % DECS;
        for (int k = 0; k < CWID; ++k) { const int idx = t + k; const float xv = idx < 30 ? cache[((size_t)b * 30 + idx) * CONVD + c] : bf2f(vb[(size_t)(MP + b * DECS + idx - 30) * CONVD + c]); y += w[k * CONVD + c] * xv; }
        if (t == 0) for (int j = 0; j < 22; ++j) out[O_CVS + ((size_t)b * 30 + j) * CONVD + c] = cache[((size_t)b * 30 + j + 8) * CONVD + c];
    }
    float s = wave_sum(y); if ((c & 63) == 0) red[0][c >> 6] = s; __syncthreads();
    float mu = 0.f; for (int i = 0; i < 8; ++i) mu += red[0][i]; mu *= (1.f / CONVD);
    const float d = y - mu; float q = wave_sum(d * d); if ((c & 63) == 0) red[1][c >> 6] = q; __syncthreads();
    float var = 0.f; for (int i = 0; i < 8; ++i) var += red[1][i]; var *= (1.f / CONVD);
    const float z = d * rsqrtf(var + EPS) * lg[c] + lb[c];
    mixb[(size_t)row * D + SSM + c] = (bf16_t)f2bf(siluf_(z));
}

__global__ void __launch_bounds__(256) k_ref_attn(const bf16_t* qb, const bf16_t* kb, const bf16_t* vb2, const float* ck, const float* cv, bf16_t* ob) {
    __shared__ float q[256], p[256], red[4];
    const int row = blockIdx.x >> 2, h = blockIdx.x & 3, tid = threadIdx.x;
    q[tid] = bf2f(qb[(size_t)row * D + h * HD + tid]);
    __syncthreads();
    float s = 0.f;
    if (row < MP) { const int b = row / SEQ; const bf16_t* kr = kb + ((size_t)b * NMEM + tid) * D + h * HD; for (int d = 0; d < HD; ++d) s += q[d] * bf2f(kr[d]); }
    else { const int b = (row - MP) / DECS; const float* kr = ck + ((size_t)b * NMEM + tid) * D + h * HD; for (int d = 0; d < HD; ++d) s += q[d] * kr[d]; }
    float mx = s; for (int o = 1; o < 64; o <<= 1) mx = fmaxf(mx, __shfl_xor(mx, o));
    if ((tid & 63) == 0) red[tid >> 6] = mx; __syncthreads();
    mx = fmaxf(fmaxf(red[0], red[1]), fmaxf(red[2], red[3])); __syncthreads();
    const float e = exp2f(s - mx); float sm = wave_sum(e);
    if ((tid & 63) == 0) red[tid >> 6] = sm; __syncthreads();
    sm = red[0] + red[1] + red[2] + red[3];
    p[tid] = e / sm; __syncthreads();
    float o = 0.f;
    if (row < MP) { const int b = row / SEQ; const bf16_t* vr = vb2 + (size_t)b * NMEM * D + h * HD + tid; for (int m = 0; m < NMEM; ++m) o += p[m] * bf2f(vr[(size_t)m * D]); }
    else { const int b = (row - MP) / DECS; const float* vr = cv + (size_t)b * NMEM * D + h * HD + tid; for (int m = 0; m < NMEM; ++m) o += p[m] * vr[(size_t)m * D]; }
    ob[(size_t)row * D + h * HD + tid] = (bf16_t)f2bf(o);
}

__global__ void k_final(float* y, const float* ss, const float* g) {
    const int row = blockIdx.x * 4 + (threadIdx.x >> 6), lane = threadIdx.x & 63;
    const float r = rstd_from_ss(ss, row);
    for (int j = 0; j < 4; ++j) { f32x4* p = (f32x4*)(y + (size_t)row * D + j * 256 + lane * 4); const f32x4 gg = *(const f32x4*)(g + j * 256 + lane * 4); f32x4 v = *p; v = v * r * gg; *p = v; }
}


namespace pg8 {
#define PG8_LAS __attribute__((address_space(3)))
typedef unsigned short bf16_t;
typedef short bf16x8 __attribute__((ext_vector_type(8)));
typedef float f32x4 __attribute__((ext_vector_type(4)));
typedef unsigned u32x4 __attribute__((ext_vector_type(4)));
constexpr int BM = 256, BK = 64, HALF = 128, HTB = HALF * BK * 2  , STAGE_BYTES = 8 * HTB, NXCD = 8, WGM = 8;

__host__ __device__ __forceinline__ int lds_byte(int r, int c) { const int st = (r >> 4) * 2 + (c >> 5), rr = r & 15, cc = c & 31, ob = rr * 64 + cc * 2; return st * 1024 + (ob ^ (((ob >> 9) & 1) << 5)); }
__host__ __device__ __forceinline__ void stage_rc(int b, int& R, int& C) { const int st = b / 1024, sb = b % 1024, swz = sb ^ (((sb >> 9) & 1) << 5); R = (st >> 1) * 16 + swz / 64; C = (st & 1) * 32 + (swz % 64) / 2; }
__host__ __device__ __forceinline__ int perm32(int rho) { const int n = rho >> 4, i = rho & 15; return 8 * (i >> 2) + 4 * n + (i & 3); }

struct Unit { int pm, pn; };
struct Gemm { const bf16_t* A; const bf16_t* Bt; int M, N, K; };

struct StaticOrder {
    int nM, nN, nwg, G, c;
    __host__ __device__ void init(int M, int N, int G_, int c_) { nM = M / BM; nN = N / BM; nwg = nM * nN; G = G_; c = c_; }
    __host__ __device__ bool next(int i, Unit& u) const {
        const long L = (long)i * G + c; if (L >= nwg) return false;
        int wgid = (int)L; { const int q = nwg / NXCD, r = nwg % NXCD, xcd = wgid % NXCD, off = wgid / NXCD; wgid = (xcd < r ? xcd * (q + 1) : r * (q + 1) + (xcd - r) * q) + off; }
        const int nig = WGM * nN, gid = wgid / nig, fm = gid * WGM, gsz = (nM - fm) < WGM ? (nM - fm) : WGM;
        u.pm = fm + ((wgid % nig) % gsz); u.pn = (wgid % nig) / gsz; return true;
    }
    __device__ __forceinline__ void a_ready(const Unit&) const {}
    __device__ __forceinline__ void done(const Unit&) const {}
};
__device__ __forceinline__ unsigned cvt_pk_bf16(float lo, float hi) { unsigned r; asm volatile("v_cvt_pk_bf16_f32 %0, %1, %2" : "=v"(r) : "v"(lo), "v"(hi)); return r; }
typedef float f32x2 __attribute__((ext_vector_type(2)));
template <class Epi, class Sched, bool ALIGN_EPI = false, bool SP2 = false>
__device__ __forceinline__ void gemm_phase(PG8_LAS unsigned char* lds, const Gemm g, const Sched& S, const Epi& E) {
    const int tid = threadIdx.x, wid = __builtin_amdgcn_readfirstlane(tid >> 6), lane = tid & 63, wr = wid >> 2, wc = wid & 3, fr = lane & 15, fq = lane >> 4;
    const int K = g.K, nt = K / BK;
    unsigned voffA[2], voffB[2];
#pragma unroll
    for (int i = 0; i < 2; ++i) { int R, C; stage_rc(tid * 16 + i * 8192, R, C); const int Rb = Epi::PERM ? ((R & ~31) + perm32(R & 31)) : R;
        voffA[i] = (unsigned)(R * K + C) * 2u; voffB[i] = (unsigned)(Rb * K + C) * 2u; }
    const size_t kstep = (size_t)(BK * 2);
    const size_t hstep = (size_t)HALF * K * 2;
    const size_t tstep = 2 * hstep;
    const unsigned ldsw = (unsigned)wid * 1024u;
    const int aoff = lds_byte(wr * 64 + fr, fq * 8), boff = lds_byte(wc * 32 + fr, fq * 8);
#define PG8_SA(b, h) (((b) * 2 + (h)) * HTB)
#define PG8_SB(b, h) ((4 + (b) * 2 + (h)) * HTB)
#define PG8_STAGE(bufoff, gbase, voff) do { _Pragma("unroll") for (int _i = 0; _i < 2; ++_i) \
        __builtin_amdgcn_global_load_lds((const unsigned*)((const char*)(gbase) + (voff)[_i]), (PG8_LAS unsigned*)(lds + (bufoff) + ldsw + _i * 8192), 16, 0, 0); } while (0)
#define PG8_LDA(dst, b, h) do { _Pragma("unroll") for (int m = 0; m < 4; ++m) _Pragma("unroll") for (int k = 0; k < 2; ++k) dst[m][k] = *(const PG8_LAS bf16x8*)(lds + PG8_SA(b, h) + aoff + m * 2048 + k * 1024); } while (0)
#define PG8_LDB(dst, b, h) do { _Pragma("unroll") for (int n = 0; n < 2; ++n) _Pragma("unroll") for (int k = 0; k < 2; ++k) dst[n][k] = *(const PG8_LAS bf16x8*)(lds + PG8_SB(b, h) + boff + n * 2048 + k * 1024); } while (0)
#define PG8_MMA(ai, bj, At, Bt) do { __builtin_amdgcn_s_setprio(1); _Pragma("unroll") for (int m = 0; m < 4; ++m) _Pragma("unroll") for (int n = 0; n < 2; ++n) _Pragma("unroll") for (int k = 0; k < 2; ++k) \
        acc[ai][bj][m][n] = __builtin_amdgcn_mfma_f32_16x16x32_bf16(Bt[n][k], At[m][k], acc[ai][bj][m][n], 0, 0, 0); __builtin_amdgcn_s_setprio(0); } while (0)
#define PG8_WAIT_V(n) asm volatile("s_waitcnt vmcnt(" #n ")" ::: "memory")
#define PG8_WAIT_L(n) asm volatile("s_waitcnt lgkmcnt(" #n ")" ::: "memory")
#define PG8_BAR __builtin_amdgcn_s_barrier()
#define PG8_SCHED __builtin_amdgcn_sched_barrier(0)
    Unit cur, nxt; int ui = 0;
    if (!S.next(0, cur)) return;
    f32x4 acc[2][2][4][2];
#pragma unroll
    for (int a = 0; a < 2; ++a)
#pragma unroll
        for (int b = 0; b < 2; ++b)
#pragma unroll
            for (int m = 0; m < 4; ++m)
#pragma unroll
                for (int n = 0; n < 2; ++n) acc[a][b][m][n] = (f32x4){0.f, 0.f, 0.f, 0.f};
    bf16x8 At[4][2], B0[2][2], B1[2][2];
    const char* cA = (const char*)g.A + (size_t)cur.pm * tstep; const char* cB = (const char*)g.Bt + (size_t)cur.pn * tstep;
    S.a_ready(cur);
    if constexpr (SP2) {
        PG8_STAGE(PG8_SB(0, 0), cB, voffB); PG8_STAGE(PG8_SB(0, 1), cB + hstep, voffB); PG8_STAGE(PG8_SA(0, 0), cA, voffA); PG8_STAGE(PG8_SA(0, 1), cA + hstep, voffA);
        if (wr == 1) PG8_BAR;
        PG8_WAIT_V(2); PG8_BAR;
        PG8_STAGE(PG8_SB(1, 0), cB + kstep, voffB); PG8_STAGE(PG8_SA(1, 0), cA + kstep, voffA); PG8_STAGE(PG8_SB(1, 1), cB + hstep + kstep, voffB);
        PG8_WAIT_V(6); PG8_BAR;
    } else {
        PG8_STAGE(PG8_SB(0, 0), cB, voffB); PG8_STAGE(PG8_SA(0, 0), cA, voffA); PG8_STAGE(PG8_SB(0, 1), cB + hstep, voffB); PG8_STAGE(PG8_SA(0, 1), cA + hstep, voffA);
        if (wr == 1) PG8_BAR;
        PG8_WAIT_V(4); PG8_BAR;
        PG8_STAGE(PG8_SB(1, 0), cB + kstep, voffB); PG8_STAGE(PG8_SA(1, 0), cA + kstep, voffA); PG8_STAGE(PG8_SB(1, 1), cB + hstep + kstep, voffB);
        PG8_WAIT_V(6); PG8_BAR;
    }
    for (;;) {
        const bool has_next = S.next(ui + 1, nxt);
        const char* nA = has_next ? (const char*)g.A + (size_t)nxt.pm * tstep : cA; const char* nB = has_next ? (const char*)g.Bt + (size_t)nxt.pn * tstep : cB;
        for (int t = 0; t < nt; t += 2) {
            const bool last = (t == nt - 2);
            const char* a1 = cA + (size_t)(t + 1) * kstep;
            const char* a2 = last ? nA : cA + (size_t)(t + 2) * kstep; const char* b2 = last ? nB : cB + (size_t)(t + 2) * kstep;
            const char* a3 = a2 + kstep; const char* b3 = b2 + kstep;
            if (last && has_next) S.a_ready(nxt);
            if constexpr (SP2) {
            PG8_LDB(B0, 0, 0); PG8_LDB(B1, 0, 1); PG8_SCHED; PG8_LDA(At, 0, 0); PG8_STAGE(PG8_SA(1, 1), a1 + hstep, voffA);
            PG8_WAIT_V(8); PG8_WAIT_L(0); PG8_BAR; PG8_MMA(0, 0, At, B0); PG8_MMA(0, 1, At, B1); PG8_BAR; PG8_SCHED;
            PG8_LDA(At, 0, 1); PG8_STAGE(PG8_SB(0, 0), b2, voffB); PG8_STAGE(PG8_SB(0, 1), b2 + hstep, voffB); PG8_STAGE(PG8_SA(0, 0), a2, voffA);
            PG8_WAIT_V(8); PG8_WAIT_L(0); PG8_BAR; PG8_MMA(1, 0, At, B0); PG8_MMA(1, 1, At, B1); PG8_BAR; PG8_SCHED;
            PG8_LDB(B0, 1, 0); PG8_LDB(B1, 1, 1); PG8_SCHED; PG8_LDA(At, 1, 0); PG8_STAGE(PG8_SA(0, 1), a2 + hstep, voffA);
            PG8_WAIT_V(8); PG8_WAIT_L(0); PG8_BAR; PG8_MMA(0, 0, At, B0); PG8_MMA(0, 1, At, B1); PG8_BAR; PG8_SCHED;
            PG8_LDA(At, 1, 1); PG8_STAGE(PG8_SB(1, 0), b3, voffB); PG8_STAGE(PG8_SB(1, 1), b3 + hstep, voffB); PG8_STAGE(PG8_SA(1, 0), a3, voffA);
            PG8_WAIT_V(8); PG8_WAIT_L(0); PG8_BAR; PG8_MMA(1, 0, At, B0); PG8_MMA(1, 1, At, B1); PG8_BAR; PG8_SCHED;
            } else {
            PG8_LDB(B0, 0, 0); PG8_SCHED; PG8_LDA(At, 0, 0); PG8_STAGE(PG8_SA(1, 1), a1 + hstep, voffA);
            PG8_WAIT_L(8); PG8_BAR; PG8_WAIT_L(0); PG8_MMA(0, 0, At, B0); PG8_BAR; PG8_SCHED;
            PG8_LDB(B1, 0, 1); PG8_STAGE(PG8_SB(0, 0), b2, voffB);
            PG8_BAR; PG8_WAIT_L(0); PG8_MMA(0, 1, At, B1); PG8_BAR;
            PG8_LDA(At, 0, 1); PG8_STAGE(PG8_SA(0, 0), a2, voffA);
            PG8_BAR; PG8_WAIT_L(0); PG8_MMA(1, 0, At, B0); PG8_BAR; PG8_SCHED;
            PG8_STAGE(PG8_SB(0, 1), b2 + hstep, voffB);
            PG8_WAIT_V(6); PG8_BAR; PG8_MMA(1, 1, At, B1); PG8_BAR;
            PG8_LDB(B0, 1, 0); PG8_SCHED; PG8_LDA(At, 1, 0); PG8_STAGE(PG8_SA(0, 1), a2 + hstep, voffA);
            PG8_WAIT_L(8); PG8_BAR; PG8_WAIT_L(0); PG8_MMA(0, 0, At, B0); PG8_BAR; PG8_SCHED;
            PG8_LDB(B1, 1, 1); PG8_STAGE(PG8_SB(1, 0), b3, voffB);
            PG8_BAR; PG8_WAIT_L(0); PG8_MMA(0, 1, At, B1); PG8_BAR;
            PG8_LDA(At, 1, 1); PG8_STAGE(PG8_SA(1, 0), a3, voffA);
            PG8_BAR; PG8_WAIT_L(0); PG8_MMA(1, 0, At, B0); PG8_BAR; PG8_SCHED;
            PG8_STAGE(PG8_SB(1, 1), b3 + hstep, voffB);
            PG8_WAIT_V(6); PG8_BAR; PG8_MMA(1, 1, At, B1); PG8_BAR;
            }
        }
        if constexpr (ALIGN_EPI) { if (wr == 0) PG8_BAR; }
        if constexpr (!Epi::AFTER_DRAIN) { E(acc, cur, wr, wc, fr, fq); S.done(cur); }
        if (!has_next) break;
#pragma unroll
        for (int a = 0; a < 2; ++a)
#pragma unroll
            for (int b = 0; b < 2; ++b)
#pragma unroll
                for (int m = 0; m < 4; ++m)
#pragma unroll
                    for (int n = 0; n < 2; ++n) acc[a][b][m][n] = (f32x4){0.f, 0.f, 0.f, 0.f};
        cur = nxt; cA = nA; cB = nB; ++ui;
        if constexpr (ALIGN_EPI) { if (wr == 1) PG8_BAR; }
    }
    PG8_WAIT_V(0);
    if constexpr (!ALIGN_EPI) { if (wr == 0) PG8_BAR; }
    PG8_BAR;
    if constexpr (Epi::AFTER_DRAIN) { E.fused(acc, cur, wr, wc, fr, fq, lds, wid, lane); S.done(cur); }
#undef PG8_SA
#undef PG8_SB
#undef PG8_STAGE
#undef PG8_LDA
#undef PG8_LDB
#undef PG8_MMA
#undef PG8_WAIT_V
#undef PG8_WAIT_L
#undef PG8_BAR
#undef PG8_SCHED
}
}

namespace fx {
using pg8::f32x4; using pg8::u32x4; using pg8::Unit; using pg8::HALF; using pg8::BM; using pg8::cvt_pk_bf16;
__device__ __forceinline__ float rstd_row(const float* ss, int row) {
    const f32x4* p = (const f32x4*)(ss + (size_t)row * 16); const f32x4 a = p[0], b = p[1], c = p[2], d = p[3];
    const float s = ((a.x + a.y) + (a.z + a.w)) + ((b.x + b.y) + (b.z + b.w)) + ((c.x + c.y) + (c.z + c.w)) + ((d.x + d.y) + (d.z + d.w));
    return rsqrtf(s * (1.f / D) + EPS);
}
__device__ __forceinline__ float fsig(float x) { return __builtin_amdgcn_rcpf(1.f + __builtin_amdgcn_exp2f(-1.4426950408889634f * x)); }
__device__ __forceinline__ u32x4 pack8(const f32x4 a, const f32x4 b) { u32x4 w; w.x = cvt_pk_bf16(a[0], a[1]); w.y = cvt_pk_bf16(a[2], a[3]); w.z = cvt_pk_bf16(b[0], b[1]); w.w = cvt_pk_bf16(b[2], b[3]); return w; }
__device__ __forceinline__ f32x4 sig4(const f32x4 x) { return (f32x4){fsig(x[0]), fsig(x[1]), fsig(x[2]), fsig(x[3])}; }

struct EpiKV { static constexpr bool PERM = true, AFTER_DRAIN = false; const float* ss; bf16_t* kb; bf16_t* vb2; float* out;
    __device__ __forceinline__ void operator()(const f32x4 (&acc)[2][2][4][2], const Unit& u, int wr, int wc, int fr, int fq) const {
        const int row0 = u.pm * BM + wr * 64 + fr; const bool isv = u.pn >= 4; const int colt = (isv ? u.pn - 4 : u.pn) * BM + wc * 32 + 8 * fq;
        float* of = out + (isv ? O_MVP : O_MKP); bf16_t* ob = isv ? vb2 : kb;
#pragma unroll
        for (int ai = 0; ai < 2; ++ai)
#pragma unroll
            for (int m = 0; m < 4; ++m) { const int row = row0 + ai * HALF + m * 16; const float r = rstd_row(ss, row);
#pragma unroll
                for (int bj = 0; bj < 2; ++bj) { const f32x4 v0 = acc[ai][bj][m][0] * r, v1 = acc[ai][bj][m][1] * r; const size_t o = (size_t)row * D + colt + bj * HALF;
                    *(f32x4*)(of + o) = v0; *(f32x4*)(of + o + 4) = v1; *(u32x4*)(ob + o) = pack8(v0, v1); } }
    }
};
struct EpiSwiglu { static constexpr bool PERM = true, AFTER_DRAIN = false; const float* ss; bf16_t* H;
    __device__ __forceinline__ void operator()(const f32x4 (&acc)[2][2][4][2], const Unit& u, int wr, int wc, int fr, int fq) const {
        const int row0 = u.pm * BM + wr * 64 + fr, col0 = u.pn * HALF + wc * 32 + 8 * fq;
#pragma unroll
        for (int ai = 0; ai < 2; ++ai)
#pragma unroll
            for (int m = 0; m < 4; ++m) { const int row = row0 + ai * HALF + m * 16; const float r = rstd_row(ss, row);
                const f32x4 g0 = acc[ai][0][m][0] * r, g1 = acc[ai][0][m][1] * r, u0 = acc[ai][1][m][0] * r, u1 = acc[ai][1][m][1] * r;
                *(u32x4*)(H + (size_t)row * FF + col0) = pack8(g0 * sig4(g0) * u0, g1 * sig4(g1) * u1); }
    }
};
struct EpiRes { static constexpr bool PERM = true, AFTER_DRAIN = false; const float* rin0; const float* rin1; float* rout; bf16_t* xb; float* ss; float alpha;
    __device__ __forceinline__ void operator()(const f32x4 (&acc)[2][2][4][2], const Unit& u, int wr, int wc, int fr, int fq) const {
        const int row0 = u.pm * BM + wr * 64 + fr, col0 = u.pn * BM + wc * 32 + 8 * fq; const float* rin = u.pm >= MP / BM ? rin1 : rin0;
#pragma unroll
        for (int ai = 0; ai < 2; ++ai)
#pragma unroll
            for (int m = 0; m < 4; ++m) { const int row = row0 + ai * HALF + m * 16; float sq = 0.f;
#pragma unroll
                for (int bj = 0; bj < 2; ++bj) { const size_t o = (size_t)row * D + col0 + bj * HALF;
                    const f32x4 v0 = *(const f32x4*)(rin + o) + acc[ai][bj][m][0] * alpha, v1 = *(const f32x4*)(rin + o + 4) + acc[ai][bj][m][1] * alpha;
                    *(f32x4*)(rout + o) = v0; *(f32x4*)(rout + o + 4) = v1; if (xb) *(u32x4*)(xb + o) = pack8(v0, v1);
                    sq += (v0[0] * v0[0] + v0[1] * v0[1]) + (v0[2] * v0[2] + v0[3] * v0[3]) + (v1[0] * v1[0] + v1[1] * v1[1]) + (v1[2] * v1[2] + v1[3] * v1[3]); }
                sq += __shfl_xor(sq, 16); sq += __shfl_xor(sq, 32);
                if (fq == 0) ss[(size_t)row * 16 + u.pn * 4 + wc] = sq;
                if (m & 1) asm volatile("" ::: "memory"); }
    }
};
struct EpiIn { static constexpr bool PERM = true, AFTER_DRAIN = false; const float* ss; bf16_t* ug; bf16_t* vb; float* out;
    __device__ __forceinline__ void operator()(const f32x4 (&acc)[2][2][4][2], const Unit& u, int wr, int wc, int fr, int fq) const {
        const int row0 = u.pm * BM + wr * 64 + fr;
        if (u.pn < 2) {
#pragma unroll
            for (int ai = 0; ai < 2; ++ai)
#pragma unroll
                for (int m = 0; m < 4; ++m) { const int row = row0 + ai * HALF + m * 16; const float r = rstd_row(ss, row);
#pragma unroll
                    for (int bj = 0; bj < 2; ++bj) { const int c0 = u.pn * BM + bj * HALF + wc * 32 + 8 * fq;
                        *(u32x4*)(ug + ((size_t)(c0 >> 4) * M + row) * 16 + (c0 & 15)) = pack8(acc[ai][bj][m][0] * r, acc[ai][bj][m][1] * r); } }
        } else {
            const int p0 = (u.pn - 2) * HALF + wc * 32 + 8 * fq;
#pragma unroll
            for (int ai = 0; ai < 2; ++ai)
#pragma unroll
                for (int m = 0; m < 4; ++m) { const int row = row0 + ai * HALF + m * 16; const float r = rstd_row(ss, row);
                    const f32x4 a0 = acc[ai][0][m][0] * r, a1 = acc[ai][0][m][1] * r, g0 = acc[ai][1][m][0] * r, g1 = acc[ai][1][m][1] * r;
                    const f32x4 v0 = a0 * sig4(g0), v1 = a1 * sig4(g1);
                    *(u32x4*)(vb + (size_t)row * CONVD + p0) = pack8(v0, v1);
                    float* o = nullptr;
                    if (row >= MP) { const int rs = row - MP; o = out + O_CVS + ((size_t)(rs >> 3) * 30 + 22 + (rs & 7)) * CONVD + p0; }
                    else { const int t = row & (SEQ - 1); if (t >= SEQ - 30) o = out + O_CVP + ((size_t)(row >> 11) * 30 + (t - (SEQ - 30))) * CONVD + p0; }
                    if (o) { *(f32x4*)o = v0; *(f32x4*)(o + 4) = v1; } }
        }
    }
};
struct EpiGlu { static constexpr bool PERM = true, AFTER_DRAIN = false; const bf16_t* gb; bf16_t* mixb;
    __device__ __forceinline__ void operator()(const f32x4 (&acc)[2][2][4][2], const Unit& u, int wr, int wc, int fr, int fq) const {
        const int row0 = u.pm * BM + wr * 64 + fr, col0 = u.pn * BM + wc * 32 + 8 * fq;
#pragma unroll
        for (int ai = 0; ai < 2; ++ai)
#pragma unroll
            for (int m = 0; m < 4; ++m) { const int row = row0 + ai * HALF + m * 16;
#pragma unroll
                for (int bj = 0; bj < 2; ++bj) { const int c0 = col0 + bj * HALF; const u32x4 gw = *(const u32x4*)(gb + (size_t)row * SSM + c0);
                    const f32x4 ga = {__builtin_bit_cast(float, gw.x << 16), __builtin_bit_cast(float, gw.x & 0xffff0000u), __builtin_bit_cast(float, gw.y << 16), __builtin_bit_cast(float, gw.y & 0xffff0000u)};
                    const f32x4 gc = {__builtin_bit_cast(float, gw.z << 16), __builtin_bit_cast(float, gw.z & 0xffff0000u), __builtin_bit_cast(float, gw.w << 16), __builtin_bit_cast(float, gw.w & 0xffff0000u)};
                    *(u32x4*)(mixb + (size_t)row * D + c0) = pack8(ga * sig4(acc[ai][bj][m][0]), gc * sig4(acc[ai][bj][m][1])); } }
    }
};
struct EpiQ { static constexpr bool PERM = true, AFTER_DRAIN = false; const float* ss; bf16_t* qb;
    __device__ __forceinline__ void operator()(const f32x4 (&acc)[2][2][4][2], const Unit& u, int wr, int wc, int fr, int fq) const {
        const int row0 = u.pm * BM + wr * 64 + fr, col0 = u.pn * BM + wc * 32 + 8 * fq;
#pragma unroll
        for (int ai = 0; ai < 2; ++ai)
#pragma unroll
            for (int m = 0; m < 4; ++m) { const int row = row0 + ai * HALF + m * 16; const float r = rstd_row(ss, row) * QSCALE;
#pragma unroll
                for (int bj = 0; bj < 2; ++bj) *(u32x4*)(qb + (size_t)row * D + col0 + bj * HALF) = pack8(acc[ai][bj][m][0] * r, acc[ai][bj][m][1] * r); }
    }
};
}

#define GAS __attribute__((address_space(1)))
#define LAS __attribute__((address_space(3)))
typedef unsigned v4u __attribute__((ext_vector_type(4)));
typedef float f32x4 __attribute__((ext_vector_type(4)));
typedef short bf16x8 __attribute__((ext_vector_type(8)));
typedef GAS unsigned gu32;
typedef GAS unsigned long long gu64;
#define RLX_AGENT __ATOMIC_RELAXED, __HIP_MEMORY_SCOPE_AGENT
#define LDS_WAIT() asm volatile("s_waitcnt lgkmcnt(0)" ::: "memory")
#define VM_WAIT() asm volatile("s_waitcnt vmcnt(0)" ::: "memory")
__device__ __forceinline__ unsigned long long rt() { return __builtin_amdgcn_s_memrealtime(); }
__device__ __forceinline__ unsigned pk2(float lo, float hi) { return f2bf(lo) | (f2bf(hi) << 16); }

#define XB_TMO      128
#define XB_XCNT(j)  (256  + 64 * (j))
#define XB_XSUB(j)  (1280 + 64 * (j))
#define XB_XGEN(j)  (2304 + 64 * (j))
#define XB_TOP      3328
#define XB_TOPGEN   3392
#define XCD_BAR_WORDS 3456
#define XB_SPIN_CAP (1u << 18)

__device__ __forceinline__ unsigned xb_ld(unsigned* p)              { return __hip_atomic_load(p, __ATOMIC_RELAXED, __HIP_MEMORY_SCOPE_AGENT); }
__device__ __forceinline__ unsigned xb_add(unsigned* p, unsigned v) { return __hip_atomic_fetch_add(p, v, __ATOMIC_RELAXED, __HIP_MEMORY_SCOPE_AGENT); }
__device__ __forceinline__ unsigned xb_xcc_id() { return (unsigned)__builtin_amdgcn_s_getreg((3 << 11) | 20) & 0xFu; }
#define XB_SPIN(cond, bar) do { unsigned _sp = 0; while (cond) { __builtin_amdgcn_s_sleep(1); \
    if ((++_sp & 255u) == 0u) { if (xb_ld(&(bar)[XB_TMO])) break; if (_sp > XB_SPIN_CAP) { atomicAdd(&(bar)[XB_TMO], 1u); break; } } } } while (0)

struct XcdBarrier {
    unsigned* bar; unsigned x;
    volatile LAS unsigned* st;
};

__device__ __forceinline__ XcdBarrier xcd_barrier_post(unsigned* bar, volatile LAS unsigned* st) {
    XcdBarrier b; b.bar = bar; b.x = xb_xcc_id(); b.st = st;
    if (threadIdx.x == 0) (void)xb_add(&bar[XB_XCNT(b.x)], 1u);
    return b;
}
__device__ __forceinline__ void xcd_barrier_complete(unsigned* bar, unsigned x, unsigned& nloc, unsigned& nx) {
    const unsigned G = gridDim.x * gridDim.y * gridDim.z;
    unsigned sum, cnt, mine, sp = 0u;
    for (;;) {
        sum = 0u; cnt = 0u; mine = 0u;
#pragma unroll
        for (unsigned j = 0; j < 16; ++j) { const unsigned c = xb_ld(&bar[XB_XCNT(j)]); sum += c; cnt += (c > 0u) ? 1u : 0u; mine = (j == x) ? c : mine; }
        if (sum == G) break;
        __builtin_amdgcn_s_sleep(1);
        if ((++sp & 255u) == 0u) { if (xb_ld(&bar[XB_TMO])) break; if (sp > XB_SPIN_CAP) { atomicAdd(&bar[XB_TMO], 1u); break; } }
    }
    nloc = mine > 0u ? mine : 1u; nx = cnt > 0u ? cnt : 1u;
}

__device__ __forceinline__ void xcd_barrier(const XcdBarrier& b) {
    asm volatile("s_waitcnt vmcnt(0)" ::: "memory");
    __syncthreads();
    if (threadIdx.x == 0) {
        unsigned* bar = b.bar;
        __builtin_amdgcn_s_waitcnt(0);
        unsigned nloc = b.st[0], nx = b.st[1];
        if (nloc == 0u) { xcd_barrier_complete(bar, b.x, nloc, nx); b.st[0] = nloc; b.st[1] = nx; }
        const unsigned old = xb_add(&bar[XB_XSUB(b.x)], 1u);
        const unsigned gen = old / nloc;
        if (old + 1u == (gen + 1u) * nloc) {
            __builtin_amdgcn_fence(__ATOMIC_RELEASE, "agent");
            asm volatile("s_waitcnt vmcnt(0)" ::: "memory");
            const unsigned og = xb_add(&bar[XB_TOP], 1u);
            const unsigned tg = og / nx;
            if (og + 1u == (tg + 1u) * nx) xb_add(&bar[XB_TOPGEN], 1u);
            else XB_SPIN(xb_ld(&bar[XB_TOPGEN]) == tg, bar);
            __builtin_amdgcn_fence(__ATOMIC_ACQUIRE, "agent");
            xb_add(&bar[XB_XGEN(b.x)], 1u);
            asm volatile("s_waitcnt vmcnt(0)" ::: "memory");
        } else {
            XB_SPIN(xb_ld(&bar[XB_XGEN(b.x)]) == gen, bar);
            __builtin_amdgcn_fence(__ATOMIC_ACQUIRE, "agent");
            asm volatile("s_waitcnt vmcnt(0)" ::: "memory");
        }
    }
    __syncthreads();
}

namespace sb {
__device__ __forceinline__ void transpose_item(const float* W, int ldw, int c0, const float* gain, bf16_t* WT, int K, int n0, int k0, LAS float* scr, int lane) {
#pragma unroll 8
    for (int i = 0; i < 32; ++i) { const int kk = 2 * i + (lane >> 5); float v = W[(size_t)(k0 + kk) * ldw + c0 + (lane & 31)]; if (gain) v *= gain[k0 + kk]; scr[kk * 33 + (lane & 31)] = v; }
    LDS_WAIT(); asm volatile("" ::: "memory");
    const int c = lane & 7;
#pragma unroll
    for (int j = 0; j < 4; ++j) { const int n = (lane >> 3) + 8 * j; const LAS float* s = scr + (8 * c) * 33 + n;
        v4u o; o.x = pk2(s[0 * 33], s[1 * 33]); o.y = pk2(s[2 * 33], s[3 * 33]); o.z = pk2(s[4 * 33], s[5 * 33]); o.w = pk2(s[6 * 33], s[7 * 33]);
        *(GAS v4u*)(WT + (size_t)(n0 + n) * K + k0 + 8 * c) = o; }
    LDS_WAIT(); asm volatile("" ::: "memory");
}
template <int MAP>
__device__ __forceinline__ void transpose_job_item(const float* W0, const float* W1, const float* gain, bf16_t* WT, int K, int N, int ldw, int item, LAS float* scr, int lane) {
    const int nblk = N / 32, kb = item / nblk, nb = item % nblk, n0 = 32 * nb, k0 = 64 * kb;
    const float* W = W0; int c0 = n0;
    if (MAP == 1) { const int pn = n0 / 256, half = (n0 % 256) / 128, jj = n0 % 128; W = half ? W1 : W0; c0 = pn * 128 + jj; }
    if (MAP == 2) { if (n0 >= 512) { const int m = n0 - 512, pc = m / 256, half = (m % 256) / 128, jj = m % 128; c0 = 512 + half * 512 + pc * 128 + jj; } }
    if (MAP == 3) { if (n0 >= 1024) { W = W1; c0 = n0 - 1024; } }
    transpose_item(W, ldw, c0, gain, WT, K, n0, k0, scr, lane);
}
__device__ __forceinline__ void row_bf16_ss(const float* xr, bf16_t* orow, float* ssrow, int lane) {
    float s = 0.f;
#pragma unroll
    for (int j = 0; j < 4; ++j) { const f32x4 v = *(const f32x4*)(xr + j * 256 + lane * 4); s += (v.x * v.x + v.y * v.y) + (v.z * v.z + v.w * v.w);
        uint2 o; o.x = pk2(v.x, v.y); o.y = pk2(v.z, v.w); *(uint2*)(orow + j * 256 + lane * 4) = o; }
    s = wave_sum(s);
    if (lane < 16) ssrow[lane] = lane == 0 ? s : 0.f;
}

__device__ __forceinline__ void s5_task(int task, const bf16_t* ug, const float* h0re, const float* h0im, const float* a_re, const float* a_im, const float* log_dt,
                                        const float* b_re, const float* b_im, const float* c_re, const float* c_im, const float* dskip, bf16_t* gb, float* out, int n) {
    const int g = task % NG, sq = task / NG;
    const bool prompt = sq < NBATCH; const int b = prompt ? sq : sq - NBATCH, T = prompt ? SEQ : DECS, row0 = prompt ? b * SEQ : MP + b * DECS;
    const float dt = expf(log_dt[g]), lr = a_re[g * NST + n], li = a_im[g * NST + n];
    const float mag = expf(lr * dt), abr = mag * cosf(li * dt), abi = mag * sinf(li * dt);
    const float den = lr * lr + li * li, nr = abr - 1.f, ni = abi, cr = (nr * lr + ni * li) / den, ci = (ni * lr - nr * li) / den;
    float Br[16], Bi[16], Cr[16], Ci[16];
#pragma unroll
    for (int c = 0; c < 16; ++c) { const float br = b_re[((size_t)g * NST + n) * 16 + c], bi = b_im[((size_t)g * NST + n) * 16 + c];
        Br[c] = cr * br - ci * bi; Bi[c] = cr * bi + ci * br; Cr[c] = c_re[((size_t)g * 16 + c) * NST + n]; Ci[c] = c_im[((size_t)g * 16 + c) * NST + n]; }
    float hr = 0.f, hi = 0.f;
    if (!prompt) { hr = h0re[((size_t)b * NG + g) * NST + n]; hi = h0im[((size_t)b * NG + g) * NST + n]; }
    const float dsk = dskip[g * 16 + (n & 15)];
    for (int t = 0; t < T; ++t) {
        const bf16_t* up = ug + ((size_t)g * M + row0 + t) * 16;
        const v4u w0 = *(const v4u*)up, w1 = *(const v4u*)(up + 8);
        float u[16];
        u[0] = __builtin_bit_cast(float, w0.x << 16); u[1] = __builtin_bit_cast(float, w0.x & 0xffff0000u); u[2] = __builtin_bit_cast(float, w0.y << 16); u[3] = __builtin_bit_cast(float, w0.y & 0xffff0000u);
        u[4] = __builtin_bit_cast(float, w0.z << 16); u[5] = __builtin_bit_cast(float, w0.z & 0xffff0000u); u[6] = __builtin_bit_cast(float, w0.w << 16); u[7] = __builtin_bit_cast(float, w0.w & 0xffff0000u);
        u[8] = __builtin_bit_cast(float, w1.x << 16); u[9] = __builtin_bit_cast(float, w1.x & 0xffff0000u); u[10] = __builtin_bit_cast(float, w1.y << 16); u[11] = __builtin_bit_cast(float, w1.y & 0xffff0000u);
        u[12] = __builtin_bit_cast(float, w1.z << 16); u[13] = __builtin_bit_cast(float, w1.z & 0xffff0000u); u[14] = __builtin_bit_cast(float, w1.w << 16); u[15] = __builtin_bit_cast(float, w1.w & 0xffff0000u);
        float xr = 0.f, xi = 0.f;
#pragma unroll
        for (int c = 0; c < 16; ++c) { xr += Br[c] * u[c]; xi += Bi[c] * u[c]; }
        const float nhr = abr * hr - abi * hi + xr, nhi = abr * hi + abi * hr + xi; hr = nhr; hi = nhi;
        float ymine = 0.f;
#pragma unroll
        for (int c = 0; c < 16; ++c) { const float y = wave_sum(Cr[c] * hr - Ci[c] * hi); if ((n & 15) == c) ymine = y + dsk * u[c]; }
        if (n < 16) gb[(size_t)(row0 + t) * SSM + g * 16 + n] = (bf16_t)f2bf(gelu_tanh(ymine));
    }
    if (prompt) { out[O_SRP + ((size_t)b * NG + g) * NST + n] = hr; out[O_SIP + ((size_t)b * NG + g) * NST + n] = hi; }
    else { out[O_SRS + ((size_t)b * NG + g) * NST + n] = hr; out[O_SIS + ((size_t)b * NG + g) * NST + n] = hi; }
}

__device__ __forceinline__ void conv_row(int row, const bf16_t* vb, const float* cache, const float* w, const float* bias, const float* lg, const float* lb, bf16_t* mixb, float* out, LAS float* red, int c) {
    float y = bias[c];
    if (row < MP) { const int t = row % SEQ;
        for (int k = 0; k < CWID; ++k) { const int tt = t - 30 + k; if (tt >= 0) y += w[k * CONVD + c] * bf2f(vb[(size_t)(row - 30 + k) * CONVD + c]); }
    } else { const int rs = row - MP, b = rs / DECS, t = rs % DECS;
        for (int k = 0; k < CWID; ++k) { const int idx = t + k; const float xv = idx < 30 ? cache[((size_t)b * 30 + idx) * CONVD + c] : bf2f(vb[(size_t)(MP + b * DECS + idx - 30) * CONVD + c]); y += w[k * CONVD + c] * xv; }
        if (t == 0) for (int j = 0; j < 22; ++j) out[O_CVS + ((size_t)b * 30 + j) * CONVD + c] = cache[((size_t)b * 30 + j + 8) * CONVD + c];
    }
    float s = wave_sum(y); if ((c & 63) == 0) red[c >> 6] = s; __syncthreads();
    float mu = 0.f;
#pragma unroll
    for (int i = 0; i < 8; ++i) mu += red[i];
    mu *= (1.f / CONVD);
    const float d = y - mu; float q = wave_sum(d * d); if ((c & 63) == 0) red[8 + (c >> 6)] = q; __syncthreads();
    float var = 0.f;
#pragma unroll
    for (int i = 0; i < 8; ++i) var += red[8 + i];
    var *= (1.f / CONVD);
    const float z = d * rsqrtf(var + EPS) * lg[c] + lb[c];
    mixb[(size_t)row * D + SSM + c] = (bf16_t)f2bf(siluf_(z));
}

__device__ __forceinline__ void attn_task(int task, const bf16_t* qb, const bf16_t* kb, const bf16_t* vb2, const float* ck, const float* cv, bf16_t* ob, LAS float* scr, int t256) {
    LAS float* q = scr; LAS float* p = scr + 2048; LAS float* red = scr + 4096;
    const int rg = task >> 2, h = task & 3, row0 = rg * 8; const bool prompt = row0 < MP; const int b = prompt ? row0 / SEQ : (row0 - MP) / DECS;
#pragma unroll
    for (int r = 0; r < 8; ++r) q[r * 256 + t256] = bf2f(qb[(size_t)(row0 + r) * D + h * HD + t256]);
    __syncthreads();
    float s[8];
#pragma unroll
    for (int r = 0; r < 8; ++r) s[r] = 0.f;
    if (prompt) { const bf16_t* kr = kb + ((size_t)b * NMEM + t256) * D + h * HD;
        for (int d = 0; d < HD; d += 8) { const v4u w = *(const v4u*)(kr + d); float kv[8];
            kv[0] = __builtin_bit_cast(float, w.x << 16); kv[1] = __builtin_bit_cast(float, w.x & 0xffff0000u); kv[2] = __builtin_bit_cast(float, w.y << 16); kv[3] = __builtin_bit_cast(float, w.y & 0xffff0000u);
            kv[4] = __builtin_bit_cast(float, w.z << 16); kv[5] = __builtin_bit_cast(float, w.z & 0xffff0000u); kv[6] = __builtin_bit_cast(float, w.w << 16); kv[7] = __builtin_bit_cast(float, w.w & 0xffff0000u);
#pragma unroll
            for (int r = 0; r < 8; ++r)
#pragma unroll
                for (int j = 0; j < 8; ++j) s[r] += q[r * 256 + d + j] * kv[j]; }
    } else { const float* kr = ck + ((size_t)b * NMEM + t256) * D + h * HD;
        for (int d = 0; d < HD; d += 4) { const f32x4 kv = *(const f32x4*)(kr + d);
#pragma unroll
            for (int r = 0; r < 8; ++r) s[r] += (q[r * 256 + d] * kv.x + q[r * 256 + d + 1] * kv.y) + (q[r * 256 + d + 2] * kv.z + q[r * 256 + d + 3] * kv.w); }
    }
    const int w4 = t256 >> 6;
#pragma unroll
    for (int r = 0; r < 8; ++r) { float mx = s[r];
#pragma unroll
        for (int o = 1; o < 64; o <<= 1) mx = fmaxf(mx, __shfl_xor(mx, o));
        if ((t256 & 63) == 0) red[r * 4 + w4] = mx; }
    __syncthreads();
    float e[8];
#pragma unroll
    for (int r = 0; r < 8; ++r) { const float mx = fmaxf(fmaxf(red[r * 4], red[r * 4 + 1]), fmaxf(red[r * 4 + 2], red[r * 4 + 3])); e[r] = exp2f(s[r] - mx); }
    __syncthreads();
#pragma unroll
    for (int r = 0; r < 8; ++r) { const float sm = wave_sum(e[r]); if ((t256 & 63) == 0) red[r * 4 + w4] = sm; }
    __syncthreads();
#pragma unroll
    for (int r = 0; r < 8; ++r) { const float sm = (red[r * 4] + red[r * 4 + 1]) + (red[r * 4 + 2] + red[r * 4 + 3]); p[r * 256 + t256] = e[r] / sm; }
    __syncthreads();
    float o[8];
#pragma unroll
    for (int r = 0; r < 8; ++r) o[r] = 0.f;
    if (prompt) { const bf16_t* vr = vb2 + (size_t)b * NMEM * D + h * HD + t256;
        for (int m = 0; m < NMEM; ++m) { const float vv = bf2f(vr[(size_t)m * D]);
#pragma unroll
            for (int r = 0; r < 8; ++r) o[r] += p[r * 256 + m] * vv; }
    } else { const float* vr = cv + (size_t)b * NMEM * D + h * HD + t256;
        for (int m = 0; m < NMEM; ++m) { const float vv = vr[(size_t)m * D];
#pragma unroll
            for (int r = 0; r < 8; ++r) o[r] += p[r * 256 + m] * vv; }
    }
#pragma unroll
    for (int r = 0; r < 8; ++r) ob[(size_t)(row0 + r) * D + h * HD + t256] = (bf16_t)f2bf(o[r]);
    __syncthreads();
}
}

constexpr int NWAVES = 8;
constexpr int RING_OFF = 0, RING_BYTES = 131072;
constexpr int LDSCTL_OFF = RING_BYTES, MISC_OFF = LDSCTL_OFF + 320;
constexpr int LDS_BYTES = 147456;
constexpr size_t CTL_ZERO_BYTES = 1 * MiB;
constexpr int CW_TMO = 0, CW_CODE = 1, CW_BAR = 4096;
constexpr int MAX_LAUNCHES = 8;
static_assert((CW_BAR + MAX_LAUNCHES * XCD_BAR_WORDS) * 4 <= (int)CTL_ZERO_BYTES, "barrier words inside the memset region");

enum Phase { PH_PRO = 0, PH_GU1 = 1, PH_D1 = 2, PH_IN = 3, PH_MIX = 4, PH_GLU = 5, PH_OUT = 6, PH_Q = 7, PH_ATT = 8, PH_O = 9, PH_GU2 = 10, PH_D2 = 11, PH_FIN = 12, PH_N = 13 };

struct Args { const float* in[39]; float* out; unsigned char* ws; int ph_lo, ph_hi, li, pad; };

__global__ void __launch_bounds__(NWAVES * 64, 2) mk_fwd(Args args) {
    extern __shared__ __attribute__((aligned(16))) unsigned char lds[];
    LAS unsigned char* L = (LAS unsigned char*)lds;
    volatile LAS unsigned* MISC = (volatile LAS unsigned*)(L + MISC_OFF);
    const int tid = threadIdx.x;
    const int G = gridDim.x, bx = blockIdx.x;
    unsigned char* ws = args.ws; float* out = args.out;
    gu32* ctl = (gu32*)(ws + WS_CTL);
    for (int u = tid; u < (LDS_BYTES - LDSCTL_OFF) / 4; u += NWAVES * 64) ((LAS unsigned*)(L + LDSCTL_OFF))[u] = 0u;
    __syncthreads();
    XcdBarrier bar = xcd_barrier_post((unsigned*)(ctl + CW_BAR) + args.li * XCD_BAR_WORDS, MISC + 8);
    const int lo = args.ph_lo, hi = args.ph_hi;
#define IN(k) (lo <= (k) && (k) < hi)
#define BOTH(k) (IN(k) && IN((k) + 1))
#define GRID_BAR() xcd_barrier(bar)
    bf16_t *Wgu1 = (bf16_t*)(ws + WS_WGU1), *Wgu2 = (bf16_t*)(ws + WS_WGU2), *Wd1 = (bf16_t*)(ws + WS_WD1), *Wd2 = (bf16_t*)(ws + WS_WD2), *Win = (bf16_t*)(ws + WS_WIN), *Wglu = (bf16_t*)(ws + WS_WGLU),
           *Wout = (bf16_t*)(ws + WS_WOUT), *Wq = (bf16_t*)(ws + WS_WQ), *Wo = (bf16_t*)(ws + WS_WO), *Wkv = (bf16_t*)(ws + WS_WKV);
    bf16_t *xb = (bf16_t*)(ws + WS_XB), *memb = (bf16_t*)(ws + WS_MEMB), *kb = (bf16_t*)(ws + WS_KB), *vb2 = (bf16_t*)(ws + WS_VB2), *hb = (bf16_t*)(ws + WS_H), *ug = (bf16_t*)(ws + WS_UG),
           *vb = (bf16_t*)(ws + WS_VB), *gb = (bf16_t*)(ws + WS_GB), *mixb = (bf16_t*)(ws + WS_MIXB), *qb = (bf16_t*)(ws + WS_QB), *ob = (bf16_t*)(ws + WS_OB);
    float *ss0 = (float*)(ws + WS_SS0), *ss1 = (float*)(ws + WS_SS1), *ss2 = (float*)(ws + WS_SS2), *ss3 = (float*)(ws + WS_SS3), *ss4 = (float*)(ws + WS_SS4), *ssm = (float*)(ws + WS_SSM), *xres = (float*)(ws + WS_XRES);

    const int wave = __builtin_amdgcn_readfirstlane(tid >> 6), lane = tid & 63;
    const float* const* in = args.in;
    if (IN(PH_PRO)) {
        LAS float* scr = (LAS float*)(L + RING_OFF + wave * 16384);
        const int gw = bx * NWAVES + wave, NGW = G * NWAVES;
        constexpr int I_GU = (D / 64) * (2 * FF / 32), I_D = (FF / 64) * (D / 32), I_IN = (D / 64) * (1536 / 32), I_GLU = (SSM / 64) * (SSM / 32), I_SQ = (D / 64) * (D / 32), I_KV = (D / 64) * (2048 / 32);
        constexpr int NITEMS = 2 * I_GU + 2 * I_D + I_IN + I_GLU + 3 * I_SQ + I_KV;
        for (int it = gw; it < NITEMS; it += NGW) {
            int r = it;
            if (r < I_GU) { sb::transpose_job_item<1>(in[12], in[13], in[11], Wgu1, D, 2 * FF, FF, r, scr, lane); continue; } r -= I_GU;
            if (r < I_GU) { sb::transpose_job_item<1>(in[35], in[36], in[34], Wgu2, D, 2 * FF, FF, r, scr, lane); continue; } r -= I_GU;
            if (r < I_D) { sb::transpose_job_item<0>(in[14], nullptr, nullptr, Wd1, FF, D, D, r, scr, lane); continue; } r -= I_D;
            if (r < I_D) { sb::transpose_job_item<0>(in[37], nullptr, nullptr, Wd2, FF, D, D, r, scr, lane); continue; } r -= I_D;
            if (r < I_IN) { sb::transpose_job_item<2>(in[16], nullptr, in[15], Win, D, 1536, 1536, r, scr, lane); continue; } r -= I_IN;
            if (r < I_GLU) { sb::transpose_job_item<0>(in[25], nullptr, nullptr, Wglu, SSM, SSM, SSM, r, scr, lane); continue; } r -= I_GLU;
            if (r < I_SQ) { sb::transpose_job_item<0>(in[30], nullptr, nullptr, Wout, D, D, D, r, scr, lane); continue; } r -= I_SQ;
            if (r < I_SQ) { sb::transpose_job_item<0>(in[32], nullptr, in[31], Wq, D, D, D, r, scr, lane); continue; } r -= I_SQ;
            if (r < I_SQ) { sb::transpose_job_item<0>(in[33], nullptr, nullptr, Wo, D, D, D, r, scr, lane); continue; } r -= I_SQ;
            sb::transpose_job_item<3>(in[9], in[10], in[8], Wkv, D, 2048, D, r, scr, lane);
        }
        for (int m = gw; m < M; m += NGW) sb::row_bf16_ss(m < MP ? in[0] + (size_t)m * D : in[1] + (size_t)(m - MP) * D, xb + (size_t)m * D, ss0 + (size_t)m * 16, lane);
        for (int m = gw; m < MMEM; m += NGW) sb::row_bf16_ss(in[7] + (size_t)m * D, memb + (size_t)m * D, ssm + (size_t)m * 16, lane);
        if (BOTH(PH_PRO)) GRID_BAR();
    }

    if (IN(PH_GU1)) {
        { pg8::Gemm g{memb, Wkv, MMEM, 2048, D}; pg8::StaticOrder S; S.init(MMEM, 2048, G, bx); fx::EpiKV E{ssm, kb, vb2, out};
          pg8::gemm_phase<fx::EpiKV, pg8::StaticOrder, true, true>(L + RING_OFF, g, S, E); }
        { pg8::Gemm g{xb, Wgu1, M, 2 * FF, D}; pg8::StaticOrder S; S.init(M, 2 * FF, G, bx); fx::EpiSwiglu E{ss0, hb};
          pg8::gemm_phase<fx::EpiSwiglu, pg8::StaticOrder, true, true>(L + RING_OFF, g, S, E); }
        if (BOTH(PH_GU1)) GRID_BAR();
    }
    if (IN(PH_D1)) {
        pg8::Gemm g{hb, Wd1, M, D, FF}; pg8::StaticOrder S; S.init(M, D, G, bx); fx::EpiRes E{args.in[0], args.in[1] - (size_t)MP * D, xres, xb, ss1, 0.5f};
        pg8::gemm_phase<fx::EpiRes, pg8::StaticOrder, true, true>(L + RING_OFF, g, S, E);
        if (BOTH(PH_D1)) GRID_BAR();
    }
    if (IN(PH_IN)) {
        pg8::Gemm g{xb, Win, M, 1536, D}; pg8::StaticOrder S; S.init(M, 1536, G, bx); fx::EpiIn E{ss1, ug, vb, out};
        pg8::gemm_phase<fx::EpiIn, pg8::StaticOrder, true, true>(L + RING_OFF, g, S, E);
        if (BOTH(PH_IN)) GRID_BAR();
    }
    if (IN(PH_MIX)) {
        for (int task = wave * G + bx; task < (NBATCH + DECB) * NG; task += G * NWAVES)
            sb::s5_task(task, ug, in[2], in[3], in[17], in[18], in[19], in[20], in[21], in[22], in[23], in[24], gb, out, lane);
        __syncthreads();
        LAS float* red = (LAS float*)(L + RING_OFF);
        for (int row = bx; row < M; row += G) { sb::conv_row(row, vb, in[4], in[26], in[27], in[28], in[29], mixb, out, red, tid); __syncthreads(); }
        if (BOTH(PH_MIX)) GRID_BAR();
    }

    if (IN(PH_GLU)) {
        pg8::Gemm g{gb, Wglu, M, SSM, SSM}; pg8::StaticOrder S; S.init(M, SSM, G, bx); fx::EpiGlu E{gb, mixb};
        pg8::gemm_phase<fx::EpiGlu, pg8::StaticOrder, true, true>(L + RING_OFF, g, S, E);
        if (BOTH(PH_GLU)) GRID_BAR();
    }
    if (IN(PH_OUT)) {
        pg8::Gemm g{mixb, Wout, M, D, D}; pg8::StaticOrder S; S.init(M, D, G, bx); fx::EpiRes E{xres, xres, xres, xb, ss2, 1.f};
        pg8::gemm_phase<fx::EpiRes, pg8::StaticOrder, true, true>(L + RING_OFF, g, S, E);
        if (BOTH(PH_OUT)) GRID_BAR();
    }
    if (IN(PH_Q)) {
        pg8::Gemm g{xb, Wq, M, D, D}; pg8::StaticOrder S; S.init(M, D, G, bx); fx::EpiQ E{ss2, qb};
        pg8::gemm_phase<fx::EpiQ, pg8::StaticOrder, true, true>(L + RING_OFF, g, S, E);
        if (BOTH(PH_Q)) GRID_BAR();
    }
    if (IN(PH_ATT)) {
        const int half = tid >> 8, t256 = tid & 255;
        LAS float* scr = (LAS float*)(L + RING_OFF + half * 32768);
        constexpr int NPAIR = (M / 8) * NH / 2;
        for (int pi = bx; pi < NPAIR; pi += G) sb::attn_task(pi * 2 + half, qb, kb, vb2, in[5], in[6], ob, scr, t256);
        if (BOTH(PH_ATT)) GRID_BAR();
    }

    if (IN(PH_O)) {
        pg8::Gemm g{ob, Wo, M, D, D}; pg8::StaticOrder S; S.init(M, D, G, bx); fx::EpiRes E{xres, xres, xres, xb, ss3, 1.f};
        pg8::gemm_phase<fx::EpiRes, pg8::StaticOrder, true, true>(L + RING_OFF, g, S, E);
        if (BOTH(PH_O)) GRID_BAR();
    }
    if (IN(PH_GU2)) {
        pg8::Gemm g{xb, Wgu2, M, 2 * FF, D}; pg8::StaticOrder S; S.init(M, 2 * FF, G, bx); fx::EpiSwiglu E{ss3, hb};
        pg8::gemm_phase<fx::EpiSwiglu, pg8::StaticOrder, true, true>(L + RING_OFF, g, S, E);
        if (BOTH(PH_GU2)) GRID_BAR();
    }
    if (IN(PH_D2)) {
        pg8::Gemm g{hb, Wd2, M, D, FF}; pg8::StaticOrder S; S.init(M, D, G, bx); fx::EpiRes E{xres, xres, out + O_Y, nullptr, ss4, 0.5f};
        pg8::gemm_phase<fx::EpiRes, pg8::StaticOrder, true, true>(L + RING_OFF, g, S, E);
        if (BOTH(PH_D2)) GRID_BAR();
    }

    if (IN(PH_FIN)) {
        float* y = out + O_Y; const float* gfin = in[38];
        for (int m = bx * NWAVES + wave; m < M; m += G * NWAVES) { const float r = rstd_from_ss(ss4, m);
#pragma unroll
            for (int j = 0; j < 4; ++j) { f32x4* p = (f32x4*)(y + (size_t)m * D + j * 256 + lane * 4); const f32x4 gg = *(const f32x4*)(gfin + j * 256 + lane * 4); f32x4 v = *p; v = v * r * gg; *p = v; } }
    }
#undef IN
#undef BOTH
#undef GRID_BAR
}

#ifndef FAST_MERGE
#define FAST_MERGE 1
#endif
extern "C" void kernel_launch(void* const* d_in, const int* in_sizes, int n_in, void* d_out, int out_size, void* d_ws, size_t ws_size, hipStream_t stream) {
    if (n_in != 39 || out_size != (int)O_END || ws_size < WS_END) { fprintf(stderr, "kernel_launch: unexpected shapes n_in %d out %d ws %zu\n", n_in, out_size, ws_size); return; }
    static int grid = 0;
    if (grid == 0) {
        int dev = 0, cus = 0;
        if (hipGetDevice(&dev) != hipSuccess || hipDeviceGetAttribute(&cus, hipDeviceAttributeMultiprocessorCount, dev) != hipSuccess) { grid = -1; return; }
        if (hipFuncSetAttribute((const void*)mk_fwd, hipFuncAttributeMaxDynamicSharedMemorySize, LDS_BYTES) != hipSuccess) { fprintf(stderr, "kernel_launch: hipFuncSetAttribute failed\n"); grid = -1; return; }
        int per_cu = 0;
        if (hipOccupancyMaxActiveBlocksPerMultiprocessor(&per_cu, (const void*)mk_fwd, NWAVES * 64, LDS_BYTES) != hipSuccess || per_cu < 1) { fprintf(stderr, "kernel_launch: occupancy query says %d\n", per_cu); }
        (void)hipGetLastError();
        grid = cus;
    }
    if (grid < 0) return;
    const float* const* in = (const float* const*)d_in;
    const float *x_p = in[0], *x_s = in[1], *st_re = in[2], *st_im = in[3], *cconv = in[4], *cmk = in[5], *cmv = in[6], *memp = in[7], *g_mem = in[8], *w_k = in[9], *w_v = in[10],
                *g_ffn1 = in[11], *w1g = in[12], *w1u = in[13], *w1d = in[14], *g_mix = in[15], *w_in = in[16], *a_re = in[17], *a_im = in[18], *log_dt = in[19], *b_re = in[20], *b_im = in[21],
                *c_re = in[22], *c_im = in[23], *ssm_d = in[24], *w_glu = in[25], *conv_w = in[26], *conv_b = in[27], *ln_g = in[28], *ln_b = in[29], *w_out = in[30], *g_xattn = in[31],
                *w_q = in[32], *w_o = in[33], *g_ffn2 = in[34], *w2g = in[35], *w2u = in[36], *w2d = in[37], *g_final = in[38];
    (void)x_p; (void)x_s;
    unsigned char* ws = (unsigned char*)d_ws; float* out = (float*)d_out;
    bf16_t *Wgu1 = (bf16_t*)(ws + WS_WGU1), *Wgu2 = (bf16_t*)(ws + WS_WGU2), *Wd1 = (bf16_t*)(ws + WS_WD1), *Wd2 = (bf16_t*)(ws + WS_WD2), *Win = (bf16_t*)(ws + WS_WIN), *Wglu = (bf16_t*)(ws + WS_WGLU),
           *Wout = (bf16_t*)(ws + WS_WOUT), *Wq = (bf16_t*)(ws + WS_WQ), *Wo = (bf16_t*)(ws + WS_WO), *Wkv = (bf16_t*)(ws + WS_WKV);
    bf16_t *xb = (bf16_t*)(ws + WS_XB), *memb = (bf16_t*)(ws + WS_MEMB), *kb = (bf16_t*)(ws + WS_KB), *vb2 = (bf16_t*)(ws + WS_VB2), *ug = (bf16_t*)(ws + WS_UG),
           *vb = (bf16_t*)(ws + WS_VB), *gb = (bf16_t*)(ws + WS_GB), *mixb = (bf16_t*)(ws + WS_MIXB), *qb = (bf16_t*)(ws + WS_QB), *ob = (bf16_t*)(ws + WS_OB);
    float *ss0 = (float*)(ws + WS_SS0), *ss4 = (float*)(ws + WS_SS4), *ssm = (float*)(ws + WS_SSM);

    if (hipMemsetAsync(ws + WS_CTL, 0, CTL_ZERO_BYTES, stream) != hipSuccess) return;
    Args a{};
    for (int i = 0; i < 39; ++i) a.in[i] = in[i];
    a.out = out; a.ws = ws;
    int li = 0;
    auto run = [&](int lo, int hi) {
        if (FAST_MERGE) { a.ph_lo = lo; a.ph_hi = hi; a.li = li++; hipLaunchKernelGGL(mk_fwd, dim3(grid), dim3(NWAVES * 64), LDS_BYTES, stream, a); }
        else for (int p = lo; p < hi; ++p) { a.ph_lo = p; a.ph_hi = p + 1; a.li = li; hipLaunchKernelGGL(mk_fwd, dim3(grid), dim3(NWAVES * 64), LDS_BYTES, stream, a); }
    };

    run(PH_PRO, PH_N);
}
```

```cpp
#include <hip/hip_runtime.h>
#include <cstdint>
#include <cstdio>

typedef unsigned short bf16_t;
typedef float f32x4 __attribute__((ext_vector_type(4)));

constexpr int D = 1024, FF = 2816, MP = 16384, MS = 1024, M = MP + MS;
constexpr int SEQ = 2048, DECB = 128, DECS = 8, NBATCH = 8;
constexpr int SSM = 512, CONVD = 512, NG = 32, GC = 16, NST = 64, CWID = 31, NMEM = 256, NH = 4, HD = 256;
constexpr int MMEM = NBATCH * NMEM;
constexpr float EPS = 1e-6f;
constexpr float QSCALE = 0.0625f * 1.4426950408889634f;

constexpr size_t O_Y = 0;
constexpr size_t O_SRP = (size_t)M * D;
constexpr size_t O_SIP = O_SRP + 16384;
constexpr size_t O_CVP = O_SIP + 16384;
constexpr size_t O_MKP = O_CVP + 122880;
constexpr size_t O_MVP = O_MKP + 2097152;
constexpr size_t O_SRS = O_MVP + 2097152;
constexpr size_t O_SIS = O_SRS + 262144;
constexpr size_t O_CVS = O_SIS + 262144;
constexpr size_t O_END = O_CVS + 1966080;

constexpr size_t MiB = 1u << 20;
constexpr size_t WS_CTL = 0;
constexpr size_t WS_WGU1 = 2 * MiB, WS_WGU2 = 13 * MiB, WS_WD1 = 24 * MiB, WS_WD2 = 30 * MiB, WS_WIN = 36 * MiB, WS_WGLU = 39 * MiB,
                 WS_WOUT = 40 * MiB, WS_WQ = 42 * MiB, WS_WO = 44 * MiB, WS_WKV = 46 * MiB;
constexpr size_t WS_TAB = 50 * MiB;
constexpr size_t WS_XB = 72 * MiB, WS_MEMB = 106 * MiB, WS_KB = 110 * MiB, WS_VB2 = 114 * MiB;
constexpr size_t WS_SS0 = 118 * MiB, WS_SS1 = 120 * MiB, WS_SS2 = 122 * MiB, WS_SS3 = 124 * MiB, WS_SS4 = 126 * MiB, WS_SSM = 127 * MiB + 512 * 1024;
constexpr size_t WS_XRES = 128 * MiB, WS_H = 196 * MiB, WS_UG = 290 * MiB, WS_VB = 307 * MiB, WS_GB = 324 * MiB, WS_MIXB = 342 * MiB,
                 WS_QB = 376 * MiB, WS_OB = 410 * MiB, WS_END = 444 * MiB;

__device__ __forceinline__ unsigned f2bf(float f) { unsigned u = __builtin_bit_cast(unsigned, f); return (u + 0x7fffu + ((u >> 16) & 1u)) >> 16; }
__device__ __forceinline__ float bf2f(bf16_t b) { return __builtin_bit_cast(float, (unsigned)b << 16); }
__device__ __forceinline__ float sigmoidf_(float x) { return 1.f / (1.f + __expf(-x)); }
__device__ __forceinline__ float siluf_(float x) { return x * sigmoidf_(x); }
__device__ __forceinline__ float gelu_tanh(float x) { const float u = 0.7978845608028654f * (x + 0.044715f * x * x * x); return 0.5f * x * (1.f + tanhf(u)); }
__device__ __forceinline__ float wave_sum(float v) {
#pragma unroll
    for (int o = 1; o < 64; o <<= 1) v += __shfl_xor(v, o);
    return v;
}
__device__ __forceinline__ float rstd_from_ss(const float* ss, int row) {
    float s = 0.f;
#pragma unroll
    for (int i = 0; i < 16; ++i) s += ss[(size_t)row * 16 + i];
    return rsqrtf(s * (1.f / D) + EPS);
}

template <int MAP>
__global__ void k_wt(const float* W0, const float* W1, const float* gain, bf16_t* WT, int K, int N, int ldw) {
    __shared__ float tile[32][33];
    const int n0 = blockIdx.x * 32, k0 = blockIdx.y * 32, tx = threadIdx.x & 31, ty = threadIdx.x >> 5;
    const float* W = W0; int c0 = n0;
    if (MAP == 1) { const int pn = n0 / 256, half = (n0 % 256) / 128, jj = n0 % 128; W = half ? W1 : W0; c0 = pn * 128 + jj; }
    if (MAP == 2) { if (n0 >= 512) { const int m = n0 - 512, pc = m / 256, half = (m % 256) / 128, jj = m % 128; c0 = 512 + half * 512 + pc * 128 + jj; } }
    if (MAP == 3) { if (n0 >= 1024) { W = W1; c0 = n0 - 1024; } }
    for (int i = ty; i < 32; i += 8) { const int k = k0 + i; tile[i][tx] = W[(size_t)k * ldw + c0 + tx] * (gain ? gain[k] : 1.f); }
    __syncthreads();
    for (int i = ty; i < 32; i += 8) WT[(size_t)(n0 + i) * K + k0 + tx] = (bf16_t)f2bf(tile[tx][i]);
}
__global__ void k_rows_bf16_ss(const float* x0, int rows0, const float* x1, int rows1, bf16_t* xb, float* ss) {
    const int row = blockIdx.x * 4 + (threadIdx.x >> 6), lane = threadIdx.x & 63;
    if (row >= rows0 + rows1) return;
    const float* xr = row < rows0 ? x0 + (size_t)row * D : x1 + (size_t)(row - rows0) * D;
    float s = 0.f;
    for (int j = 0; j < 4; ++j) { const f32x4 v = *(const f32x4*)(xr + j * 256 + lane * 4); s += v.x * v.x + v.y * v.y + v.z * v.z + v.w * v.w;
        uint2 o; o.x = f2bf(v.x) | (f2bf(v.y) << 16); o.y = f2bf(v.z) | (f2bf(v.w) << 16); *(uint2*)(xb + (size_t)row * D + j * 256 + lane * 4) = o; }
    s = wave_sum(s);
    if (lane < 16) ss[(size_t)row * 16 + lane] = lane == 0 ? s : 0.f;
}
__global__ void k_rows_ss(const float* x, int rows, float* ss) {
    const int row = blockIdx.x * 4 + (threadIdx.x >> 6), lane = threadIdx.x & 63;
    if (row >= rows) return;
    float s = 0.f;
    for (int j = 0; j < 4; ++j) { const f32x4 v = *(const f32x4*)(x + (size_t)row * D + j * 256 + lane * 4); s += v.x * v.x + v.y * v.y + v.z * v.z + v.w * v.w; }
    s = wave_sum(s);
    if (lane < 16) ss[(size_t)row * 16 + lane] = lane == 0 ? s : 0.f;
}

enum { E_KV = 1, E_SWIGLU = 2, E_RES = 3, E_U = 4, E_V = 5, E_GLU = 6, E_Q = 7 };
struct EpiP {
    const float* ss;
    const float* resin;
    float* resout;
    bf16_t* ob;
    bf16_t* ob2;
    const bf16_t* gb;
    float* out;
    float alpha;
    int pad;
};
template <int MODE>
__device__ __forceinline__ void epi_elem(const EpiP& P, int row, int c, float a0, float a1, float rstd) {
    if (MODE == E_KV) {
        const float v = a0 * rstd;
        if (c < 1024) { P.out[O_MKP + (size_t)row * 1024 + c] = v; P.ob[(size_t)row * 1024 + c] = (bf16_t)f2bf(v); }
        else { P.out[O_MVP + (size_t)row * 1024 + c - 1024] = v; P.ob2[(size_t)row * 1024 + c - 1024] = (bf16_t)f2bf(v); }
    } else if (MODE == E_SWIGLU) {
        const float g = a0 * rstd, u = a1 * rstd; P.ob[(size_t)row * FF + c] = (bf16_t)f2bf(siluf_(g) * u);
    } else if (MODE == E_RES) {
        const float v = P.resin[(size_t)row * D + c] + P.alpha * a0; P.resout[(size_t)row * D + c] = v; if (P.ob) P.ob[(size_t)row * D + c] = (bf16_t)f2bf(v);
    } else if (MODE == E_U) {
        P.ob[((size_t)(c >> 4) * M + row) * 16 + (c & 15)] = (bf16_t)f2bf(a0 * rstd);
    } else if (MODE == E_V) {
        const float v = (a0 * rstd) * sigmoidf_(a1 * rstd); P.ob[(size_t)row * CONVD + c] = (bf16_t)f2bf(v);
        if (row < MP) { const int b = row / SEQ, t = row % SEQ; if (t >= SEQ - 30) P.out[O_CVP + ((size_t)b * 30 + (t - (SEQ - 30))) * CONVD + c] = v; }
        else { const int rs = row - MP, b = rs / DECS, t = rs % DECS; P.out[O_CVS + ((size_t)b * 30 + 22 + t) * CONVD + c] = v; }
    } else if (MODE == E_GLU) {
        const float g = bf2f(P.gb[(size_t)row * SSM + c]); P.ob[(size_t)row * D + c] = (bf16_t)f2bf(g * sigmoidf_(a0));
    } else if (MODE == E_Q) {
        P.ob[(size_t)row * D + c] = (bf16_t)f2bf(a0 * rstd * QSCALE);
    }
}
template <int MODE> struct ModeTraits { static constexpr bool PAIRED = (MODE == E_SWIGLU || MODE == E_V); static constexpr bool RSTD = (MODE == E_KV || MODE == E_SWIGLU || MODE == E_U || MODE == E_V || MODE == E_Q); };

template <int MODE>
__global__ void __launch_bounds__(256) k_ref_gemm(const bf16_t* A, const bf16_t* BT, int K, EpiP P) {
    constexpr bool PAIRED = ModeTraits<MODE>::PAIRED;
    __shared__ float As[32][65], B0[32][65], B1[PAIRED ? 32 : 1][65];
    const int tid = threadIdx.x, tx = tid & 15, ty = tid >> 4;
    const int m0 = blockIdx.y * 64, p0 = blockIdx.x * 64;
    const int cb0 = PAIRED ? (p0 / 128) * 256 + (p0 % 128) : p0;
    float acc0[4][4], acc1[4][4];
    for (int i = 0; i < 4; ++i) for (int j = 0; j < 4; ++j) { acc0[i][j] = 0.f; acc1[i][j] = 0.f; }
    for (int k0 = 0; k0 < K; k0 += 32) {
        for (int e = tid; e < 64 * 32; e += 256) { const int r = e >> 5, k = e & 31;
            As[k][r] = bf2f(A[(size_t)(m0 + r) * K + k0 + k]); B0[k][r] = bf2f(BT[(size_t)(cb0 + r) * K + k0 + k]);
            if (PAIRED) B1[k][r] = bf2f(BT[(size_t)(cb0 + 128 + r) * K + k0 + k]); }
        __syncthreads();
        for (int k = 0; k < 32; ++k) {
            float a[4], b0[4], b1[4];
            for (int i = 0; i < 4; ++i) a[i] = As[k][ty * 4 + i];
            for (int j = 0; j < 4; ++j) { b0[j] = B0[k][tx * 4 + j]; b1[j] = PAIRED ? B1[k][tx * 4 + j] : 0.f; }
            for (int i = 0; i < 4; ++i) for (int j = 0; j < 4; ++j) { acc0[i][j] += a[i] * b0[j]; if (PAIRED) acc1[i][j] += a[i] * b1[j]; }
        }
        __syncthreads();
    }
    for (int i = 0; i < 4; ++i) { const int row = m0 + ty * 4 + i; const float rstd = ModeTraits<MODE>::RSTD ? rstd_from_ss(P.ss, row) : 1.f;
        for (int j = 0; j < 4; ++j) epi_elem<MODE>(P, row, p0 + tx * 4 + j, acc0[i][j], acc1[i][j], rstd); }
}

__global__ void __launch_bounds__(64) k_ref_s5(const bf16_t* ug, const float* h0re, const float* h0im, const float* a_re, const float* a_im, const float* log_dt,
                                               const float* b_re, const float* b_im, const float* c_re, const float* c_im, const float* dskip, bf16_t* gb, float* out) {
    const int g = blockIdx.x % NG, sq = blockIdx.x / NG, n = threadIdx.x;
    const bool prompt = sq < NBATCH; const int b = prompt ? sq : sq - NBATCH, T = prompt ? SEQ : DECS, row0 = prompt ? b * SEQ : MP + b * DECS;
    const float dt = expf(log_dt[g]), lr = a_re[g * NST + n], li = a_im[g * NST + n];
    const float mag = expf(lr * dt), abr = mag * cosf(li * dt), abi = mag * sinf(li * dt);
    const float den = lr * lr + li * li, nr = abr - 1.f, ni = abi, cr = (nr * lr + ni * li) / den, ci = (ni * lr - nr * li) / den;
    float Br[16], Bi[16], Cr[16], Ci[16];
    for (int c = 0; c < 16; ++c) { const float br = b_re[((size_t)g * NST + n) * 16 + c], bi = b_im[((size_t)g * NST + n) * 16 + c];
        Br[c] = cr * br - ci * bi; Bi[c] = cr * bi + ci * br; Cr[c] = c_re[((size_t)g * 16 + c) * NST + n]; Ci[c] = c_im[((size_t)g * 16 + c) * NST + n]; }
    float hr = 0.f, hi = 0.f;
    if (!prompt) { hr = h0re[((size_t)b * NG + g) * NST + n]; hi = h0im[((size_t)b * NG + g) * NST + n]; }
    const float dsk = dskip[g * 16 + (n & 15)];
    for (int t = 0; t < T; ++t) {
        const bf16_t* up = ug + ((size_t)g * M + row0 + t) * 16;
        float u[16], xr = 0.f, xi = 0.f;
#pragma unroll
        for (int c = 0; c < 16; ++c) { u[c] = bf2f(up[c]); xr += Br[c] * u[c]; xi += Bi[c] * u[c]; }
        const float nhr = abr * hr - abi * hi + xr, nhi = abr * hi + abi * hr + xi; hr = nhr; hi = nhi;
        float ymine = 0.f;
#pragma unroll
        for (int c = 0; c < 16; ++c) { const float y = wave_sum(Cr[c] * hr - Ci[c] * hi); if ((n & 15) == c) ymine = y + dsk * u[c]; }
        if (n < 16) gb[(size_t)(row0 + t) * SSM + g * 16 + n] = (bf16_t)f2bf(gelu_tanh(ymine));
    }
    if (prompt) { out[O_SRP + ((size_t)b * NG + g) * NST + n] = hr; out[O_SIP + ((size_t)b * NG + g) * NST + n] = hi; }
    else { out[O_SRS + ((size_t)b * NG + g) * NST + n] = hr; out[O_SIS + ((size_t)b * NG + g) * NST + n] = hi; }
}

__global__ void __launch_bounds__(512) k_ref_conv(const bf16_t* vb, const float* cache, const float* w, const float* bias, const float* lg, const float* lb, bf16_t* mixb, float* out) {
    __shared__ float red[2][8];
    const int row = blockIdx.x, c = threadIdx.x;
    float y = bias[c];
    if (row < MP) { const int t = row % SEQ;
        for (int k = 0; k < CWID; ++k) { const int tt = t - 30 + k; if (tt >= 0) y += w[k * CONVD + c] * bf2f(vb[(size_t)(row - 30 + k) * CONVD + c]); }
    } else { const int rs = row - MP, b = rs / DECS, t = rs % DECS;
        for (int k = 0; k < CWID; ++k) { const int idx = t + k; const float xv = idx < 30 ? cache[((size_t)b * 30 + idx) * CONVD + c] : bf2f(vb[(size_t)(MP + b * DECS + idx - 30) * CONVD + c]); y += w[k * CONVD + c] * xv; }
        if (t == 0) for (int j = 0; j < 22; ++j) out[O_CVS + ((size_t)b * 30 + j) * CONVD + c] = cache[((size_t)b * 30 + j + 8) * CONVD + c];
    }
    float s = wave_sum(y); if ((c & 63) == 0) red[0][c >> 6] = s; __syncthreads();
    float mu = 0.f; for (int i = 0; i < 8; ++i) mu += red[0][i]; mu *= (1.f / CONVD);
    const float d = y - mu; float q = wave_sum(d * d); if ((c & 63) == 0) red[1][c >> 6] = q; __syncthreads();
    float var = 0.f; for (int i = 0; i < 8; ++i) var += red[1][i]; var *= (1.f / CONVD);
    const float z = d * rsqrtf(var + EPS) * lg[c] + lb[c];
    mixb[(size_t)row * D + SSM + c] = (bf16_t)f2bf(siluf_(z));
}

__global__ void __launch_bounds__(256) k_ref_attn(const bf16_t* qb, const bf16_t* kb, const bf16_t* vb2, const float* ck, const float* cv, bf16_t* ob) {
    __shared__ float q[256], p[256], red[4];
    const int row = blockIdx.x >> 2, h = blockIdx.x & 3, tid = threadIdx.x;
    q[tid] = bf2f(qb[(size_t)row * D + h * HD + tid]);
    __syncthreads();
    float s = 0.f;
    if (row < MP) { const int b = row / SEQ; const bf16_t* kr = kb + ((size_t)b * NMEM + tid) * D + h * HD; for (int d = 0; d < HD; ++d) s += q[d] * bf2f(kr[d]); }
    else { const int b = (row - MP) / DECS; const float* kr = ck + ((size_t)b * NMEM + tid) * D + h * HD; for (int d = 0; d < HD; ++d) s += q[d] * kr[d]; }
    float mx = s; for (int o = 1; o < 64; o <<= 1) mx = fmaxf(mx, __shfl_xor(mx, o));
    if ((tid & 63) == 0) red[tid >> 6] = mx; __syncthreads();
    mx = fmaxf(fmaxf(red[0], red[1]), fmaxf(red[2], red[3])); __syncthreads();
    const float e = exp2f(s - mx); float sm = wave_sum(e);
    if ((tid & 63) == 0) red[tid >> 6] = sm; __syncthreads();
    sm = red[0] + red[1] + red[2] + red[3];
    p[tid] = e / sm; __syncthreads();
    float o = 0.f;
    if (row < MP) { const int b = row / SEQ; const bf16_t* vr = vb2 + (size_t)b * NMEM * D + h * HD + tid; for (int m = 0; m < NMEM; ++m) o += p[m] * bf2f(vr[(size_t)m * D]); }
    else { const int b = (row - MP) / DECS; const float* vr = cv + (size_t)b * NMEM * D + h * HD + tid; for (int m = 0; m < NMEM; ++m) o += p[m] * vr[(size_t)m * D]; }
    ob[(size_t)row * D + h * HD + tid] = (bf16_t)f2bf(o);
}

__global__ void k_final(float* y, const float* ss, const float* g) {
    const int row = blockIdx.x * 4 + (threadIdx.x >> 6), lane = threadIdx.x & 63;
    const float r = rstd_from_ss(ss, row);
    for (int j = 0; j < 4; ++j) { f32x4* p = (f32x4*)(y + (size_t)row * D + j * 256 + lane * 4); const f32x4 gg = *(const f32x4*)(g + j * 256 + lane * 4); f32x4 v = *p; v = v * r * gg; *p = v; }
}


namespace pg8 {
#define PG8_LAS __attribute__((address_space(3)))
typedef unsigned short bf16_t;
typedef short bf16x8 __attribute__((ext_vector_type(8)));
typedef float f32x4 __attribute__((ext_vector_type(4)));
typedef unsigned u32x4 __attribute__((ext_vector_type(4)));
constexpr int BM = 256, BK = 64, HALF = 128, HTB = HALF * BK * 2  , STAGE_BYTES = 8 * HTB, NXCD = 8, WGM = 8;

__host__ __device__ __forceinline__ int lds_byte(int r, int c) { const int st = (r >> 4) * 2 + (c >> 5), rr = r & 15, cc = c & 31, ob = rr * 64 + cc * 2; return st * 1024 + (ob ^ (((ob >> 9) & 1) << 5)); }
__host__ __device__ __forceinline__ void stage_rc(int b, int& R, int& C) { const int st = b / 1024, sb = b % 1024, swz = sb ^ (((sb >> 9) & 1) << 5); R = (st >> 1) * 16 + swz / 64; C = (st & 1) * 32 + (swz % 64) / 2; }
__host__ __device__ __forceinline__ int perm32(int rho) { const int n = rho >> 4, i = rho & 15; return 8 * (i >> 2) + 4 * n + (i & 3); }

struct Unit { int pm, pn; };
struct Gemm { const bf16_t* A; const bf16_t* Bt; int M, N, K; };

struct StaticOrder {
    int nM, nN, nwg, G, c;
    __host__ __device__ void init(int M, int N, int G_, int c_) { nM = M / BM; nN = N / BM; nwg = nM * nN; G = G_; c = c_; }
    __host__ __device__ bool next(int i, Unit& u) const {
        const long L = (long)i * G + c; if (L >= nwg) return false;
        int wgid = (int)L; { const int q = nwg / NXCD, r = nwg % NXCD, xcd = wgid % NXCD, off = wgid / NXCD; wgid = (xcd < r ? xcd * (q + 1) : r * (q + 1) + (xcd - r) * q) + off; }
        const int nig = WGM * nN, gid = wgid / nig, fm = gid * WGM, gsz = (nM - fm) < WGM ? (nM - fm) : WGM;
        u.pm = fm + ((wgid % nig) % gsz); u.pn = (wgid % nig) / gsz; return true;
    }
    __device__ __forceinline__ void a_ready(const Unit&) const {}
    __device__ __forceinline__ void done(const Unit&) const {}
};
__device__ __forceinline__ unsigned cvt_pk_bf16(float lo, float hi) { unsigned r; asm volatile("v_cvt_pk_bf16_f32 %0, %1, %2" : "=v"(r) : "v"(lo), "v"(hi)); return r; }
typedef float f32x2 __attribute__((ext_vector_type(2)));
template <class Epi, class Sched, bool ALIGN_EPI = false, bool SP2 = false>
__device__ __forceinline__ void gemm_phase(PG8_LAS unsigned char* lds, const Gemm g, const Sched& S, const Epi& E) {
    const int tid = threadIdx.x, wid = __builtin_amdgcn_readfirstlane(tid >> 6), lane = tid & 63, wr = wid >> 2, wc = wid & 3, fr = lane & 15, fq = lane >> 4;
    const int K = g.K, nt = K / BK;
    unsigned voffA[2], voffB[2];
#pragma unroll
    for (int i = 0; i < 2; ++i) { int R, C; stage_rc(tid * 16 + i * 8192, R, C); const int Rb = Epi::PERM ? ((R & ~31) + perm32(R & 31)) : R;
        voffA[i] = (unsigned)(R * K + C) * 2u; voffB[i] = (unsigned)(Rb * K + C) * 2u; }
    const size_t kstep = (size_t)(BK * 2);
    const size_t hstep = (size_t)HALF * K * 2;
    const size_t tstep = 2 * hstep;
    const unsigned ldsw = (unsigned)wid * 1024u;
    const int aoff = lds_byte(wr * 64 + fr, fq * 8), boff = lds_byte(wc * 32 + fr, fq * 8);
#define PG8_SA(b, h) (((b) * 2 + (h)) * HTB)
#define PG8_SB(b, h) ((4 + (b) * 2 + (h)) * HTB)
#define PG8_STAGE(bufoff, gbase, voff) do { _Pragma("unroll") for (int _i = 0; _i < 2; ++_i) \
        __builtin_amdgcn_global_load_lds((const unsigned*)((const char*)(gbase) + (voff)[_i]), (PG8_LAS unsigned*)(lds + (bufoff) + ldsw + _i * 8192), 16, 0, 0); } while (0)
#define PG8_LDA(dst, b, h) do { _Pragma("unroll") for (int m = 0; m < 4; ++m) _Pragma("unroll") for (int k = 0; k < 2; ++k) dst[m][k] = *(const PG8_LAS bf16x8*)(lds + PG8_SA(b, h) + aoff + m * 2048 + k * 1024); } while (0)
#define PG8_LDB(dst, b, h) do { _Pragma("unroll") for (int n = 0; n < 2; ++n) _Pragma("unroll") for (int k = 0; k < 2; ++k) dst[n][k] = *(const PG8_LAS bf16x8*)(lds + PG8_SB(b, h) + boff + n * 2048 + k * 1024); } while (0)
#define PG8_MMA(ai, bj, At, Bt) do { __builtin_amdgcn_s_setprio(1); _Pragma("unroll") for (int m = 0; m < 4; ++m) _Pragma("unroll") for (int n = 0; n < 2; ++n) _Pragma("unroll") for (int k = 0; k < 2; ++k) \
        acc[ai][bj][m][n] = __builtin_amdgcn_mfma_f32_16x16x32_bf16(Bt[n][k], At[m][k], acc[ai][bj][m][n], 0, 0, 0); __builtin_amdgcn_s_setprio(0); } while (0)
#define PG8_WAIT_V(n) asm volatile("s_waitcnt vmcnt(" #n ")" ::: "memory")
#define PG8_WAIT_L(n) asm volatile("s_waitcnt lgkmcnt(" #n ")" ::: "memory")
#define PG8_BAR __builtin_amdgcn_s_barrier()
#define PG8_SCHED __builtin_amdgcn_sched_barrier(0)
    Unit cur, nxt; int ui = 0;
    if (!S.next(0, cur)) return;
    f32x4 acc[2][2][4][2];
#pragma unroll
    for (int a = 0; a < 2; ++a)
#pragma unroll
        for (int b = 0; b < 2; ++b)
#pragma unroll
            for (int m = 0; m < 4; ++m)
#pragma unroll
                for (int n = 0; n < 2; ++n) acc[a][b][m][n] = (f32x4){0.f, 0.f, 0.f, 0.f};
    bf16x8 At[4][2], B0[2][2], B1[2][2];
    const char* cA = (const char*)g.A + (size_t)cur.pm * tstep; const char* cB = (const char*)g.Bt + (size_t)cur.pn * tstep;
    S.a_ready(cur);
    if constexpr (SP2) {
        PG8_STAGE(PG8_SB(0, 0), cB, voffB); PG8_STAGE(PG8_SB(0, 1), cB + hstep, voffB); PG8_STAGE(PG8_SA(0, 0), cA, voffA); PG8_STAGE(PG8_SA(0, 1), cA + hstep, voffA);
        if (wr == 1) PG8_BAR;
        PG8_WAIT_V(2); PG8_BAR;
        PG8_STAGE(PG8_SB(1, 0), cB + kstep, voffB); PG8_STAGE(PG8_SA(1, 0), cA + kstep, voffA); PG8_STAGE(PG8_SB(1, 1), cB + hstep + kstep, voffB);
        PG8_WAIT_V(6); PG8_BAR;
    } else {
        PG8_STAGE(PG8_SB(0, 0), cB, voffB); PG8_STAGE(PG8_SA(0, 0), cA, voffA); PG8_STAGE(PG8_SB(0, 1), cB + hstep, voffB); PG8_STAGE(PG8_SA(0, 1), cA + hstep, voffA);
        if (wr == 1) PG8_BAR;
        PG8_WAIT_V(4); PG8_BAR;
        PG8_STAGE(PG8_SB(1, 0), cB + kstep, voffB); PG8_STAGE(PG8_SA(1, 0), cA + kstep, voffA); PG8_STAGE(PG8_SB(1, 1), cB + hstep + kstep, voffB);
        PG8_WAIT_V(6); PG8_BAR;
    }
    for (;;) {
        const bool has_next = S.next(ui + 1, nxt);
        const char* nA = has_next ? (const char*)g.A + (size_t)nxt.pm * tstep : cA; const char* nB = has_next ? (const char*)g.Bt + (size_t)nxt.pn * tstep : cB;
        for (int t = 0; t < nt; t += 2) {
            const bool last = (t == nt - 2);
            const char* a1 = cA + (size_t)(t + 1) * kstep;
            const char* a2 = last ? nA : cA + (size_t)(t + 2) * kstep; const char* b2 = last ? nB : cB + (size_t)(t + 2) * kstep;
            const char* a3 = a2 + kstep; const char* b3 = b2 + kstep;
            if (last && has_next) S.a_ready(nxt);
            if constexpr (SP2) {
            PG8_LDB(B0, 0, 0); PG8_LDB(B1, 0, 1); PG8_SCHED; PG8_LDA(At, 0, 0); PG8_STAGE(PG8_SA(1, 1), a1 + hstep, voffA);
            PG8_WAIT_V(8); PG8_WAIT_L(0); PG8_BAR; PG8_MMA(0, 0, At, B0); PG8_MMA(0, 1, At, B1); PG8_BAR; PG8_SCHED;
            PG8_LDA(At, 0, 1); PG8_STAGE(PG8_SB(0, 0), b2, voffB); PG8_STAGE(PG8_SB(0, 1), b2 + hstep, voffB); PG8_STAGE(PG8_SA(0, 0), a2, voffA);
            PG8_WAIT_V(8); PG8_WAIT_L(0); PG8_BAR; PG8_MMA(1, 0, At, B0); PG8_MMA(1, 1, At, B1); PG8_BAR; PG8_SCHED;
            PG8_LDB(B0, 1, 0); PG8_LDB(B1, 1, 1); PG8_SCHED; PG8_LDA(At, 1, 0); PG8_STAGE(PG8_SA(0, 1), a2 + hstep, voffA);
            PG8_WAIT_V(8); PG8_WAIT_L(0); PG8_BAR; PG8_MMA(0, 0, At, B0); PG8_MMA(0, 1, At, B1); PG8_BAR; PG8_SCHED;
            PG8_LDA(At, 1, 1); PG8_STAGE(PG8_SB(1, 0), b3, voffB); PG8_STAGE(PG8_SB(1, 1), b3 + hstep, voffB); PG8_STAGE(PG8_SA(1, 0), a3, voffA);
            PG8_WAIT_V(8); PG8_WAIT_L(0); PG8_BAR; PG8_MMA(1, 0, At, B0); PG8_MMA(1, 1, At, B1); PG8_BAR; PG8_SCHED;
            } else {
            PG8_LDB(B0, 0, 0); PG8_SCHED; PG8_LDA(At, 0, 0); PG8_STAGE(PG8_SA(1, 1), a1 + hstep, voffA);
            PG8_WAIT_L(8); PG8_BAR; PG8_WAIT_L(0); PG8_MMA(0, 0, At, B0); PG8_BAR; PG8_SCHED;
            PG8_LDB(B1, 0, 1); PG8_STAGE(PG8_SB(0, 0), b2, voffB);
            PG8_BAR; PG8_WAIT_L(0); PG8_MMA(0, 1, At, B1); PG8_BAR;
            PG8_LDA(At, 0, 1); PG8_STAGE(PG8_SA(0, 0), a2, voffA);
            PG8_BAR; PG8_WAIT_L(0); PG8_MMA(1, 0, At, B0); PG8_BAR; PG8_SCHED;
            PG8_STAGE(PG8_SB(0, 1), b2 + hstep, voffB);
            PG8_WAIT_V(6); PG8_BAR; PG8_MMA(1, 1, At, B1); PG8_BAR;
            PG8_LDB(B0, 1, 0); PG8_SCHED; PG8_LDA(At, 1, 0); PG8_STAGE(PG8_SA(0, 1), a2 + hstep, voffA);
            PG8_WAIT_L(8); PG8_BAR; PG8_WAIT_L(0); PG8_MMA(0, 0, At, B0); PG8_BAR; PG8_SCHED;
            PG8_LDB(B1, 1, 1); PG8_STAGE(PG8_SB(1, 0), b3, voffB);
            PG8_BAR; PG8_WAIT_L(0); PG8_MMA(0, 1, At, B1); PG8_BAR;
            PG8_LDA(At, 1, 1); PG8_STAGE(PG8_SA(1, 0), a3, voffA);
            PG8_BAR; PG8_WAIT_L(0); PG8_MMA(1, 0, At, B0); PG8_BAR; PG8_SCHED;
            PG8_STAGE(PG8_SB(1, 1), b3 + hstep, voffB);
            PG8_WAIT_V(6); PG8_BAR; PG8_MMA(1, 1, At, B1); PG8_BAR;
            }
        }
        if constexpr (ALIGN_EPI) { if (wr == 0) PG8_BAR; }
        if constexpr (!Epi::AFTER_DRAIN) { E(acc, cur, wr, wc, fr, fq); S.done(cur); }
        if (!has_next) break;
#pragma unroll
        for (int a = 0; a < 2; ++a)
#pragma unroll
            for (int b = 0; b < 2; ++b)
#pragma unroll
                for (int m = 0; m < 4; ++m)
#pragma unroll
                    for (int n = 0; n < 2; ++n) acc[a][b][m][n] = (f32x4){0.f, 0.f, 0.f, 0.f};
        cur = nxt; cA = nA; cB = nB; ++ui;
        if constexpr (ALIGN_EPI) { if (wr == 1) PG8_BAR; }
    }
    PG8_WAIT_V(0);
    if constexpr (!ALIGN_EPI) { if (wr == 0) PG8_BAR; }
    PG8_BAR;
    if constexpr (Epi::AFTER_DRAIN) { E.fused(acc, cur, wr, wc, fr, fq, lds, wid, lane); S.done(cur); }
#undef PG8_SA
#undef PG8_SB
#undef PG8_STAGE
#undef PG8_LDA
#undef PG8_LDB
#undef PG8_MMA
#undef PG8_WAIT_V
#undef PG8_WAIT_L
#undef PG8_BAR
#undef PG8_SCHED
}
}

namespace fx {
using pg8::f32x4; using pg8::u32x4; using pg8::Unit; using pg8::HALF; using pg8::BM; using pg8::cvt_pk_bf16;
__device__ __forceinline__ float rstd_row(const float* ss, int row) {
    const f32x4* p = (const f32x4*)(ss + (size_t)row * 16); const f32x4 a = p[0], b = p[1], c = p[2], d = p[3];
    const float s = ((a.x + a.y) + (a.z + a.w)) + ((b.x + b.y) + (b.z + b.w)) + ((c.x + c.y) + (c.z + c.w)) + ((d.x + d.y) + (d.z + d.w));
    return rsqrtf(s * (1.f / D) + EPS);
}
__device__ __forceinline__ float fsig(float x) { return __builtin_amdgcn_rcpf(1.f + __builtin_amdgcn_exp2f(-1.4426950408889634f * x)); }
__device__ __forceinline__ u32x4 pack8(const f32x4 a, const f32x4 b) { u32x4 w; w.x = cvt_pk_bf16(a[0], a[1]); w.y = cvt_pk_bf16(a[2], a[3]); w.z = cvt_pk_bf16(b[0], b[1]); w.w = cvt_pk_bf16(b[2], b[3]); return w; }
__device__ __forceinline__ f32x4 sig4(const f32x4 x) { return (f32x4){fsig(x[0]), fsig(x[1]), fsig(x[2]), fsig(x[3])}; }

struct EpiKV { static constexpr bool PERM = true, AFTER_DRAIN = false; const float* ss; bf16_t* kb; bf16_t* vb2; float* out;
    __device__ __forceinline__ void operator()(const f32x4 (&acc)[2][2][4][2], const Unit& u, int wr, int wc, int fr, int fq) const {
        const int row0 = u.pm * BM + wr * 64 + fr; const bool isv = u.pn >= 4; const int colt = (isv ? u.pn - 4 : u.pn) * BM + wc * 32 + 8 * fq;
        float* of = out + (isv ? O_MVP : O_MKP); bf16_t* ob = isv ? vb2 : kb;
#pragma unroll
        for (int ai = 0; ai < 2; ++ai)
#pragma unroll
            for (int m = 0; m < 4; ++m) { const int row = row0 + ai * HALF + m * 16; const float r = rstd_row(ss, row);
#pragma unroll
                for (int bj = 0; bj < 2; ++bj) { const f32x4 v0 = acc[ai][bj][m][0] * r, v1 = acc[ai][bj][m][1] * r; const size_t o = (size_t)row * D + colt + bj * HALF;
                    *(f32x4*)(of + o) = v0; *(f32x4*)(of + o + 4) = v1; *(u32x4*)(ob + o) = pack8(v0, v1); } }
    }
};
struct EpiSwiglu { static constexpr bool PERM = true, AFTER_DRAIN = false; const float* ss; bf16_t* H;
    __device__ __forceinline__ void operator()(const f32x4 (&acc)[2][2][4][2], const Unit& u, int wr, int wc, int fr, int fq) const {
        const int row0 = u.pm * BM + wr * 64 + fr, col0 = u.pn * HALF + wc * 32 + 8 * fq;
#pragma unroll
        for (int ai = 0; ai < 2; ++ai)
#pragma unroll
            for (int m = 0; m < 4; ++m) { const int row = row0 + ai * HALF + m * 16; const float r = rstd_row(ss, row);
                const f32x4 g0 = acc[ai][0][m][0] * r, g1 = acc[ai][0][m][1] * r, u0 = acc[ai][1][m][0] * r, u1 = acc[ai][1][m][1] * r;
                *(u32x4*)(H + (size_t)row * FF + col0) = pack8(g0 * sig4(g0) * u0, g1 * sig4(g1) * u1); }
    }
};
struct EpiRes { static constexpr bool PERM = true, AFTER_DRAIN = false; const float* rin0; const float* rin1; float* rout; bf16_t* xb; float* ss; float alpha;
    __device__ __forceinline__ void operator()(const f32x4 (&acc)[2][2][4][2], const Unit& u, int wr, int wc, int fr, int fq) const {
        const int row0 = u.pm * BM + wr * 64 + fr, col0 = u.pn * BM + wc * 32 + 8 * fq; const float* rin = u.pm >= MP / BM ? rin1 : rin0;
#pragma unroll
        for (int ai = 0; ai < 2; ++ai)
#pragma unroll
            for (int m = 0; m < 4; ++m) { const int row = row0 + ai * HALF + m * 16; float sq = 0.f;
#pragma unroll
                for (int bj = 0; bj < 2; ++bj) { const size_t o = (size_t)row * D + col0 + bj * HALF;
                    const f32x4 v0 = *(const f32x4*)(rin + o) + acc[ai][bj][m][0] * alpha, v1 = *(const f32x4*)(rin + o + 4) + acc[ai][bj][m][1] * alpha;
                    *(f32x4*)(rout + o) = v0; *(f32x4*)(rout + o + 4) = v1; if (xb) *(u32x4*)(xb + o) = pack8(v0, v1);
                    sq += (v0[0] * v0[0] + v0[1] * v0[1]) + (v0[2] * v0[2] + v0[3] * v0[3]) + (v1[0] * v1[0] + v1[1] * v1[1]) + (v1[2] * v1[2] + v1[3] * v1[3]); }
                sq += __shfl_xor(sq, 16); sq += __shfl_xor(sq, 32);
                if (fq == 0) ss[(size_t)row * 16 + u.pn * 4 + wc] = sq;
                if (m & 1) asm volatile("" ::: "memory"); }
    }
};
struct EpiIn { static constexpr bool PERM = true, AFTER_DRAIN = false; const float* ss; bf16_t* ug; bf16_t* vb; float* out;
    __device__ __forceinline__ void operator()(const f32x4 (&acc)[2][2][4][2], const Unit& u, int wr, int wc, int fr, int fq) const {
        const int row0 = u.pm * BM + wr * 64 + fr;
        if (u.pn < 2) {
#pragma unroll
            for (int ai = 0; ai < 2; ++ai)
#pragma unroll
                for (int m = 0; m < 4; ++m) { const int row = row0 + ai * HALF + m * 16; const float r = rstd_row(ss, row);
#pragma unroll
                    for (int bj = 0; bj < 2; ++bj) { const int c0 = u.pn * BM + bj * HALF + wc * 32 + 8 * fq;
                        *(u32x4*)(ug + ((size_t)(c0 >> 4) * M + row) * 16 + (c0 & 15)) = pack8(acc[ai][bj][m][0] * r, acc[ai][bj][m][1] * r); } }
        } else {
            const int p0 = (u.pn - 2) * HALF + wc * 32 + 8 * fq;
#pragma unroll
            for (int ai = 0; ai < 2; ++ai)
#pragma unroll
                for (int m = 0; m < 4; ++m) { const int row = row0 + ai * HALF + m * 16; const float r = rstd_row(ss, row);
                    const f32x4 a0 = acc[ai][0][m][0] * r, a1 = acc[ai][0][m][1] * r, g0 = acc[ai][1][m][0] * r, g1 = acc[ai][1][m][1] * r;
                    const f32x4 v0 = a0 * sig4(g0), v1 = a1 * sig4(g1);
                    *(u32x4*)(vb + (size_t)row * CONVD + p0) = pack8(v0, v1);
                    float* o = nullptr;
                    if (row >= MP) { const int rs = row - MP; o = out + O_CVS + ((size_t)(rs >> 3) * 30 + 22 + (rs & 7)) * CONVD + p0; }
                    else { const int t = row & (SEQ - 1); if (t >= SEQ - 30) o = out + O_CVP + ((size_t)(row >> 11) * 30 + (t - (SEQ - 30))) * CONVD + p0; }
                    if (o) { *(f32x4*)o = v0; *(f32x4*)(o + 4) = v1; } }
        }
    }
};
struct EpiGlu { static constexpr bool PERM = true, AFTER_DRAIN = false; const bf16_t* gb; bf16_t* mixb;
    __device__ __forceinline__ void operator()(const f32x4 (&acc)[2][2][4][2], const Unit& u, int wr, int wc, int fr, int fq) const {
        const int row0 = u.pm * BM + wr * 64 + fr, col0 = u.pn * BM + wc * 32 + 8 * fq;
#pragma unroll
        for (int ai = 0; ai < 2; ++ai)
#pragma unroll
            for (int m = 0; m < 4; ++m) { const int row = row0 + ai * HALF + m * 16;
#pragma unroll
                for (int bj = 0; bj < 2; ++bj) { const int c0 = col0 + bj * HALF; const u32x4 gw = *(const u32x4*)(gb + (size_t)row * SSM + c0);
                    const f32x4 ga = {__builtin_bit_cast(float, gw.x << 16), __builtin_bit_cast(float, gw.x & 0xffff0000u), __builtin_bit_cast(float, gw.y << 16), __builtin_bit_cast(float, gw.y & 0xffff0000u)};
                    const f32x4 gc = {__builtin_bit_cast(float, gw.z << 16), __builtin_bit_cast(float, gw.z & 0xffff0000u), __builtin_bit_cast(float, gw.w << 16), __builtin_bit_cast(float, gw.w & 0xffff0000u)};
                    *(u32x4*)(mixb + (size_t)row * D + c0) = pack8(ga * sig4(acc[ai][bj][m][0]), gc * sig4(acc[ai][bj][m][1])); } }
    }
};
struct EpiQ { static constexpr bool PERM = true, AFTER_DRAIN = false; const float* ss; bf16_t* qb;
    __device__ __forceinline__ void operator()(const f32x4 (&acc)[2][2][4][2], const Unit& u, int wr, int wc, int fr, int fq) const {
        const int row0 = u.pm * BM + wr * 64 + fr, col0 = u.pn * BM + wc * 32 + 8 * fq;
#pragma unroll
        for (int ai = 0; ai < 2; ++ai)
#pragma unroll
            for (int m = 0; m < 4; ++m) { const int row = row0 + ai * HALF + m * 16; const float r = rstd_row(ss, row) * QSCALE;
#pragma unroll
                for (int bj = 0; bj < 2; ++bj) *(u32x4*)(qb + (size_t)row * D + col0 + bj * HALF) = pack8(acc[ai][bj][m][0] * r, acc[ai][bj][m][1] * r); }
    }
};
}

#define GAS __attribute__((address_space(1)))
#define LAS __attribute__((address_space(3)))
typedef unsigned v4u __attribute__((ext_vector_type(4)));
typedef float f32x4 __attribute__((ext_vector_type(4)));
typedef short bf16x8 __attribute__((ext_vector_type(8)));
typedef GAS unsigned gu32;
typedef GAS unsigned long long gu64;
#define RLX_AGENT __ATOMIC_RELAXED, __HIP_MEMORY_SCOPE_AGENT
#define LDS_WAIT() asm volatile("s_waitcnt lgkmcnt(0)" ::: "memory")
#define VM_WAIT() asm volatile("s_waitcnt vmcnt(0)" ::: "memory")
__device__ __forceinline__ unsigned long long rt() { return __builtin_amdgcn_s_memrealtime(); }
__device__ __forceinline__ unsigned pk2(float lo, float hi) { return f2bf(lo) | (f2bf(hi) << 16); }

#define XB_TMO      128
#define XB_XCNT(j)  (256  + 64 * (j))
#define XB_XSUB(j)  (1280 + 64 * (j))
#define XB_XGEN(j)  (2304 + 64 * (j))
#define XB_TOP      3328
#define XB_TOPGEN   3392
#define XCD_BAR_WORDS 3456
#define XB_SPIN_CAP (1u << 18)

__device__ __forceinline__ unsigned xb_ld(unsigned* p)              { return __hip_atomic_load(p, __ATOMIC_RELAXED, __HIP_MEMORY_SCOPE_AGENT); }
__device__ __forceinline__ unsigned xb_add(unsigned* p, unsigned v) { return __hip_atomic_fetch_add(p, v, __ATOMIC_RELAXED, __HIP_MEMORY_SCOPE_AGENT); }
__device__ __forceinline__ unsigned xb_xcc_id() { return (unsigned)__builtin_amdgcn_s_getreg((3 << 11) | 20) & 0xFu; }
#define XB_SPIN(cond, bar) do { unsigned _sp = 0; while (cond) { __builtin_amdgcn_s_sleep(1); \
    if ((++_sp & 255u) == 0u) { if (xb_ld(&(bar)[XB_TMO])) break; if (_sp > XB_SPIN_CAP) { atomicAdd(&(bar)[XB_TMO], 1u); break; } } } } while (0)

struct XcdBarrier {
    unsigned* bar; unsigned x;
    volatile LAS unsigned* st;
};

__device__ __forceinline__ XcdBarrier xcd_barrier_post(unsigned* bar, volatile LAS unsigned* st) {
    XcdBarrier b; b.bar = bar; b.x = xb_xcc_id(); b.st = st;
    if (threadIdx.x == 0) (void)xb_add(&bar[XB_XCNT(b.x)], 1u);
    return b;
}
__device__ __forceinline__ void xcd_barrier_complete(unsigned* bar, unsigned x, unsigned& nloc, unsigned& nx) {
    const unsigned G = gridDim.x * gridDim.y * gridDim.z;
    unsigned sum, cnt, mine, sp = 0u;
    for (;;) {
        sum = 0u; cnt = 0u; mine = 0u;
#pragma unroll
        for (unsigned j = 0; j < 16; ++j) { const unsigned c = xb_ld(&bar[XB_XCNT(j)]); sum += c; cnt += (c > 0u) ? 1u : 0u; mine = (j == x) ? c : mine; }
        if (sum == G) break;
        __builtin_amdgcn_s_sleep(1);
        if ((++sp & 255u) == 0u) { if (xb_ld(&bar[XB_TMO])) break; if (sp > XB_SPIN_CAP) { atomicAdd(&bar[XB_TMO], 1u); break; } }
    }
    nloc = mine > 0u ? mine : 1u; nx = cnt > 0u ? cnt : 1u;
}

__device__ __forceinline__ void xcd_barrier(const XcdBarrier& b) {
    asm volatile("s_waitcnt vmcnt(0)" ::: "memory");
    __syncthreads();
    if (threadIdx.x == 0) {
        unsigned* bar = b.bar;
        __builtin_amdgcn_s_waitcnt(0);
        unsigned nloc = b.st[0], nx = b.st[1];
        if (nloc == 0u) { xcd_barrier_complete(bar, b.x, nloc, nx); b.st[0] = nloc; b.st[1] = nx; }
        const unsigned old = xb_add(&bar[XB_XSUB(b.x)], 1u);
        const unsigned gen = old / nloc;
        if (old + 1u == (gen + 1u) * nloc) {
            __builtin_amdgcn_fence(__ATOMIC_RELEASE, "agent");
            asm volatile("s_waitcnt vmcnt(0)" ::: "memory");
            const unsigned og = xb_add(&bar[XB_TOP], 1u);
            const unsigned tg = og / nx;
            if (og + 1u == (tg + 1u) * nx) xb_add(&bar[XB_TOPGEN], 1u);
            else XB_SPIN(xb_ld(&bar[XB_TOPGEN]) == tg, bar);
            __builtin_amdgcn_fence(__ATOMIC_ACQUIRE, "agent");
            xb_add(&bar[XB_XGEN(b.x)], 1u);
            asm volatile("s_waitcnt vmcnt(0)" ::: "memory");
        } else {
            XB_SPIN(xb_ld(&bar[XB_XGEN(b.x)]) == gen, bar);
            __builtin_amdgcn_fence(__ATOMIC_ACQUIRE, "agent");
            asm volatile("s_waitcnt vmcnt(0)" ::: "memory");
        }
    }
    __syncthreads();
}

namespace sb {
__device__ __forceinline__ void transpose_item(const float* W, int ldw, int c0, const float* gain, bf16_t* WT, int K, int n0, int k0, LAS float* scr, int lane) {
#pragma unroll 8
    for (int i = 0; i < 32; ++i) { const int kk = 2 * i + (lane >> 5); float v = W[(size_t)(k0 + kk) * ldw + c0 + (lane & 31)]; if (gain) v *= gain[k0 + kk]; scr[kk * 33 + (lane & 31)] = v; }
    LDS_WAIT(); asm volatile("" ::: "memory");
    const int c = lane & 7;
#pragma unroll
    for (int j = 0; j < 4; ++j) { const int n = (lane >> 3) + 8 * j; const LAS float* s = scr + (8 * c) * 33 + n;
        v4u o; o.x = pk2(s[0 * 33], s[1 * 33]); o.y = pk2(s[2 * 33], s[3 * 33]); o.z = pk2(s[4 * 33], s[5 * 33]); o.w = pk2(s[6 * 33], s[7 * 33]);
        *(GAS v4u*)(WT + (size_t)(n0 + n) * K + k0 + 8 * c) = o; }
    LDS_WAIT(); asm volatile("" ::: "memory");
}
template <int MAP>
__device__ __forceinline__ void transpose_job_item(const float* W0, const float* W1, const float* gain, bf16_t* WT, int K, int N, int ldw, int item, LAS float* scr, int lane) {
    const int nblk = N / 32, kb = item / nblk, nb = item % nblk, n0 = 32 * nb, k0 = 64 * kb;
    const float* W = W0; int c0 = n0;
    if (MAP == 1) { const int pn = n0 / 256, half = (n0 % 256) / 128, jj = n0 % 128; W = half ? W1 : W0; c0 = pn * 128 + jj; }
    if (MAP == 2) { if (n0 >= 512) { const int m = n0 - 512, pc = m / 256, half = (m % 256) / 128, jj = m % 128; c0 = 512 + half * 512 + pc * 128 + jj; } }
    if (MAP == 3) { if (n0 >= 1024) { W = W1; c0 = n0 - 1024; } }
    transpose_item(W, ldw, c0, gain, WT, K, n0, k0, scr, lane);
}
__device__ __forceinline__ void row_bf16_ss(const float* xr, bf16_t* orow, float* ssrow, int lane) {
    float s = 0.f;
#pragma unroll
    for (int j = 0; j < 4; ++j) { const f32x4 v = *(const f32x4*)(xr + j * 256 + lane * 4); s += (v.x * v.x + v.y * v.y) + (v.z * v.z + v.w * v.w);
        uint2 o; o.x = pk2(v.x, v.y); o.y = pk2(v.z, v.w); *(uint2*)(orow + j * 256 + lane * 4) = o; }
    s = wave_sum(s);
    if (lane < 16) ssrow[lane] = lane == 0 ? s : 0.f;
}

__device__ __forceinline__ void s5_task(int task, const bf16_t* ug, const float* h0re, const float* h0im, const float* a_re, const float* a_im, const float* log_dt,
                                        const float* b_re, const float* b_im, const float* c_re, const float* c_im, const float* dskip, bf16_t* gb, float* out, int n) {
    const int g = task % NG, sq = task / NG;
    const bool prompt = sq < NBATCH; const int b = prompt ? sq : sq - NBATCH, T = prompt ? SEQ : DECS, row0 = prompt ? b * SEQ : MP + b * DECS;
    const float dt = expf(log_dt[g]), lr = a_re[g * NST + n], li = a_im[g * NST + n];
    const float mag = expf(lr * dt), abr = mag * cosf(li * dt), abi = mag * sinf(li * dt);
    const float den = lr * lr + li * li, nr = abr - 1.f, ni = abi, cr = (nr * lr + ni * li) / den, ci = (ni * lr - nr * li) / den;
    float Br[16], Bi[16], Cr[16], Ci[16];
#pragma unroll
    for (int c = 0; c < 16; ++c) { const float br = b_re[((size_t)g * NST + n) * 16 + c], bi = b_im[((size_t)g * NST + n) * 16 + c];
        Br[c] = cr * br - ci * bi; Bi[c] = cr * bi + ci * br; Cr[c] = c_re[((size_t)g * 16 + c) * NST + n]; Ci[c] = c_im[((size_t)g * 16 + c) * NST + n]; }
    float hr = 0.f, hi = 0.f;
    if (!prompt) { hr = h0re[((size_t)b * NG + g) * NST + n]; hi = h0im[((size_t)b * NG + g) * NST + n]; }
    const float dsk = dskip[g * 16 + (n & 15)];
    for (int t = 0; t < T; ++t) {
        const bf16_t* up = ug + ((size_t)g * M + row0 + t) * 16;
        const v4u w0 = *(const v4u*)up, w1 = *(const v4u*)(up + 8);
        float u[16];
        u[0] = __builtin_bit_cast(float, w0.x << 16); u[1] = __builtin_bit_cast(float, w0.x & 0xffff0000u); u[2] = __builtin_bit_cast(float, w0.y << 16); u[3] = __builtin_bit_cast(float, w0.y & 0xffff0000u);
        u[4] = __builtin_bit_cast(float, w0.z << 16); u[5] = __builtin_bit_cast(float, w0.z & 0xffff0000u); u[6] = __builtin_bit_cast(float, w0.w << 16); u[7] = __builtin_bit_cast(float, w0.w & 0xffff0000u);
        u[8] = __builtin_bit_cast(float, w1.x << 16); u[9] = __builtin_bit_cast(float, w1.x & 0xffff0000u); u[10] = __builtin_bit_cast(float, w1.y << 16); u[11] = __builtin_bit_cast(float, w1.y & 0xffff0000u);
        u[12] = __builtin_bit_cast(float, w1.z << 16); u[13] = __builtin_bit_cast(float, w1.z & 0xffff0000u); u[14] = __builtin_bit_cast(float, w1.w << 16); u[15] = __builtin_bit_cast(float, w1.w & 0xffff0000u);
        float xr = 0.f, xi = 0.f;
#pragma unroll
        for (int c = 0; c < 16; ++c) { xr += Br[c] * u[c]; xi += Bi[c] * u[c]; }
        const float nhr = abr * hr - abi * hi + xr, nhi = abr * hi + abi * hr + xi; hr = nhr; hi = nhi;
        float ymine = 0.f;
#pragma unroll
        for (int c = 0; c < 16; ++c) { const float y = wave_sum(Cr[c] * hr - Ci[c] * hi); if ((n & 15) == c) ymine = y + dsk * u[c]; }
        if (n < 16) gb[(size_t)(row0 + t) * SSM + g * 16 + n] = (bf16_t)f2bf(gelu_tanh(ymine));
    }
    if (prompt) { out[O_SRP + ((size_t)b * NG + g) * NST + n] = hr; out[O_SIP + ((size_t)b * NG + g) * NST + n] = hi; }
    else { out[O_SRS + ((size_t)b * NG + g) * NST + n] = hr; out[O_SIS + ((size_t)b * NG + g) * NST + n] = hi; }
}

__device__ __forceinline__ void conv_row(int row, const bf16_t* vb, const float* cache, const float* w, const float* bias, const float* lg, const float* lb, bf16_t* mixb, float* out, LAS float* red, int c) {
    float y = bias[c];
    if (row < MP) { const int t = row % SEQ;
        for (int k = 0; k < CWID; ++k) { const int tt = t - 30 + k; if (tt >= 0) y += w[k * CONVD + c] * bf2f(vb[(size_t)(row - 30 + k) * CONVD + c]); }
    } else { const int rs = row - MP, b = rs / DECS, t = rs % DECS;
        for (int k = 0; k < CWID; ++k) { const int idx = t + k; const float xv = idx < 30 ? cache[((size_t)b * 30 + idx) * CONVD + c] : bf2f(vb[(size_t)(MP + b * DECS + idx - 30) * CONVD + c]); y += w[k * CONVD + c] * xv; }
        if (t == 0) for (int j = 0; j < 22; ++j) out[O_CVS + ((size_t)b * 30 + j) * CONVD + c] = cache[((size_t)b * 30 + j + 8) * CONVD + c];
    }
    float s = wave_sum(y); if ((c & 63) == 0) red[c >> 6] = s; __syncthreads();
    float mu = 0.f;
#pragma unroll
    for (int i = 0; i < 8; ++i) mu += red[i];
    mu *= (1.f / CONVD);
    const float d = y - mu; float q = wave_sum(d * d); if ((c & 63) == 0) red[8 + (c >> 6)] = q; __syncthreads();
    float var = 0.f;
#pragma unroll
    for (int i = 0; i < 8; ++i) var += red[8 + i];
    var *= (1.f / CONVD);
    const float z = d * rsqrtf(var + EPS) * lg[c] + lb[c];
    mixb[(size_t)row * D + SSM + c] = (bf16_t)f2bf(siluf_(z));
}

__device__ __forceinline__ void attn_task(int task, const bf16_t* qb, const bf16_t* kb, const bf16_t* vb2, const float* ck, const float* cv, bf16_t* ob, LAS float* scr, int t256) {
    LAS float* q = scr; LAS float* p = scr + 2048; LAS float* red = scr + 4096;
    const int rg = task >> 2, h = task & 3, row0 = rg * 8; const bool prompt = row0 < MP; const int b = prompt ? row0 / SEQ : (row0 - MP) / DECS;
#pragma unroll
    for (int r = 0; r < 8; ++r) q[r * 256 + t256] = bf2f(qb[(size_t)(row0 + r) * D + h * HD + t256]);
    __syncthreads();
    float s[8];
#pragma unroll
    for (int r = 0; r < 8; ++r) s[r] = 0.f;
    if (prompt) { const bf16_t* kr = kb + ((size_t)b * NMEM + t256) * D + h * HD;
        for (int d = 0; d < HD; d += 8) { const v4u w = *(const v4u*)(kr + d); float kv[8];
            kv[0] = __builtin_bit_cast(float, w.x << 16); kv[1] = __builtin_bit_cast(float, w.x & 0xffff0000u); kv[2] = __builtin_bit_cast(float, w.y << 16); kv[3] = __builtin_bit_cast(float, w.y & 0xffff0000u);
            kv[4] = __builtin_bit_cast(float, w.z << 16); kv[5] = __builtin_bit_cast(float, w.z & 0xffff0000u); kv[6] = __builtin_bit_cast(float, w.w << 16); kv[7] = __builtin_bit_cast(float, w.w & 0xffff0000u);
#pragma unroll
            for (int r = 0; r < 8; ++r)
#pragma unroll
                for (int j = 0; j < 8; ++j) s[r] += q[r * 256 + d + j] * kv[j]; }
    } else { const float* kr = ck + ((size_t)b * NMEM + t256) * D + h * HD;
        for (int d = 0; d < HD; d += 4) { const f32x4 kv = *(const f32x4*)(kr + d);
#pragma unroll
            for (int r = 0; r < 8; ++r) s[r] += (q[r * 256 + d] * kv.x + q[r * 256 + d + 1] * kv.y) + (q[r * 256 + d + 2] * kv.z + q[r * 256 + d + 3] * kv.w); }
    }
    const int w4 = t256 >> 6;
#pragma unroll
    for (int r = 0; r < 8; ++r) { float mx = s[r];
#pragma unroll
        for (int o = 1; o < 64; o <<= 1) mx = fmaxf(mx, __shfl_xor(mx, o));
        if ((t256 & 63) == 0) red[r * 4 + w4] = mx; }
    __syncthreads();
    float e[8];
#pragma unroll
    for (int r = 0; r < 8; ++r) { const float mx = fmaxf(fmaxf(red[r * 4], red[r * 4 + 1]), fmaxf(red[r * 4 + 2], red[r * 4 + 3])); e[r] = exp2f(s[r] - mx); }
    __syncthreads();
#pragma unroll
    for (int r = 0; r < 8; ++r) { const float sm = wave_sum(e[r]); if ((t256 & 63) == 0) red[r * 4 + w4] = sm; }
    __syncthreads();
#pragma unroll
    for (int r = 0; r < 8; ++r) { const float sm = (red[r * 4] + red[r * 4 + 1]) + (red[r * 4 + 2] + red[r * 4 + 3]); p[r * 256 + t256] = e[r] / sm; }
    __syncthreads();
    float o[8];
#pragma unroll
    for (int r = 0; r < 8; ++r) o[r] = 0.f;
    if (prompt) { const bf16_t* vr = vb2 + (size_t)b * NMEM * D + h * HD + t256;
        for (int m = 0; m < NMEM; ++m) { const float vv = bf2f(vr[(size_t)m * D]);
#pragma unroll
            for (int r = 0; r < 8; ++r) o[r] += p[r * 256 + m] * vv; }
    } else { const float* vr = cv + (size_t)b * NMEM * D + h * HD + t256;
        for (int m = 0; m < NMEM; ++m) { const float vv = vr[(size_t)m * D];
#pragma unroll
            for (int r = 0; r < 8; ++r) o[r] += p[r * 256 + m] * vv; }
    }
#pragma unroll
    for (int r = 0; r < 8; ++r) ob[(size_t)(row0 + r) * D + h * HD + t256] = (bf16_t)f2bf(o[r]);
    __syncthreads();
}
}

namespace s5f {
typedef short bf16x8 __attribute__((ext_vector_type(8)));
constexpr int KT_OFF = 0, KT_BYTES = 65 * 256 * 2, U_OFF = 33792, U_CSTR = 2064, S_OFF = U_OFF + 32 * U_CSTR, H_OFF = S_OFF + 32 * 128 * 4, H_RSTR = 272, END_OFF = H_OFF + 32 * H_RSTR;
static_assert(KT_BYTES <= U_OFF && END_OFF <= 131072, "S5 LDS map");
constexpr size_t TAB_KT = 0, TAB_P = 2 * MiB, TAB_Q = 10 * MiB, TAB_AL = 18 * MiB;
struct cf { float re, im; };
typedef float f32x2v __attribute__((ext_vector_type(2)));
typedef unsigned u32x2v __attribute__((ext_vector_type(2)));
__device__ __forceinline__ f32x2v tov(cf a) { return (f32x2v){a.re, a.im}; }
__device__ __forceinline__ cf toc(f32x2v a) { return cf{a.x, a.y}; }
__device__ __forceinline__ cf cmul(cf a, cf b) { return cf{a.re * b.re - a.im * b.im, a.re * b.im + a.im * b.re}; }
__device__ __forceinline__ cf cpow_a(float lr, float li, float dt, float p) { const float mag = expf(lr * dt * p); float s, c; sincosf(li * dt * p, &s, &c); return cf{mag * c, mag * s}; }
__device__ __forceinline__ cf coef_of(float lr, float li, float dt) { const cf a = cpow_a(lr, li, dt, 1.f); const float den = lr * lr + li * li, nr = a.re - 1.f, ni = a.im; return cf{(nr * lr + ni * li) / den, (ni * lr - nr * li) / den}; }

__device__ __forceinline__ void kt_task(int task, const float* a_re, const float* a_im, const float* log_dt, const float* b_re, const float* b_im, const float* c_re, const float* c_im,
                                        bf16_t* Ktab, LAS unsigned char* scr, int tid) {
    const int g = task >> 3, tb = task & 7;
    LAS f32x2v* Wb = (LAS f32x2v*)scr; LAS f32x2v* Bb = (LAS f32x2v*)(scr + 4096); LAS f32x2v* Cc = (LAS f32x2v*)(scr + 4096 + 8192);
    const float dt = expf(log_dt[g]);
    { const int tl = tid >> 6, n = tid & 63; Wb[tl * 64 + n] = tov(cpow_a(a_re[g * NST + n], a_im[g * NST + n], dt, (float)(8 * tb + tl))); }
#pragma unroll
    for (int e = tid; e < 1024; e += 512) { const int n = e >> 4, c = e & 15; const cf co = coef_of(a_re[g * NST + n], a_im[g * NST + n], dt);
        Bb[e] = tov(cmul(co, cf{b_re[((size_t)g * NST + n) * 16 + c], b_im[((size_t)g * NST + n) * 16 + c]})); }
#pragma unroll
    for (int e = tid; e < 1024; e += 512) Cc[e] = (f32x2v){c_re[(size_t)g * 1024 + e], c_im[(size_t)g * 1024 + e]};
    __syncthreads();
    { const int tl = tid >> 6, cc = tid & 63, c = cc >> 2, c0 = 4 * (cc & 3); float acc[4] = {0.f, 0.f, 0.f, 0.f};
        for (int n = 0; n < 64; ++n) { const cf T = cmul(toc(Cc[c * 64 + n]), toc(Wb[tl * 64 + n]));
#pragma unroll
            for (int k = 0; k < 4; ++k) { const cf E = toc(Bb[n * 16 + c0 + k]); acc[k] += T.re * E.re - T.im * E.im; } }
        uint2 o; o.x = pk2(acc[0], acc[1]); o.y = pk2(acc[2], acc[3]);
        *(uint2*)(Ktab + (((size_t)g * 65 + 8 * tb + tl + 1) * 16 + c) * 16 + c0) = o; }
    if (tb == 0 && tid < 32) *(v4u*)(Ktab + (size_t)g * 65 * 256 + tid * 8) = (v4u){0u, 0u, 0u, 0u};
    __syncthreads();
}
__device__ __forceinline__ void pq_entry(int e, const float* a_re, const float* a_im, const float* log_dt, const float* b_re, const float* b_im, const float* c_re, const float* c_im,
                                         bf16_t* Ptab, bf16_t* Qtab, float* ALtab) {
    {
        const int n = e & 63, j = (e >> 6) & 63, g = e >> 12; const float dt = expf(log_dt[g]);
        const cf W = cpow_a(a_re[g * NST + n], a_im[g * NST + n], dt, (float)(j + 1));
#pragma unroll
        for (int c = 0; c < 16; ++c) { const cf w = cmul(cf{c_re[((size_t)g * 16 + c) * NST + n], c_im[((size_t)g * 16 + c) * NST + n]}, W);
            bf16_t* p = Ptab + (((size_t)g * 64 + j) * 16 + c) * 128; p[n] = (bf16_t)f2bf(w.re); p[64 + n] = (bf16_t)f2bf(-w.im); }
        if (j == 0) { const cf al = cpow_a(a_re[g * NST + n], a_im[g * NST + n], dt, 64.f); ALtab[(g * NST + n) * 2] = al.re; ALtab[(g * NST + n) * 2 + 1] = al.im; }
    }
    {
        const int i = e & 63, n = (e >> 6) & 63, g = e >> 12; const float dt = expf(log_dt[g]);
        const float lr = a_re[g * NST + n], li = a_im[g * NST + n];
        const cf V = cmul(cpow_a(lr, li, dt, (float)(63 - i)), coef_of(lr, li, dt));
        unsigned wr[8], wi[8];
#pragma unroll
        for (int c = 0; c < 16; c += 2) { const cf v0 = cmul(V, cf{b_re[((size_t)g * NST + n) * 16 + c], b_im[((size_t)g * NST + n) * 16 + c]}), v1 = cmul(V, cf{b_re[((size_t)g * NST + n) * 16 + c + 1], b_im[((size_t)g * NST + n) * 16 + c + 1]});
            wr[c >> 1] = pk2(v0.re, v1.re); wi[c >> 1] = pk2(v0.im, v1.im); }
        v4u* qr = (v4u*)(Qtab + ((size_t)g * 128 + n) * 1024 + i * 16); v4u* qi = (v4u*)(Qtab + ((size_t)g * 128 + 64 + n) * 1024 + i * 16);
        qr[0] = (v4u){wr[0], wr[1], wr[2], wr[3]}; qr[1] = (v4u){wr[4], wr[5], wr[6], wr[7]}; qi[0] = (v4u){wi[0], wi[1], wi[2], wi[3]}; qi[1] = (v4u){wi[4], wi[5], wi[6], wi[7]};
    }
}
__device__ __forceinline__ float gelu_fast(float x) { const float u = 1.5957691216057308f * (x + 0.044715f * x * x * x); return x * __builtin_amdgcn_rcpf(1.f + __builtin_amdgcn_exp2f(-1.4426950408889634f * u)); }

__device__ __forceinline__ void prompt_unit(int b, int g, const bf16_t* ug, const bf16_t* Ktab, const bf16_t* Ptab, const bf16_t* Qtab, const float* ALtab, const float* dskip, bf16_t* gb, float* out,
                                            LAS unsigned char* L, int tid, int wave, int lane) {
    {
        const v4u* src = (const v4u*)(Ktab + (size_t)g * 65 * 256);
        for (int q = tid; q < KT_BYTES / 16; q += 512) *(LAS v4u*)(L + KT_OFF + q * 16) = src[q];
        const v4u* us = (const v4u*)(ug + ((size_t)g * M + (size_t)b * SEQ) * 16);
#pragma unroll
        for (int p = 0; p < 8; ++p) { const int q = p * 512 + tid; *(LAS v4u*)(L + U_OFF + (q >> 7) * U_CSTR + (q & 127) * 16) = us[q]; }
    }
    __syncthreads();
    const int fr = lane & 15, kq = lane >> 4;
    const LAS unsigned char* ub0 = L + U_OFF + fr * U_CSTR + kq * 16; const LAS unsigned char* ub1 = ub0 + 16 * U_CSTR;
    {
        f32x4 a0 = {0.f, 0.f, 0.f, 0.f}, a1 = {0.f, 0.f, 0.f, 0.f};
        const bf16_t* qrow = Qtab + ((size_t)g * 128 + wave * 16 + fr) * 1024 + kq * 8;
#pragma unroll 4
        for (int s = 0; s < 32; ++s) { const bf16x8 a = *(const bf16x8*)(qrow + s * 32);
            a0 = __builtin_amdgcn_mfma_f32_16x16x32_bf16(a, *(const LAS bf16x8*)(ub0 + s * 64), a0, 0, 0, 0);
            a1 = __builtin_amdgcn_mfma_f32_16x16x32_bf16(a, *(const LAS bf16x8*)(ub1 + s * 64), a1, 0, 0, 0); }
        *(LAS f32x4*)(L + S_OFF + (fr * 128 + wave * 16 + kq * 4) * 4) = a0;
        *(LAS f32x4*)(L + S_OFF + ((16 + fr) * 128 + wave * 16 + kq * 4) * 4) = a1;
    }
    __syncthreads();
    if (tid < 64) {
        const int n = tid; const float alr = ALtab[(g * NST + n) * 2], ali = ALtab[(g * NST + n) * 2 + 1]; float hr = 0.f, hi = 0.f;
        const LAS float* Sb = (const LAS float*)(L + S_OFF);
        for (int c = 0; c < 32; ++c) { LAS bf16_t* hb = (LAS bf16_t*)(L + H_OFF + c * H_RSTR); hb[n] = (bf16_t)f2bf(hr); hb[64 + n] = (bf16_t)f2bf(hi);
            const float sr = Sb[c * 128 + n], si = Sb[c * 128 + 64 + n]; const float nhr = alr * hr - ali * hi + sr, nhi = alr * hi + ali * hr + si; hr = nhr; hi = nhi; }
        out[O_SRP + ((size_t)b * NG + g) * NST + n] = hr; out[O_SIP + ((size_t)b * NG + g) * NST + n] = hi;
    }
    __syncthreads();
    f32x4 acc[8][2];
#pragma unroll
    for (int q = 0; q < 8; ++q) { acc[q][0] = (f32x4){0.f, 0.f, 0.f, 0.f}; acc[q][1] = (f32x4){0.f, 0.f, 0.f, 0.f}; }
    {
        const LAS unsigned char* kt = L + KT_OFF + (fr * 16 + (kq & 1) * 8) * 2 + (wave + 1 - (kq >> 1)) * 512;
        const int smax = (wave + 56) >> 1;
        for (int s = 0; s <= smax; ++s) {
            const bf16x8 b0 = *(const LAS bf16x8*)(ub0 + s * 64), b1 = *(const LAS bf16x8*)(ub1 + s * 64);
#pragma unroll
            for (int q = 0; q < 8; ++q) if (wave + 8 * q >= 2 * s) { const bf16x8 a = *(const LAS bf16x8*)(kt + (8 * q - 2 * s) * 512);
                acc[q][0] = __builtin_amdgcn_mfma_f32_16x16x32_bf16(a, b0, acc[q][0], 0, 0, 0); acc[q][1] = __builtin_amdgcn_mfma_f32_16x16x32_bf16(a, b1, acc[q][1], 0, 0, 0); }
        }
    }
    {
        const LAS unsigned char* hb0 = L + H_OFF + fr * H_RSTR + kq * 16; const LAS unsigned char* hb1 = hb0 + 16 * H_RSTR;
        const bf16_t* prow = Ptab + (((size_t)g * 64 + wave) * 16 + fr) * 128 + kq * 8;
#pragma unroll
        for (int s2 = 0; s2 < 4; ++s2) { const bf16x8 b0 = *(const LAS bf16x8*)(hb0 + s2 * 64), b1 = *(const LAS bf16x8*)(hb1 + s2 * 64);
#pragma unroll
            for (int q = 0; q < 8; ++q) { const bf16x8 a = *(const bf16x8*)(prow + (size_t)q * 8 * 16 * 128 + s2 * 32);
                acc[q][0] = __builtin_amdgcn_mfma_f32_16x16x32_bf16(a, b0, acc[q][0], 0, 0, 0); acc[q][1] = __builtin_amdgcn_mfma_f32_16x16x32_bf16(a, b1, acc[q][1], 0, 0, 0); } }
    }
    {
        const f32x4 dsk = *(const f32x4*)(dskip + g * 16 + kq * 4);
#pragma unroll
        for (int q = 0; q < 8; ++q)
#pragma unroll
            for (int nb = 0; nb < 2; ++nb) { const int chunk = nb * 16 + fr, j = wave + 8 * q;
                const u32x2v uw = *(const LAS u32x2v*)(L + U_OFF + chunk * U_CSTR + (j * 16 + kq * 4) * 2);
                const f32x4 u4 = {__builtin_bit_cast(float, uw.x << 16), __builtin_bit_cast(float, uw.x & 0xffff0000u), __builtin_bit_cast(float, uw.y << 16), __builtin_bit_cast(float, uw.y & 0xffff0000u)};
                const f32x4 y = acc[q][nb] + dsk * u4;
                uint2 o; o.x = pk2(gelu_fast(y[0]), gelu_fast(y[1])); o.y = pk2(gelu_fast(y[2]), gelu_fast(y[3]));
                *(uint2*)(gb + ((size_t)b * SEQ + chunk * 64 + j) * SSM + g * 16 + kq * 4) = o; }
    }
    __syncthreads();
}
}

constexpr int NWAVES = 8;
constexpr int RING_OFF = 0, RING_BYTES = 131072;
constexpr int LDSCTL_OFF = RING_BYTES, MISC_OFF = LDSCTL_OFF + 320;
constexpr int LDS_BYTES = 147456;
constexpr size_t CTL_ZERO_BYTES = 1 * MiB;
constexpr int CW_TMO = 0, CW_CODE = 1, CW_BAR = 4096;
constexpr int MAX_LAUNCHES = 8;
static_assert((CW_BAR + MAX_LAUNCHES * XCD_BAR_WORDS) * 4 <= (int)CTL_ZERO_BYTES, "barrier words inside the memset region");

enum Phase { PH_PRO = 0, PH_GU1 = 1, PH_D1 = 2, PH_IN = 3, PH_MIX = 4, PH_GLU = 5, PH_OUT = 6, PH_Q = 7, PH_ATT = 8, PH_O = 9, PH_GU2 = 10, PH_D2 = 11, PH_FIN = 12, PH_N = 13 };

struct Args { const float* in[39]; float* out; unsigned char* ws; int ph_lo, ph_hi, li, pad; };

__global__ void __launch_bounds__(NWAVES * 64, 2) mk_fwd(Args args) {
    extern __shared__ __attribute__((aligned(16))) unsigned char lds[];
    LAS unsigned char* L = (LAS unsigned char*)lds;
    volatile LAS unsigned* MISC = (volatile LAS unsigned*)(L + MISC_OFF);
    const int tid = threadIdx.x;
    const int G = gridDim.x, bx = blockIdx.x;
    unsigned char* ws = args.ws; float* out = args.out;
    gu32* ctl = (gu32*)(ws + WS_CTL);
    for (int u = tid; u < (LDS_BYTES - LDSCTL_OFF) / 4; u += NWAVES * 64) ((LAS unsigned*)(L + LDSCTL_OFF))[u] = 0u;
    __syncthreads();
    XcdBarrier bar = xcd_barrier_post((unsigned*)(ctl + CW_BAR) + args.li * XCD_BAR_WORDS, MISC + 8);
    const int lo = args.ph_lo, hi = args.ph_hi;
#define IN(k) (lo <= (k) && (k) < hi)
#define BOTH(k) (IN(k) && IN((k) + 1))
#define GRID_BAR() xcd_barrier(bar)
    bf16_t *Wgu1 = (bf16_t*)(ws + WS_WGU1), *Wgu2 = (bf16_t*)(ws + WS_WGU2), *Wd1 = (bf16_t*)(ws + WS_WD1), *Wd2 = (bf16_t*)(ws + WS_WD2), *Win = (bf16_t*)(ws + WS_WIN), *Wglu = (bf16_t*)(ws + WS_WGLU),
           *Wout = (bf16_t*)(ws + WS_WOUT), *Wq = (bf16_t*)(ws + WS_WQ), *Wo = (bf16_t*)(ws + WS_WO), *Wkv = (bf16_t*)(ws + WS_WKV);
    bf16_t *xb = (bf16_t*)(ws + WS_XB), *memb = (bf16_t*)(ws + WS_MEMB), *kb = (bf16_t*)(ws + WS_KB), *vb2 = (bf16_t*)(ws + WS_VB2), *hb = (bf16_t*)(ws + WS_H), *ug = (bf16_t*)(ws + WS_UG),
           *vb = (bf16_t*)(ws + WS_VB), *gb = (bf16_t*)(ws + WS_GB), *mixb = (bf16_t*)(ws + WS_MIXB), *qb = (bf16_t*)(ws + WS_QB), *ob = (bf16_t*)(ws + WS_OB);
    bf16_t *Ktab = (bf16_t*)(ws + WS_TAB + s5f::TAB_KT), *Ptab = (bf16_t*)(ws + WS_TAB + s5f::TAB_P), *Qtab = (bf16_t*)(ws + WS_TAB + s5f::TAB_Q); float* ALtab = (float*)(ws + WS_TAB + s5f::TAB_AL);
    float *ss0 = (float*)(ws + WS_SS0), *ss1 = (float*)(ws + WS_SS1), *ss2 = (float*)(ws + WS_SS2), *ss3 = (float*)(ws + WS_SS3), *ss4 = (float*)(ws + WS_SS4), *ssm = (float*)(ws + WS_SSM), *xres = (float*)(ws + WS_XRES);

    const int wave = __builtin_amdgcn_readfirstlane(tid >> 6), lane = tid & 63;
    const float* const* in = args.in;
    if (IN(PH_PRO)) {
        for (int task = bx; task < 256; task += G) s5f::kt_task(task, in[17], in[18], in[19], in[20], in[21], in[22], in[23], Ktab, L + RING_OFF, tid);
        for (int e = bx * 512 + tid; e < 131072; e += G * 512) s5f::pq_entry(e, in[17], in[18], in[19], in[20], in[21], in[22], in[23], Ptab, Qtab, ALtab);
        LAS float* scr = (LAS float*)(L + RING_OFF + wave * 16384);
        const int gw = bx * NWAVES + wave, NGW = G * NWAVES;
        constexpr int I_GU = (D / 64) * (2 * FF / 32), I_D = (FF / 64) * (D / 32), I_IN = (D / 64) * (1536 / 32), I_GLU = (SSM / 64) * (SSM / 32), I_SQ = (D / 64) * (D / 32), I_KV = (D / 64) * (2048 / 32);
        constexpr int NITEMS = 2 * I_GU + 2 * I_D + I_IN + I_GLU + 3 * I_SQ + I_KV;
        for (int it = gw; it < NITEMS; it += NGW) {
            int r = it;
            if (r < I_GU) { sb::transpose_job_item<1>(in[12], in[13], in[11], Wgu1, D, 2 * FF, FF, r, scr, lane); continue; } r -= I_GU;
            if (r < I_GU) { sb::transpose_job_item<1>(in[35], in[36], in[34], Wgu2, D, 2 * FF, FF, r, scr, lane); continue; } r -= I_GU;
            if (r < I_D) { sb::transpose_job_item<0>(in[14], nullptr, nullptr, Wd1, FF, D, D, r, scr, lane); continue; } r -= I_D;
            if (r < I_D) { sb::transpose_job_item<0>(in[37], nullptr, nullptr, Wd2, FF, D, D, r, scr, lane); continue; } r -= I_D;
            if (r < I_IN) { sb::transpose_job_item<2>(in[16], nullptr, in[15], Win, D, 1536, 1536, r, scr, lane); continue; } r -= I_IN;
            if (r < I_GLU) { sb::transpose_job_item<0>(in[25], nullptr, nullptr, Wglu, SSM, SSM, SSM, r, scr, lane); continue; } r -= I_GLU;
            if (r < I_SQ) { sb::transpose_job_item<0>(in[30], nullptr, nullptr, Wout, D, D, D, r, scr, lane); continue; } r -= I_SQ;
            if (r < I_SQ) { sb::transpose_job_item<0>(in[32], nullptr, in[31], Wq, D, D, D, r, scr, lane); continue; } r -= I_SQ;
            if (r < I_SQ) { sb::transpose_job_item<0>(in[33], nullptr, nullptr, Wo, D, D, D, r, scr, lane); continue; } r -= I_SQ;
            sb::transpose_job_item<3>(in[9], in[10], in[8], Wkv, D, 2048, D, r, scr, lane);
        }
        for (int m = gw; m < M; m += NGW) sb::row_bf16_ss(m < MP ? in[0] + (size_t)m * D : in[1] + (size_t)(m - MP) * D, xb + (size_t)m * D, ss0 + (size_t)m * 16, lane);
        for (int m = gw; m < MMEM; m += NGW) sb::row_bf16_ss(in[7] + (size_t)m * D, memb + (size_t)m * D, ssm + (size_t)m * 16, lane);
        if (BOTH(PH_PRO)) GRID_BAR();
    }

    if (IN(PH_GU1)) {
        { pg8::Gemm g{memb, Wkv, MMEM, 2048, D}; pg8::StaticOrder S; S.init(MMEM, 2048, G, bx); fx::EpiKV E{ssm, kb, vb2, out};
          pg8::gemm_phase<fx::EpiKV, pg8::StaticOrder, true, true>(L + RING_OFF, g, S, E); }
        { pg8::Gemm g{xb, Wgu1, M, 2 * FF, D}; pg8::StaticOrder S; S.init(M, 2 * FF, G, bx); fx::EpiSwiglu E{ss0, hb};
          pg8::gemm_phase<fx::EpiSwiglu, pg8::StaticOrder, true, true>(L + RING_OFF, g, S, E); }
        if (BOTH(PH_GU1)) GRID_BAR();
    }
    if (IN(PH_D1)) {
        pg8::Gemm g{hb, Wd1, M, D, FF}; pg8::StaticOrder S; S.init(M, D, G, bx); fx::EpiRes E{args.in[0], args.in[1] - (size_t)MP * D, xres, xb, ss1, 0.5f};
        pg8::gemm_phase<fx::EpiRes, pg8::StaticOrder, true, true>(L + RING_OFF, g, S, E);
        if (BOTH(PH_D1)) GRID_BAR();
    }
    if (IN(PH_IN)) {
        pg8::Gemm g{xb, Win, M, 1536, D}; pg8::StaticOrder S; S.init(M, 1536, G, bx); fx::EpiIn E{ss1, ug, vb, out};
        pg8::gemm_phase<fx::EpiIn, pg8::StaticOrder, true, true>(L + RING_OFF, g, S, E);
        if (BOTH(PH_IN)) GRID_BAR();
    }
    if (IN(PH_MIX)) {
        for (int unit = bx; unit < NBATCH * NG; unit += G) s5f::prompt_unit(unit >> 5, unit & 31, ug, Ktab, Ptab, Qtab, ALtab, in[24], gb, out, L + RING_OFF, tid, wave, lane);
        for (int task = NBATCH * NG + wave * G + bx; task < (NBATCH + DECB) * NG; task += G * NWAVES)
            sb::s5_task(task, ug, in[2], in[3], in[17], in[18], in[19], in[20], in[21], in[22], in[23], in[24], gb, out, lane);
        __syncthreads();
        LAS float* red = (LAS float*)(L + RING_OFF);
        for (int row = bx; row < M; row += G) { sb::conv_row(row, vb, in[4], in[26], in[27], in[28], in[29], mixb, out, red, tid); __syncthreads(); }
        if (BOTH(PH_MIX)) GRID_BAR();
    }

    if (IN(PH_GLU)) {
        pg8::Gemm g{gb, Wglu, M, SSM, SSM}; pg8::StaticOrder S; S.init(M, SSM, G, bx); fx::EpiGlu E{gb, mixb};
        pg8::gemm_phase<fx::EpiGlu, pg8::StaticOrder, true, true>(L + RING_OFF, g, S, E);
        if (BOTH(PH_GLU)) GRID_BAR();
    }
    if (IN(PH_OUT)) {
        pg8::Gemm g{mixb, Wout, M, D, D}; pg8::StaticOrder S; S.init(M, D, G, bx); fx::EpiRes E{xres, xres, xres, xb, ss2, 1.f};
        pg8::gemm_phase<fx::EpiRes, pg8::StaticOrder, true, true>(L + RING_OFF, g, S, E);
        if (BOTH(PH_OUT)) GRID_BAR();
    }
    if (IN(PH_Q)) {
        pg8::Gemm g{xb, Wq, M, D, D}; pg8::StaticOrder S; S.init(M, D, G, bx); fx::EpiQ E{ss2, qb};
        pg8::gemm_phase<fx::EpiQ, pg8::StaticOrder, true, true>(L + RING_OFF, g, S, E);
        if (BOTH(PH_Q)) GRID_BAR();
    }
    if (IN(PH_ATT)) {
        const int half = tid >> 8, t256 = tid & 255;
        LAS float* scr = (LAS float*)(L + RING_OFF + half * 32768);
        constexpr int NPAIR = (M / 8) * NH / 2;
        for (int pi = bx; pi < NPAIR; pi += G) sb::attn_task(pi * 2 + half, qb, kb, vb2, in[5], in[6], ob, scr, t256);
        if (BOTH(PH_ATT)) GRID_BAR();
    }

    if (IN(PH_O)) {
        pg8::Gemm g{ob, Wo, M, D, D}; pg8::StaticOrder S; S.init(M, D, G, bx); fx::EpiRes E{xres, xres, xres, xb, ss3, 1.f};
        pg8::gemm_phase<fx::EpiRes, pg8::StaticOrder, true, true>(L + RING_OFF, g, S, E);
        if (BOTH(PH_O)) GRID_BAR();
    }
    if (IN(PH_GU2)) {
        pg8::Gemm g{xb, Wgu2, M, 2 * FF, D}; pg8::StaticOrder S; S.init(M, 2 * FF, G, bx); fx::EpiSwiglu E{ss3, hb};
        pg8::gemm_phase<fx::EpiSwiglu, pg8::StaticOrder, true, true>(L + RING_OFF, g, S, E);
        if (BOTH(PH_GU2)) GRID_BAR();
    }
    if (IN(PH_D2)) {
        pg8::Gemm g{hb, Wd2, M, D, FF}; pg8::StaticOrder S; S.init(M, D, G, bx); fx::EpiRes E{xres, xres, out + O_Y, nullptr, ss4, 0.5f};
        pg8::gemm_phase<fx::EpiRes, pg8::StaticOrder, true, true>(L + RING_OFF, g, S, E);
        if (BOTH(PH_D2)) GRID_BAR();
    }

    if (IN(PH_FIN)) {
        float* y = out + O_Y; const float* gfin = in[38];
        for (int m = bx * NWAVES + wave; m < M; m += G * NWAVES) { const float r = rstd_from_ss(ss4, m);
#pragma unroll
            for (int j = 0; j < 4; ++j) { f32x4* p = (f32x4*)(y + (size_t)m * D + j * 256 + lane * 4); const f32x4 gg = *(const f32x4*)(gfin + j * 256 + lane * 4); f32x4 v = *p; v = v * r * gg; *p = v; } }
    }
#undef IN
#undef BOTH
#undef GRID_BAR
}

#ifndef FAST_MERGE
#define FAST_MERGE 1
#endif
extern "C" void kernel_launch(void* const* d_in, const int* in_sizes, int n_in, void* d_out, int out_size, void* d_ws, size_t ws_size, hipStream_t stream) {
    if (n_in != 39 || out_size != (int)O_END || ws_size < WS_END) { fprintf(stderr, "kernel_launch: unexpected shapes n_in %d out %d ws %zu\n", n_in, out_size, ws_size); return; }
    static int grid = 0;
    if (grid == 0) {
        int dev = 0, cus = 0;
        if (hipGetDevice(&dev) != hipSuccess || hipDeviceGetAttribute(&cus, hipDeviceAttributeMultiprocessorCount, dev) != hipSuccess) { grid = -1; return; }
        if (hipFuncSetAttribute((const void*)mk_fwd, hipFuncAttributeMaxDynamicSharedMemorySize, LDS_BYTES) != hipSuccess) { fprintf(stderr, "kernel_launch: hipFuncSetAttribute failed\n"); grid = -1; return; }
        int per_cu = 0;
        if (hipOccupancyMaxActiveBlocksPerMultiprocessor(&per_cu, (const void*)mk_fwd, NWAVES * 64, LDS_BYTES) != hipSuccess || per_cu < 1) { fprintf(stderr, "kernel_launch: occupancy query says %d\n", per_cu); }
        (void)hipGetLastError();
        grid = cus;
    }
    if (grid < 0) return;
    const float* const* in = (const float* const*)d_in;
    const float *x_p = in[0], *x_s = in[1], *st_re = in[2], *st_im = in[3], *cconv = in[4], *cmk = in[5], *cmv = in[6], *memp = in[7], *g_mem = in[8], *w_k = in[9], *w_v = in[10],
                *g_ffn1 = in[11], *w1g = in[12], *w1u = in[13], *w1d = in[14], *g_mix = in[15], *w_in = in[16], *a_re = in[17], *a_im = in[18], *log_dt = in[19], *b_re = in[20], *b_im = in[21],
                *c_re = in[22], *c_im = in[23], *ssm_d = in[24], *w_glu = in[25], *conv_w = in[26], *conv_b = in[27], *ln_g = in[28], *ln_b = in[29], *w_out = in[30], *g_xattn = in[31],
                *w_q = in[32], *w_o = in[33], *g_ffn2 = in[34], *w2g = in[35], *w2u = in[36], *w2d = in[37], *g_final = in[38];
    (void)x_p; (void)x_s;
    unsigned char* ws = (unsigned char*)d_ws; float* out = (float*)d_out;
    bf16_t *Wgu1 = (bf16_t*)(ws + WS_WGU1), *Wgu2 = (bf16_t*)(ws + WS_WGU2), *Wd1 = (bf16_t*)(ws + WS_WD1), *Wd2 = (bf16_t*)(ws + WS_WD2), *Win = (bf16_t*)(ws + WS_WIN), *Wglu = (bf16_t*)(ws + WS_WGLU),
           *Wout = (bf16_t*)(ws + WS_WOUT), *Wq = (bf16_t*)(ws + WS_WQ), *Wo = (bf16_t*)(ws + WS_WO), *Wkv = (bf16_t*)(ws + WS_WKV);
    bf16_t *xb = (bf16_t*)(ws + WS_XB), *memb = (bf16_t*)(ws + WS_MEMB), *kb = (bf16_t*)(ws + WS_KB), *vb2 = (bf16_t*)(ws + WS_VB2), *ug = (bf16_t*)(ws + WS_UG),
           *vb = (bf16_t*)(ws + WS_VB), *gb = (bf16_t*)(ws + WS_GB), *mixb = (bf16_t*)(ws + WS_MIXB), *qb = (bf16_t*)(ws + WS_QB), *ob = (bf16_t*)(ws + WS_OB);
    float *ss0 = (float*)(ws + WS_SS0), *ss4 = (float*)(ws + WS_SS4), *ssm = (float*)(ws + WS_SSM);

    if (hipMemsetAsync(ws + WS_CTL, 0, CTL_ZERO_BYTES, stream) != hipSuccess) return;
    Args a{};
    for (int i = 0; i < 39; ++i) a.in[i] = in[i];
    a.out = out; a.ws = ws;
    int li = 0;
    auto run = [&](int lo, int hi) {
        if (FAST_MERGE) { a.ph_lo = lo; a.ph_hi = hi; a.li = li++; hipLaunchKernelGGL(mk_fwd, dim3(grid), dim3(NWAVES * 64), LDS_BYTES, stream, a); }
        else for (int p = lo; p < hi; ++p) { a.ph_lo = p; a.ph_hi = p + 1; a.li = li; hipLaunchKernelGGL(mk_fwd, dim3(grid), dim3(NWAVES * 64), LDS_BYTES, stream, a); }
    };

    run(PH_PRO, PH_N);
}
```

```cpp
#include <hip/hip_runtime.h>
#include <cstdint>
#include <cstdio>

typedef unsigned short bf16_t;
typedef float f32x4 __attribute__((ext_vector_type(4)));

constexpr int D = 1024, FF = 2816, MP = 16384, MS = 1024, M = MP + MS;
constexpr int SEQ = 2048, DECB = 128, DECS = 8, NBATCH = 8;
constexpr int SSM = 512, CONVD = 512, NG = 32, GC = 16, NST = 64, CWID = 31, NMEM = 256, NH = 4, HD = 256;
constexpr int MMEM = NBATCH * NMEM;
constexpr float EPS = 1e-6f;
constexpr float QSCALE = 0.0625f * 1.4426950408889634f;

constexpr size_t O_Y = 0;
constexpr size_t O_SRP = (size_t)M * D;
constexpr size_t O_SIP = O_SRP + 16384;
constexpr size_t O_CVP = O_SIP + 16384;
constexpr size_t O_MKP = O_CVP + 122880;
constexpr size_t O_MVP = O_MKP + 2097152;
constexpr size_t O_SRS = O_MVP + 2097152;
constexpr size_t O_SIS = O_SRS + 262144;
constexpr size_t O_CVS = O_SIS + 262144;
constexpr size_t O_END = O_CVS + 1966080;

constexpr size_t MiB = 1u << 20;
constexpr size_t WS_CTL = 0;
constexpr size_t WS_WGU1 = 2 * MiB, WS_WGU2 = 13 * MiB, WS_WD1 = 24 * MiB, WS_WD2 = 30 * MiB, WS_WIN = 36 * MiB, WS_WGLU = 39 * MiB,
                 WS_WOUT = 40 * MiB, WS_WQ = 42 * MiB, WS_WO = 44 * MiB, WS_WKV = 46 * MiB;
constexpr size_t WS_TAB = 50 * MiB;
constexpr size_t WS_XB = 72 * MiB, WS_MEMB = 106 * MiB, WS_KB = 110 * MiB, WS_VB2 = 114 * MiB;
constexpr size_t WS_SS0 = 118 * MiB, WS_SS1 = 120 * MiB, WS_SS2 = 122 * MiB, WS_SS3 = 124 * MiB, WS_SS4 = 126 * MiB, WS_SSM = 127 * MiB + 512 * 1024;
constexpr size_t WS_XRES = 128 * MiB, WS_H = 196 * MiB, WS_UG = 290 * MiB, WS_VB = 307 * MiB, WS_GB = 324 * MiB, WS_MIXB = 342 * MiB,
                 WS_QB = 376 * MiB, WS_OB = 410 * MiB, WS_END = 444 * MiB;

__device__ __forceinline__ unsigned f2bf(float f) { unsigned u = __builtin_bit_cast(unsigned, f); return (u + 0x7fffu + ((u >> 16) & 1u)) >> 16; }
__device__ __forceinline__ float bf2f(bf16_t b) { return __builtin_bit_cast(float, (unsigned)b << 16); }
__device__ __forceinline__ float sigmoidf_(float x) { return 1.f / (1.f + __expf(-x)); }
__device__ __forceinline__ float siluf_(float x) { return x * sigmoidf_(x); }
__device__ __forceinline__ float gelu_tanh(float x) { const float u = 0.7978845608028654f * (x + 0.044715f * x * x * x); return 0.5f * x * (1.f + tanhf(u)); }
__device__ __forceinline__ float wave_sum(float v) {
#pragma unroll
    for (int o = 1; o < 64; o <<= 1) v += __shfl_xor(v, o);
    return v;
}
__device__ __forceinline__ float rstd_from_ss(const float* ss, int row) {
    float s = 0.f;
#pragma unroll
    for (int i = 0; i < 16; ++i) s += ss[(size_t)row * 16 + i];
    return rsqrtf(s * (1.f / D) + EPS);
}

template <int MAP>
__global__ void k_wt(const float* W0, const float* W1, const float* gain, bf16_t* WT, int K, int N, int ldw) {
    __shared__ float tile[32][33];
    const int n0 = blockIdx.x * 32, k0 = blockIdx.y * 32, tx = threadIdx.x & 31, ty = threadIdx.x >> 5;
    const float* W = W0; int c0 = n0;
    if (MAP == 1) { const int pn = n0 / 256, half = (n0 % 256) / 128, jj = n0 % 128; W = half ? W1 : W0; c0 = pn * 128 + jj; }
    if (MAP == 2) { if (n0 >= 512) { const int m = n0 - 512, pc = m / 256, half = (m % 256) / 128, jj = m % 128; c0 = 512 + half * 512 + pc * 128 + jj; } }
    if (MAP == 3) { if (n0 >= 1024) { W = W1; c0 = n0 - 1024; } }
    for (int i = ty; i < 32; i += 8) { const int k = k0 + i; tile[i][tx] = W[(size_t)k * ldw + c0 + tx] * (gain ? gain[k] : 1.f); }
    __syncthreads();
    for (int i = ty; i < 32; i += 8) WT[(size_t)(n0 + i) * K + k0 + tx] = (bf16_t)f2bf(tile[tx][i]);
}
__global__ void k_rows_bf16_ss(const float* x0, int rows0, const float* x1, int rows1, bf16_t* xb, float* ss) {
    const int row = blockIdx.x * 4 + (threadIdx.x >> 6), lane = threadIdx.x & 63;
    if (row >= rows0 + rows1) return;
    const float* xr = row < rows0 ? x0 + (size_t)row * D : x1 + (size_t)(row - rows0) * D;
    float s = 0.f;
    for (int j = 0; j < 4; ++j) { const f32x4 v = *(const f32x4*)(xr + j * 256 + lane * 4); s += v.x * v.x + v.y * v.y + v.z * v.z + v.w * v.w;
        uint2 o; o.x = f2bf(v.x) | (f2bf(v.y) << 16); o.y = f2bf(v.z) | (f2bf(v.w) << 16); *(uint2*)(xb + (size_t)row * D + j * 256 + lane * 4) = o; }
    s = wave_sum(s);
    if (lane < 16) ss[(size_t)row * 16 + lane] = lane == 0 ? s : 0.f;
}
__global__ void k_rows_ss(const float* x, int rows, float* ss) {
    const int row = blockIdx.x * 4 + (threadIdx.x >> 6), lane = threadIdx.x & 63;
    if (row >= rows) return;
    float s = 0.f;
    for (int j = 0; j < 4; ++j) { const f32x4 v = *(const f32x4*)(x + (size_t)row * D + j * 256 + lane * 4); s += v.x * v.x + v.y * v.y + v.z * v.z + v.w * v.w; }
    s = wave_sum(s);
    if (lane < 16) ss[(size_t)row * 16 + lane] = lane == 0 ? s : 0.f;
}

enum { E_KV = 1, E_SWIGLU = 2, E_RES = 3, E_U = 4, E_V = 5, E_GLU = 6, E_Q = 7 };
struct EpiP {
    const float* ss;
    const float* resin;
    float* resout;
    bf16_t* ob;
    bf16_t* ob2;
    const bf16_t* gb;
    float* out;
    float alpha;
    int pad;
};
template <int MODE>
__device__ __forceinline__ void epi_elem(const EpiP& P, int row, int c, float a0, float a1, float rstd) {
    if (MODE == E_KV) {
        const float v = a0 * rstd;
        if (c < 1024) { P.out[O_MKP + (size_t)row * 1024 + c] = v; P.ob[(size_t)row * 1024 + c] = (bf16_t)f2bf(v); }
        else { P.out[O_MVP + (size_t)row * 1024 + c - 1024] = v; P.ob2[(size_t)row * 1024 + c - 1024] = (bf16_t)f2bf(v); }
    } else if (MODE == E_SWIGLU) {
        const float g = a0 * rstd, u = a1 * rstd; P.ob[(size_t)row * FF + c] = (bf16_t)f2bf(siluf_(g) * u);
    } else if (MODE == E_RES) {
        const float v = P.resin[(size_t)row * D + c] + P.alpha * a0; P.resout[(size_t)row * D + c] = v; if (P.ob) P.ob[(size_t)row * D + c] = (bf16_t)f2bf(v);
    } else if (MODE == E_U) {
        P.ob[((size_t)(c >> 4) * M + row) * 16 + (c & 15)] = (bf16_t)f2bf(a0 * rstd);
    } else if (MODE == E_V) {
        const float v = (a0 * rstd) * sigmoidf_(a1 * rstd); P.ob[(size_t)row * CONVD + c] = (bf16_t)f2bf(v);
        if (row < MP) { const int b = row / SEQ, t = row % SEQ; if (t >= SEQ - 30) P.out[O_CVP + ((size_t)b * 30 + (t - (SEQ - 30))) * CONVD + c] = v; }
        else { const int rs = row - MP, b = rs / DECS, t = rs % DECS; P.out[O_CVS + ((size_t)b * 30 + 22 + t) * CONVD + c] = v; }
    } else if (MODE == E_GLU) {
        const float g = bf2f(P.gb[(size_t)row * SSM + c]); P.ob[(size_t)row * D + c] = (bf16_t)f2bf(g * sigmoidf_(a0));
    } else if (MODE == E_Q) {
        P.ob[(size_t)row * D + c] = (bf16_t)f2bf(a0 * rstd * QSCALE);
    }
}
template <int MODE> struct ModeTraits { static constexpr bool PAIRED = (MODE == E_SWIGLU || MODE == E_V); static constexpr bool RSTD = (MODE == E_KV || MODE == E_SWIGLU || MODE == E_U || MODE == E_V || MODE == E_Q); };

template <int MODE>
__global__ void __launch_bounds__(256) k_ref_gemm(const bf16_t* A, const bf16_t* BT, int K, EpiP P) {
    constexpr bool PAIRED = ModeTraits<MODE>::PAIRED;
    __shared__ float As[32][65], B0[32][65], B1[PAIRED ? 32 : 1][65];
    const int tid = threadIdx.x, tx = tid & 15, ty = tid >> 4;
    const int m0 = blockIdx.y * 64, p0 = blockIdx.x * 64;
    const int cb0 = PAIRED ? (p0 / 128) * 256 + (p0 % 128) : p0;
    float acc0[4][4], acc1[4][4];
    for (int i = 0; i < 4; ++i) for (int j = 0; j < 4; ++j) { acc0[i][j] = 0.f; acc1[i][j] = 0.f; }
    for (int k0 = 0; k0 < K; k0 += 32) {
        for (int e = tid; e < 64 * 32; e += 256) { const int r = e >> 5, k = e & 31;
            As[k][r] = bf2f(A[(size_t)(m0 + r) * K + k0 + k]); B0[k][r] = bf2f(BT[(size_t)(cb0 + r) * K + k0 + k]);
            if (PAIRED) B1[k][r] = bf2f(BT[(size_t)(cb0 + 128 + r) * K + k0 + k]); }
        __syncthreads();
        for (int k = 0; k < 32; ++k) {
            float a[4], b0[4], b1[4];
            for (int i = 0; i < 4; ++i) a[i] = As[k][ty * 4 + i];
            for (int j = 0; j < 4; ++j) { b0[j] = B0[k][tx * 4 + j]; b1[j] = PAIRED ? B1[k][tx * 4 + j] : 0.f; }
            for (int i = 0; i < 4; ++i) for (int j = 0; j < 4; ++j) { acc0[i][j] += a[i] * b0[j]; if (PAIRED) acc1[i][j] += a[i] * b1[j]; }
        }
        __syncthreads();
    }
    for (int i = 0; i < 4; ++i) { const int row = m0 + ty * 4 + i; const float rstd = ModeTraits<MODE>::RSTD ? rstd_from_ss(P.ss, row) : 1.f;
        for (int j = 0; j < 4; ++j) epi_elem<MODE>(P, row, p0 + tx * 4 + j, acc0[i][j], acc1[i][j], rstd); }
}

__global__ void __launch_bounds__(64) k_ref_s5(const bf16_t* ug, const float* h0re, const float* h0im, const float* a_re, const float* a_im, const float* log_dt,
                                               const float* b_re, const float* b_im, const float* c_re, const float* c_im, const float* dskip, bf16_t* gb, float* out) {
    const int g = blockIdx.x % NG, sq = blockIdx.x / NG, n = threadIdx.x;
    const bool prompt = sq < NBATCH; const int b = prompt ? sq : sq - NBATCH, T = prompt ? SEQ : DECS, row0 = prompt ? b * SEQ : MP + b * DECS;
    const float dt = expf(log_dt[g]), lr = a_re[g * NST + n], li = a_im[g * NST + n];
    const float mag = expf(lr * dt), abr = mag * cosf(li * dt), abi = mag * sinf(li * dt);
    const float den = lr * lr + li * li, nr = abr - 1.f, ni = abi, cr = (nr * lr + ni * li) / den, ci = (ni * lr - nr * li) / den;
    float Br[16], Bi[16], Cr[16], Ci[16];
    for (int c = 0; c < 16; ++c) { const float br = b_re[((size_t)g * NST + n) * 16 + c], bi = b_im[((size_t)g * NST + n) * 16 + c];
        Br[c] = cr * br - ci * bi; Bi[c] = cr * bi + ci * br; Cr[c] = c_re[((size_t)g * 16 + c) * NST + n]; Ci[c] = c_im[((size_t)g * 16 + c) * NST + n]; }
    float hr = 0.f, hi = 0.f;
    if (!prompt) { hr = h0re[((size_t)b * NG + g) * NST + n]; hi = h0im[((size_t)b * NG + g) * NST + n]; }
    const float dsk = dskip[g * 16 + (n & 15)];
    for (int t = 0; t < T; ++t) {
        const bf16_t* up = ug + ((size_t)g * M + row0 + t) * 16;
        float u[16], xr = 0.f, xi = 0.f;
#pragma unroll
        for (int c = 0; c < 16; ++c) { u[c] = bf2f(up[c]); xr += Br[c] * u[c]; xi += Bi[c] * u[c]; }
        const float nhr = abr * hr - abi * hi + xr, nhi = abr * hi + abi * hr + xi; hr = nhr; hi = nhi;
        float ymine = 0.f;
#pragma unroll
        for (int c = 0; c < 16; ++c) { const float y = wave_sum(Cr[c] * hr - Ci[c] * hi); if ((n & 15) == c) ymine = y + dsk * u[c]; }
        if (n < 16) gb[(size_t)(row0 + t) * SSM + g * 16 + n] = (bf16_t)f2bf(gelu_tanh(ymine));
    }
    if (prompt) { out[O_SRP + ((size_t)b * NG + g) * NST + n] = hr; out[O_SIP + ((size_t)b * NG + g) * NST + n] = hi; }
    else { out[O_SRS + ((size_t)b * NG + g) * NST + n] = hr; out[O_SIS + ((size_t)b * NG + g) * NST + n] = hi; }
}

__global__ void __launch_bounds__(512) k_ref_conv(const bf16_t* vb, const float* cache, const float* w, const float* bias, const float* lg, const float* lb, bf16_t* mixb, float* out) {
    __shared__ float red[2][8];
    const int row = blockIdx.x, c = threadIdx.x;
    float y = bias[c];
    if (row < MP) { const int t = row % SEQ;
        for (int k = 0; k < CWID; ++k) { const int tt = t - 30 + k; if (tt >= 0) y += w[k * CONVD + c] * bf2f(vb[(size_t)(row - 30 + k) * CONVD + c]); }
    } else { const int rs = row - MP, b = rs / DECS, t = rs % DECS;
        for (int k = 0; k < CWID; ++k) { const int idx = t + k; const float xv = idx < 30 ? cache[((size_t)b * 30 + idx) * CONVD + c] : bf2f(vb[(size_t)(MP + b * DECS + idx - 30) * CONVD + c]); y += w[k * CONVD + c] * xv; }
        if (t == 0) for (int j = 0; j < 22; ++j) out[O_CVS + ((size_t)b * 30 + j) * CONVD + c] = cache[((size_t)b * 30 + j + 8) * CONVD + c];
    }
    float s = wave_sum(y); if ((c & 63) == 0) red[0][c >> 6] = s; __syncthreads();
    float mu = 0.f; for (int i = 0; i < 8; ++i) mu += red[0][i]; mu *= (1.f / CONVD);
    const float d = y - mu; float q = wave_sum(d * d); if ((c & 63) == 0) red[1][c >> 6] = q; __syncthreads();
    float var = 0.f; for (int i = 0; i < 8; ++i) var += red[1][i]; var *= (1.f / CONVD);
    const float z = d * rsqrtf(var + EPS) * lg[c] + lb[c];
    mixb[(size_t)row * D + SSM + c] = (bf16_t)f2bf(siluf_(z));
}

__global__ void __launch_bounds__(256) k_ref_attn(const bf16_t* qb, const bf16_t* kb, const bf16_t* vb2, const float* ck, const float* cv, bf16_t* ob) {
    __shared__ float q[256], p[256], red[4];
    const int row = blockIdx.x >> 2, h = blockIdx.x & 3, tid = threadIdx.x;
    q[tid] = bf2f(qb[(size_t)row * D + h * HD + tid]);
    __syncthreads();
    float s = 0.f;
    if (row < MP) { const int b = row / SEQ; const bf16_t* kr = kb + ((size_t)b * NMEM + tid) * D + h * HD; for (int d = 0; d < HD; ++d) s += q[d] * bf2f(kr[d]); }
    else { const int b = (row - MP) / DECS; const float* kr = ck + ((size_t)b * NMEM + tid) * D + h * HD; for (int d = 0; d < HD; ++d) s += q[d] * kr[d]; }
    float mx = s; for (int o = 1; o < 64; o <<= 1) mx = fmaxf(mx, __shfl_xor(mx, o));
    if ((tid & 63) == 0) red[tid >> 6] = mx; __syncthreads();
    mx = fmaxf(fmaxf(red[0], red[1]), fmaxf(red[2], red[3])); __syncthreads();
    const float e = exp2f(s - mx); float sm = wave_sum(e);
    if ((tid & 63) == 0) red[tid >> 6] = sm; __syncthreads();
    sm = red[0] + red[1] + red[2] + red[3];
    p[tid] = e / sm; __syncthreads();
    float o = 0.f;
    if (row < MP) { const int b = row / SEQ; const bf16_t* vr = vb2 + (size_t)b * NMEM * D + h * HD + tid; for (int m = 0; m < NMEM; ++m) o += p[m] * bf2f(vr[(size_t)m * D]); }
    else { const int b = (row - MP) / DECS; const float* vr = cv + (size_t)b * NMEM * D + h * HD + tid; for (int m = 0; m < NMEM; ++m) o += p[m] * vr[(size_t)m * D]; }
    ob[(size_t)row * D + h * HD + tid] = (bf16_t)f2bf(o);
}

__global__ void k_final(float* y, const float* ss, const float* g) {
    const int row = blockIdx.x * 4 + (threadIdx.x >> 6), lane = threadIdx.x & 63;
    const float r = rstd_from_ss(ss, row);
    for (int j = 0; j < 4; ++j) { f32x4* p = (f32x4*)(y + (size_t)row * D + j * 256 + lane * 4); const f32x4 gg = *(const f32x4*)(g + j * 256 + lane * 4); f32x4 v = *p; v = v * r * gg; *p = v; }
}


namespace pg8 {
#define PG8_LAS __attribute__((address_space(3)))
typedef unsigned short bf16_t;
typedef short bf16x8 __attribute__((ext_vector_type(8)));
typedef float f32x4 __attribute__((ext_vector_type(4)));
typedef unsigned u32x4 __attribute__((ext_vector_type(4)));
constexpr int BM = 256, BK = 64, HALF = 128, HTB = HALF * BK * 2  , STAGE_BYTES = 8 * HTB, NXCD = 8, WGM = 8;

__host__ __device__ __forceinline__ int lds_byte(int r, int c) { const int st = (r >> 4) * 2 + (c >> 5), rr = r & 15, cc = c & 31, ob = rr * 64 + cc * 2; return st * 1024 + (ob ^ (((ob >> 9) & 1) << 5)); }
__host__ __device__ __forceinline__ void stage_rc(int b, int& R, int& C) { const int st = b / 1024, sb = b % 1024, swz = sb ^ (((sb >> 9) & 1) << 5); R = (st >> 1) * 16 + swz / 64; C = (st & 1) * 32 + (swz % 64) / 2; }
__host__ __device__ __forceinline__ int perm32(int rho) { const int n = rho >> 4, i = rho & 15; return 8 * (i >> 2) + 4 * n + (i & 3); }

struct Unit { int pm, pn; };
struct Gemm { const bf16_t* A; const bf16_t* Bt; int M, N, K; };

struct StaticOrder {
    int nM, nN, nwg, G, c;
    __host__ __device__ void init(int M, int N, int G_, int c_) { nM = M / BM; nN = N / BM; nwg = nM * nN; G = G_; c = c_; }
    __host__ __device__ bool next(int i, Unit& u) const {
        const long L = (long)i * G + c; if (L >= nwg) return false;
        int wgid = (int)L; { const int q = nwg / NXCD, r = nwg % NXCD, xcd = wgid % NXCD, off = wgid / NXCD; wgid = (xcd < r ? xcd * (q + 1) : r * (q + 1) + (xcd - r) * q) + off; }
        const int nig = WGM * nN, gid = wgid / nig, fm = gid * WGM, gsz = (nM - fm) < WGM ? (nM - fm) : WGM;
        u.pm = fm + ((wgid % nig) % gsz); u.pn = (wgid % nig) / gsz; return true;
    }
    __device__ __forceinline__ void a_ready(const Unit&) const {}
    __device__ __forceinline__ void done(const Unit&) const {}
};
__device__ __forceinline__ unsigned cvt_pk_bf16(float lo, float hi) { unsigned r; asm volatile("v_cvt_pk_bf16_f32 %0, %1, %2" : "=v"(r) : "v"(lo), "v"(hi)); return r; }
typedef float f32x2 __attribute__((ext_vector_type(2)));
template <class Epi, class Sched, bool ALIGN_EPI = false, bool SP2 = false>
__device__ __forceinline__ void gemm_phase(PG8_LAS unsigned char* lds, const Gemm g, const Sched& S, const Epi& E) {
    const int tid = threadIdx.x, wid = __builtin_amdgcn_readfirstlane(tid >> 6), lane = tid & 63, wr = wid >> 2, wc = wid & 3, fr = lane & 15, fq = lane >> 4;
    const int K = g.K, nt = K / BK;
    unsigned voffA[2], voffB[2];
#pragma unroll
    for (int i = 0; i < 2; ++i) { int R, C; stage_rc(tid * 16 + i * 8192, R, C); const int Rb = Epi::PERM ? ((R & ~31) + perm32(R & 31)) : R;
        voffA[i] = (unsigned)(R * K + C) * 2u; voffB[i] = (unsigned)(Rb * K + C) * 2u; }
    const size_t kstep = (size_t)(BK * 2);
    const size_t hstep = (size_t)HALF * K * 2;
    const size_t tstep = 2 * hstep;
    const unsigned ldsw = (unsigned)wid * 1024u;
    const int aoff = lds_byte(wr * 64 + fr, fq * 8), boff = lds_byte(wc * 32 + fr, fq * 8);
#define PG8_SA(b, h) (((b) * 2 + (h)) * HTB)
#define PG8_SB(b, h) ((4 + (b) * 2 + (h)) * HTB)
#define PG8_STAGE(bufoff, gbase, voff) do { _Pragma("unroll") for (int _i = 0; _i < 2; ++_i) \
        __builtin_amdgcn_global_load_lds((const unsigned*)((const char*)(gbase) + (voff)[_i]), (PG8_LAS unsigned*)(lds + (bufoff) + ldsw + _i * 8192), 16, 0, 0); } while (0)
#define PG8_LDA(dst, b, h) do { _Pragma("unroll") for (int m = 0; m < 4; ++m) _Pragma("unroll") for (int k = 0; k < 2; ++k) dst[m][k] = *(const PG8_LAS bf16x8*)(lds + PG8_SA(b, h) + aoff + m * 2048 + k * 1024); } while (0)
#define PG8_LDB(dst, b, h) do { _Pragma("unroll") for (int n = 0; n < 2; ++n) _Pragma("unroll") for (int k = 0; k < 2; ++k) dst[n][k] = *(const PG8_LAS bf16x8*)(lds + PG8_SB(b, h) + boff + n * 2048 + k * 1024); } while (0)
#define PG8_MMA(ai, bj, At, Bt) do { __builtin_amdgcn_s_setprio(1); _Pragma("unroll") for (int m = 0; m < 4; ++m) _Pragma("unroll") for (int n = 0; n < 2; ++n) _Pragma("unroll") for (int k = 0; k < 2; ++k) \
        acc[ai][bj][m][n] = __builtin_amdgcn_mfma_f32_16x16x32_bf16(Bt[n][k], At[m][k], acc[ai][bj][m][n], 0, 0, 0); __builtin_amdgcn_s_setprio(0); } while (0)
#define PG8_WAIT_V(n) asm volatile("s_waitcnt vmcnt(" #n ")" ::: "memory")
#define PG8_WAIT_L(n) asm volatile("s_waitcnt lgkmcnt(" #n ")" ::: "memory")
#define PG8_BAR __builtin_amdgcn_s_barrier()
#define PG8_SCHED __builtin_amdgcn_sched_barrier(0)
    Unit cur, nxt; int ui = 0;
    if (!S.next(0, cur)) return;
    f32x4 acc[2][2][4][2];
#pragma unroll
    for (int a = 0; a < 2; ++a)
#pragma unroll
        for (int b = 0; b < 2; ++b)
#pragma unroll
            for (int m = 0; m < 4; ++m)
#pragma unroll
                for (int n = 0; n < 2; ++n) acc[a][b][m][n] = (f32x4){0.f, 0.f, 0.f, 0.f};
    bf16x8 At[4][2], B0[2][2], B1[2][2];
    const char* cA = (const char*)g.A + (size_t)cur.pm * tstep; const char* cB = (const char*)g.Bt + (size_t)cur.pn * tstep;
    S.a_ready(cur);
    if constexpr (SP2) {
        PG8_STAGE(PG8_SB(0, 0), cB, voffB); PG8_STAGE(PG8_SB(0, 1), cB + hstep, voffB); PG8_STAGE(PG8_SA(0, 0), cA, voffA); PG8_STAGE(PG8_SA(0, 1), cA + hstep, voffA);
        if (wr == 1) PG8_BAR;
        PG8_WAIT_V(2); PG8_BAR;
        PG8_STAGE(PG8_SB(1, 0), cB + kstep, voffB); PG8_STAGE(PG8_SA(1, 0), cA + kstep, voffA); PG8_STAGE(PG8_SB(1, 1), cB + hstep + kstep, voffB);
        PG8_WAIT_V(6); PG8_BAR;
    } else {
        PG8_STAGE(PG8_SB(0, 0), cB, voffB); PG8_STAGE(PG8_SA(0, 0), cA, voffA); PG8_STAGE(PG8_SB(0, 1), cB + hstep, voffB); PG8_STAGE(PG8_SA(0, 1), cA + hstep, voffA);
        if (wr == 1) PG8_BAR;
        PG8_WAIT_V(4); PG8_BAR;
        PG8_STAGE(PG8_SB(1, 0), cB + kstep, voffB); PG8_STAGE(PG8_SA(1, 0), cA + kstep, voffA); PG8_STAGE(PG8_SB(1, 1), cB + hstep + kstep, voffB);
        PG8_WAIT_V(6); PG8_BAR;
    }
    for (;;) {
        const bool has_next = S.next(ui + 1, nxt);
        const char* nA = has_next ? (const char*)g.A + (size_t)nxt.pm * tstep : cA; const char* nB = has_next ? (const char*)g.Bt + (size_t)nxt.pn * tstep : cB;
        for (int t = 0; t < nt; t += 2) {
            const bool last = (t == nt - 2);
            const char* a1 = cA + (size_t)(t + 1) * kstep;
            const char* a2 = last ? nA : cA + (size_t)(t + 2) * kstep; const char* b2 = last ? nB : cB + (size_t)(t + 2) * kstep;
            const char* a3 = a2 + kstep; const char* b3 = b2 + kstep;
            if (last && has_next) S.a_ready(nxt);
            if constexpr (SP2) {
            PG8_LDB(B0, 0, 0); PG8_LDB(B1, 0, 1); PG8_SCHED; PG8_LDA(At, 0, 0); PG8_STAGE(PG8_SA(1, 1), a1 + hstep, voffA);
            PG8_WAIT_V(8); PG8_WAIT_L(0); PG8_BAR; PG8_MMA(0, 0, At, B0); PG8_MMA(0, 1, At, B1); PG8_BAR; PG8_SCHED;
            PG8_LDA(At, 0, 1); PG8_STAGE(PG8_SB(0, 0), b2, voffB); PG8_STAGE(PG8_SB(0, 1), b2 + hstep, voffB); PG8_STAGE(PG8_SA(0, 0), a2, voffA);
            PG8_WAIT_V(8); PG8_WAIT_L(0); PG8_BAR; PG8_MMA(1, 0, At, B0); PG8_MMA(1, 1, At, B1); PG8_BAR; PG8_SCHED;
            PG8_LDB(B0, 1, 0); PG8_LDB(B1, 1, 1); PG8_SCHED; PG8_LDA(At, 1, 0); PG8_STAGE(PG8_SA(0, 1), a2 + hstep, voffA);
            PG8_WAIT_V(8); PG8_WAIT_L(0); PG8_BAR; PG8_MMA(0, 0, At, B0); PG8_MMA(0, 1, At, B1); PG8_BAR; PG8_SCHED;
            PG8_LDA(At, 1, 1); PG8_STAGE(PG8_SB(1, 0), b3, voffB); PG8_STAGE(PG8_SB(1, 1), b3 + hstep, voffB); PG8_STAGE(PG8_SA(1, 0), a3, voffA);
            PG8_WAIT_V(8); PG8_WAIT_L(0); PG8_BAR; PG8_MMA(1, 0, At, B0); PG8_MMA(1, 1, At, B1); PG8_BAR; PG8_SCHED;
            } else {
            PG8_LDB(B0, 0, 0); PG8_SCHED; PG8_LDA(At, 0, 0); PG8_STAGE(PG8_SA(1, 1), a1 + hstep, voffA);
            PG8_WAIT_L(8); PG8_BAR; PG8_WAIT_L(0); PG8_MMA(0, 0, At, B0); PG8_BAR; PG8_SCHED;
            PG8_LDB(B1, 0, 1); PG8_STAGE(PG8_SB(0, 0), b2, voffB);
            PG8_BAR; PG8_WAIT_L(0); PG8_MMA(0, 1, At, B1); PG8_BAR;
            PG8_LDA(At, 0, 1); PG8_STAGE(PG8_SA(0, 0), a2, voffA);
            PG8_BAR; PG8_WAIT_L(0); PG8_MMA(1, 0, At, B0); PG8_BAR; PG8_SCHED;
            PG8_STAGE(PG8_SB(0, 1), b2 + hstep, voffB);
            PG8_WAIT_V(6); PG8_BAR; PG8_MMA(1, 1, At, B1); PG8_BAR;
            PG8_LDB(B0, 1, 0); PG8_SCHED; PG8_LDA(At, 1, 0); PG8_STAGE(PG8_SA(0, 1), a2 + hstep, voffA);
            PG8_WAIT_L(8); PG8_BAR; PG8_WAIT_L(0); PG8_MMA(0, 0, At, B0); PG8_BAR; PG8_SCHED;
            PG8_LDB(B1, 1, 1); PG8_STAGE(PG8_SB(1, 0), b3, voffB);
            PG8_BAR; PG8_WAIT_L(0); PG8_MMA(0, 1, At, B1); PG8_BAR;
            PG8_LDA(At, 1, 1); PG8_STAGE(PG8_SA(1, 0), a3, voffA);
            PG8_BAR; PG8_WAIT_L(0); PG8_MMA(1, 0, At, B0); PG8_BAR; PG8_SCHED;
            PG8_STAGE(PG8_SB(1, 1), b3 + hstep, voffB);
            PG8_WAIT_V(6); PG8_BAR; PG8_MMA(1, 1, At, B1); PG8_BAR;
            }
        }
        if constexpr (ALIGN_EPI) { if (wr == 0) PG8_BAR; }
        if constexpr (!Epi::AFTER_DRAIN) { E(acc, cur, wr, wc, fr, fq); S.done(cur); }
        if (!has_next) break;
#pragma unroll
        for (int a = 0; a < 2; ++a)
#pragma unroll
            for (int b = 0; b < 2; ++b)
#pragma unroll
                for (int m = 0; m < 4; ++m)
#pragma unroll
                    for (int n = 0; n < 2; ++n) acc[a][b][m][n] = (f32x4){0.f, 0.f, 0.f, 0.f};
        cur = nxt; cA = nA; cB = nB; ++ui;
        if constexpr (ALIGN_EPI) { if (wr == 1) PG8_BAR; }
    }
    PG8_WAIT_V(0);
    if constexpr (!ALIGN_EPI) { if (wr == 0) PG8_BAR; }
    PG8_BAR;
    if constexpr (Epi::AFTER_DRAIN) { E.fused(acc, cur, wr, wc, fr, fq, lds, wid, lane); S.done(cur); }
#undef PG8_SA
#undef PG8_SB
#undef PG8_STAGE
#undef PG8_LDA
#undef PG8_LDB
#undef PG8_MMA
#undef PG8_WAIT_V
#undef PG8_WAIT_L
#undef PG8_BAR
#undef PG8_SCHED
}
}

namespace fx {
using pg8::f32x4; using pg8::u32x4; using pg8::Unit; using pg8::HALF; using pg8::BM; using pg8::cvt_pk_bf16;
__device__ __forceinline__ float rstd_row(const float* ss, int row) {
    const f32x4* p = (const f32x4*)(ss + (size_t)row * 16); const f32x4 a = p[0], b = p[1], c = p[2], d = p[3];
    const float s = ((a.x + a.y) + (a.z + a.w)) + ((b.x + b.y) + (b.z + b.w)) + ((c.x + c.y) + (c.z + c.w)) + ((d.x + d.y) + (d.z + d.w));
    return rsqrtf(s * (1.f / D) + EPS);
}
__device__ __forceinline__ float fsig(float x) { return __builtin_amdgcn_rcpf(1.f + __builtin_amdgcn_exp2f(-1.4426950408889634f * x)); }
__device__ __forceinline__ u32x4 pack8(const f32x4 a, const f32x4 b) { u32x4 w; w.x = cvt_pk_bf16(a[0], a[1]); w.y = cvt_pk_bf16(a[2], a[3]); w.z = cvt_pk_bf16(b[0], b[1]); w.w = cvt_pk_bf16(b[2], b[3]); return w; }
__device__ __forceinline__ f32x4 sig4(const f32x4 x) { return (f32x4){fsig(x[0]), fsig(x[1]), fsig(x[2]), fsig(x[3])}; }

struct EpiKV { static constexpr bool PERM = true, AFTER_DRAIN = false; const float* ss; bf16_t* kb; bf16_t* vb2; float* out;
    __device__ __forceinline__ void operator()(const f32x4 (&acc)[2][2][4][2], const Unit& u, int wr, int wc, int fr, int fq) const {
        const int row0 = u.pm * BM + wr * 64 + fr; const bool isv = u.pn >= 4; const int colt = (isv ? u.pn - 4 : u.pn) * BM + wc * 32 + 8 * fq;
        float* of = out + (isv ? O_MVP : O_MKP); bf16_t* ob = isv ? vb2 : kb;
#pragma unroll
        for (int ai = 0; ai < 2; ++ai)
#pragma unroll
            for (int m = 0; m < 4; ++m) { const int row = row0 + ai * HALF + m * 16; const float r = rstd_row(ss, row);
#pragma unroll
                for (int bj = 0; bj < 2; ++bj) { const f32x4 v0 = acc[ai][bj][m][0] * r, v1 = acc[ai][bj][m][1] * r; const size_t o = (size_t)row * D + colt + bj * HALF;
                    *(f32x4*)(of + o) = v0; *(f32x4*)(of + o + 4) = v1; *(u32x4*)(ob + o) = pack8(v0, v1); } }
    }
};

struct EpiK { static constexpr bool PERM = true, AFTER_DRAIN = false; const float* rstdm; bf16_t* kb; float* out;
    __device__ __forceinline__ void operator()(const f32x4 (&acc)[2][2][4][2], const Unit& u, int wr, int wc, int fr, int fq) const {
        const int row0 = u.pm * BM + wr * 64 + fr, colt = u.pn * BM + wc * 32 + 8 * fq;
#pragma unroll
        for (int ai = 0; ai < 2; ++ai)
#pragma unroll
            for (int m = 0; m < 4; ++m) { const int row = row0 + ai * HALF + m * 16; const float r = rstdm[row];
#pragma unroll
                for (int bj = 0; bj < 2; ++bj) { const f32x4 v0 = acc[ai][bj][m][0] * r, v1 = acc[ai][bj][m][1] * r; const size_t o = (size_t)row * D + colt + bj * HALF;
                    *(f32x4*)(out + O_MKP + o) = v0; *(f32x4*)(out + O_MKP + o + 4) = v1; *(u32x4*)(kb + o) = pack8(v0, v1); } }
    }
};
struct EpiVT { static constexpr bool PERM = true, AFTER_DRAIN = false; const float* rstdm; bf16_t* vT; float* out;
    __device__ __forceinline__ void operator()(const f32x4 (&acc)[2][2][4][2], const Unit& u, int wr, int wc, int fr, int fq) const {
        const int row0 = u.pm * BM + wr * 64 + fr;
#pragma unroll
        for (int bj = 0; bj < 2; ++bj) { const int cl = bj * HALF + wc * 32 + 8 * fq, c0 = u.pn * BM + cl;
            const f32x4 r0 = *(const f32x4*)(rstdm + c0), r1 = *(const f32x4*)(rstdm + c0 + 4);
            const int pos0 = (cl & ~15) + 4 * ((cl >> 3) & 1);
#pragma unroll
            for (int ai = 0; ai < 2; ++ai)
#pragma unroll
                for (int m = 0; m < 4; ++m) { const int row = row0 + ai * HALF + m * 16; const f32x4 v0 = acc[ai][bj][m][0] * r0, v1 = acc[ai][bj][m][1] * r1;
                    bf16_t* vp = vT + (size_t)row * MMEM + u.pn * BM;
                    typedef unsigned u32x2 __attribute__((ext_vector_type(2)));
                    *(u32x2*)(vp + pos0) = (u32x2){cvt_pk_bf16(v0[0], v0[1]), cvt_pk_bf16(v0[2], v0[3])}; *(u32x2*)(vp + pos0 + 8) = (u32x2){cvt_pk_bf16(v1[0], v1[1]), cvt_pk_bf16(v1[2], v1[3])};
                    float* op = out + O_MVP + (size_t)c0 * D + row;
                    op[0] = v0[0]; op[D] = v0[1]; op[2 * D] = v0[2]; op[3 * D] = v0[3]; op[4 * D] = v1[0]; op[5 * D] = v1[1]; op[6 * D] = v1[2]; op[7 * D] = v1[3]; } }
    }
};
struct EpiSwiglu { static constexpr bool PERM = true, AFTER_DRAIN = false; const float* ss; bf16_t* H;
    __device__ __forceinline__ void operator()(const f32x4 (&acc)[2][2][4][2], const Unit& u, int wr, int wc, int fr, int fq) const {
        const int row0 = u.pm * BM + wr * 64 + fr, col0 = u.pn * HALF + wc * 32 + 8 * fq;
#pragma unroll
        for (int ai = 0; ai < 2; ++ai)
#pragma unroll
            for (int m = 0; m < 4; ++m) { const int row = row0 + ai * HALF + m * 16; const float r = rstd_row(ss, row);
                const f32x4 g0 = acc[ai][0][m][0] * r, g1 = acc[ai][0][m][1] * r, u0 = acc[ai][1][m][0] * r, u1 = acc[ai][1][m][1] * r;
                *(u32x4*)(H + (size_t)row * FF + col0) = pack8(g0 * sig4(g0) * u0, g1 * sig4(g1) * u1); }
    }
};
struct EpiRes { static constexpr bool PERM = true, AFTER_DRAIN = false; const float* rin0; const float* rin1; float* rout; bf16_t* xb; float* ss; float alpha;
    __device__ __forceinline__ void operator()(const f32x4 (&acc)[2][2][4][2], const Unit& u, int wr, int wc, int fr, int fq) const {
        const int row0 = u.pm * BM + wr * 64 + fr, col0 = u.pn * BM + wc * 32 + 8 * fq; const float* rin = u.pm >= MP / BM ? rin1 : rin0;
#pragma unroll
        for (int ai = 0; ai < 2; ++ai)
#pragma unroll
            for (int m = 0; m < 4; ++m) { const int row = row0 + ai * HALF + m * 16; float sq = 0.f;
#pragma unroll
                for (int bj = 0; bj < 2; ++bj) { const size_t o = (size_t)row * D + col0 + bj * HALF;
                    const f32x4 v0 = *(const f32x4*)(rin + o) + acc[ai][bj][m][0] * alpha, v1 = *(const f32x4*)(rin + o + 4) + acc[ai][bj][m][1] * alpha;
                    *(f32x4*)(rout + o) = v0; *(f32x4*)(rout + o + 4) = v1; if (xb) *(u32x4*)(xb + o) = pack8(v0, v1);
                    sq += (v0[0] * v0[0] + v0[1] * v0[1]) + (v0[2] * v0[2] + v0[3] * v0[3]) + (v1[0] * v1[0] + v1[1] * v1[1]) + (v1[2] * v1[2] + v1[3] * v1[3]); }
                sq += __shfl_xor(sq, 16); sq += __shfl_xor(sq, 32);
                if (fq == 0) ss[(size_t)row * 16 + u.pn * 4 + wc] = sq;
                if (m & 1) asm volatile("" ::: "memory"); }
    }
};
struct EpiIn { static constexpr bool PERM = true, AFTER_DRAIN = false; const float* ss; bf16_t* ug; bf16_t* vb; float* out;
    __device__ __forceinline__ void operator()(const f32x4 (&acc)[2][2][4][2], const Unit& u, int wr, int wc, int fr, int fq) const {
        const int row0 = u.pm * BM + wr * 64 + fr;
        if (u.pn < 2) {
#pragma unroll
            for (int ai = 0; ai < 2; ++ai)
#pragma unroll
                for (int m = 0; m < 4; ++m) { const int row = row0 + ai * HALF + m * 16; const float r = rstd_row(ss, row);
#pragma unroll
                    for (int bj = 0; bj < 2; ++bj) { const int c0 = u.pn * BM + bj * HALF + wc * 32 + 8 * fq;
                        *(u32x4*)(ug + ((size_t)(c0 >> 4) * M + row) * 16 + (c0 & 15)) = pack8(acc[ai][bj][m][0] * r, acc[ai][bj][m][1] * r); } }
        } else {
            const int p0 = (u.pn - 2) * HALF + wc * 32 + 8 * fq;
#pragma unroll
            for (int ai = 0; ai < 2; ++ai)
#pragma unroll
                for (int m = 0; m < 4; ++m) { const int row = row0 + ai * HALF + m * 16; const float r = rstd_row(ss, row);
                    const f32x4 a0 = acc[ai][0][m][0] * r, a1 = acc[ai][0][m][1] * r, g0 = acc[ai][1][m][0] * r, g1 = acc[ai][1][m][1] * r;
                    const f32x4 v0 = a0 * sig4(g0), v1 = a1 * sig4(g1);
                    *(u32x4*)(vb + (size_t)row * CONVD + p0) = pack8(v0, v1);
                    float* o = nullptr;
                    if (row >= MP) { const int rs = row - MP; o = out + O_CVS + ((size_t)(rs >> 3) * 30 + 22 + (rs & 7)) * CONVD + p0; }
                    else { const int t = row & (SEQ - 1); if (t >= SEQ - 30) o = out + O_CVP + ((size_t)(row >> 11) * 30 + (t - (SEQ - 30))) * CONVD + p0; }
                    if (o) { *(f32x4*)o = v0; *(f32x4*)(o + 4) = v1; } }
        }
    }
};
struct EpiGlu { static constexpr bool PERM = true, AFTER_DRAIN = false; const bf16_t* gb; bf16_t* mixb;
    __device__ __forceinline__ void operator()(const f32x4 (&acc)[2][2][4][2], const Unit& u, int wr, int wc, int fr, int fq) const {
        const int row0 = u.pm * BM + wr * 64 + fr, col0 = u.pn * BM + wc * 32 + 8 * fq;
#pragma unroll
        for (int ai = 0; ai < 2; ++ai)
#pragma unroll
            for (int m = 0; m < 4; ++m) { const int row = row0 + ai * HALF + m * 16;
#pragma unroll
                for (int bj = 0; bj < 2; ++bj) { const int c0 = col0 + bj * HALF; const u32x4 gw = *(const u32x4*)(gb + (size_t)row * SSM + c0);
                    const f32x4 ga = {__builtin_bit_cast(float, gw.x << 16), __builtin_bit_cast(float, gw.x & 0xffff0000u), __builtin_bit_cast(float, gw.y << 16), __builtin_bit_cast(float, gw.y & 0xffff0000u)};
                    const f32x4 gc = {__builtin_bit_cast(float, gw.z << 16), __builtin_bit_cast(float, gw.z & 0xffff0000u), __builtin_bit_cast(float, gw.w << 16), __builtin_bit_cast(float, gw.w & 0xffff0000u)};
                    *(u32x4*)(mixb + (size_t)row * D + c0) = pack8(ga * sig4(acc[ai][bj][m][0]), gc * sig4(acc[ai][bj][m][1])); } }
    }
};
struct EpiQ { static constexpr bool PERM = true, AFTER_DRAIN = false; const float* ss; bf16_t* qb;
    __device__ __forceinline__ void operator()(const f32x4 (&acc)[2][2][4][2], const Unit& u, int wr, int wc, int fr, int fq) const {
        const int row0 = u.pm * BM + wr * 64 + fr, col0 = u.pn * BM + wc * 32 + 8 * fq;
#pragma unroll
        for (int ai = 0; ai < 2; ++ai)
#pragma unroll
            for (int m = 0; m < 4; ++m) { const int row = row0 + ai * HALF + m * 16; const float r = rstd_row(ss, row) * QSCALE;
#pragma unroll
                for (int bj = 0; bj < 2; ++bj) *(u32x4*)(qb + (size_t)row * D + col0 + bj * HALF) = pack8(acc[ai][bj][m][0] * r, acc[ai][bj][m][1] * r); }
    }
};
}

#define GAS __attribute__((address_space(1)))
#define LAS __attribute__((address_space(3)))
typedef unsigned v4u __attribute__((ext_vector_type(4)));
typedef float f32x4 __attribute__((ext_vector_type(4)));
typedef short bf16x8 __attribute__((ext_vector_type(8)));
typedef GAS unsigned gu32;
typedef GAS unsigned long long gu64;
#define RLX_AGENT __ATOMIC_RELAXED, __HIP_MEMORY_SCOPE_AGENT
#define LDS_WAIT() asm volatile("s_waitcnt lgkmcnt(0)" ::: "memory")
#define VM_WAIT() asm volatile("s_waitcnt vmcnt(0)" ::: "memory")
__device__ __forceinline__ unsigned long long rt() { return __builtin_amdgcn_s_memrealtime(); }
__device__ __forceinline__ unsigned pk2(float lo, float hi) { return f2bf(lo) | (f2bf(hi) << 16); }

#define XB_TMO      128
#define XB_XCNT(j)  (256  + 64 * (j))
#define XB_XSUB(j)  (1280 + 64 * (j))
#define XB_XGEN(j)  (2304 + 64 * (j))
#define XB_TOP      3328
#define XB_TOPGEN   3392
#define XCD_BAR_WORDS 3456
#define XB_SPIN_CAP (1u << 18)

__device__ __forceinline__ unsigned xb_ld(unsigned* p)              { return __hip_atomic_load(p, __ATOMIC_RELAXED, __HIP_MEMORY_SCOPE_AGENT); }
__device__ __forceinline__ unsigned xb_add(unsigned* p, unsigned v) { return __hip_atomic_fetch_add(p, v, __ATOMIC_RELAXED, __HIP_MEMORY_SCOPE_AGENT); }
__device__ __forceinline__ unsigned xb_xcc_id() { return (unsigned)__builtin_amdgcn_s_getreg((3 << 11) | 20) & 0xFu; }
#define XB_SPIN(cond, bar) do { unsigned _sp = 0; while (cond) { __builtin_amdgcn_s_sleep(1); \
    if ((++_sp & 255u) == 0u) { if (xb_ld(&(bar)[XB_TMO])) break; if (_sp > XB_SPIN_CAP) { atomicAdd(&(bar)[XB_TMO], 1u); break; } } } } while (0)

struct XcdBarrier {
    unsigned* bar; unsigned x;
    volatile LAS unsigned* st;
};

__device__ __forceinline__ XcdBarrier xcd_barrier_post(unsigned* bar, volatile LAS unsigned* st) {
    XcdBarrier b; b.bar = bar; b.x = xb_xcc_id(); b.st = st;
    if (threadIdx.x == 0) (void)xb_add(&bar[XB_XCNT(b.x)], 1u);
    return b;
}
__device__ __forceinline__ void xcd_barrier_complete(unsigned* bar, unsigned x, unsigned& nloc, unsigned& nx) {
    const unsigned G = gridDim.x * gridDim.y * gridDim.z;
    unsigned sum, cnt, mine, sp = 0u;
    for (;;) {
        sum = 0u; cnt = 0u; mine = 0u;
#pragma unroll
        for (unsigned j = 0; j < 16; ++j) { const unsigned c = xb_ld(&bar[XB_XCNT(j)]); sum += c; cnt += (c > 0u) ? 1u : 0u; mine = (j == x) ? c : mine; }
        if (sum == G) break;
        __builtin_amdgcn_s_sleep(1);
        if ((++sp & 255u) == 0u) { if (xb_ld(&bar[XB_TMO])) break; if (sp > XB_SPIN_CAP) { atomicAdd(&bar[XB_TMO], 1u); break; } }
    }
    nloc = mine > 0u ? mine : 1u; nx = cnt > 0u ? cnt : 1u;
}

__device__ __forceinline__ void xcd_barrier(const XcdBarrier& b) {
    asm volatile("s_waitcnt vmcnt(0)" ::: "memory");
    __syncthreads();
    if (threadIdx.x == 0) {
        unsigned* bar = b.bar;
        __builtin_amdgcn_s_waitcnt(0);
        unsigned nloc = b.st[0], nx = b.st[1];
        if (nloc == 0u) { xcd_barrier_complete(bar, b.x, nloc, nx); b.st[0] = nloc; b.st[1] = nx; }
        const unsigned old = xb_add(&bar[XB_XSUB(b.x)], 1u);
        const unsigned gen = old / nloc;
        if (old + 1u == (gen + 1u) * nloc) {
            __builtin_amdgcn_fence(__ATOMIC_RELEASE, "agent");
            asm volatile("s_waitcnt vmcnt(0)" ::: "memory");
            const unsigned og = xb_add(&bar[XB_TOP], 1u);
            const unsigned tg = og / nx;
            if (og + 1u == (tg + 1u) * nx) xb_add(&bar[XB_TOPGEN], 1u);
            else XB_SPIN(xb_ld(&bar[XB_TOPGEN]) == tg, bar);
            __builtin_amdgcn_fence(__ATOMIC_ACQUIRE, "agent");
            xb_add(&bar[XB_XGEN(b.x)], 1u);
            asm volatile("s_waitcnt vmcnt(0)" ::: "memory");
        } else {
            XB_SPIN(xb_ld(&bar[XB_XGEN(b.x)]) == gen, bar);
            __builtin_amdgcn_fence(__ATOMIC_ACQUIRE, "agent");
            asm volatile("s_waitcnt vmcnt(0)" ::: "memory");
        }
    }
    __syncthreads();
}

namespace sb {
__device__ __forceinline__ void transpose_item(const float* W, int ldw, int c0, const float* gain, bf16_t* WT, int K, int n0, int k0, LAS float* scr, int lane) {
#pragma unroll 8
    for (int i = 0; i < 32; ++i) { const int kk = 2 * i + (lane >> 5); float v = W[(size_t)(k0 + kk) * ldw + c0 + (lane & 31)]; if (gain) v *= gain[k0 + kk]; scr[kk * 33 + (lane & 31)] = v; }
    LDS_WAIT(); asm volatile("" ::: "memory");
    const int c = lane & 7;
#pragma unroll
    for (int j = 0; j < 4; ++j) { const int n = (lane >> 3) + 8 * j; const LAS float* s = scr + (8 * c) * 33 + n;
        v4u o; o.x = pk2(s[0 * 33], s[1 * 33]); o.y = pk2(s[2 * 33], s[3 * 33]); o.z = pk2(s[4 * 33], s[5 * 33]); o.w = pk2(s[6 * 33], s[7 * 33]);
        *(GAS v4u*)(WT + (size_t)(n0 + n) * K + k0 + 8 * c) = o; }
    LDS_WAIT(); asm volatile("" ::: "memory");
}
template <int MAP>
__device__ __forceinline__ void transpose_job_item(const float* W0, const float* W1, const float* gain, bf16_t* WT, int K, int N, int ldw, int item, LAS float* scr, int lane) {
    const int nblk = N / 32, kb = item / nblk, nb = item % nblk, n0 = 32 * nb, k0 = 64 * kb;
    const float* W = W0; int c0 = n0;
    if (MAP == 1) { const int pn = n0 / 256, half = (n0 % 256) / 128, jj = n0 % 128; W = half ? W1 : W0; c0 = pn * 128 + jj; }
    if (MAP == 2) { if (n0 >= 512) { const int m = n0 - 512, pc = m / 256, half = (m % 256) / 128, jj = m % 128; c0 = 512 + half * 512 + pc * 128 + jj; } }
    if (MAP == 3) { if (n0 >= 1024) { W = W1; c0 = n0 - 1024; } }
    transpose_item(W, ldw, c0, gain, WT, K, n0, k0, scr, lane);
}
__device__ __forceinline__ void row_bf16_ss(const float* xr, bf16_t* orow, float* ssrow, float* rstd1, int lane) {
    float s = 0.f;
#pragma unroll
    for (int j = 0; j < 4; ++j) { const f32x4 v = *(const f32x4*)(xr + j * 256 + lane * 4); s += (v.x * v.x + v.y * v.y) + (v.z * v.z + v.w * v.w);
        uint2 o; o.x = pk2(v.x, v.y); o.y = pk2(v.z, v.w); *(uint2*)(orow + j * 256 + lane * 4) = o; }
    s = wave_sum(s);
    if (lane < 16) ssrow[lane] = lane == 0 ? s : 0.f;
    if (rstd1 && lane == 0) *rstd1 = rsqrtf(s * (1.f / D) + EPS);
}

__device__ __forceinline__ void s5_task(int task, const bf16_t* ug, const float* h0re, const float* h0im, const float* a_re, const float* a_im, const float* log_dt,
                                        const float* b_re, const float* b_im, const float* c_re, const float* c_im, const float* dskip, bf16_t* gb, float* out, int n) {
    const int g = task % NG, sq = task / NG;
    const bool prompt = sq < NBATCH; const int b = prompt ? sq : sq - NBATCH, T = prompt ? SEQ : DECS, row0 = prompt ? b * SEQ : MP + b * DECS;
    const float dt = expf(log_dt[g]), lr = a_re[g * NST + n], li = a_im[g * NST + n];
    const float mag = expf(lr * dt), abr = mag * cosf(li * dt), abi = mag * sinf(li * dt);
    const float den = lr * lr + li * li, nr = abr - 1.f, ni = abi, cr = (nr * lr + ni * li) / den, ci = (ni * lr - nr * li) / den;
    float Br[16], Bi[16], Cr[16], Ci[16];
#pragma unroll
    for (int c = 0; c < 16; ++c) { const float br = b_re[((size_t)g * NST + n) * 16 + c], bi = b_im[((size_t)g * NST + n) * 16 + c];
        Br[c] = cr * br - ci * bi; Bi[c] = cr * bi + ci * br; Cr[c] = c_re[((size_t)g * 16 + c) * NST + n]; Ci[c] = c_im[((size_t)g * 16 + c) * NST + n]; }
    float hr = 0.f, hi = 0.f;
    if (!prompt) { hr = h0re[((size_t)b * NG + g) * NST + n]; hi = h0im[((size_t)b * NG + g) * NST + n]; }
    const float dsk = dskip[g * 16 + (n & 15)];
    for (int t = 0; t < T; ++t) {
        const bf16_t* up = ug + ((size_t)g * M + row0 + t) * 16;
        const v4u w0 = *(const v4u*)up, w1 = *(const v4u*)(up + 8);
        float u[16];
        u[0] = __builtin_bit_cast(float, w0.x << 16); u[1] = __builtin_bit_cast(float, w0.x & 0xffff0000u); u[2] = __builtin_bit_cast(float, w0.y << 16); u[3] = __builtin_bit_cast(float, w0.y & 0xffff0000u);
        u[4] = __builtin_bit_cast(float, w0.z << 16); u[5] = __builtin_bit_cast(float, w0.z & 0xffff0000u); u[6] = __builtin_bit_cast(float, w0.w << 16); u[7] = __builtin_bit_cast(float, w0.w & 0xffff0000u);
        u[8] = __builtin_bit_cast(float, w1.x << 16); u[9] = __builtin_bit_cast(float, w1.x & 0xffff0000u); u[10] = __builtin_bit_cast(float, w1.y << 16); u[11] = __builtin_bit_cast(float, w1.y & 0xffff0000u);
        u[12] = __builtin_bit_cast(float, w1.z << 16); u[13] = __builtin_bit_cast(float, w1.z & 0xffff0000u); u[14] = __builtin_bit_cast(float, w1.w << 16); u[15] = __builtin_bit_cast(float, w1.w & 0xffff0000u);
        float xr = 0.f, xi = 0.f;
#pragma unroll
        for (int c = 0; c < 16; ++c) { xr += Br[c] * u[c]; xi += Bi[c] * u[c]; }
        const float nhr = abr * hr - abi * hi + xr, nhi = abr * hi + abi * hr + xi; hr = nhr; hi = nhi;
        float ymine = 0.f;
#pragma unroll
        for (int c = 0; c < 16; ++c) { const float y = wave_sum(Cr[c] * hr - Ci[c] * hi); if ((n & 15) == c) ymine = y + dsk * u[c]; }
        if (n < 16) gb[(size_t)(row0 + t) * SSM + g * 16 + n] = (bf16_t)f2bf(gelu_tanh(ymine));
    }
    if (prompt) { out[O_SRP + ((size_t)b * NG + g) * NST + n] = hr; out[O_SIP + ((size_t)b * NG + g) * NST + n] = hi; }
    else { out[O_SRS + ((size_t)b * NG + g) * NST + n] = hr; out[O_SIS + ((size_t)b * NG + g) * NST + n] = hi; }
}

__device__ __forceinline__ void conv_row(int row, const bf16_t* vb, const float* cache, const float* w, const float* bias, const float* lg, const float* lb, bf16_t* mixb, float* out, LAS float* red, int c) {
    float y = bias[c];
    if (row < MP) { const int t = row % SEQ;
        for (int k = 0; k < CWID; ++k) { const int tt = t - 30 + k; if (tt >= 0) y += w[k * CONVD + c] * bf2f(vb[(size_t)(row - 30 + k) * CONVD + c]); }
    } else { const int rs = row - MP, b = rs / DECS, t = rs % DECS;
        for (int k = 0; k < CWID; ++k) { const int idx = t + k; const float xv = idx < 30 ? cache[((size_t)b * 30 + idx) * CONVD + c] : bf2f(vb[(size_t)(MP + b * DECS + idx - 30) * CONVD + c]); y += w[k * CONVD + c] * xv; }
        if (t == 0) for (int j = 0; j < 22; ++j) out[O_CVS + ((size_t)b * 30 + j) * CONVD + c] = cache[((size_t)b * 30 + j + 8) * CONVD + c];
    }
    float s = wave_sum(y); if ((c & 63) == 0) red[c >> 6] = s; __syncthreads();
    float mu = 0.f;
#pragma unroll
    for (int i = 0; i < 8; ++i) mu += red[i];
    mu *= (1.f / CONVD);
    const float d = y - mu; float q = wave_sum(d * d); if ((c & 63) == 0) red[8 + (c >> 6)] = q; __syncthreads();
    float var = 0.f;
#pragma unroll
    for (int i = 0; i < 8; ++i) var += red[8 + i];
    var *= (1.f / CONVD);
    const float z = d * rsqrtf(var + EPS) * lg[c] + lb[c];
    mixb[(size_t)row * D + SSM + c] = (bf16_t)f2bf(siluf_(z));
}

__device__ __forceinline__ void attn_task(int task, const bf16_t* qb, const bf16_t* kb, const bf16_t* vb2, const float* ck, const float* cv, bf16_t* ob, LAS float* scr, int t256) {
    LAS float* q = scr; LAS float* p = scr + 2048; LAS float* red = scr + 4096;
    const int rg = task >> 2, h = task & 3, row0 = rg * 8; const bool prompt = row0 < MP; const int b = prompt ? row0 / SEQ : (row0 - MP) / DECS;
#pragma unroll
    for (int r = 0; r < 8; ++r) q[r * 256 + t256] = bf2f(qb[(size_t)(row0 + r) * D + h * HD + t256]);
    __syncthreads();
    float s[8];
#pragma unroll
    for (int r = 0; r < 8; ++r) s[r] = 0.f;
    if (prompt) { const bf16_t* kr = kb + ((size_t)b * NMEM + t256) * D + h * HD;
        for (int d = 0; d < HD; d += 8) { const v4u w = *(const v4u*)(kr + d); float kv[8];
            kv[0] = __builtin_bit_cast(float, w.x << 16); kv[1] = __builtin_bit_cast(float, w.x & 0xffff0000u); kv[2] = __builtin_bit_cast(float, w.y << 16); kv[3] = __builtin_bit_cast(float, w.y & 0xffff0000u);
            kv[4] = __builtin_bit_cast(float, w.z << 16); kv[5] = __builtin_bit_cast(float, w.z & 0xffff0000u); kv[6] = __builtin_bit_cast(float, w.w << 16); kv[7] = __builtin_bit_cast(float, w.w & 0xffff0000u);
#pragma unroll
            for (int r = 0; r < 8; ++r)
#pragma unroll
                for (int j = 0; j < 8; ++j) s[r] += q[r * 256 + d + j] * kv[j]; }
    } else { const float* kr = ck + ((size_t)b * NMEM + t256) * D + h * HD;
        for (int d = 0; d < HD; d += 4) { const f32x4 kv = *(const f32x4*)(kr + d);
#pragma unroll
            for (int r = 0; r < 8; ++r) s[r] += (q[r * 256 + d] * kv.x + q[r * 256 + d + 1] * kv.y) + (q[r * 256 + d + 2] * kv.z + q[r * 256 + d + 3] * kv.w); }
    }
    const int w4 = t256 >> 6;
#pragma unroll
    for (int r = 0; r < 8; ++r) { float mx = s[r];
#pragma unroll
        for (int o = 1; o < 64; o <<= 1) mx = fmaxf(mx, __shfl_xor(mx, o));
        if ((t256 & 63) == 0) red[r * 4 + w4] = mx; }
    __syncthreads();
    float e[8];
#pragma unroll
    for (int r = 0; r < 8; ++r) { const float mx = fmaxf(fmaxf(red[r * 4], red[r * 4 + 1]), fmaxf(red[r * 4 + 2], red[r * 4 + 3])); e[r] = exp2f(s[r] - mx); }
    __syncthreads();
#pragma unroll
    for (int r = 0; r < 8; ++r) { const float sm = wave_sum(e[r]); if ((t256 & 63) == 0) red[r * 4 + w4] = sm; }
    __syncthreads();
#pragma unroll
    for (int r = 0; r < 8; ++r) { const float sm = (red[r * 4] + red[r * 4 + 1]) + (red[r * 4 + 2] + red[r * 4 + 3]); p[r * 256 + t256] = e[r] / sm; }
    __syncthreads();
    float o[8];
#pragma unroll
    for (int r = 0; r < 8; ++r) o[r] = 0.f;
    if (prompt) { const bf16_t* vr = vb2 + (size_t)b * NMEM * D + h * HD + t256;
        for (int m = 0; m < NMEM; ++m) { const float vv = bf2f(vr[(size_t)m * D]);
#pragma unroll
            for (int r = 0; r < 8; ++r) o[r] += p[r * 256 + m] * vv; }
    } else { const float* vr = cv + (size_t)b * NMEM * D + h * HD + t256;
        for (int m = 0; m < NMEM; ++m) { const float vv = vr[(size_t)m * D];
#pragma unroll
            for (int r = 0; r < 8; ++r) o[r] += p[r * 256 + m] * vv; }
    }
#pragma unroll
    for (int r = 0; r < 8; ++r) ob[(size_t)(row0 + r) * D + h * HD + t256] = (bf16_t)f2bf(o[r]);
    __syncthreads();
}
}

namespace s5f {
typedef short bf16x8 __attribute__((ext_vector_type(8)));
constexpr int KT_OFF = 0, KT_BYTES = 65 * 256 * 2, U_OFF = 33792, U_CSTR = 2064, S_OFF = U_OFF + 32 * U_CSTR, H_OFF = S_OFF + 32 * 128 * 4, H_RSTR = 272, END_OFF = H_OFF + 32 * H_RSTR;
static_assert(KT_BYTES <= U_OFF && END_OFF <= 131072, "S5 LDS map");
constexpr size_t TAB_KT = 0, TAB_P = 2 * MiB, TAB_Q = 10 * MiB, TAB_AL = 18 * MiB;
struct cf { float re, im; };
typedef float f32x2v __attribute__((ext_vector_type(2)));
typedef unsigned u32x2v __attribute__((ext_vector_type(2)));
__device__ __forceinline__ f32x2v tov(cf a) { return (f32x2v){a.re, a.im}; }
__device__ __forceinline__ cf toc(f32x2v a) { return cf{a.x, a.y}; }
__device__ __forceinline__ cf cmul(cf a, cf b) { return cf{a.re * b.re - a.im * b.im, a.re * b.im + a.im * b.re}; }
__device__ __forceinline__ cf cpow_a(float lr, float li, float dt, float p) { const float mag = expf(lr * dt * p); float s, c; sincosf(li * dt * p, &s, &c); return cf{mag * c, mag * s}; }
__device__ __forceinline__ cf coef_of(float lr, float li, float dt) { const cf a = cpow_a(lr, li, dt, 1.f); const float den = lr * lr + li * li, nr = a.re - 1.f, ni = a.im; return cf{(nr * lr + ni * li) / den, (ni * lr - nr * li) / den}; }

__device__ __forceinline__ void kt_task(int task, const float* a_re, const float* a_im, const float* log_dt, const float* b_re, const float* b_im, const float* c_re, const float* c_im,
                                        bf16_t* Ktab, LAS unsigned char* scr, int tid) {
    const int g = task >> 3, tb = task & 7;
    LAS f32x2v* Wb = (LAS f32x2v*)scr; LAS f32x2v* Bb = (LAS f32x2v*)(scr + 4096); LAS f32x2v* Cc = (LAS f32x2v*)(scr + 4096 + 8192);
    const float dt = expf(log_dt[g]);
    { const int tl = tid >> 6, n = tid & 63; Wb[tl * 64 + n] = tov(cpow_a(a_re[g * NST + n], a_im[g * NST + n], dt, (float)(8 * tb + tl))); }
#pragma unroll
    for (int e = tid; e < 1024; e += 512) { const int n = e >> 4, c = e & 15; const cf co = coef_of(a_re[g * NST + n], a_im[g * NST + n], dt);
        Bb[e] = tov(cmul(co, cf{b_re[((size_t)g * NST + n) * 16 + c], b_im[((size_t)g * NST + n) * 16 + c]})); }
#pragma unroll
    for (int e = tid; e < 1024; e += 512) Cc[e] = (f32x2v){c_re[(size_t)g * 1024 + e], c_im[(size_t)g * 1024 + e]};
    __syncthreads();
    { const int tl = tid >> 6, cc = tid & 63, c = cc >> 2, c0 = 4 * (cc & 3); float acc[4] = {0.f, 0.f, 0.f, 0.f};
        for (int n = 0; n < 64; ++n) { const cf T = cmul(toc(Cc[c * 64 + n]), toc(Wb[tl * 64 + n]));
#pragma unroll
            for (int k = 0; k < 4; ++k) { const cf E = toc(Bb[n * 16 + c0 + k]); acc[k] += T.re * E.re - T.im * E.im; } }
        uint2 o; o.x = pk2(acc[0], acc[1]); o.y = pk2(acc[2], acc[3]);
        *(uint2*)(Ktab + (((size_t)g * 65 + 8 * tb + tl + 1) * 16 + c) * 16 + c0) = o; }
    if (tb == 0 && tid < 32) *(v4u*)(Ktab + (size_t)g * 65 * 256 + tid * 8) = (v4u){0u, 0u, 0u, 0u};
    __syncthreads();
}
__device__ __forceinline__ void pq_entry(int e, const float* a_re, const float* a_im, const float* log_dt, const float* b_re, const float* b_im, const float* c_re, const float* c_im,
                                         bf16_t* Ptab, bf16_t* Qtab, float* ALtab) {
    {
        const int n = e & 63, j = (e >> 6) & 63, g = e >> 12; const float dt = expf(log_dt[g]);
        const cf W = cpow_a(a_re[g * NST + n], a_im[g * NST + n], dt, (float)(j + 1));
#pragma unroll
        for (int c = 0; c < 16; ++c) { const cf w = cmul(cf{c_re[((size_t)g * 16 + c) * NST + n], c_im[((size_t)g * 16 + c) * NST + n]}, W);
            bf16_t* p = Ptab + (((size_t)g * 64 + j) * 16 + c) * 128; p[n] = (bf16_t)f2bf(w.re); p[64 + n] = (bf16_t)f2bf(-w.im); }
        if (j == 0) { const cf al = cpow_a(a_re[g * NST + n], a_im[g * NST + n], dt, 64.f); ALtab[(g * NST + n) * 2] = al.re; ALtab[(g * NST + n) * 2 + 1] = al.im; }
    }
    {
        const int i = e & 63, n = (e >> 6) & 63, g = e >> 12; const float dt = expf(log_dt[g]);
        const float lr = a_re[g * NST + n], li = a_im[g * NST + n];
        const cf V = cmul(cpow_a(lr, li, dt, (float)(63 - i)), coef_of(lr, li, dt));
        unsigned wr[8], wi[8];
#pragma unroll
        for (int c = 0; c < 16; c += 2) { const cf v0 = cmul(V, cf{b_re[((size_t)g * NST + n) * 16 + c], b_im[((size_t)g * NST + n) * 16 + c]}), v1 = cmul(V, cf{b_re[((size_t)g * NST + n) * 16 + c + 1], b_im[((size_t)g * NST + n) * 16 + c + 1]});
            wr[c >> 1] = pk2(v0.re, v1.re); wi[c >> 1] = pk2(v0.im, v1.im); }
        v4u* qr = (v4u*)(Qtab + ((size_t)g * 128 + n) * 1024 + i * 16); v4u* qi = (v4u*)(Qtab + ((size_t)g * 128 + 64 + n) * 1024 + i * 16);
        qr[0] = (v4u){wr[0], wr[1], wr[2], wr[3]}; qr[1] = (v4u){wr[4], wr[5], wr[6], wr[7]}; qi[0] = (v4u){wi[0], wi[1], wi[2], wi[3]}; qi[1] = (v4u){wi[4], wi[5], wi[6], wi[7]};
    }
}
__device__ __forceinline__ float gelu_fast(float x) { const float u = 1.5957691216057308f * (x + 0.044715f * x * x * x); return x * __builtin_amdgcn_rcpf(1.f + __builtin_amdgcn_exp2f(-1.4426950408889634f * u)); }

__device__ __forceinline__ void prompt_unit(int b, int g, const bf16_t* ug, const bf16_t* Ktab, const bf16_t* Ptab, const bf16_t* Qtab, const float* ALtab, const float* dskip, bf16_t* gb, float* out,
                                            LAS unsigned char* L, int tid, int wave, int lane) {
    {
        const v4u* src = (const v4u*)(Ktab + (size_t)g * 65 * 256);
        for (int q = tid; q < KT_BYTES / 16; q += 512) *(LAS v4u*)(L + KT_OFF + q * 16) = src[q];
        const v4u* us = (const v4u*)(ug + ((size_t)g * M + (size_t)b * SEQ) * 16);
#pragma unroll
        for (int p = 0; p < 8; ++p) { const int q = p * 512 + tid; *(LAS v4u*)(L + U_OFF + (q >> 7) * U_CSTR + (q & 127) * 16) = us[q]; }
    }
    __syncthreads();
    const int fr = lane & 15, kq = lane >> 4;
    const LAS unsigned char* ub0 = L + U_OFF + fr * U_CSTR + kq * 16; const LAS unsigned char* ub1 = ub0 + 16 * U_CSTR;
    {
        f32x4 a0 = {0.f, 0.f, 0.f, 0.f}, a1 = {0.f, 0.f, 0.f, 0.f};
        const bf16_t* qrow = Qtab + ((size_t)g * 128 + wave * 16 + fr) * 1024 + kq * 8;
#pragma unroll 4
        for (int s = 0; s < 32; ++s) { const bf16x8 a = *(const bf16x8*)(qrow + s * 32);
            a0 = __builtin_amdgcn_mfma_f32_16x16x32_bf16(a, *(const LAS bf16x8*)(ub0 + s * 64), a0, 0, 0, 0);
            a1 = __builtin_amdgcn_mfma_f32_16x16x32_bf16(a, *(const LAS bf16x8*)(ub1 + s * 64), a1, 0, 0, 0); }
        *(LAS f32x4*)(L + S_OFF + (fr * 128 + wave * 16 + kq * 4) * 4) = a0;
        *(LAS f32x4*)(L + S_OFF + ((16 + fr) * 128 + wave * 16 + kq * 4) * 4) = a1;
    }
    __syncthreads();
    if (tid < 64) {
        const int n = tid; const float alr = ALtab[(g * NST + n) * 2], ali = ALtab[(g * NST + n) * 2 + 1]; float hr = 0.f, hi = 0.f;
        const LAS float* Sb = (const LAS float*)(L + S_OFF);
        for (int c = 0; c < 32; ++c) { LAS bf16_t* hb = (LAS bf16_t*)(L + H_OFF + c * H_RSTR); hb[n] = (bf16_t)f2bf(hr); hb[64 + n] = (bf16_t)f2bf(hi);
            const float sr = Sb[c * 128 + n], si = Sb[c * 128 + 64 + n]; const float nhr = alr * hr - ali * hi + sr, nhi = alr * hi + ali * hr + si; hr = nhr; hi = nhi; }
        out[O_SRP + ((size_t)b * NG + g) * NST + n] = hr; out[O_SIP + ((size_t)b * NG + g) * NST + n] = hi;
    }
    __syncthreads();
    f32x4 acc[8][2];
#pragma unroll
    for (int q = 0; q < 8; ++q) { acc[q][0] = (f32x4){0.f, 0.f, 0.f, 0.f}; acc[q][1] = (f32x4){0.f, 0.f, 0.f, 0.f}; }
    {
        const LAS unsigned char* kt = L + KT_OFF + (fr * 16 + (kq & 1) * 8) * 2 + (wave + 1 - (kq >> 1)) * 512;
        const int smax = (wave + 56) >> 1;
        for (int s = 0; s <= smax; ++s) {
            const bf16x8 b0 = *(const LAS bf16x8*)(ub0 + s * 64), b1 = *(const LAS bf16x8*)(ub1 + s * 64);
#pragma unroll
            for (int q = 0; q < 8; ++q) if (wave + 8 * q >= 2 * s) { const bf16x8 a = *(const LAS bf16x8*)(kt + (8 * q - 2 * s) * 512);
                acc[q][0] = __builtin_amdgcn_mfma_f32_16x16x32_bf16(a, b0, acc[q][0], 0, 0, 0); acc[q][1] = __builtin_amdgcn_mfma_f32_16x16x32_bf16(a, b1, acc[q][1], 0, 0, 0); }
        }
    }
    {
        const LAS unsigned char* hb0 = L + H_OFF + fr * H_RSTR + kq * 16; const LAS unsigned char* hb1 = hb0 + 16 * H_RSTR;
        const bf16_t* prow = Ptab + (((size_t)g * 64 + wave) * 16 + fr) * 128 + kq * 8;
#pragma unroll
        for (int s2 = 0; s2 < 4; ++s2) { const bf16x8 b0 = *(const LAS bf16x8*)(hb0 + s2 * 64), b1 = *(const LAS bf16x8*)(hb1 + s2 * 64);
#pragma unroll
            for (int q = 0; q < 8; ++q) { const bf16x8 a = *(const bf16x8*)(prow + (size_t)q * 8 * 16 * 128 + s2 * 32);
                acc[q][0] = __builtin_amdgcn_mfma_f32_16x16x32_bf16(a, b0, acc[q][0], 0, 0, 0); acc[q][1] = __builtin_amdgcn_mfma_f32_16x16x32_bf16(a, b1, acc[q][1], 0, 0, 0); } }
    }
    {
        const f32x4 dsk = *(const f32x4*)(dskip + g * 16 + kq * 4);
#pragma unroll
        for (int q = 0; q < 8; ++q)
#pragma unroll
            for (int nb = 0; nb < 2; ++nb) { const int chunk = nb * 16 + fr, j = wave + 8 * q;
                const u32x2v uw = *(const LAS u32x2v*)(L + U_OFF + chunk * U_CSTR + (j * 16 + kq * 4) * 2);
                const f32x4 u4 = {__builtin_bit_cast(float, uw.x << 16), __builtin_bit_cast(float, uw.x & 0xffff0000u), __builtin_bit_cast(float, uw.y << 16), __builtin_bit_cast(float, uw.y & 0xffff0000u)};
                const f32x4 y = acc[q][nb] + dsk * u4;
                uint2 o; o.x = pk2(gelu_fast(y[0]), gelu_fast(y[1])); o.y = pk2(gelu_fast(y[2]), gelu_fast(y[3]));
                *(uint2*)(gb + ((size_t)b * SEQ + chunk * 64 + j) * SSM + g * 16 + kq * 4) = o; }
    }
    __syncthreads();
}
}

namespace att {
typedef short bf16x8 __attribute__((ext_vector_type(8)));
typedef float f32x16 __attribute__((ext_vector_type(16)));
typedef float f32x2v __attribute__((ext_vector_type(2)));
typedef unsigned u32x2v __attribute__((ext_vector_type(2)));
__device__ __forceinline__ int crow(int r, int hi) { return (r & 3) + 8 * (r >> 2) + 4 * hi; }
__device__ __forceinline__ unsigned cvtpk(float lo, float hi) { return pg8::cvt_pk_bf16(lo, hi); }

__device__ __forceinline__ void prompt_unit(int b, int h, int qblk, const bf16_t* qb, const bf16_t* kb, const bf16_t* vT, bf16_t* ob, LAS unsigned char* L, LAS float* wsf, int tid, int wave, int lane) {
    const int r32 = lane & 31, hh = lane >> 5, x = r32 & 15;
    const bf16_t* Kg = kb + (size_t)b * NMEM * D + h * HD;
    for (int half = 0; half < 2; ++half)
#pragma unroll 4
        for (int p = 0; p < 8; ++p) { const int q = p * 512 + tid, mem = q >> 4, c16 = q & 15;
            *(LAS v4u*)(L + half * 65536 + mem * 256 + ((c16 ^ (mem & 15)) << 4)) = *(const v4u*)(Kg + (size_t)mem * D + half * 128 + c16 * 8); }
    const size_t qrow = (size_t)b * SEQ + qblk * 256 + wave * 32 + r32;
    const bf16_t* Qg = qb + qrow * D + h * HD + hh * 8;
    unsigned koff[8];
#pragma unroll
    for (int ks = 0; ks < 8; ++ks) koff[ks] = (unsigned)(((2 * ks + hh) ^ x) << 4);
    __syncthreads();
    f32x16 S[8];
#pragma unroll
    for (int mb = 0; mb < 8; ++mb)
#pragma unroll
        for (int r = 0; r < 16; ++r) S[mb][r] = 0.f;
#pragma unroll
    for (int half = 0; half < 2; ++half) {
        bf16x8 qf[8];
#pragma unroll
        for (int ks = 0; ks < 8; ++ks) qf[ks] = *(const bf16x8*)(Qg + half * 128 + ks * 16);
        const LAS unsigned char* kbase = L + half * 65536 + r32 * 256;
#pragma unroll
        for (int mb = 0; mb < 8; ++mb) {
#pragma unroll
            for (int ks = 0; ks < 8; ++ks) S[mb] = __builtin_amdgcn_mfma_f32_32x32x16_bf16(*(const LAS bf16x8*)(kbase + mb * 8192 + koff[ks]), qf[ks], S[mb], 0, 0, 0);
            asm volatile("" : "+v"(S[mb])); __builtin_amdgcn_sched_barrier(0); }
    }
    __syncthreads();
    const bf16_t* Vg = vT + (size_t)h * HD * MMEM + (size_t)b * NMEM;
    for (int dh = 0; dh < 2; ++dh)
#pragma unroll 4
        for (int p = 0; p < 8; ++p) { const int q = p * 512 + tid, dd = q >> 5, c32 = q & 31;
            *(LAS v4u*)(L + dh * 65536 + dd * 512 + ((c32 ^ (dd & 15)) << 4)) = *(const v4u*)(Vg + (size_t)(dh * 128 + dd) * MMEM + c32 * 8); }
    float mx = S[0][0];
#pragma unroll
    for (int mb = 0; mb < 8; ++mb)
#pragma unroll
        for (int r = 0; r < 16; ++r) mx = fmaxf(mx, S[mb][r]);
    mx = fmaxf(mx, __shfl_xor(mx, 32));
    float lsum = 0.f;
    v4u pa[8][2];
#pragma unroll
    for (int mb = 0; mb < 8; ++mb) {
#pragma unroll
        for (int r = 0; r < 16; ++r) { const float e = __builtin_amdgcn_exp2f(S[mb][r] - mx); S[mb][r] = e; lsum += e; }
#pragma unroll
        for (int s = 0; s < 2; ++s) pa[mb][s] = (v4u){cvtpk(S[mb][8 * s], S[mb][8 * s + 1]), cvtpk(S[mb][8 * s + 2], S[mb][8 * s + 3]), cvtpk(S[mb][8 * s + 4], S[mb][8 * s + 5]), cvtpk(S[mb][8 * s + 6], S[mb][8 * s + 7])};
    }
    lsum += __shfl_xor(lsum, 32);
    if (hh == 0) wsf[r32] = lsum;
    __syncthreads();
    unsigned voff[2][4];
#pragma unroll
    for (int s = 0; s < 2; ++s)
#pragma unroll
        for (int ml = 0; ml < 4; ++ml) voff[s][ml] = (unsigned)(((4 * ml + 2 * s) ^ (hh ^ x)) << 4);
    bf16_t* Og = ob + ((size_t)b * SEQ + qblk * 256 + wave * 32 + 4 * hh) * D + h * HD + r32;
#pragma unroll
    for (int dh = 0; dh < 2; ++dh) {
        f32x16 O[4];
#pragma unroll
        for (int db = 0; db < 4; ++db)
#pragma unroll
            for (int r = 0; r < 16; ++r) O[db][r] = 0.f;
        const LAS unsigned char* vbase = L + dh * 65536 + r32 * 512;
#pragma unroll
        for (int mb = 0; mb < 8; ++mb)
#pragma unroll
            for (int s = 0; s < 2; ++s) { const bf16x8 a = __builtin_bit_cast(bf16x8, pa[mb][s]);
#pragma unroll
                for (int db = 0; db < 4; ++db)
                    O[db] = __builtin_amdgcn_mfma_f32_32x32x16_bf16(a, *(const LAS bf16x8*)(vbase + db * 16384 + (mb >> 2) * 256 + voff[s][mb & 3]), O[db], 0, 0, 0);
                asm volatile("" : "+v"(O[0]), "+v"(O[1]), "+v"(O[2]), "+v"(O[3])); __builtin_amdgcn_sched_barrier(0); }
#pragma unroll
        for (int r = 0; r < 16; ++r) { const float rl = __builtin_amdgcn_rcpf(wsf[crow(r, hh)]);
#pragma unroll
            for (int db = 0; db < 4; ++db) Og[(size_t)((r & 3) + 8 * (r >> 2)) * D + dh * 128 + db * 32] = (bf16_t)f2bf(O[db][r] * rl);
            __builtin_amdgcn_sched_barrier(0); }
    }
    __syncthreads();
}

__device__ __forceinline__ void sample_unit(int b, int hp, const bf16_t* qb, const float* ck, const float* cv, bf16_t* ob, LAS unsigned char* L, int tid, int wave, int lane) {
    const int hsel = wave >> 2, mq = wave & 3, head = 2 * hp + hsel;
    LAS float* sbuf = (LAS float*)L; LAS float* pT = (LAS float*)(L + 16384); LAS float* obuf = (LAS float*)(L + 32768);
    float q[8][4];
#pragma unroll
    for (int t = 0; t < 8; ++t) { const u32x2v w = *(const u32x2v*)(qb + ((size_t)MP + b * DECS + t) * D + head * HD + lane * 4);
        q[t][0] = __builtin_bit_cast(float, w.x << 16); q[t][1] = __builtin_bit_cast(float, w.x & 0xffff0000u); q[t][2] = __builtin_bit_cast(float, w.y << 16); q[t][3] = __builtin_bit_cast(float, w.y & 0xffff0000u); }
    const float* Kr = ck + (((size_t)b * NMEM + mq * 64) * NH + head) * HD + lane * 4;
    for (int m0 = 0; m0 < 64; m0 += 4) {
        f32x4 k4[4];
#pragma unroll
        for (int i = 0; i < 4; ++i) k4[i] = *(const f32x4*)(Kr + (size_t)(m0 + i) * NH * HD);
#pragma unroll
        for (int i = 0; i < 4; ++i) {
            float v[8];
#pragma unroll
            for (int t = 0; t < 8; ++t) v[t] = (q[t][0] * k4[i].x + q[t][1] * k4[i].y) + (q[t][2] * k4[i].z + q[t][3] * k4[i].w);
            float r4[4], r2[2], r1;
#pragma unroll
            for (int j = 0; j < 4; ++j) { const bool up = lane & 32; const float send = up ? v[j] : v[j + 4], keep = up ? v[j + 4] : v[j]; r4[j] = keep + __shfl_xor(send, 32); }
#pragma unroll
            for (int j = 0; j < 2; ++j) { const bool up = lane & 16; const float send = up ? r4[j] : r4[j + 2], keep = up ? r4[j + 2] : r4[j]; r2[j] = keep + __shfl_xor(send, 16); }
            { const bool up = lane & 8; const float send = up ? r2[0] : r2[1], keep = up ? r2[1] : r2[0]; r1 = keep + __shfl_xor(send, 8); }
            r1 += __shfl_xor(r1, 4); r1 += __shfl_xor(r1, 2); r1 += __shfl_xor(r1, 1);
            const int t = ((lane >> 5) & 1) * 4 + ((lane >> 4) & 1) * 2 + ((lane >> 3) & 1);
            if ((lane & 7) == 0) sbuf[(hsel * 8 + t) * 256 + mq * 64 + m0 + i] = r1;
        }
    }
    __syncthreads();
#pragma unroll
    for (int rr = 0; rr < 2; ++rr) { const int row = wave * 2 + rr;
        const f32x4 s4 = *(const LAS f32x4*)(sbuf + row * 256 + lane * 4);
        float mx = fmaxf(fmaxf(s4.x, s4.y), fmaxf(s4.z, s4.w));
#pragma unroll
        for (int o = 1; o < 64; o <<= 1) mx = fmaxf(mx, __shfl_xor(mx, o));
        const float e0 = exp2f(s4.x - mx), e1 = exp2f(s4.y - mx), e2 = exp2f(s4.z - mx), e3 = exp2f(s4.w - mx);
        const float inv = 1.f / wave_sum((e0 + e1) + (e2 + e3));
        LAS float* pp = pT + ((row >> 3) * 256 + lane * 4) * 8 + (row & 7);
        pp[0] = e0 * inv; pp[8] = e1 * inv; pp[16] = e2 * inv; pp[24] = e3 * inv; }
    __syncthreads();
    float o[8][4];
#pragma unroll
    for (int t = 0; t < 8; ++t) { o[t][0] = 0.f; o[t][1] = 0.f; o[t][2] = 0.f; o[t][3] = 0.f; }
    const float* Vr = cv + (((size_t)b * NMEM + mq * 64) * NH + head) * HD + lane * 4;
    for (int m0 = 0; m0 < 64; m0 += 4) {
        f32x4 v4[4];
#pragma unroll
        for (int i = 0; i < 4; ++i) v4[i] = *(const f32x4*)(Vr + (size_t)(m0 + i) * NH * HD);
#pragma unroll
        for (int i = 0; i < 4; ++i) { const LAS f32x4* pp = (const LAS f32x4*)(pT + (hsel * 256 + mq * 64 + m0 + i) * 8); const f32x4 pa = pp[0], pb = pp[1];
            const float pv[8] = {pa.x, pa.y, pa.z, pa.w, pb.x, pb.y, pb.z, pb.w};
#pragma unroll
            for (int t = 0; t < 8; ++t) { o[t][0] += pv[t] * v4[i].x; o[t][1] += pv[t] * v4[i].y; o[t][2] += pv[t] * v4[i].z; o[t][3] += pv[t] * v4[i].w; } }
    }
#pragma unroll
    for (int t = 0; t < 8; ++t) *(LAS f32x4*)(obuf + ((hsel * 4 + mq) * 8 + t) * 256 + lane * 4) = (f32x4){o[t][0], o[t][1], o[t][2], o[t][3]};
    __syncthreads();
    { const int hs = tid >> 8, t = (tid >> 5) & 7, d8 = tid & 31;
        f32x4 a0 = {0.f, 0.f, 0.f, 0.f}, a1 = {0.f, 0.f, 0.f, 0.f};
#pragma unroll
        for (int m = 0; m < 4; ++m) { const LAS f32x4* pp = (const LAS f32x4*)(obuf + ((hs * 4 + m) * 8 + t) * 256 + d8 * 8); a0 = a0 + pp[0]; a1 = a1 + pp[1]; }
        *(v4u*)(ob + ((size_t)MP + b * DECS + t) * D + (2 * hp + hs) * HD + d8 * 8) = (v4u){pk2(a0.x, a0.y), pk2(a0.z, a0.w), pk2(a1.x, a1.y), pk2(a1.z, a1.w)};
    }
    __syncthreads();
}
}

constexpr int NWAVES = 8;
constexpr int RING_OFF = 0, RING_BYTES = 131072;
constexpr int LDSCTL_OFF = RING_BYTES, MISC_OFF = LDSCTL_OFF + 320, XTRA_OFF = RING_BYTES + 1024;
constexpr int LDS_BYTES = 147456;
constexpr size_t CTL_ZERO_BYTES = 1 * MiB;
constexpr int CW_TMO = 0, CW_CODE = 1, CW_BAR = 4096;
constexpr int MAX_LAUNCHES = 8;
static_assert((CW_BAR + MAX_LAUNCHES * XCD_BAR_WORDS) * 4 <= (int)CTL_ZERO_BYTES, "barrier words inside the memset region");

enum Phase { PH_PRO = 0, PH_GU1 = 1, PH_D1 = 2, PH_IN = 3, PH_MIX = 4, PH_GLU = 5, PH_OUT = 6, PH_Q = 7, PH_ATT = 8, PH_O = 9, PH_GU2 = 10, PH_D2 = 11, PH_FIN = 12, PH_N = 13 };

struct Args { const float* in[39]; float* out; unsigned char* ws; int ph_lo, ph_hi, li, pad; };

__global__ void __launch_bounds__(NWAVES * 64, 2) mk_fwd(Args args) {
    extern __shared__ __attribute__((aligned(16))) unsigned char lds[];
    LAS unsigned char* L = (LAS unsigned char*)lds;
    volatile LAS unsigned* MISC = (volatile LAS unsigned*)(L + MISC_OFF);
    const int tid = threadIdx.x;
    const int G = gridDim.x, bx = blockIdx.x;
    unsigned char* ws = args.ws; float* out = args.out;
    gu32* ctl = (gu32*)(ws + WS_CTL);
    for (int u = tid; u < (LDS_BYTES - LDSCTL_OFF) / 4; u += NWAVES * 64) ((LAS unsigned*)(L + LDSCTL_OFF))[u] = 0u;
    __syncthreads();
    XcdBarrier bar = xcd_barrier_post((unsigned*)(ctl + CW_BAR) + args.li * XCD_BAR_WORDS, MISC + 8);
    const int lo = args.ph_lo, hi = args.ph_hi;
#define IN(k) (lo <= (k) && (k) < hi)
#define BOTH(k) (IN(k) && IN((k) + 1))
#define GRID_BAR() xcd_barrier(bar)
    bf16_t *Wgu1 = (bf16_t*)(ws + WS_WGU1), *Wgu2 = (bf16_t*)(ws + WS_WGU2), *Wd1 = (bf16_t*)(ws + WS_WD1), *Wd2 = (bf16_t*)(ws + WS_WD2), *Win = (bf16_t*)(ws + WS_WIN), *Wglu = (bf16_t*)(ws + WS_WGLU),
           *Wout = (bf16_t*)(ws + WS_WOUT), *Wq = (bf16_t*)(ws + WS_WQ), *Wo = (bf16_t*)(ws + WS_WO), *Wkv = (bf16_t*)(ws + WS_WKV);
    bf16_t *xb = (bf16_t*)(ws + WS_XB), *memb = (bf16_t*)(ws + WS_MEMB), *kb = (bf16_t*)(ws + WS_KB), *vb2 = (bf16_t*)(ws + WS_VB2), *hb = (bf16_t*)(ws + WS_H), *ug = (bf16_t*)(ws + WS_UG),
           *vb = (bf16_t*)(ws + WS_VB), *gb = (bf16_t*)(ws + WS_GB), *mixb = (bf16_t*)(ws + WS_MIXB), *qb = (bf16_t*)(ws + WS_QB), *ob = (bf16_t*)(ws + WS_OB);
    bf16_t *Ktab = (bf16_t*)(ws + WS_TAB + s5f::TAB_KT), *Ptab = (bf16_t*)(ws + WS_TAB + s5f::TAB_P), *Qtab = (bf16_t*)(ws + WS_TAB + s5f::TAB_Q); float* ALtab = (float*)(ws + WS_TAB + s5f::TAB_AL);
    float *ss0 = (float*)(ws + WS_SS0), *ss1 = (float*)(ws + WS_SS1), *ss2 = (float*)(ws + WS_SS2), *ss3 = (float*)(ws + WS_SS3), *ss4 = (float*)(ws + WS_SS4), *ssm = (float*)(ws + WS_SSM), *xres = (float*)(ws + WS_XRES);
    float* rstdm = ssm + (size_t)MMEM * 16; bf16_t* vT = vb2;

    const int wave = __builtin_amdgcn_readfirstlane(tid >> 6), lane = tid & 63;
    const float* const* in = args.in;
    if (IN(PH_PRO)) {
        for (int task = bx; task < 256; task += G) s5f::kt_task(task, in[17], in[18], in[19], in[20], in[21], in[22], in[23], Ktab, L + RING_OFF, tid);
        for (int e = bx * 512 + tid; e < 131072; e += G * 512) s5f::pq_entry(e, in[17], in[18], in[19], in[20], in[21], in[22], in[23], Ptab, Qtab, ALtab);
        LAS float* scr = (LAS float*)(L + RING_OFF + wave * 16384);
        const int gw = bx * NWAVES + wave, NGW = G * NWAVES;
        constexpr int I_GU = (D / 64) * (2 * FF / 32), I_D = (FF / 64) * (D / 32), I_IN = (D / 64) * (1536 / 32), I_GLU = (SSM / 64) * (SSM / 32), I_SQ = (D / 64) * (D / 32), I_KV = (D / 64) * (2048 / 32);
        constexpr int NITEMS = 2 * I_GU + 2 * I_D + I_IN + I_GLU + 3 * I_SQ + I_KV;
        for (int it = gw; it < NITEMS; it += NGW) {
            int r = it;
            if (r < I_GU) { sb::transpose_job_item<1>(in[12], in[13], in[11], Wgu1, D, 2 * FF, FF, r, scr, lane); continue; } r -= I_GU;
            if (r < I_GU) { sb::transpose_job_item<1>(in[35], in[36], in[34], Wgu2, D, 2 * FF, FF, r, scr, lane); continue; } r -= I_GU;
            if (r < I_D) { sb::transpose_job_item<0>(in[14], nullptr, nullptr, Wd1, FF, D, D, r, scr, lane); continue; } r -= I_D;
            if (r < I_D) { sb::transpose_job_item<0>(in[37], nullptr, nullptr, Wd2, FF, D, D, r, scr, lane); continue; } r -= I_D;
            if (r < I_IN) { sb::transpose_job_item<2>(in[16], nullptr, in[15], Win, D, 1536, 1536, r, scr, lane); continue; } r -= I_IN;
            if (r < I_GLU) { sb::transpose_job_item<0>(in[25], nullptr, nullptr, Wglu, SSM, SSM, SSM, r, scr, lane); continue; } r -= I_GLU;
            if (r < I_SQ) { sb::transpose_job_item<0>(in[30], nullptr, nullptr, Wout, D, D, D, r, scr, lane); continue; } r -= I_SQ;
            if (r < I_SQ) { sb::transpose_job_item<0>(in[32], nullptr, in[31], Wq, D, D, D, r, scr, lane); continue; } r -= I_SQ;
            if (r < I_SQ) { sb::transpose_job_item<0>(in[33], nullptr, nullptr, Wo, D, D, D, r, scr, lane); continue; } r -= I_SQ;
            sb::transpose_job_item<3>(in[9], in[10], in[8], Wkv, D, 2048, D, r, scr, lane);
        }
        for (int m = gw; m < M; m += NGW) sb::row_bf16_ss(m < MP ? in[0] + (size_t)m * D : in[1] + (size_t)(m - MP) * D, xb + (size_t)m * D, ss0 + (size_t)m * 16, nullptr, lane);
        for (int m = gw; m < MMEM; m += NGW) sb::row_bf16_ss(in[7] + (size_t)m * D, memb + (size_t)m * D, ssm + (size_t)m * 16, rstdm + m, lane);
        if (BOTH(PH_PRO)) GRID_BAR();
    }

    if (IN(PH_GU1)) {
        { pg8::Gemm g{memb, Wkv, MMEM, D, D}; pg8::StaticOrder S; S.init(MMEM, D, G, bx); fx::EpiK E{rstdm, kb, out};
          pg8::gemm_phase<fx::EpiK, pg8::StaticOrder, true, true>(L + RING_OFF, g, S, E); }
        { pg8::Gemm g{Wkv + (size_t)D * D, memb, D, MMEM, D}; pg8::StaticOrder S; S.init(D, MMEM, G, (bx + 128) % G); fx::EpiVT E{rstdm, vT, out};
          pg8::gemm_phase<fx::EpiVT, pg8::StaticOrder, true, true>(L + RING_OFF, g, S, E); }
        { pg8::Gemm g{xb, Wgu1, M, 2 * FF, D}; pg8::StaticOrder S; S.init(M, 2 * FF, G, bx); fx::EpiSwiglu E{ss0, hb};
          pg8::gemm_phase<fx::EpiSwiglu, pg8::StaticOrder, true, true>(L + RING_OFF, g, S, E); }
        if (BOTH(PH_GU1)) GRID_BAR();
    }
    if (IN(PH_D1)) {
        pg8::Gemm g{hb, Wd1, M, D, FF}; pg8::StaticOrder S; S.init(M, D, G, bx); fx::EpiRes E{args.in[0], args.in[1] - (size_t)MP * D, xres, xb, ss1, 0.5f};
        pg8::gemm_phase<fx::EpiRes, pg8::StaticOrder, true, true>(L + RING_OFF, g, S, E);
        if (BOTH(PH_D1)) GRID_BAR();
    }
    if (IN(PH_IN)) {
        pg8::Gemm g{xb, Win, M, 1536, D}; pg8::StaticOrder S; S.init(M, 1536, G, bx); fx::EpiIn E{ss1, ug, vb, out};
        pg8::gemm_phase<fx::EpiIn, pg8::StaticOrder, true, true>(L + RING_OFF, g, S, E);
        if (BOTH(PH_IN)) GRID_BAR();
    }
    if (IN(PH_MIX)) {
        for (int unit = bx; unit < NBATCH * NG; unit += G) s5f::prompt_unit(unit >> 5, unit & 31, ug, Ktab, Ptab, Qtab, ALtab, in[24], gb, out, L + RING_OFF, tid, wave, lane);
        for (int task = NBATCH * NG + wave * G + bx; task < (NBATCH + DECB) * NG; task += G * NWAVES)
            sb::s5_task(task, ug, in[2], in[3], in[17], in[18], in[19], in[20], in[21], in[22], in[23], in[24], gb, out, lane);
        __syncthreads();
        LAS float* red = (LAS float*)(L + RING_OFF);
        for (int row = bx; row < M; row += G) { sb::conv_row(row, vb, in[4], in[26], in[27], in[28], in[29], mixb, out, red, tid); __syncthreads(); }
        if (BOTH(PH_MIX)) GRID_BAR();
    }

    if (IN(PH_GLU)) {
        pg8::Gemm g{gb, Wglu, M, SSM, SSM}; pg8::StaticOrder S; S.init(M, SSM, G, bx); fx::EpiGlu E{gb, mixb};
        pg8::gemm_phase<fx::EpiGlu, pg8::StaticOrder, true, true>(L + RING_OFF, g, S, E);
        if (BOTH(PH_GLU)) GRID_BAR();
    }
    if (IN(PH_OUT)) {
        pg8::Gemm g{mixb, Wout, M, D, D}; pg8::StaticOrder S; S.init(M, D, G, bx); fx::EpiRes E{xres, xres, xres, xb, ss2, 1.f};
        pg8::gemm_phase<fx::EpiRes, pg8::StaticOrder, true, true>(L + RING_OFF, g, S, E);
        if (BOTH(PH_OUT)) GRID_BAR();
    }
    if (IN(PH_Q)) {
        pg8::Gemm g{xb, Wq, M, D, D}; pg8::StaticOrder S; S.init(M, D, G, bx); fx::EpiQ E{ss2, qb};
        pg8::gemm_phase<fx::EpiQ, pg8::StaticOrder, true, true>(L + RING_OFF, g, S, E);
        if (BOTH(PH_Q)) GRID_BAR();
    }
    if (IN(PH_ATT)) {
        LAS float* wsf = (LAS float*)(L + XTRA_OFF) + wave * 32;
        const int vcu = (G % 8 == 0) ? (bx % 8) * (G / 8) + bx / 8 : bx;
        for (int unit = vcu; unit < NBATCH * NH * 8; unit += G) att::prompt_unit(unit >> 5, (unit >> 3) & 3, unit & 7, qb, kb, vT, ob, L + RING_OFF, wsf, tid, wave, lane);
        for (int unit = bx; unit < DECB * 2; unit += G) att::sample_unit(unit >> 1, unit & 1, qb, in[5], in[6], ob, L + RING_OFF, tid, wave, lane);
        if (BOTH(PH_ATT)) GRID_BAR();
    }

    if (IN(PH_O)) {
        pg8::Gemm g{ob, Wo, M, D, D}; pg8::StaticOrder S; S.init(M, D, G, bx); fx::EpiRes E{xres, xres, xres, xb, ss3, 1.f};
        pg8::gemm_phase<fx::EpiRes, pg8::StaticOrder, true, true>(L + RING_OFF, g, S, E);
        if (BOTH(PH_O)) GRID_BAR();
    }
    if (IN(PH_GU2)) {
        pg8::Gemm g{xb, Wgu2, M, 2 * FF, D}; pg8::StaticOrder S; S.init(M, 2 * FF, G, bx); fx::EpiSwiglu E{ss3, hb};
        pg8::gemm_phase<fx::EpiSwiglu, pg8::StaticOrder, true, true>(L + RING_OFF, g, S, E);
        if (BOTH(PH_GU2)) GRID_BAR();
    }
    if (IN(PH_D2)) {
        pg8::Gemm g{hb, Wd2, M, D, FF}; pg8::StaticOrder S; S.init(M, D, G, bx); fx::EpiRes E{xres, xres, out + O_Y, nullptr, ss4, 0.5f};
        pg8::gemm_phase<fx::EpiRes, pg8::StaticOrder, true, true>(L + RING_OFF, g, S, E);
        if (BOTH(PH_D2)) GRID_BAR();
    }

    if (IN(PH_FIN)) {
        float* y = out + O_Y; const float* gfin = in[38];
        for (int m = bx * NWAVES + wave; m < M; m += G * NWAVES) { const float r = rstd_from_ss(ss4, m);
#pragma unroll
            for (int j = 0; j < 4; ++j) { f32x4* p = (f32x4*)(y + (size_t)m * D + j * 256 + lane * 4); const f32x4 gg = *(const f32x4*)(gfin + j * 256 + lane * 4); f32x4 v = *p; v = v * r * gg; *p = v; } }
    }
#undef IN
#undef BOTH
#undef GRID_BAR
}

#ifndef FAST_MERGE
#define FAST_MERGE 1
#endif
extern "C" void kernel_launch(void* const* d_in, const int* in_sizes, int n_in, void* d_out, int out_size, void* d_ws, size_t ws_size, hipStream_t stream) {
    if (n_in != 39 || out_size != (int)O_END || ws_size < WS_END) { fprintf(stderr, "kernel_launch: unexpected shapes n_in %d out %d ws %zu\n", n_in, out_size, ws_size); return; }
    static int grid = 0;
    if (grid == 0) {
        int dev = 0, cus = 0;
        if (hipGetDevice(&dev) != hipSuccess || hipDeviceGetAttribute(&cus, hipDeviceAttributeMultiprocessorCount, dev) != hipSuccess) { grid = -1; return; }
        if (hipFuncSetAttribute((const void*)mk_fwd, hipFuncAttributeMaxDynamicSharedMemorySize, LDS_BYTES) != hipSuccess) { fprintf(stderr, "kernel_launch: hipFuncSetAttribute failed\n"); grid = -1; return; }
        int per_cu = 0;
        if (hipOccupancyMaxActiveBlocksPerMultiprocessor(&per_cu, (const void*)mk_fwd, NWAVES * 64, LDS_BYTES) != hipSuccess || per_cu < 1) { fprintf(stderr, "kernel_launch: occupancy query says %d\n", per_cu); }
        (void)hipGetLastError();
        grid = cus;
    }
    if (grid < 0) return;
    const float* const* in = (const float* const*)d_in;
    const float *x_p = in[0], *x_s = in[1], *st_re = in[2], *st_im = in[3], *cconv = in[4], *cmk = in[5], *cmv = in[6], *memp = in[7], *g_mem = in[8], *w_k = in[9], *w_v = in[10],
                *g_ffn1 = in[11], *w1g = in[12], *w1u = in[13], *w1d = in[14], *g_mix = in[15], *w_in = in[16], *a_re = in[17], *a_im = in[18], *log_dt = in[19], *b_re = in[20], *b_im = in[21],
                *c_re = in[22], *c_im = in[23], *ssm_d = in[24], *w_glu = in[25], *conv_w = in[26], *conv_b = in[27], *ln_g = in[28], *ln_b = in[29], *w_out = in[30], *g_xattn = in[31],
                *w_q = in[32], *w_o = in[33], *g_ffn2 = in[34], *w2g = in[35], *w2u = in[36], *w2d = in[37], *g_final = in[38];
    (void)x_p; (void)x_s;
    unsigned char* ws = (unsigned char*)d_ws; float* out = (float*)d_out;
    bf16_t *Wgu1 = (bf16_t*)(ws + WS_WGU1), *Wgu2 = (bf16_t*)(ws + WS_WGU2), *Wd1 = (bf16_t*)(ws + WS_WD1), *Wd2 = (bf16_t*)(ws + WS_WD2), *Win = (bf16_t*)(ws + WS_WIN), *Wglu = (bf16_t*)(ws + WS_WGLU),
           *Wout = (bf16_t*)(ws + WS_WOUT), *Wq = (bf16_t*)(ws + WS_WQ), *Wo = (bf16_t*)(ws + WS_WO), *Wkv = (bf16_t*)(ws + WS_WKV);
    bf16_t *xb = (bf16_t*)(ws + WS_XB), *memb = (bf16_t*)(ws + WS_MEMB), *kb = (bf16_t*)(ws + WS_KB), *vb2 = (bf16_t*)(ws + WS_VB2), *ug = (bf16_t*)(ws + WS_UG),
           *vb = (bf16_t*)(ws + WS_VB), *gb = (bf16_t*)(ws + WS_GB), *mixb = (bf16_t*)(ws + WS_MIXB), *qb = (bf16_t*)(ws + WS_QB), *ob = (bf16_t*)(ws + WS_OB);
    float *ss0 = (float*)(ws + WS_SS0), *ss4 = (float*)(ws + WS_SS4), *ssm = (float*)(ws + WS_SSM);

    if (hipMemsetAsync(ws + WS_CTL, 0, CTL_ZERO_BYTES, stream) != hipSuccess) return;
    Args a{};
    for (int i = 0; i < 39; ++i) a.in[i] = in[i];
    a.out = out; a.ws = ws;
    int li = 0;
    auto run = [&](int lo, int hi) {
        if (FAST_MERGE) { a.ph_lo = lo; a.ph_hi = hi; a.li = li++; hipLaunchKernelGGL(mk_fwd, dim3(grid), dim3(NWAVES * 64), LDS_BYTES, stream, a); }
        else for (int p = lo; p < hi; ++p) { a.ph_lo = p; a.ph_hi = p + 1; a.li = li; hipLaunchKernelGGL(mk_fwd, dim3(grid), dim3(NWAVES * 64), LDS_BYTES, stream, a); }
    };

    run(PH_PRO, PH_N);
}
```

```cpp
#include <hip/hip_runtime.h>
#include <cstdint>
#include <cstdio>

typedef unsigned short bf16_t;
typedef float f32x4 __attribute__((ext_vector_type(4)));

constexpr int D = 1024, FF = 2816, MP = 16384, MS = 1024, M = MP + MS;
constexpr int SEQ = 2048, DECB = 128, DECS = 8, NBATCH = 8;
constexpr int SSM = 512, CONVD = 512, NG = 32, GC = 16, NST = 64, CWID = 31, NMEM = 256, NH = 4, HD = 256;
constexpr int MMEM = NBATCH * NMEM;
constexpr float EPS = 1e-6f;
constexpr float QSCALE = 0.0625f * 1.4426950408889634f;

constexpr size_t O_Y = 0;
constexpr size_t O_SRP = (size_t)M * D;
constexpr size_t O_SIP = O_SRP + 16384;
constexpr size_t O_CVP = O_SIP + 16384;
constexpr size_t O_MKP = O_CVP + 122880;
constexpr size_t O_MVP = O_MKP + 2097152;
constexpr size_t O_SRS = O_MVP + 2097152;
constexpr size_t O_SIS = O_SRS + 262144;
constexpr size_t O_CVS = O_SIS + 262144;
constexpr size_t O_END = O_CVS + 1966080;

constexpr size_t MiB = 1u << 20;
constexpr size_t WS_CTL = 0;
constexpr size_t WS_WGU1 = 2 * MiB, WS_WGU2 = 13 * MiB, WS_WD1 = 24 * MiB, WS_WD2 = 30 * MiB, WS_WIN = 36 * MiB, WS_WGLU = 39 * MiB,
                 WS_WOUT = 40 * MiB, WS_WQ = 42 * MiB, WS_WO = 44 * MiB, WS_WKV = 46 * MiB;
constexpr size_t WS_TAB = 50 * MiB;
constexpr size_t WS_XB = 72 * MiB, WS_MEMB = 106 * MiB, WS_KB = 110 * MiB, WS_VB2 = 114 * MiB;
constexpr size_t WS_SS0 = 118 * MiB, WS_SS1 = 120 * MiB, WS_SS2 = 122 * MiB, WS_SS3 = 124 * MiB, WS_SS4 = 126 * MiB, WS_SSM = 127 * MiB + 512 * 1024;
constexpr size_t WS_XRES = 128 * MiB, WS_H = 196 * MiB, WS_UG = 290 * MiB, WS_VB = 307 * MiB, WS_GB = 324 * MiB, WS_MIXB = 342 * MiB,
                 WS_QB = 376 * MiB, WS_OB = 410 * MiB, WS_END = 444 * MiB;

__device__ __forceinline__ unsigned f2bf(float f) { unsigned u = __builtin_bit_cast(unsigned, f); return (u + 0x7fffu + ((u >> 16) & 1u)) >> 16; }
__device__ __forceinline__ float bf2f(bf16_t b) { return __builtin_bit_cast(float, (unsigned)b << 16); }
__device__ __forceinline__ float sigmoidf_(float x) { return 1.f / (1.f + __expf(-x)); }
__device__ __forceinline__ float siluf_(float x) { return x * sigmoidf_(x); }
__device__ __forceinline__ float gelu_tanh(float x) { const float u = 0.7978845608028654f * (x + 0.044715f * x * x * x); return 0.5f * x * (1.f + tanhf(u)); }
__device__ __forceinline__ float wave_sum(float v) {
#pragma unroll
    for (int o = 1; o < 64; o <<= 1) v += __shfl_xor(v, o);
    return v;
}
__device__ __forceinline__ float rstd_from_ss(const float* ss, int row) {
    float s = 0.f;
#pragma unroll
    for (int i = 0; i < 16; ++i) s += ss[(size_t)row * 16 + i];
    return rsqrtf(s * (1.f / D) + EPS);
}

template <int MAP>
__global__ void k_wt(const float* W0, const float* W1, const float* gain, bf16_t* WT, int K, int N, int ldw) {
    __shared__ float tile[32][33];
    const int n0 = blockIdx.x * 32, k0 = blockIdx.y * 32, tx = threadIdx.x & 31, ty = threadIdx.x >> 5;
    const float* W = W0; int c0 = n0;
    if (MAP == 1) { const int pn = n0 / 256, half = (n0 % 256) / 128, jj = n0 % 128; W = half ? W1 : W0; c0 = pn * 128 + jj; }
    if (MAP == 2) { if (n0 >= 512) { const int m = n0 - 512, pc = m / 256, half = (m % 256) / 128, jj = m % 128; c0 = 512 + half * 512 + pc * 128 + jj; } }
    if (MAP == 3) { if (n0 >= 1024) { W = W1; c0 = n0 - 1024; } }
    for (int i = ty; i < 32; i += 8) { const int k = k0 + i; tile[i][tx] = W[(size_t)k * ldw + c0 + tx] * (gain ? gain[k] : 1.f); }
    __syncthreads();
    for (int i = ty; i < 32; i += 8) WT[(size_t)(n0 + i) * K + k0 + tx] = (bf16_t)f2bf(tile[tx][i]);
}
__global__ void k_rows_bf16_ss(const float* x0, int rows0, const float* x1, int rows1, bf16_t* xb, float* ss) {
    const int row = blockIdx.x * 4 + (threadIdx.x >> 6), lane = threadIdx.x & 63;
    if (row >= rows0 + rows1) return;
    const float* xr = row < rows0 ? x0 + (size_t)row * D : x1 + (size_t)(row - rows0) * D;
    float s = 0.f;
    for (int j = 0; j < 4; ++j) { const f32x4 v = *(const f32x4*)(xr + j * 256 + lane * 4); s += v.x * v.x + v.y * v.y + v.z * v.z + v.w * v.w;
        uint2 o; o.x = f2bf(v.x) | (f2bf(v.y) << 16); o.y = f2bf(v.z) | (f2bf(v.w) << 16); *(uint2*)(xb + (size_t)row * D + j * 256 + lane * 4) = o; }
    s = wave_sum(s);
    if (lane < 16) ss[(size_t)row * 16 + lane] = lane == 0 ? s : 0.f;
}
__global__ void k_rows_ss(const float* x, int rows, float* ss) {
    const int row = blockIdx.x * 4 + (threadIdx.x >> 6), lane = threadIdx.x & 63;
    if (row >= rows) return;
    float s = 0.f;
    for (int j = 0; j < 4; ++j) { const f32x4 v = *(const f32x4*)(x + (size_t)row * D + j * 256 + lane * 4); s += v.x * v.x + v.y * v.y + v.z * v.z + v.w * v.w; }
    s = wave_sum(s);
    if (lane < 16) ss[(size_t)row * 16 + lane] = lane == 0 ? s : 0.f;
}

enum { E_KV = 1, E_SWIGLU = 2, E_RES = 3, E_U = 4, E_V = 5, E_GLU = 6, E_Q = 7 };
struct EpiP {
    const float* ss;
    const float* resin;
    float* resout;
    bf16_t* ob;
    bf16_t* ob2;
    const bf16_t* gb;
    float* out;
    float alpha;
    int pad;
};
template <int MODE>
__device__ __forceinline__ void epi_elem(const EpiP& P, int row, int c, float a0, float a1, float rstd) {
    if (MODE == E_KV) {
        const float v = a0 * rstd;
        if (c < 1024) { P.out[O_MKP + (size_t)row * 1024 + c] = v; P.ob[(size_t)row * 1024 + c] = (bf16_t)f2bf(v); }
        else { P.out[O_MVP + (size_t)row * 1024 + c - 1024] = v; P.ob2[(size_t)row * 1024 + c - 1024] = (bf16_t)f2bf(v); }
    } else if (MODE == E_SWIGLU) {
        const float g = a0 * rstd, u = a1 * rstd; P.ob[(size_t)row * FF + c] = (bf16_t)f2bf(siluf_(g) * u);
    } else if (MODE == E_RES) {
        const float v = P.resin[(size_t)row * D + c] + P.alpha * a0; P.resout[(size_t)row * D + c] = v; if (P.ob) P.ob[(size_t)row * D + c] = (bf16_t)f2bf(v);
    } else if (MODE == E_U) {
        P.ob[((size_t)(c >> 4) * M + row) * 16 + (c & 15)] = (bf16_t)f2bf(a0 * rstd);
    } else if (MODE == E_V) {
        const float v = (a0 * rstd) * sigmoidf_(a1 * rstd); P.ob[(size_t)row * CONVD + c] = (bf16_t)f2bf(v);
        if (row < MP) { const int b = row / SEQ, t = row % SEQ; if (t >= SEQ - 30) P.out[O_CVP + ((size_t)b * 30 + (t - (SEQ - 30))) * CONVD + c] = v; }
        else { const int rs = row - MP, b = rs / DECS, t = rs % DECS; P.out[O_CVS + ((size_t)b * 30 + 22 + t) * CONVD + c] = v; }
    } else if (MODE == E_GLU) {
        const float g = bf2f(P.gb[(size_t)row * SSM + c]); P.ob[(size_t)row * D + c] = (bf16_t)f2bf(g * sigmoidf_(a0));
    } else if (MODE == E_Q) {
        P.ob[(size_t)row * D + c] = (bf16_t)f2bf(a0 * rstd * QSCALE);
    }
}
template <int MODE> struct ModeTraits { static constexpr bool PAIRED = (MODE == E_SWIGLU || MODE == E_V); static constexpr bool RSTD = (MODE == E_KV || MODE == E_SWIGLU || MODE == E_U || MODE == E_V || MODE == E_Q); };

template <int MODE>
__global__ void __launch_bounds__(256) k_ref_gemm(const bf16_t* A, const bf16_t* BT, int K, EpiP P) {
    constexpr bool PAIRED = ModeTraits<MODE>::PAIRED;
    __shared__ float As[32][65], B0[32][65], B1[PAIRED ? 32 : 1][65];
    const int tid = threadIdx.x, tx = tid & 15, ty = tid >> 4;
    const int m0 = blockIdx.y * 64, p0 = blockIdx.x * 64;
    const int cb0 = PAIRED ? (p0 / 128) * 256 + (p0 % 128) : p0;
    float acc0[4][4], acc1[4][4];
    for (int i = 0; i < 4; ++i) for (int j = 0; j < 4; ++j) { acc0[i][j] = 0.f; acc1[i][j] = 0.f; }
    for (int k0 = 0; k0 < K; k0 += 32) {
        for (int e = tid; e < 64 * 32; e += 256) { const int r = e >> 5, k = e & 31;
            As[k][r] = bf2f(A[(size_t)(m0 + r) * K + k0 + k]); B0[k][r] = bf2f(BT[(size_t)(cb0 + r) * K + k0 + k]);
            if (PAIRED) B1[k][r] = bf2f(BT[(size_t)(cb0 + 128 + r) * K + k0 + k]); }
        __syncthreads();
        for (int k = 0; k < 32; ++k) {
            float a[4], b0[4], b1[4];
            for (int i = 0; i < 4; ++i) a[i] = As[k][ty * 4 + i];
            for (int j = 0; j < 4; ++j) { b0[j] = B0[k][tx * 4 + j]; b1[j] = PAIRED ? B1[k][tx * 4 + j] : 0.f; }
            for (int i = 0; i < 4; ++i) for (int j = 0; j < 4; ++j) { acc0[i][j] += a[i] * b0[j]; if (PAIRED) acc1[i][j] += a[i] * b1[j]; }
        }
        __syncthreads();
    }
    for (int i = 0; i < 4; ++i) { const int row = m0 + ty * 4 + i; const float rstd = ModeTraits<MODE>::RSTD ? rstd_from_ss(P.ss, row) : 1.f;
        for (int j = 0; j < 4; ++j) epi_elem<MODE>(P, row, p0 + tx * 4 + j, acc0[i][j], acc1[i][j], rstd); }
}

__global__ void __launch_bounds__(64) k_ref_s5(const bf16_t* ug, const float* h0re, const float* h0im, const float* a_re, const float* a_im, const float* log_dt,
                                               const float* b_re, const float* b_im, const float* c_re, const float* c_im, const float* dskip, bf16_t* gb, float* out) {
    const int g = blockIdx.x % NG, sq = blockIdx.x / NG, n = threadIdx.x;
    const bool prompt = sq < NBATCH; const int b = prompt ? sq : sq - NBATCH, T = prompt ? SEQ : DECS, row0 = prompt ? b * SEQ : MP + b * DECS;
    const float dt = expf(log_dt[g]), lr = a_re[g * NST + n], li = a_im[g * NST + n];
    const float mag = expf(lr * dt), abr = mag * cosf(li * dt), abi = mag * sinf(li * dt);
    const float den = lr * lr + li * li, nr = abr - 1.f, ni = abi, cr = (nr * lr + ni * li) / den, ci = (ni * lr - nr * li) / den;
    float Br[16], Bi[16], Cr[16], Ci[16];
    for (int c = 0; c < 16; ++c) { const float br = b_re[((size_t)g * NST + n) * 16 + c], bi = b_im[((size_t)g * NST + n) * 16 + c];
        Br[c] = cr * br - ci * bi; Bi[c] = cr * bi + ci * br; Cr[c] = c_re[((size_t)g * 16 + c) * NST + n]; Ci[c] = c_im[((size_t)g * 16 + c) * NST + n]; }
    float hr = 0.f, hi = 0.f;
    if (!prompt) { hr = h0re[((size_t)b * NG + g) * NST + n]; hi = h0im[((size_t)b * NG + g) * NST + n]; }
    const float dsk = dskip[g * 16 + (n & 15)];
    for (int t = 0; t < T; ++t) {
        const bf16_t* up = ug + ((size_t)g * M + row0 + t) * 16;
        float u[16], xr = 0.f, xi = 0.f;
#pragma unroll
        for (int c = 0; c < 16; ++c) { u[c] = bf2f(up[c]); xr += Br[c] * u[c]; xi += Bi[c] * u[c]; }
        const float nhr = abr * hr - abi * hi + xr, nhi = abr * hi + abi * hr + xi; hr = nhr; hi = nhi;
        float ymine = 0.f;
#pragma unroll
        for (int c = 0; c < 16; ++c) { const float y = wave_sum(Cr[c] * hr - Ci[c] * hi); if ((n & 15) == c) ymine = y + dsk * u[c]; }
        if (n < 16) gb[(size_t)(row0 + t) * SSM + g * 16 + n] = (bf16_t)f2bf(gelu_tanh(ymine));
    }
    if (prompt) { out[O_SRP + ((size_t)b * NG + g) * NST + n] = hr; out[O_SIP + ((size_t)b * NG + g) * NST + n] = hi; }
    else { out[O_SRS + ((size_t)b * NG + g) * NST + n] = hr; out[O_SIS + ((size_t)b * NG + g) * NST + n] = hi; }
}

__global__ void __launch_bounds__(512) k_ref_conv(const bf16_t* vb, const float* cache, const float* w, const float* bias, const float* lg, const float* lb, bf16_t* mixb, float* out) {
    __shared__ float red[2][8];
    const int row = blockIdx.x, c = threadIdx.x;
    float y = bias[c];
    if (row < MP) { const int t = row % SEQ;
        for (int k = 0; k < CWID; ++k) { const int tt = t - 30 + k; if (tt >= 0) y += w[k * CONVD + c] * bf2f(vb[(size_t)(row - 30 + k) * CONVD + c]); }
    } else { const int rs = row - MP, b = rs / DECS, t = rs % DECS;
        for (int k = 0; k < CWID; ++k) { const int idx = t + k; const float xv = idx < 30 ? cache[((size_t)b * 30 + idx) * CONVD + c] : bf2f(vb[(size_t)(MP + b * DECS + idx - 30) * CONVD + c]); y += w[k * CONVD + c] * xv; }
        if (t == 0) for (int j = 0; j < 22; ++j) out[O_CVS + ((size_t)b * 30 + j) * CONVD + c] = cache[((size_t)b * 30 + j + 8) * CONVD + c];
    }
    float s = wave_sum(y); if ((c & 63) == 0) red[0][c >> 6] = s; __syncthreads();
    float mu = 0.f; for (int i = 0; i < 8; ++i) mu += red[0][i]; mu *= (1.f / CONVD);
    const float d = y - mu; float q = wave_sum(d * d); if ((c & 63) == 0) red[1][c >> 6] = q; __syncthreads();
    float var = 0.f; for (int i = 0; i < 8; ++i) var += red[1][i]; var *= (1.f / CONVD);
    const float z = d * rsqrtf(var + EPS) * lg[c] + lb[c];
    mixb[(size_t)row * D + SSM + c] = (bf16_t)f2bf(siluf_(z));
}

__global__ void __launch_bounds__(256) k_ref_attn(const bf16_t* qb, const bf16_t* kb, const bf16_t* vb2, const float* ck, const float* cv, bf16_t* ob) {
    __shared__ float q[256], p[256], red[4];
    const int row = blockIdx.x >> 2, h = blockIdx.x & 3, tid = threadIdx.x;
    q[tid] = bf2f(qb[(size_t)row * D + h * HD + tid]);
    __syncthreads();
    float s = 0.f;
    if (row < MP) { const int b = row / SEQ; const bf16_t* kr = kb + ((size_t)b * NMEM + tid) * D + h * HD; for (int d = 0; d < HD; ++d) s += q[d] * bf2f(kr[d]); }
    else { const int b = (row - MP) / DECS; const float* kr = ck + ((size_t)b * NMEM + tid) * D + h * HD; for (int d = 0; d < HD; ++d) s += q[d] * kr[d]; }
    float mx = s; for (int o = 1; o < 64; o <<= 1) mx = fmaxf(mx, __shfl_xor(mx, o));
    if ((tid & 63) == 0) red[tid >> 6] = mx; __syncthreads();
    mx = fmaxf(fmaxf(red[0], red[1]), fmaxf(red[2], red[3])); __syncthreads();
    const float e = exp2f(s - mx); float sm = wave_sum(e);
    if ((tid & 63) == 0) red[tid >> 6] = sm; __syncthreads();
    sm = red[0] + red[1] + red[2] + red[3];
    p[tid] = e / sm; __syncthreads();
    float o = 0.f;
    if (row < MP) { const int b = row / SEQ; const bf16_t* vr = vb2 + (size_t)b * NMEM * D + h * HD + tid; for (int m = 0; m < NMEM; ++m) o += p[m] * bf2f(vr[(size_t)m * D]); }
    else { const int b = (row - MP) / DECS; const float* vr = cv + (size_t)b * NMEM * D + h * HD + tid; for (int m = 0; m < NMEM; ++m) o += p[m] * vr[(size_t)m * D]; }
    ob[(size_t)row * D + h * HD + tid] = (bf16_t)f2bf(o);
}

__global__ void k_final(float* y, const float* ss, const float* g) {
    const int row = blockIdx.x * 4 + (threadIdx.x >> 6), lane = threadIdx.x & 63;
    const float r = rstd_from_ss(ss, row);
    for (int j = 0; j < 4; ++j) { f32x4* p = (f32x4*)(y + (size_t)row * D + j * 256 + lane * 4); const f32x4 gg = *(const f32x4*)(g + j * 256 + lane * 4); f32x4 v = *p; v = v * r * gg; *p = v; }
}


namespace pg8 {
#define PG8_LAS __attribute__((address_space(3)))
typedef unsigned short bf16_t;
typedef short bf16x8 __attribute__((ext_vector_type(8)));
typedef float f32x4 __attribute__((ext_vector_type(4)));
typedef unsigned u32x4 __attribute__((ext_vector_type(4)));
constexpr int BM = 256, BK = 64, HALF = 128, HTB = HALF * BK * 2  , STAGE_BYTES = 8 * HTB, NXCD = 8, WGM = 8;

__host__ __device__ __forceinline__ int lds_byte(int r, int c) { const int st = (r >> 4) * 2 + (c >> 5), rr = r & 15, cc = c & 31, ob = rr * 64 + cc * 2; return st * 1024 + (ob ^ (((ob >> 9) & 1) << 5)); }
__host__ __device__ __forceinline__ void stage_rc(int b, int& R, int& C) { const int st = b / 1024, sb = b % 1024, swz = sb ^ (((sb >> 9) & 1) << 5); R = (st >> 1) * 16 + swz / 64; C = (st & 1) * 32 + (swz % 64) / 2; }
__host__ __device__ __forceinline__ int perm32(int rho) { const int n = rho >> 4, i = rho & 15; return 8 * (i >> 2) + 4 * n + (i & 3); }

struct Unit { int pm, pn; };
struct Gemm { const bf16_t* A; const bf16_t* Bt; int M, N, K; };

struct StaticOrder {
    int nM, nN, nwg, G, c;
    __host__ __device__ void init(int M, int N, int G_, int c_) { nM = M / BM; nN = N / BM; nwg = nM * nN; G = G_; c = c_; }
    __host__ __device__ bool next(int i, Unit& u) const {
        const long L = (long)i * G + c; if (L >= nwg) return false;
        int wgid = (int)L; { const int q = nwg / NXCD, r = nwg % NXCD, xcd = wgid % NXCD, off = wgid / NXCD; wgid = (xcd < r ? xcd * (q + 1) : r * (q + 1) + (xcd - r) * q) + off; }
        const int nig = WGM * nN, gid = wgid / nig, fm = gid * WGM, gsz = (nM - fm) < WGM ? (nM - fm) : WGM;
        u.pm = fm + ((wgid % nig) % gsz); u.pn = (wgid % nig) / gsz; return true;
    }
    __device__ __forceinline__ void a_ready(const Unit&) const {}
    __device__ __forceinline__ void done(const Unit&) const {}
};
__device__ __forceinline__ unsigned cvt_pk_bf16(float lo, float hi) { unsigned r; asm volatile("v_cvt_pk_bf16_f32 %0, %1, %2" : "=v"(r) : "v"(lo), "v"(hi)); return r; }
typedef float f32x2 __attribute__((ext_vector_type(2)));
template <class Epi, class Sched, bool ALIGN_EPI = false, bool SP2 = false>
__device__ __forceinline__ void gemm_phase(PG8_LAS unsigned char* lds, const Gemm g, const Sched& S, const Epi& E) {
    const int tid = threadIdx.x, wid = __builtin_amdgcn_readfirstlane(tid >> 6), lane = tid & 63, wr = wid >> 2, wc = wid & 3, fr = lane & 15, fq = lane >> 4;
    const int K = g.K, nt = K / BK;
    unsigned voffA[2], voffB[2];
#pragma unroll
    for (int i = 0; i < 2; ++i) { int R, C; stage_rc(tid * 16 + i * 8192, R, C); const int Rb = Epi::PERM ? ((R & ~31) + perm32(R & 31)) : R;
        voffA[i] = (unsigned)(R * K + C) * 2u; voffB[i] = (unsigned)(Rb * K + C) * 2u; }
    const size_t kstep = (size_t)(BK * 2);
    const size_t hstep = (size_t)HALF * K * 2;
    const size_t tstep = 2 * hstep;
    const unsigned ldsw = (unsigned)wid * 1024u;
    const int aoff = lds_byte(wr * 64 + fr, fq * 8), boff = lds_byte(wc * 32 + fr, fq * 8);
#define PG8_SA(b, h) (((b) * 2 + (h)) * HTB)
#define PG8_SB(b, h) ((4 + (b) * 2 + (h)) * HTB)
#define PG8_STAGE(bufoff, gbase, voff) do { _Pragma("unroll") for (int _i = 0; _i < 2; ++_i) \
        __builtin_amdgcn_global_load_lds((const unsigned*)((const char*)(gbase) + (voff)[_i]), (PG8_LAS unsigned*)(lds + (bufoff) + ldsw + _i * 8192), 16, 0, 0); } while (0)
#define PG8_LDA(dst, b, h) do { _Pragma("unroll") for (int m = 0; m < 4; ++m) _Pragma("unroll") for (int k = 0; k < 2; ++k) dst[m][k] = *(const PG8_LAS bf16x8*)(lds + PG8_SA(b, h) + aoff + m * 2048 + k * 1024); } while (0)
#define PG8_LDB(dst, b, h) do { _Pragma("unroll") for (int n = 0; n < 2; ++n) _Pragma("unroll") for (int k = 0; k < 2; ++k) dst[n][k] = *(const PG8_LAS bf16x8*)(lds + PG8_SB(b, h) + boff + n * 2048 + k * 1024); } while (0)
#define PG8_MMA(ai, bj, At, Bt) do { __builtin_amdgcn_s_setprio(1); _Pragma("unroll") for (int m = 0; m < 4; ++m) _Pragma("unroll") for (int n = 0; n < 2; ++n) _Pragma("unroll") for (int k = 0; k < 2; ++k) \
        acc[ai][bj][m][n] = __builtin_amdgcn_mfma_f32_16x16x32_bf16(Bt[n][k], At[m][k], acc[ai][bj][m][n], 0, 0, 0); __builtin_amdgcn_s_setprio(0); } while (0)
#define PG8_WAIT_V(n) asm volatile("s_waitcnt vmcnt(" #n ")" ::: "memory")
#define PG8_WAIT_L(n) asm volatile("s_waitcnt lgkmcnt(" #n ")" ::: "memory")
#define PG8_BAR __builtin_amdgcn_s_barrier()
#define PG8_SCHED __builtin_amdgcn_sched_barrier(0)
    Unit cur, nxt; int ui = 0;
    if (!S.next(0, cur)) return;
    f32x4 acc[2][2][4][2];
#pragma unroll
    for (int a = 0; a < 2; ++a)
#pragma unroll
        for (int b = 0; b < 2; ++b)
#pragma unroll
            for (int m = 0; m < 4; ++m)
#pragma unroll
                for (int n = 0; n < 2; ++n) acc[a][b][m][n] = (f32x4){0.f, 0.f, 0.f, 0.f};
    bf16x8 At[4][2], B0[2][2], B1[2][2];
    const char* cA = (const char*)g.A + (size_t)cur.pm * tstep; const char* cB = (const char*)g.Bt + (size_t)cur.pn * tstep;
    S.a_ready(cur);
    if constexpr (SP2) {
        PG8_STAGE(PG8_SB(0, 0), cB, voffB); PG8_STAGE(PG8_SB(0, 1), cB + hstep, voffB); PG8_STAGE(PG8_SA(0, 0), cA, voffA); PG8_STAGE(PG8_SA(0, 1), cA + hstep, voffA);
        if (wr == 1) PG8_BAR;
        PG8_WAIT_V(2); PG8_BAR;
        PG8_STAGE(PG8_SB(1, 0), cB + kstep, voffB); PG8_STAGE(PG8_SA(1, 0), cA + kstep, voffA); PG8_STAGE(PG8_SB(1, 1), cB + hstep + kstep, voffB);
        PG8_WAIT_V(6); PG8_BAR;
    } else {
        PG8_STAGE(PG8_SB(0, 0), cB, voffB); PG8_STAGE(PG8_SA(0, 0), cA, voffA); PG8_STAGE(PG8_SB(0, 1), cB + hstep, voffB); PG8_STAGE(PG8_SA(0, 1), cA + hstep, voffA);
        if (wr == 1) PG8_BAR;
        PG8_WAIT_V(4); PG8_BAR;
        PG8_STAGE(PG8_SB(1, 0), cB + kstep, voffB); PG8_STAGE(PG8_SA(1, 0), cA + kstep, voffA); PG8_STAGE(PG8_SB(1, 1), cB + hstep + kstep, voffB);
        PG8_WAIT_V(6); PG8_BAR;
    }
    for (;;) {
        const bool has_next = S.next(ui + 1, nxt);
        const char* nA = has_next ? (const char*)g.A + (size_t)nxt.pm * tstep : cA; const char* nB = has_next ? (const char*)g.Bt + (size_t)nxt.pn * tstep : cB;
        for (int t = 0; t < nt; t += 2) {
            const bool last = (t == nt - 2);
            const char* a1 = cA + (size_t)(t + 1) * kstep;
            const char* a2 = last ? nA : cA + (size_t)(t + 2) * kstep; const char* b2 = last ? nB : cB + (size_t)(t + 2) * kstep;
            const char* a3 = a2 + kstep; const char* b3 = b2 + kstep;
            if (last && has_next) S.a_ready(nxt);
            if constexpr (SP2) {
            PG8_LDB(B0, 0, 0); PG8_LDB(B1, 0, 1); PG8_SCHED; PG8_LDA(At, 0, 0); PG8_STAGE(PG8_SA(1, 1), a1 + hstep, voffA);
            PG8_WAIT_V(8); PG8_WAIT_L(0); PG8_BAR; PG8_MMA(0, 0, At, B0); PG8_MMA(0, 1, At, B1); PG8_BAR; PG8_SCHED;
            PG8_LDA(At, 0, 1); PG8_STAGE(PG8_SB(0, 0), b2, voffB); PG8_STAGE(PG8_SB(0, 1), b2 + hstep, voffB); PG8_STAGE(PG8_SA(0, 0), a2, voffA);
            PG8_WAIT_V(8); PG8_WAIT_L(0); PG8_BAR; PG8_MMA(1, 0, At, B0); PG8_MMA(1, 1, At, B1); PG8_BAR; PG8_SCHED;
            PG8_LDB(B0, 1, 0); PG8_LDB(B1, 1, 1); PG8_SCHED; PG8_LDA(At, 1, 0); PG8_STAGE(PG8_SA(0, 1), a2 + hstep, voffA);
            PG8_WAIT_V(8); PG8_WAIT_L(0); PG8_BAR; PG8_MMA(0, 0, At, B0); PG8_MMA(0, 1, At, B1); PG8_BAR; PG8_SCHED;
            PG8_LDA(At, 1, 1); PG8_STAGE(PG8_SB(1, 0), b3, voffB); PG8_STAGE(PG8_SB(1, 1), b3 + hstep, voffB); PG8_STAGE(PG8_SA(1, 0), a3, voffA);
            PG8_WAIT_V(8); PG8_WAIT_L(0); PG8_BAR; PG8_MMA(1, 0, At, B0); PG8_MMA(1, 1, At, B1); PG8_BAR; PG8_SCHED;
            } else {
            PG8_LDB(B0, 0, 0); PG8_SCHED; PG8_LDA(At, 0, 0); PG8_STAGE(PG8_SA(1, 1), a1 + hstep, voffA);
            PG8_WAIT_L(8); PG8_BAR; PG8_WAIT_L(0); PG8_MMA(0, 0, At, B0); PG8_BAR; PG8_SCHED;
            PG8_LDB(B1, 0, 1); PG8_STAGE(PG8_SB(0, 0), b2, voffB);
            PG8_BAR; PG8_WAIT_L(0); PG8_MMA(0, 1, At, B1); PG8_BAR;
            PG8_LDA(At, 0, 1); PG8_STAGE(PG8_SA(0, 0), a2, voffA);
            PG8_BAR; PG8_WAIT_L(0); PG8_MMA(1, 0, At, B0); PG8_BAR; PG8_SCHED;
            PG8_STAGE(PG8_SB(0, 1), b2 + hstep, voffB);
            PG8_WAIT_V(6); PG8_BAR; PG8_MMA(1, 1, At, B1); PG8_BAR;
            PG8_LDB(B0, 1, 0); PG8_SCHED; PG8_LDA(At, 1, 0); PG8_STAGE(PG8_SA(0, 1), a2 + hstep, voffA);
            PG8_WAIT_L(8); PG8_BAR; PG8_WAIT_L(0); PG8_MMA(0, 0, At, B0); PG8_BAR; PG8_SCHED;
            PG8_LDB(B1, 1, 1); PG8_STAGE(PG8_SB(1, 0), b3, voffB);
            PG8_BAR; PG8_WAIT_L(0); PG8_MMA(0, 1, At, B1); PG8_BAR;
            PG8_LDA(At, 1, 1); PG8_STAGE(PG8_SA(1, 0), a3, voffA);
            PG8_BAR; PG8_WAIT_L(0); PG8_MMA(1, 0, At, B0); PG8_BAR; PG8_SCHED;
            PG8_STAGE(PG8_SB(1, 1), b3 + hstep, voffB);
            PG8_WAIT_V(6); PG8_BAR; PG8_MMA(1, 1, At, B1); PG8_BAR;
            }
        }
        if constexpr (ALIGN_EPI) { if (wr == 0) PG8_BAR; }
        if constexpr (!Epi::AFTER_DRAIN) { E(acc, cur, wr, wc, fr, fq); S.done(cur); }
        if (!has_next) break;
#pragma unroll
        for (int a = 0; a < 2; ++a)
#pragma unroll
            for (int b = 0; b < 2; ++b)
#pragma unroll
                for (int m = 0; m < 4; ++m)
#pragma unroll
                    for (int n = 0; n < 2; ++n) acc[a][b][m][n] = (f32x4){0.f, 0.f, 0.f, 0.f};
        cur = nxt; cA = nA; cB = nB; ++ui;
        if constexpr (ALIGN_EPI) { if (wr == 1) PG8_BAR; }
    }
    PG8_WAIT_V(0);
    if constexpr (!ALIGN_EPI) { if (wr == 0) PG8_BAR; }
    PG8_BAR;
    if constexpr (Epi::AFTER_DRAIN) { E.fused(acc, cur, wr, wc, fr, fq, lds, wid, lane); S.done(cur); }
#undef PG8_SA
#undef PG8_SB
#undef PG8_STAGE
#undef PG8_LDA
#undef PG8_LDB
#undef PG8_MMA
#undef PG8_WAIT_V
#undef PG8_WAIT_L
#undef PG8_BAR
#undef PG8_SCHED
}
}

namespace fx {
using pg8::f32x4; using pg8::u32x4; using pg8::Unit; using pg8::HALF; using pg8::BM; using pg8::cvt_pk_bf16;
__device__ __forceinline__ float rstd_row(const float* ss, int row) {
    const f32x4* p = (const f32x4*)(ss + (size_t)row * 16); const f32x4 a = p[0], b = p[1], c = p[2], d = p[3];
    const float s = ((a.x + a.y) + (a.z + a.w)) + ((b.x + b.y) + (b.z + b.w)) + ((c.x + c.y) + (c.z + c.w)) + ((d.x + d.y) + (d.z + d.w));
    return rsqrtf(s * (1.f / D) + EPS);
}
__device__ __forceinline__ float fsig(float x) { return __builtin_amdgcn_rcpf(1.f + __builtin_amdgcn_exp2f(-1.4426950408889634f * x)); }
__device__ __forceinline__ u32x4 pack8(const f32x4 a, const f32x4 b) { u32x4 w; w.x = cvt_pk_bf16(a[0], a[1]); w.y = cvt_pk_bf16(a[2], a[3]); w.z = cvt_pk_bf16(b[0], b[1]); w.w = cvt_pk_bf16(b[2], b[3]); return w; }
__device__ __forceinline__ f32x4 sig4(const f32x4 x) { return (f32x4){fsig(x[0]), fsig(x[1]), fsig(x[2]), fsig(x[3])}; }

struct EpiKV { static constexpr bool PERM = true, AFTER_DRAIN = false; const float* ss; bf16_t* kb; bf16_t* vb2; float* out;
    __device__ __forceinline__ void operator()(const f32x4 (&acc)[2][2][4][2], const Unit& u, int wr, int wc, int fr, int fq) const {
        const int row0 = u.pm * BM + wr * 64 + fr; const bool isv = u.pn >= 4; const int colt = (isv ? u.pn - 4 : u.pn) * BM + wc * 32 + 8 * fq;
        float* of = out + (isv ? O_MVP : O_MKP); bf16_t* ob = isv ? vb2 : kb;
#pragma unroll
        for (int ai = 0; ai < 2; ++ai)
#pragma unroll
            for (int m = 0; m < 4; ++m) { const int row = row0 + ai * HALF + m * 16; const float r = rstd_row(ss, row);
#pragma unroll
                for (int bj = 0; bj < 2; ++bj) { const f32x4 v0 = acc[ai][bj][m][0] * r, v1 = acc[ai][bj][m][1] * r; const size_t o = (size_t)row * D + colt + bj * HALF;
                    *(f32x4*)(of + o) = v0; *(f32x4*)(of + o + 4) = v1; *(u32x4*)(ob + o) = pack8(v0, v1); } }
    }
};

struct EpiK { static constexpr bool PERM = true, AFTER_DRAIN = false; const float* rstdm; bf16_t* kb; float* out;
    __device__ __forceinline__ void operator()(const f32x4 (&acc)[2][2][4][2], const Unit& u, int wr, int wc, int fr, int fq) const {
        const int row0 = u.pm * BM + wr * 64 + fr, colt = u.pn * BM + wc * 32 + 8 * fq;
#pragma unroll
        for (int ai = 0; ai < 2; ++ai)
#pragma unroll
            for (int m = 0; m < 4; ++m) { const int row = row0 + ai * HALF + m * 16; const float r = rstdm[row];
#pragma unroll
                for (int bj = 0; bj < 2; ++bj) { const f32x4 v0 = acc[ai][bj][m][0] * r, v1 = acc[ai][bj][m][1] * r; const size_t o = (size_t)row * D + colt + bj * HALF;
                    *(f32x4*)(out + O_MKP + o) = v0; *(f32x4*)(out + O_MKP + o + 4) = v1; *(u32x4*)(kb + o) = pack8(v0, v1); } }
    }
};
struct EpiVT { static constexpr bool PERM = true, AFTER_DRAIN = false; const float* rstdm; bf16_t* vT; float* out;
    __device__ __forceinline__ void operator()(const f32x4 (&acc)[2][2][4][2], const Unit& u, int wr, int wc, int fr, int fq) const {
        const int row0 = u.pm * BM + wr * 64 + fr;
#pragma unroll
        for (int bj = 0; bj < 2; ++bj) { const int cl = bj * HALF + wc * 32 + 8 * fq, c0 = u.pn * BM + cl;
            const f32x4 r0 = *(const f32x4*)(rstdm + c0), r1 = *(const f32x4*)(rstdm + c0 + 4);
            const int pos0 = (cl & ~15) + 4 * ((cl >> 3) & 1);
#pragma unroll
            for (int ai = 0; ai < 2; ++ai)
#pragma unroll
                for (int m = 0; m < 4; ++m) { const int row = row0 + ai * HALF + m * 16; const f32x4 v0 = acc[ai][bj][m][0] * r0, v1 = acc[ai][bj][m][1] * r1;
                    bf16_t* vp = vT + (size_t)row * MMEM + u.pn * BM;
                    typedef unsigned u32x2 __attribute__((ext_vector_type(2)));
                    *(u32x2*)(vp + pos0) = (u32x2){cvt_pk_bf16(v0[0], v0[1]), cvt_pk_bf16(v0[2], v0[3])}; *(u32x2*)(vp + pos0 + 8) = (u32x2){cvt_pk_bf16(v1[0], v1[1]), cvt_pk_bf16(v1[2], v1[3])};
                    float* op = out + O_MVP + (size_t)c0 * D + row;
                    op[0] = v0[0]; op[D] = v0[1]; op[2 * D] = v0[2]; op[3 * D] = v0[3]; op[4 * D] = v1[0]; op[5 * D] = v1[1]; op[6 * D] = v1[2]; op[7 * D] = v1[3]; } }
    }
};
struct EpiSwiglu { static constexpr bool PERM = true, AFTER_DRAIN = false; const float* ss; bf16_t* H;
    __device__ __forceinline__ void operator()(const f32x4 (&acc)[2][2][4][2], const Unit& u, int wr, int wc, int fr, int fq) const {
        const int row0 = u.pm * BM + wr * 64 + fr, col0 = u.pn * HALF + wc * 32 + 8 * fq;
#pragma unroll
        for (int ai = 0; ai < 2; ++ai)
#pragma unroll
            for (int m = 0; m < 4; ++m) { const int row = row0 + ai * HALF + m * 16; const float r = rstd_row(ss, row);
                const f32x4 g0 = acc[ai][0][m][0] * r, g1 = acc[ai][0][m][1] * r, u0 = acc[ai][1][m][0] * r, u1 = acc[ai][1][m][1] * r;
                *(u32x4*)(H + (size_t)row * FF + col0) = pack8(g0 * sig4(g0) * u0, g1 * sig4(g1) * u1); }
    }
};
struct EpiRes { static constexpr bool PERM = true, AFTER_DRAIN = false; const float* rin0; const float* rin1; float* rout; bf16_t* xb; float* ss; float alpha;
    __device__ __forceinline__ void operator()(const f32x4 (&acc)[2][2][4][2], const Unit& u, int wr, int wc, int fr, int fq) const {
        const int row0 = u.pm * BM + wr * 64 + fr, col0 = u.pn * BM + wc * 32 + 8 * fq; const float* rin = u.pm >= MP / BM ? rin1 : rin0;
#pragma unroll
        for (int ai = 0; ai < 2; ++ai)
#pragma unroll
            for (int m = 0; m < 4; ++m) { const int row = row0 + ai * HALF + m * 16; float sq = 0.f;
#pragma unroll
                for (int bj = 0; bj < 2; ++bj) { const size_t o = (size_t)row * D + col0 + bj * HALF;
                    const f32x4 v0 = *(const f32x4*)(rin + o) + acc[ai][bj][m][0] * alpha, v1 = *(const f32x4*)(rin + o + 4) + acc[ai][bj][m][1] * alpha;
                    *(f32x4*)(rout + o) = v0; *(f32x4*)(rout + o + 4) = v1; if (xb) *(u32x4*)(xb + o) = pack8(v0, v1);
                    sq += (v0[0] * v0[0] + v0[1] * v0[1]) + (v0[2] * v0[2] + v0[3] * v0[3]) + (v1[0] * v1[0] + v1[1] * v1[1]) + (v1[2] * v1[2] + v1[3] * v1[3]); }
                sq += __shfl_xor(sq, 16); sq += __shfl_xor(sq, 32);
                if (fq == 0) ss[(size_t)row * 16 + u.pn * 4 + wc] = sq;
                if (m & 1) asm volatile("" ::: "memory"); }
    }
};
struct EpiIn { static constexpr bool PERM = true, AFTER_DRAIN = false; const float* ss; bf16_t* ug; bf16_t* vb; float* out;
    __device__ __forceinline__ void operator()(const f32x4 (&acc)[2][2][4][2], const Unit& u, int wr, int wc, int fr, int fq) const {
        const int row0 = u.pm * BM + wr * 64 + fr;
        if (u.pn < 2) {
#pragma unroll
            for (int ai = 0; ai < 2; ++ai)
#pragma unroll
                for (int m = 0; m < 4; ++m) { const int row = row0 + ai * HALF + m * 16; const float r = rstd_row(ss, row);
#pragma unroll
                    for (int bj = 0; bj < 2; ++bj) { const int c0 = u.pn * BM + bj * HALF + wc * 32 + 8 * fq;
                        *(u32x4*)(ug + ((size_t)(c0 >> 4) * M + row) * 16 + (c0 & 15)) = pack8(acc[ai][bj][m][0] * r, acc[ai][bj][m][1] * r); } }
        } else {
            const int p0 = (u.pn - 2) * HALF + wc * 32 + 8 * fq;
#pragma unroll
            for (int ai = 0; ai < 2; ++ai)
#pragma unroll
                for (int m = 0; m < 4; ++m) { const int row = row0 + ai * HALF + m * 16; const float r = rstd_row(ss, row);
                    const f32x4 a0 = acc[ai][0][m][0] * r, a1 = acc[ai][0][m][1] * r, g0 = acc[ai][1][m][0] * r, g1 = acc[ai][1][m][1] * r;
                    const f32x4 v0 = a0 * sig4(g0), v1 = a1 * sig4(g1);
                    *(u32x4*)(vb + (size_t)row * CONVD + p0) = pack8(v0, v1);
                    float* o = nullptr;
                    if (row >= MP) { const int rs = row - MP; o = out + O_CVS + ((size_t)(rs >> 3) * 30 + 22 + (rs & 7)) * CONVD + p0; }
                    else { const int t = row & (SEQ - 1); if (t >= SEQ - 30) o = out + O_CVP + ((size_t)(row >> 11) * 30 + (t - (SEQ - 30))) * CONVD + p0; }
                    if (o) { *(f32x4*)o = v0; *(f32x4*)(o + 4) = v1; } }
        }
    }
};
struct EpiGlu { static constexpr bool PERM = true, AFTER_DRAIN = false; const bf16_t* gb; bf16_t* mixb;
    __device__ __forceinline__ void operator()(const f32x4 (&acc)[2][2][4][2], const Unit& u, int wr, int wc, int fr, int fq) const {
        const int row0 = u.pm * BM + wr * 64 + fr, col0 = u.pn * BM + wc * 32 + 8 * fq;
#pragma unroll
        for (int ai = 0; ai < 2; ++ai)
#pragma unroll
            for (int m = 0; m < 4; ++m) { const int row = row0 + ai * HALF + m * 16;
#pragma unroll
                for (int bj = 0; bj < 2; ++bj) { const int c0 = col0 + bj * HALF; const u32x4 gw = *(const u32x4*)(gb + (size_t)row * SSM + c0);
                    const f32x4 ga = {__builtin_bit_cast(float, gw.x << 16), __builtin_bit_cast(float, gw.x & 0xffff0000u), __builtin_bit_cast(float, gw.y << 16), __builtin_bit_cast(float, gw.y & 0xffff0000u)};
                    const f32x4 gc = {__builtin_bit_cast(float, gw.z << 16), __builtin_bit_cast(float, gw.z & 0xffff0000u), __builtin_bit_cast(float, gw.w << 16), __builtin_bit_cast(float, gw.w & 0xffff0000u)};
                    *(u32x4*)(mixb + (size_t)row * D + c0) = pack8(ga * sig4(acc[ai][bj][m][0]), gc * sig4(acc[ai][bj][m][1])); } }
    }
};
struct EpiQ { static constexpr bool PERM = true, AFTER_DRAIN = false; const float* ss; bf16_t* qb;
    __device__ __forceinline__ void operator()(const f32x4 (&acc)[2][2][4][2], const Unit& u, int wr, int wc, int fr, int fq) const {
        const int row0 = u.pm * BM + wr * 64 + fr, col0 = u.pn * BM + wc * 32 + 8 * fq;
#pragma unroll
        for (int ai = 0; ai < 2; ++ai)
#pragma unroll
            for (int m = 0; m < 4; ++m) { const int row = row0 + ai * HALF + m * 16; const float r = rstd_row(ss, row) * QSCALE;
#pragma unroll
                for (int bj = 0; bj < 2; ++bj) *(u32x4*)(qb + (size_t)row * D + col0 + bj * HALF) = pack8(acc[ai][bj][m][0] * r, acc[ai][bj][m][1] * r); }
    }
};
}

#define GAS __attribute__((address_space(1)))
#define LAS __attribute__((address_space(3)))
typedef unsigned v4u __attribute__((ext_vector_type(4)));
typedef float f32x4 __attribute__((ext_vector_type(4)));
typedef short bf16x8 __attribute__((ext_vector_type(8)));
typedef GAS unsigned gu32;
typedef GAS unsigned long long gu64;
#define RLX_AGENT __ATOMIC_RELAXED, __HIP_MEMORY_SCOPE_AGENT
#define LDS_WAIT() asm volatile("s_waitcnt lgkmcnt(0)" ::: "memory")
#define VM_WAIT() asm volatile("s_waitcnt vmcnt(0)" ::: "memory")
__device__ __forceinline__ unsigned long long rt() { return __builtin_amdgcn_s_memrealtime(); }
__device__ __forceinline__ unsigned pk2(float lo, float hi) { return f2bf(lo) | (f2bf(hi) << 16); }

#define XB_TMO      128
#define XB_XCNT(j)  (256  + 64 * (j))
#define XB_XSUB(j)  (1280 + 64 * (j))
#define XB_XGEN(j)  (2304 + 64 * (j))
#define XB_TOP      3328
#define XB_TOPGEN   3392
#define XCD_BAR_WORDS 3456
#define XB_SPIN_CAP (1u << 18)

__device__ __forceinline__ unsigned xb_ld(unsigned* p)              { return __hip_atomic_load(p, __ATOMIC_RELAXED, __HIP_MEMORY_SCOPE_AGENT); }
__device__ __forceinline__ unsigned xb_add(unsigned* p, unsigned v) { return __hip_atomic_fetch_add(p, v, __ATOMIC_RELAXED, __HIP_MEMORY_SCOPE_AGENT); }
__device__ __forceinline__ unsigned xb_xcc_id() { return (unsigned)__builtin_amdgcn_s_getreg((3 << 11) | 20) & 0xFu; }
#define XB_SPIN(cond, bar) do { unsigned _sp = 0; while (cond) { __builtin_amdgcn_s_sleep(1); \
    if ((++_sp & 255u) == 0u) { if (xb_ld(&(bar)[XB_TMO])) break; if (_sp > XB_SPIN_CAP) { atomicAdd(&(bar)[XB_TMO], 1u); break; } } } } while (0)

struct XcdBarrier {
    unsigned* bar; unsigned x;
    volatile LAS unsigned* st;
};

__device__ __forceinline__ XcdBarrier xcd_barrier_post(unsigned* bar, volatile LAS unsigned* st) {
    XcdBarrier b; b.bar = bar; b.x = xb_xcc_id(); b.st = st;
    if (threadIdx.x == 0) (void)xb_add(&bar[XB_XCNT(b.x)], 1u);
    return b;
}
__device__ __forceinline__ void xcd_barrier_complete(unsigned* bar, unsigned x, unsigned& nloc, unsigned& nx) {
    const unsigned G = gridDim.x * gridDim.y * gridDim.z;
    unsigned sum, cnt, mine, sp = 0u;
    for (;;) {
        sum = 0u; cnt = 0u; mine = 0u;
#pragma unroll
        for (unsigned j = 0; j < 16; ++j) { const unsigned c = xb_ld(&bar[XB_XCNT(j)]); sum += c; cnt += (c > 0u) ? 1u : 0u; mine = (j == x) ? c : mine; }
        if (sum == G) break;
        __builtin_amdgcn_s_sleep(1);
        if ((++sp & 255u) == 0u) { if (xb_ld(&bar[XB_TMO])) break; if (sp > XB_SPIN_CAP) { atomicAdd(&bar[XB_TMO], 1u); break; } }
    }
    nloc = mine > 0u ? mine : 1u; nx = cnt > 0u ? cnt : 1u;
}

__device__ __forceinline__ void xcd_barrier(const XcdBarrier& b) {
    asm volatile("s_waitcnt vmcnt(0)" ::: "memory");
    __syncthreads();
    if (threadIdx.x == 0) {
        unsigned* bar = b.bar;
        __builtin_amdgcn_s_waitcnt(0);
        unsigned nloc = b.st[0], nx = b.st[1];
        if (nloc == 0u) { xcd_barrier_complete(bar, b.x, nloc, nx); b.st[0] = nloc; b.st[1] = nx; }
        const unsigned old = xb_add(&bar[XB_XSUB(b.x)], 1u);
        const unsigned gen = old / nloc;
        if (old + 1u == (gen + 1u) * nloc) {
            __builtin_amdgcn_fence(__ATOMIC_RELEASE, "agent");
            asm volatile("s_waitcnt vmcnt(0)" ::: "memory");
            const unsigned og = xb_add(&bar[XB_TOP], 1u);
            const unsigned tg = og / nx;
            if (og + 1u == (tg + 1u) * nx) xb_add(&bar[XB_TOPGEN], 1u);
            else XB_SPIN(xb_ld(&bar[XB_TOPGEN]) == tg, bar);
            __builtin_amdgcn_fence(__ATOMIC_ACQUIRE, "agent");
            xb_add(&bar[XB_XGEN(b.x)], 1u);
            asm volatile("s_waitcnt vmcnt(0)" ::: "memory");
        } else {
            XB_SPIN(xb_ld(&bar[XB_XGEN(b.x)]) == gen, bar);
            __builtin_amdgcn_fence(__ATOMIC_ACQUIRE, "agent");
            asm volatile("s_waitcnt vmcnt(0)" ::: "memory");
        }
    }
    __syncthreads();
}

namespace sb {
__device__ __forceinline__ void transpose_item(const float* W, int ldw, int c0, const float* gain, bf16_t* WT, int K, int n0, int k0, LAS float* scr, int lane) {
#pragma unroll 8
    for (int i = 0; i < 32; ++i) { const int kk = 2 * i + (lane >> 5); float v = W[(size_t)(k0 + kk) * ldw + c0 + (lane & 31)]; if (gain) v *= gain[k0 + kk]; scr[kk * 33 + (lane & 31)] = v; }
    LDS_WAIT(); asm volatile("" ::: "memory");
    const int c = lane & 7;
#pragma unroll
    for (int j = 0; j < 4; ++j) { const int n = (lane >> 3) + 8 * j; const LAS float* s = scr + (8 * c) * 33 + n;
        v4u o; o.x = pk2(s[0 * 33], s[1 * 33]); o.y = pk2(s[2 * 33], s[3 * 33]); o.z = pk2(s[4 * 33], s[5 * 33]); o.w = pk2(s[6 * 33], s[7 * 33]);
        *(GAS v4u*)(WT + (size_t)(n0 + n) * K + k0 + 8 * c) = o; }
    LDS_WAIT(); asm volatile("" ::: "memory");
}
template <int MAP>
__device__ __forceinline__ void transpose_job_item(const float* W0, const float* W1, const float* gain, bf16_t* WT, int K, int N, int ldw, int item, LAS float* scr, int lane) {
    const int nblk = N / 32, kb = item / nblk, nb = item % nblk, n0 = 32 * nb, k0 = 64 * kb;
    const float* W = W0; int c0 = n0;
    if (MAP == 1) { const int pn = n0 / 256, half = (n0 % 256) / 128, jj = n0 % 128; W = half ? W1 : W0; c0 = pn * 128 + jj; }
    if (MAP == 2) { if (n0 >= 512) { const int m = n0 - 512, pc = m / 256, half = (m % 256) / 128, jj = m % 128; c0 = 512 + half * 512 + pc * 128 + jj; } }
    if (MAP == 3) { if (n0 >= 1024) { W = W1; c0 = n0 - 1024; } }
    transpose_item(W, ldw, c0, gain, WT, K, n0, k0, scr, lane);
}
__device__ __forceinline__ void row_bf16_ss(const float* xr, bf16_t* orow, float* ssrow, float* rstd1, int lane) {
    float s = 0.f;
#pragma unroll
    for (int j = 0; j < 4; ++j) { const f32x4 v = *(const f32x4*)(xr + j * 256 + lane * 4); s += (v.x * v.x + v.y * v.y) + (v.z * v.z + v.w * v.w);
        uint2 o; o.x = pk2(v.x, v.y); o.y = pk2(v.z, v.w); *(uint2*)(orow + j * 256 + lane * 4) = o; }
    s = wave_sum(s);
    if (lane < 16) ssrow[lane] = lane == 0 ? s : 0.f;
    if (rstd1 && lane == 0) *rstd1 = rsqrtf(s * (1.f / D) + EPS);
}

__device__ __forceinline__ void s5_task(int task, const bf16_t* ug, const float* h0re, const float* h0im, const float* a_re, const float* a_im, const float* log_dt,
                                        const float* b_re, const float* b_im, const float* c_re, const float* c_im, const float* dskip, bf16_t* gb, float* out, int n) {
    const int g = task % NG, sq = task / NG;
    const bool prompt = sq < NBATCH; const int b = prompt ? sq : sq - NBATCH, T = prompt ? SEQ : DECS, row0 = prompt ? b * SEQ : MP + b * DECS;
    const float dt = expf(log_dt[g]), lr = a_re[g * NST + n], li = a_im[g * NST + n];
    const float mag = expf(lr * dt), abr = mag * cosf(li * dt), abi = mag * sinf(li * dt);
    const float den = lr * lr + li * li, nr = abr - 1.f, ni = abi, cr = (nr * lr + ni * li) / den, ci = (ni * lr - nr * li) / den;
    float Br[16], Bi[16], Cr[16], Ci[16];
#pragma unroll
    for (int c = 0; c < 16; ++c) { const float br = b_re[((size_t)g * NST + n) * 16 + c], bi = b_im[((size_t)g * NST + n) * 16 + c];
        Br[c] = cr * br - ci * bi; Bi[c] = cr * bi + ci * br; Cr[c] = c_re[((size_t)g * 16 + c) * NST + n]; Ci[c] = c_im[((size_t)g * 16 + c) * NST + n]; }
    float hr = 0.f, hi = 0.f;
    if (!prompt) { hr = h0re[((size_t)b * NG + g) * NST + n]; hi = h0im[((size_t)b * NG + g) * NST + n]; }
    const float dsk = dskip[g * 16 + (n & 15)];
    for (int t = 0; t < T; ++t) {
        const bf16_t* up = ug + ((size_t)g * M + row0 + t) * 16;
        const v4u w0 = *(const v4u*)up, w1 = *(const v4u*)(up + 8);
        float u[16];
        u[0] = __builtin_bit_cast(float, w0.x << 16); u[1] = __builtin_bit_cast(float, w0.x & 0xffff0000u); u[2] = __builtin_bit_cast(float, w0.y << 16); u[3] = __builtin_bit_cast(float, w0.y & 0xffff0000u);
        u[4] = __builtin_bit_cast(float, w0.z << 16); u[5] = __builtin_bit_cast(float, w0.z & 0xffff0000u); u[6] = __builtin_bit_cast(float, w0.w << 16); u[7] = __builtin_bit_cast(float, w0.w & 0xffff0000u);
        u[8] = __builtin_bit_cast(float, w1.x << 16); u[9] = __builtin_bit_cast(float, w1.x & 0xffff0000u); u[10] = __builtin_bit_cast(float, w1.y << 16); u[11] = __builtin_bit_cast(float, w1.y & 0xffff0000u);
        u[12] = __builtin_bit_cast(float, w1.z << 16); u[13] = __builtin_bit_cast(float, w1.z & 0xffff0000u); u[14] = __builtin_bit_cast(float, w1.w << 16); u[15] = __builtin_bit_cast(float, w1.w & 0xffff0000u);
        float xr = 0.f, xi = 0.f;
#pragma unroll
        for (int c = 0; c < 16; ++c) { xr += Br[c] * u[c]; xi += Bi[c] * u[c]; }
        const float nhr = abr * hr - abi * hi + xr, nhi = abr * hi + abi * hr + xi; hr = nhr; hi = nhi;
        float ymine = 0.f;
#pragma unroll
        for (int c = 0; c < 16; ++c) { const float y = wave_sum(Cr[c] * hr - Ci[c] * hi); if ((n & 15) == c) ymine = y + dsk * u[c]; }
        if (n < 16) gb[(size_t)(row0 + t) * SSM + g * 16 + n] = (bf16_t)f2bf(gelu_tanh(ymine));
    }
    if (prompt) { out[O_SRP + ((size_t)b * NG + g) * NST + n] = hr; out[O_SIP + ((size_t)b * NG + g) * NST + n] = hi; }
    else { out[O_SRS + ((size_t)b * NG + g) * NST + n] = hr; out[O_SIS + ((size_t)b * NG + g) * NST + n] = hi; }
}

__device__ __forceinline__ void conv_row(int row, const bf16_t* vb, const float* cache, const float* w, const float* bias, const float* lg, const float* lb, bf16_t* mixb, float* out, LAS float* red, int c) {
    float y = bias[c];
    if (row < MP) { const int t = row % SEQ;
        for (int k = 0; k < CWID; ++k) { const int tt = t - 30 + k; if (tt >= 0) y += w[k * CONVD + c] * bf2f(vb[(size_t)(row - 30 + k) * CONVD + c]); }
    } else { const int rs = row - MP, b = rs / DECS, t = rs % DECS;
        for (int k = 0; k < CWID; ++k) { const int idx = t + k; const float xv = idx < 30 ? cache[((size_t)b * 30 + idx) * CONVD + c] : bf2f(vb[(size_t)(MP + b * DECS + idx - 30) * CONVD + c]); y += w[k * CONVD + c] * xv; }
        if (t == 0) for (int j = 0; j < 22; ++j) out[O_CVS + ((size_t)b * 30 + j) * CONVD + c] = cache[((size_t)b * 30 + j + 8) * CONVD + c];
    }
    float s = wave_sum(y); if ((c & 63) == 0) red[c >> 6] = s; __syncthreads();
    float mu = 0.f;
#pragma unroll
    for (int i = 0; i < 8; ++i) mu += red[i];
    mu *= (1.f / CONVD);
    const float d = y - mu; float q = wave_sum(d * d); if ((c & 63) == 0) red[8 + (c >> 6)] = q; __syncthreads();
    float var = 0.f;
#pragma unroll
    for (int i = 0; i < 8; ++i) var += red[8 + i];
    var *= (1.f / CONVD);
    const float z = d * rsqrtf(var + EPS) * lg[c] + lb[c];
    mixb[(size_t)row * D + SSM + c] = (bf16_t)f2bf(siluf_(z));
}

__device__ __forceinline__ void attn_task(int task, const bf16_t* qb, const bf16_t* kb, const bf16_t* vb2, const float* ck, const float* cv, bf16_t* ob, LAS float* scr, int t256) {
    LAS float* q = scr; LAS float* p = scr + 2048; LAS float* red = scr + 4096;
    const int rg = task >> 2, h = task & 3, row0 = rg * 8; const bool prompt = row0 < MP; const int b = prompt ? row0 / SEQ : (row0 - MP) / DECS;
#pragma unroll
    for (int r = 0; r < 8; ++r) q[r * 256 + t256] = bf2f(qb[(size_t)(row0 + r) * D + h * HD + t256]);
    __syncthreads();
    float s[8];
#pragma unroll
    for (int r = 0; r < 8; ++r) s[r] = 0.f;
    if (prompt) { const bf16_t* kr = kb + ((size_t)b * NMEM + t256) * D + h * HD;
        for (int d = 0; d < HD; d += 8) { const v4u w = *(const v4u*)(kr + d); float kv[8];
            kv[0] = __builtin_bit_cast(float, w.x << 16); kv[1] = __builtin_bit_cast(float, w.x & 0xffff0000u); kv[2] = __builtin_bit_cast(float, w.y << 16); kv[3] = __builtin_bit_cast(float, w.y & 0xffff0000u);
            kv[4] = __builtin_bit_cast(float, w.z << 16); kv[5] = __builtin_bit_cast(float, w.z & 0xffff0000u); kv[6] = __builtin_bit_cast(float, w.w << 16); kv[7] = __builtin_bit_cast(float, w.w & 0xffff0000u);
#pragma unroll
            for (int r = 0; r < 8; ++r)
#pragma unroll
                for (int j = 0; j < 8; ++j) s[r] += q[r * 256 + d + j] * kv[j]; }
    } else { const float* kr = ck + ((size_t)b * NMEM + t256) * D + h * HD;
        for (int d = 0; d < HD; d += 4) { const f32x4 kv = *(const f32x4*)(kr + d);
#pragma unroll
            for (int r = 0; r < 8; ++r) s[r] += (q[r * 256 + d] * kv.x + q[r * 256 + d + 1] * kv.y) + (q[r * 256 + d + 2] * kv.z + q[r * 256 + d + 3] * kv.w); }
    }
    const int w4 = t256 >> 6;
#pragma unroll
    for (int r = 0; r < 8; ++r) { float mx = s[r];
#pragma unroll
        for (int o = 1; o < 64; o <<= 1) mx = fmaxf(mx, __shfl_xor(mx, o));
        if ((t256 & 63) == 0) red[r * 4 + w4] = mx; }
    __syncthreads();
    float e[8];
#pragma unroll
    for (int r = 0; r < 8; ++r) { const float mx = fmaxf(fmaxf(red[r * 4], red[r * 4 + 1]), fmaxf(red[r * 4 + 2], red[r * 4 + 3])); e[r] = exp2f(s[r] - mx); }
    __syncthreads();
#pragma unroll
    for (int r = 0; r < 8; ++r) { const float sm = wave_sum(e[r]); if ((t256 & 63) == 0) red[r * 4 + w4] = sm; }
    __syncthreads();
#pragma unroll
    for (int r = 0; r < 8; ++r) { const float sm = (red[r * 4] + red[r * 4 + 1]) + (red[r * 4 + 2] + red[r * 4 + 3]); p[r * 256 + t256] = e[r] / sm; }
    __syncthreads();
    float o[8];
#pragma unroll
    for (int r = 0; r < 8; ++r) o[r] = 0.f;
    if (prompt) { const bf16_t* vr = vb2 + (size_t)b * NMEM * D + h * HD + t256;
        for (int m = 0; m < NMEM; ++m) { const float vv = bf2f(vr[(size_t)m * D]);
#pragma unroll
            for (int r = 0; r < 8; ++r) o[r] += p[r * 256 + m] * vv; }
    } else { const float* vr = cv + (size_t)b * NMEM * D + h * HD + t256;
        for (int m = 0; m < NMEM; ++m) { const float vv = vr[(size_t)m * D];
#pragma unroll
            for (int r = 0; r < 8; ++r) o[r] += p[r * 256 + m] * vv; }
    }
#pragma unroll
    for (int r = 0; r < 8; ++r) ob[(size_t)(row0 + r) * D + h * HD + t256] = (bf16_t)f2bf(o[r]);
    __syncthreads();
}
}

namespace s5f {
typedef short bf16x8 __attribute__((ext_vector_type(8)));
constexpr int KT_OFF = 0, KT_BYTES = 65 * 256 * 2, U_OFF = 33792, U_CSTR = 2064, S_OFF = U_OFF + 32 * U_CSTR, H_OFF = S_OFF + 32 * 128 * 4, H_RSTR = 272, END_OFF = H_OFF + 32 * H_RSTR;
static_assert(KT_BYTES <= U_OFF && END_OFF <= 131072, "S5 LDS map");
constexpr size_t TAB_KT = 0, TAB_P = 2 * MiB, TAB_Q = 10 * MiB, TAB_AL = 18 * MiB;
struct cf { float re, im; };
typedef float f32x2v __attribute__((ext_vector_type(2)));
typedef unsigned u32x2v __attribute__((ext_vector_type(2)));
__device__ __forceinline__ f32x2v tov(cf a) { return (f32x2v){a.re, a.im}; }
__device__ __forceinline__ cf toc(f32x2v a) { return cf{a.x, a.y}; }
__device__ __forceinline__ cf cmul(cf a, cf b) { return cf{a.re * b.re - a.im * b.im, a.re * b.im + a.im * b.re}; }
__device__ __forceinline__ cf cpow_a(float lr, float li, float dt, float p) { const float mag = expf(lr * dt * p); float s, c; sincosf(li * dt * p, &s, &c); return cf{mag * c, mag * s}; }
__device__ __forceinline__ cf coef_of(float lr, float li, float dt) { const cf a = cpow_a(lr, li, dt, 1.f); const float den = lr * lr + li * li, nr = a.re - 1.f, ni = a.im; return cf{(nr * lr + ni * li) / den, (ni * lr - nr * li) / den}; }

__device__ __forceinline__ void kt_task(int task, const float* a_re, const float* a_im, const float* log_dt, const float* b_re, const float* b_im, const float* c_re, const float* c_im,
                                        bf16_t* Ktab, LAS unsigned char* scr, int tid) {
    const int g = task >> 3, tb = task & 7;
    LAS f32x2v* Wb = (LAS f32x2v*)scr; LAS f32x2v* Bb = (LAS f32x2v*)(scr + 4096); LAS f32x2v* Cc = (LAS f32x2v*)(scr + 4096 + 8192);
    const float dt = expf(log_dt[g]);
    { const int tl = tid >> 6, n = tid & 63; Wb[tl * 64 + n] = tov(cpow_a(a_re[g * NST + n], a_im[g * NST + n], dt, (float)(8 * tb + tl))); }
#pragma unroll
    for (int e = tid; e < 1024; e += 512) { const int n = e >> 4, c = e & 15; const cf co = coef_of(a_re[g * NST + n], a_im[g * NST + n], dt);
        Bb[e] = tov(cmul(co, cf{b_re[((size_t)g * NST + n) * 16 + c], b_im[((size_t)g * NST + n) * 16 + c]})); }
#pragma unroll
    for (int e = tid; e < 1024; e += 512) Cc[e] = (f32x2v){c_re[(size_t)g * 1024 + e], c_im[(size_t)g * 1024 + e]};
    __syncthreads();
    { const int tl = tid >> 6, cc = tid & 63, c = cc >> 2, c0 = 4 * (cc & 3); float acc[4] = {0.f, 0.f, 0.f, 0.f};
        for (int n = 0; n < 64; ++n) { const cf T = cmul(toc(Cc[c * 64 + n]), toc(Wb[tl * 64 + n]));
#pragma unroll
            for (int k = 0; k < 4; ++k) { const cf E = toc(Bb[n * 16 + c0 + k]); acc[k] += T.re * E.re - T.im * E.im; } }
        uint2 o; o.x = pk2(acc[0], acc[1]); o.y = pk2(acc[2], acc[3]);
        *(uint2*)(Ktab + (((size_t)g * 65 + 8 * tb + tl + 1) * 16 + c) * 16 + c0) = o; }
    if (tb == 0 && tid < 32) *(v4u*)(Ktab + (size_t)g * 65 * 256 + tid * 8) = (v4u){0u, 0u, 0u, 0u};
    __syncthreads();
}
__device__ __forceinline__ void pq_entry(int e, const float* a_re, const float* a_im, const float* log_dt, const float* b_re, const float* b_im, const float* c_re, const float* c_im,
                                         bf16_t* Ptab, bf16_t* Qtab, float* ALtab) {
    {
        const int n = e & 63, j = (e >> 6) & 63, g = e >> 12; const float dt = expf(log_dt[g]);
        const cf W = cpow_a(a_re[g * NST + n], a_im[g * NST + n], dt, (float)(j + 1));
#pragma unroll
        for (int c = 0; c < 16; ++c) { const cf w = cmul(cf{c_re[((size_t)g * 16 + c) * NST + n], c_im[((size_t)g * 16 + c) * NST + n]}, W);
            bf16_t* p = Ptab + (((size_t)g * 64 + j) * 16 + c) * 128; p[n] = (bf16_t)f2bf(w.re); p[64 + n] = (bf16_t)f2bf(-w.im); }
        if (j == 0) { const cf al = cpow_a(a_re[g * NST + n], a_im[g * NST + n], dt, 64.f); ALtab[(g * NST + n) * 2] = al.re; ALtab[(g * NST + n) * 2 + 1] = al.im; }
    }
    {
        const int i = e & 63, n = (e >> 6) & 63, g = e >> 12; const float dt = expf(log_dt[g]);
        const float lr = a_re[g * NST + n], li = a_im[g * NST + n];
        const cf V = cmul(cpow_a(lr, li, dt, (float)(63 - i)), coef_of(lr, li, dt));
        unsigned wr[8], wi[8];
#pragma unroll
        for (int c = 0; c < 16; c += 2) { const cf v0 = cmul(V, cf{b_re[((size_t)g * NST + n) * 16 + c], b_im[((size_t)g * NST + n) * 16 + c]}), v1 = cmul(V, cf{b_re[((size_t)g * NST + n) * 16 + c + 1], b_im[((size_t)g * NST + n) * 16 + c + 1]});
            wr[c >> 1] = pk2(v0.re, v1.re); wi[c >> 1] = pk2(v0.im, v1.im); }
        v4u* qr = (v4u*)(Qtab + ((size_t)g * 128 + n) * 1024 + i * 16); v4u* qi = (v4u*)(Qtab + ((size_t)g * 128 + 64 + n) * 1024 + i * 16);
        qr[0] = (v4u){wr[0], wr[1], wr[2], wr[3]}; qr[1] = (v4u){wr[4], wr[5], wr[6], wr[7]}; qi[0] = (v4u){wi[0], wi[1], wi[2], wi[3]}; qi[1] = (v4u){wi[4], wi[5], wi[6], wi[7]};
    }
}
__device__ __forceinline__ float gelu_fast(float x) { const float u = 1.5957691216057308f * (x + 0.044715f * x * x * x); return x * __builtin_amdgcn_rcpf(1.f + __builtin_amdgcn_exp2f(-1.4426950408889634f * u)); }

__device__ __forceinline__ void prompt_unit(int b, int g, const bf16_t* ug, const bf16_t* Ktab, const bf16_t* Ptab, const bf16_t* Qtab, const float* ALtab, const float* dskip, bf16_t* gb, float* out,
                                            LAS unsigned char* L, int tid, int wave, int lane) {
    {
        const v4u* src = (const v4u*)(Ktab + (size_t)g * 65 * 256);
        for (int q = tid; q < KT_BYTES / 16; q += 512) *(LAS v4u*)(L + KT_OFF + q * 16) = src[q];
        const v4u* us = (const v4u*)(ug + ((size_t)g * M + (size_t)b * SEQ) * 16);
#pragma unroll
        for (int p = 0; p < 8; ++p) { const int q = p * 512 + tid; *(LAS v4u*)(L + U_OFF + (q >> 7) * U_CSTR + (q & 127) * 16) = us[q]; }
    }
    __syncthreads();
    const int fr = lane & 15, kq = lane >> 4;
    const LAS unsigned char* ub0 = L + U_OFF + fr * U_CSTR + kq * 16; const LAS unsigned char* ub1 = ub0 + 16 * U_CSTR;
    {
        f32x4 a0 = {0.f, 0.f, 0.f, 0.f}, a1 = {0.f, 0.f, 0.f, 0.f};
        const bf16_t* qrow = Qtab + ((size_t)g * 128 + wave * 16 + fr) * 1024 + kq * 8;
#pragma unroll 4
        for (int s = 0; s < 32; ++s) { const bf16x8 a = *(const bf16x8*)(qrow + s * 32);
            a0 = __builtin_amdgcn_mfma_f32_16x16x32_bf16(a, *(const LAS bf16x8*)(ub0 + s * 64), a0, 0, 0, 0);
            a1 = __builtin_amdgcn_mfma_f32_16x16x32_bf16(a, *(const LAS bf16x8*)(ub1 + s * 64), a1, 0, 0, 0); }
        *(LAS f32x4*)(L + S_OFF + (fr * 128 + wave * 16 + kq * 4) * 4) = a0;
        *(LAS f32x4*)(L + S_OFF + ((16 + fr) * 128 + wave * 16 + kq * 4) * 4) = a1;
    }
    __syncthreads();
    if (tid < 64) {
        const int n = tid; const float alr = ALtab[(g * NST + n) * 2], ali = ALtab[(g * NST + n) * 2 + 1]; float hr = 0.f, hi = 0.f;
        const LAS float* Sb = (const LAS float*)(L + S_OFF);
        for (int c = 0; c < 32; ++c) { LAS bf16_t* hb = (LAS bf16_t*)(L + H_OFF + c * H_RSTR); hb[n] = (bf16_t)f2bf(hr); hb[64 + n] = (bf16_t)f2bf(hi);
            const float sr = Sb[c * 128 + n], si = Sb[c * 128 + 64 + n]; const float nhr = alr * hr - ali * hi + sr, nhi = alr * hi + ali * hr + si; hr = nhr; hi = nhi; }
        out[O_SRP + ((size_t)b * NG + g) * NST + n] = hr; out[O_SIP + ((size_t)b * NG + g) * NST + n] = hi;
    }
    __syncthreads();
    f32x4 acc[8][2];
#pragma unroll
    for (int q = 0; q < 8; ++q) { acc[q][0] = (f32x4){0.f, 0.f, 0.f, 0.f}; acc[q][1] = (f32x4){0.f, 0.f, 0.f, 0.f}; }
    {
        const LAS unsigned char* kt = L + KT_OFF + (fr * 16 + (kq & 1) * 8) * 2 + (wave + 1 - (kq >> 1)) * 512;
        const int smax = (wave + 56) >> 1;
        for (int s = 0; s <= smax; ++s) {
            const bf16x8 b0 = *(const LAS bf16x8*)(ub0 + s * 64), b1 = *(const LAS bf16x8*)(ub1 + s * 64);
#pragma unroll
            for (int q = 0; q < 8; ++q) if (wave + 8 * q >= 2 * s) { const bf16x8 a = *(const LAS bf16x8*)(kt + (8 * q - 2 * s) * 512);
                acc[q][0] = __builtin_amdgcn_mfma_f32_16x16x32_bf16(a, b0, acc[q][0], 0, 0, 0); acc[q][1] = __builtin_amdgcn_mfma_f32_16x16x32_bf16(a, b1, acc[q][1], 0, 0, 0); }
        }
    }
    {
        const LAS unsigned char* hb0 = L + H_OFF + fr * H_RSTR + kq * 16; const LAS unsigned char* hb1 = hb0 + 16 * H_RSTR;
        const bf16_t* prow = Ptab + (((size_t)g * 64 + wave) * 16 + fr) * 128 + kq * 8;
#pragma unroll
        for (int s2 = 0; s2 < 4; ++s2) { const bf16x8 b0 = *(const LAS bf16x8*)(hb0 + s2 * 64), b1 = *(const LAS bf16x8*)(hb1 + s2 * 64);
#pragma unroll
            for (int q = 0; q < 8; ++q) { const bf16x8 a = *(const bf16x8*)(prow + (size_t)q * 8 * 16 * 128 + s2 * 32);
                acc[q][0] = __builtin_amdgcn_mfma_f32_16x16x32_bf16(a, b0, acc[q][0], 0, 0, 0); acc[q][1] = __builtin_amdgcn_mfma_f32_16x16x32_bf16(a, b1, acc[q][1], 0, 0, 0); } }
    }
    {
        const f32x4 dsk = *(const f32x4*)(dskip + g * 16 + kq * 4);
#pragma unroll
        for (int q = 0; q < 8; ++q)
#pragma unroll
            for (int nb = 0; nb < 2; ++nb) { const int chunk = nb * 16 + fr, j = wave + 8 * q;
                const u32x2v uw = *(const LAS u32x2v*)(L + U_OFF + chunk * U_CSTR + (j * 16 + kq * 4) * 2);
                const f32x4 u4 = {__builtin_bit_cast(float, uw.x << 16), __builtin_bit_cast(float, uw.x & 0xffff0000u), __builtin_bit_cast(float, uw.y << 16), __builtin_bit_cast(float, uw.y & 0xffff0000u)};
                const f32x4 y = acc[q][nb] + dsk * u4;
                uint2 o; o.x = pk2(gelu_fast(y[0]), gelu_fast(y[1])); o.y = pk2(gelu_fast(y[2]), gelu_fast(y[3]));
                *(uint2*)(gb + ((size_t)b * SEQ + chunk * 64 + j) * SSM + g * 16 + kq * 4) = o; }
    }
    __syncthreads();
}
}

namespace att {
typedef short bf16x8 __attribute__((ext_vector_type(8)));
typedef float f32x16 __attribute__((ext_vector_type(16)));
typedef float f32x2v __attribute__((ext_vector_type(2)));
typedef unsigned u32x2v __attribute__((ext_vector_type(2)));
__device__ __forceinline__ int crow(int r, int hi) { return (r & 3) + 8 * (r >> 2) + 4 * hi; }
__device__ __forceinline__ unsigned cvtpk(float lo, float hi) { return pg8::cvt_pk_bf16(lo, hi); }

__device__ __forceinline__ void prompt_unit(int b, int h, int qblk, const bf16_t* qb, const bf16_t* kb, const bf16_t* vT, bf16_t* ob, LAS unsigned char* L, LAS float* wsf, int tid, int wave, int lane) {
    const int r32 = lane & 31, hh = lane >> 5, x = r32 & 15;
    const bf16_t* Kg = kb + (size_t)b * NMEM * D + h * HD;
    for (int half = 0; half < 2; ++half)
#pragma unroll 4
        for (int p = 0; p < 8; ++p) { const int q = p * 512 + tid, mem = q >> 4, c16 = q & 15;
            *(LAS v4u*)(L + half * 65536 + mem * 256 + ((c16 ^ (mem & 15)) << 4)) = *(const v4u*)(Kg + (size_t)mem * D + half * 128 + c16 * 8); }
    const size_t qrow = (size_t)b * SEQ + qblk * 256 + wave * 32 + r32;
    const bf16_t* Qg = qb + qrow * D + h * HD + hh * 8;
    unsigned koff[8];
#pragma unroll
    for (int ks = 0; ks < 8; ++ks) koff[ks] = (unsigned)(((2 * ks + hh) ^ x) << 4);
    __syncthreads();
    f32x16 S[8];
#pragma unroll
    for (int mb = 0; mb < 8; ++mb)
#pragma unroll
        for (int r = 0; r < 16; ++r) S[mb][r] = 0.f;
#pragma unroll
    for (int half = 0; half < 2; ++half) {
        bf16x8 qf[8];
#pragma unroll
        for (int ks = 0; ks < 8; ++ks) qf[ks] = *(const bf16x8*)(Qg + half * 128 + ks * 16);
        const LAS unsigned char* kbase = L + half * 65536 + r32 * 256;
#pragma unroll
        for (int mb = 0; mb < 8; ++mb) {
#pragma unroll
            for (int ks = 0; ks < 8; ++ks) S[mb] = __builtin_amdgcn_mfma_f32_32x32x16_bf16(*(const LAS bf16x8*)(kbase + mb * 8192 + koff[ks]), qf[ks], S[mb], 0, 0, 0);
            asm volatile("" : "+v"(S[mb])); __builtin_amdgcn_sched_barrier(0); }
    }
    __syncthreads();
    const bf16_t* Vg = vT + (size_t)h * HD * MMEM + (size_t)b * NMEM;
    for (int dh = 0; dh < 2; ++dh)
#pragma unroll 4
        for (int p = 0; p < 8; ++p) { const int q = p * 512 + tid, dd = q >> 5, c32 = q & 31;
            *(LAS v4u*)(L + dh * 65536 + dd * 512 + ((c32 ^ (dd & 15)) << 4)) = *(const v4u*)(Vg + (size_t)(dh * 128 + dd) * MMEM + c32 * 8); }
    float mx = S[0][0];
#pragma unroll
    for (int mb = 0; mb < 8; ++mb)
#pragma unroll
        for (int r = 0; r < 16; ++r) mx = fmaxf(mx, S[mb][r]);
    mx = fmaxf(mx, __shfl_xor(mx, 32));
    float lsum = 0.f;
    v4u pa[8][2];
#pragma unroll
    for (int mb = 0; mb < 8; ++mb) {
#pragma unroll
        for (int r = 0; r < 16; ++r) { const float e = __builtin_amdgcn_exp2f(S[mb][r] - mx); S[mb][r] = e; lsum += e; }
#pragma unroll
        for (int s = 0; s < 2; ++s) pa[mb][s] = (v4u){cvtpk(S[mb][8 * s], S[mb][8 * s + 1]), cvtpk(S[mb][8 * s + 2], S[mb][8 * s + 3]), cvtpk(S[mb][8 * s + 4], S[mb][8 * s + 5]), cvtpk(S[mb][8 * s + 6], S[mb][8 * s + 7])};
    }
    lsum += __shfl_xor(lsum, 32);
    if (hh == 0) wsf[r32] = lsum;
    __syncthreads();
    unsigned voff[2][4];
#pragma unroll
    for (int s = 0; s < 2; ++s)
#pragma unroll
        for (int ml = 0; ml < 4; ++ml) voff[s][ml] = (unsigned)(((4 * ml + 2 * s) ^ (hh ^ x)) << 4);
    bf16_t* Og = ob + ((size_t)b * SEQ + qblk * 256 + wave * 32 + 4 * hh) * D + h * HD + r32;
#pragma unroll
    for (int dh = 0; dh < 2; ++dh) {
        f32x16 O[4];
#pragma unroll
        for (int db = 0; db < 4; ++db)
#pragma unroll
            for (int r = 0; r < 16; ++r) O[db][r] = 0.f;
        const LAS unsigned char* vbase = L + dh * 65536 + r32 * 512;
#pragma unroll
        for (int mb = 0; mb < 8; ++mb)
#pragma unroll
            for (int s = 0; s < 2; ++s) { const bf16x8 a = __builtin_bit_cast(bf16x8, pa[mb][s]);
#pragma unroll
                for (int db = 0; db < 4; ++db)
                    O[db] = __builtin_amdgcn_mfma_f32_32x32x16_bf16(a, *(const LAS bf16x8*)(vbase + db * 16384 + (mb >> 2) * 256 + voff[s][mb & 3]), O[db], 0, 0, 0);
                asm volatile("" : "+v"(O[0]), "+v"(O[1]), "+v"(O[2]), "+v"(O[3])); __builtin_amdgcn_sched_barrier(0); }
#pragma unroll
        for (int r = 0; r < 16; ++r) { const float rl = __builtin_amdgcn_rcpf(wsf[crow(r, hh)]);
#pragma unroll
            for (int db = 0; db < 4; ++db) Og[(size_t)((r & 3) + 8 * (r >> 2)) * D + dh * 128 + db * 32] = (bf16_t)f2bf(O[db][r] * rl);
            __builtin_amdgcn_sched_barrier(0); }
    }
    __syncthreads();
}

__device__ __forceinline__ void sample_unit(int b, int hp, const bf16_t* qb, const float* ck, const float* cv, bf16_t* ob, LAS unsigned char* L, int tid, int wave, int lane) {
    const int hsel = wave >> 2, mq = wave & 3, head = 2 * hp + hsel;
    LAS float* sbuf = (LAS float*)L; LAS float* pT = (LAS float*)(L + 16384); LAS float* obuf = (LAS float*)(L + 32768);
    float q[8][4];
#pragma unroll
    for (int t = 0; t < 8; ++t) { const u32x2v w = *(const u32x2v*)(qb + ((size_t)MP + b * DECS + t) * D + head * HD + lane * 4);
        q[t][0] = __builtin_bit_cast(float, w.x << 16); q[t][1] = __builtin_bit_cast(float, w.x & 0xffff0000u); q[t][2] = __builtin_bit_cast(float, w.y << 16); q[t][3] = __builtin_bit_cast(float, w.y & 0xffff0000u); }
    const float* Kr = ck + (((size_t)b * NMEM + mq * 64) * NH + head) * HD + lane * 4;
    for (int m0 = 0; m0 < 64; m0 += 4) {
        f32x4 k4[4];
#pragma unroll
        for (int i = 0; i < 4; ++i) k4[i] = *(const f32x4*)(Kr + (size_t)(m0 + i) * NH * HD);
#pragma unroll
        for (int i = 0; i < 4; ++i) {
            float v[8];
#pragma unroll
            for (int t = 0; t < 8; ++t) v[t] = (q[t][0] * k4[i].x + q[t][1] * k4[i].y) + (q[t][2] * k4[i].z + q[t][3] * k4[i].w);
            float r4[4], r2[2], r1;
#pragma unroll
            for (int j = 0; j < 4; ++j) { const bool up = lane & 32; const float send = up ? v[j] : v[j + 4], keep = up ? v[j + 4] : v[j]; r4[j] = keep + __shfl_xor(send, 32); }
#pragma unroll
            for (int j = 0; j < 2; ++j) { const bool up = lane & 16; const float send = up ? r4[j] : r4[j + 2], keep = up ? r4[j + 2] : r4[j]; r2[j] = keep + __shfl_xor(send, 16); }
            { const bool up = lane & 8; const float send = up ? r2[0] : r2[1], keep = up ? r2[1] : r2[0]; r1 = keep + __shfl_xor(send, 8); }
            r1 += __shfl_xor(r1, 4); r1 += __shfl_xor(r1, 2); r1 += __shfl_xor(r1, 1);
            const int t = ((lane >> 5) & 1) * 4 + ((lane >> 4) & 1) * 2 + ((lane >> 3) & 1);
            if ((lane & 7) == 0) sbuf[(hsel * 8 + t) * 256 + mq * 64 + m0 + i] = r1;
        }
    }
    __syncthreads();
#pragma unroll
    for (int rr = 0; rr < 2; ++rr) { const int row = wave * 2 + rr;
        const f32x4 s4 = *(const LAS f32x4*)(sbuf + row * 256 + lane * 4);
        float mx = fmaxf(fmaxf(s4.x, s4.y), fmaxf(s4.z, s4.w));
#pragma unroll
        for (int o = 1; o < 64; o <<= 1) mx = fmaxf(mx, __shfl_xor(mx, o));
        const float e0 = exp2f(s4.x - mx), e1 = exp2f(s4.y - mx), e2 = exp2f(s4.z - mx), e3 = exp2f(s4.w - mx);
        const float inv = 1.f / wave_sum((e0 + e1) + (e2 + e3));
        LAS float* pp = pT + ((row >> 3) * 256 + lane * 4) * 8 + (row & 7);
        pp[0] = e0 * inv; pp[8] = e1 * inv; pp[16] = e2 * inv; pp[24] = e3 * inv; }
    __syncthreads();
    float o[8][4];
#pragma unroll
    for (int t = 0; t < 8; ++t) { o[t][0] = 0.f; o[t][1] = 0.f; o[t][2] = 0.f; o[t][3] = 0.f; }
    const float* Vr = cv + (((size_t)b * NMEM + mq * 64) * NH + head) * HD + lane * 4;
    for (int m0 = 0; m0 < 64; m0 += 4) {
        f32x4 v4[4];
#pragma unroll
        for (int i = 0; i < 4; ++i) v4[i] = *(const f32x4*)(Vr + (size_t)(m0 + i) * NH * HD);
#pragma unroll
        for (int i = 0; i < 4; ++i) { const LAS f32x4* pp = (const LAS f32x4*)(pT + (hsel * 256 + mq * 64 + m0 + i) * 8); const f32x4 pa = pp[0], pb = pp[1];
            const float pv[8] = {pa.x, pa.y, pa.z, pa.w, pb.x, pb.y, pb.z, pb.w};
#pragma unroll
            for (int t = 0; t < 8; ++t) { o[t][0] += pv[t] * v4[i].x; o[t][1] += pv[t] * v4[i].y; o[t][2] += pv[t] * v4[i].z; o[t][3] += pv[t] * v4[i].w; } }
    }
#pragma unroll
    for (int t = 0; t < 8; ++t) *(LAS f32x4*)(obuf + ((hsel * 4 + mq) * 8 + t) * 256 + lane * 4) = (f32x4){o[t][0], o[t][1], o[t][2], o[t][3]};
    __syncthreads();
    { const int hs = tid >> 8, t = (tid >> 5) & 7, d8 = tid & 31;
        f32x4 a0 = {0.f, 0.f, 0.f, 0.f}, a1 = {0.f, 0.f, 0.f, 0.f};
#pragma unroll
        for (int m = 0; m < 4; ++m) { const LAS f32x4* pp = (const LAS f32x4*)(obuf + ((hs * 4 + m) * 8 + t) * 256 + d8 * 8); a0 = a0 + pp[0]; a1 = a1 + pp[1]; }
        *(v4u*)(ob + ((size_t)MP + b * DECS + t) * D + (2 * hp + hs) * HD + d8 * 8) = (v4u){pk2(a0.x, a0.y), pk2(a0.z, a0.w), pk2(a1.x, a1.y), pk2(a1.z, a1.w)};
    }
    __syncthreads();
}
}

namespace cvx {
template <int NT>
__device__ __forceinline__ void ln_swish_rows(const LAS float* ybuf, int row0, const float* lg, const float* lb, bf16_t* mixb, int wave, int lane) {
    const f32x4 g0 = *(const f32x4*)(lg + lane * 4), g1 = *(const f32x4*)(lg + 256 + lane * 4), b0 = *(const f32x4*)(lb + lane * 4), b1 = *(const f32x4*)(lb + 256 + lane * 4);
    for (int j = wave; j < NT; j += 8) {
        const f32x4 a = *(const LAS f32x4*)(ybuf + j * 512 + lane * 4), b = *(const LAS f32x4*)(ybuf + j * 512 + 256 + lane * 4);
        const float s = wave_sum(((a.x + a.y) + (a.z + a.w)) + ((b.x + b.y) + (b.z + b.w)));
        const float mu = s * (1.f / CONVD); const f32x4 da = a - mu, db = b - mu;
        const float q = wave_sum(((da.x * da.x + da.y * da.y) + (da.z * da.z + da.w * da.w)) + ((db.x * db.x + db.y * db.y) + (db.z * db.z + db.w * db.w)));
        const float rs = rsqrtf(q * (1.f / CONVD) + EPS);
        const f32x4 za = da * rs * g0 + b0, zb = db * rs * g1 + b1;
        typedef unsigned u32x2 __attribute__((ext_vector_type(2)));
        bf16_t* o = mixb + (size_t)(row0 + j) * D + SSM + lane * 4;
        *(u32x2*)o = (u32x2){pk2(za.x * fx::fsig(za.x), za.y * fx::fsig(za.y)), pk2(za.z * fx::fsig(za.z), za.w * fx::fsig(za.w))};
        *(u32x2*)(o + 256) = (u32x2){pk2(zb.x * fx::fsig(zb.x), zb.y * fx::fsig(zb.y)), pk2(zb.z * fx::fsig(zb.z), zb.w * fx::fsig(zb.w))};
    }
}
__device__ __forceinline__ void prompt_tile(int b, int t0, const bf16_t* vb, const float* w, const float* bias, const float* lg, const float* lb, bf16_t* mixb, LAS float* ybuf, int tid, int wave, int lane) {
    const int c = tid;
    float wk[31];
#pragma unroll
    for (int k = 0; k < 31; ++k) wk[k] = w[k * CONVD + c];
    const float bs = bias[c];
    const bf16_t* vp = vb + (size_t)b * SEQ * CONVD + c;
#pragma unroll 1
    for (int pass = 0; pass < 4; ++pass) {
        const int tb = t0 + pass * 16;
        float xin[46];
#pragma unroll
        for (int ii = 0; ii < 46; ++ii) { const int tt = tb - 30 + ii; const int tc = tt < 0 ? 0 : tt; const float v = bf2f(vp[(size_t)tc * CONVD]); xin[ii] = tt < 0 ? 0.f : v; }
#pragma unroll
        for (int j = 0; j < 16; ++j) { float y = bs;
#pragma unroll
            for (int k = 0; k < 31; ++k) y += wk[k] * xin[j + k];
            ybuf[(pass * 16 + j) * 512 + c] = y; }
    }
    __syncthreads();
    ln_swish_rows<64>(ybuf, b * SEQ + t0, lg, lb, mixb, wave, lane);
    __syncthreads();
}
__device__ __forceinline__ void sample_batch(int b, const bf16_t* vb, const float* cache, const float* w, const float* bias, const float* lg, const float* lb, bf16_t* mixb, float* out, LAS float* ybuf, int tid, int wave, int lane) {
    const int c = tid;
    float xp[38];
#pragma unroll
    for (int i = 0; i < 30; ++i) xp[i] = cache[((size_t)b * 30 + i) * CONVD + c];
#pragma unroll
    for (int i = 0; i < 8; ++i) xp[30 + i] = bf2f(vb[((size_t)MP + b * DECS + i) * CONVD + c]);
#pragma unroll
    for (int j = 0; j < 22; ++j) out[O_CVS + ((size_t)b * 30 + j) * CONVD + c] = xp[j + 8];
    float y[8];
    const float bs = bias[c];
#pragma unroll
    for (int j = 0; j < 8; ++j) y[j] = bs;
#pragma unroll
    for (int k = 0; k < 31; ++k) { const float wv = w[k * CONVD + c];
#pragma unroll
        for (int j = 0; j < 8; ++j) y[j] += wv * xp[j + k]; }
#pragma unroll
    for (int j = 0; j < 8; ++j) ybuf[j * 512 + c] = y[j];
    __syncthreads();
    ln_swish_rows<8>(ybuf, MP + b * DECS, lg, lb, mixb, wave, lane);
    __syncthreads();
}
}

constexpr int NWAVES = 8;
constexpr int RING_OFF = 0, RING_BYTES = 131072;
constexpr int LDSCTL_OFF = RING_BYTES, MISC_OFF = LDSCTL_OFF + 320, XTRA_OFF = RING_BYTES + 1024;
constexpr int LDS_BYTES = 147456;
constexpr size_t CTL_ZERO_BYTES = 1 * MiB;
constexpr int CW_TMO = 0, CW_CODE = 1, CW_BAR = 4096;
constexpr int MAX_LAUNCHES = 8;
static_assert((CW_BAR + MAX_LAUNCHES * XCD_BAR_WORDS) * 4 <= (int)CTL_ZERO_BYTES, "barrier words inside the memset region");

enum Phase { PH_PRO = 0, PH_GU1 = 1, PH_D1 = 2, PH_IN = 3, PH_MIX = 4, PH_GLU = 5, PH_OUT = 6, PH_Q = 7, PH_ATT = 8, PH_O = 9, PH_GU2 = 10, PH_D2 = 11, PH_FIN = 12, PH_N = 13 };

struct Args { const float* in[39]; float* out; unsigned char* ws; int ph_lo, ph_hi, li, pad; };

__global__ void __launch_bounds__(NWAVES * 64, 2) mk_fwd(Args args) {
    extern __shared__ __attribute__((aligned(16))) unsigned char lds[];
    LAS unsigned char* L = (LAS unsigned char*)lds;
    volatile LAS unsigned* MISC = (volatile LAS unsigned*)(L + MISC_OFF);
    const int tid = threadIdx.x;
    const int G = gridDim.x, bx = blockIdx.x;
    unsigned char* ws = args.ws; float* out = args.out;
    gu32* ctl = (gu32*)(ws + WS_CTL);
    for (int u = tid; u < (LDS_BYTES - LDSCTL_OFF) / 4; u += NWAVES * 64) ((LAS unsigned*)(L + LDSCTL_OFF))[u] = 0u;
    __syncthreads();
    XcdBarrier bar = xcd_barrier_post((unsigned*)(ctl + CW_BAR) + args.li * XCD_BAR_WORDS, MISC + 8);
    const int lo = args.ph_lo, hi = args.ph_hi;
#define IN(k) (lo <= (k) && (k) < hi)
#define BOTH(k) (IN(k) && IN((k) + 1))
#define GRID_BAR() xcd_barrier(bar)
    bf16_t *Wgu1 = (bf16_t*)(ws + WS_WGU1), *Wgu2 = (bf16_t*)(ws + WS_WGU2), *Wd1 = (bf16_t*)(ws + WS_WD1), *Wd2 = (bf16_t*)(ws + WS_WD2), *Win = (bf16_t*)(ws + WS_WIN), *Wglu = (bf16_t*)(ws + WS_WGLU),
           *Wout = (bf16_t*)(ws + WS_WOUT), *Wq = (bf16_t*)(ws + WS_WQ), *Wo = (bf16_t*)(ws + WS_WO), *Wkv = (bf16_t*)(ws + WS_WKV);
    bf16_t *xb = (bf16_t*)(ws + WS_XB), *memb = (bf16_t*)(ws + WS_MEMB), *kb = (bf16_t*)(ws + WS_KB), *vb2 = (bf16_t*)(ws + WS_VB2), *hb = (bf16_t*)(ws + WS_H), *ug = (bf16_t*)(ws + WS_UG),
           *vb = (bf16_t*)(ws + WS_VB), *gb = (bf16_t*)(ws + WS_GB), *mixb = (bf16_t*)(ws + WS_MIXB), *qb = (bf16_t*)(ws + WS_QB), *ob = (bf16_t*)(ws + WS_OB);
    bf16_t *Ktab = (bf16_t*)(ws + WS_TAB + s5f::TAB_KT), *Ptab = (bf16_t*)(ws + WS_TAB + s5f::TAB_P), *Qtab = (bf16_t*)(ws + WS_TAB + s5f::TAB_Q); float* ALtab = (float*)(ws + WS_TAB + s5f::TAB_AL);
    float *ss0 = (float*)(ws + WS_SS0), *ss1 = (float*)(ws + WS_SS1), *ss2 = (float*)(ws + WS_SS2), *ss3 = (float*)(ws + WS_SS3), *ss4 = (float*)(ws + WS_SS4), *ssm = (float*)(ws + WS_SSM), *xres = (float*)(ws + WS_XRES);
    float* rstdm = ssm + (size_t)MMEM * 16; bf16_t* vT = vb2;

    const int wave = __builtin_amdgcn_readfirstlane(tid >> 6), lane = tid & 63;
    const float* const* in = args.in;
    if (IN(PH_PRO)) {
        for (int task = bx; task < 256; task += G) s5f::kt_task(task, in[17], in[18], in[19], in[20], in[21], in[22], in[23], Ktab, L + RING_OFF, tid);
        for (int e = bx * 512 + tid; e < 131072; e += G * 512) s5f::pq_entry(e, in[17], in[18], in[19], in[20], in[21], in[22], in[23], Ptab, Qtab, ALtab);
        LAS float* scr = (LAS float*)(L + RING_OFF + wave * 16384);
        const int gw = bx * NWAVES + wave, NGW = G * NWAVES;
        constexpr int I_GU = (D / 64) * (2 * FF / 32), I_D = (FF / 64) * (D / 32), I_IN = (D / 64) * (1536 / 32), I_GLU = (SSM / 64) * (SSM / 32), I_SQ = (D / 64) * (D / 32), I_KV = (D / 64) * (2048 / 32);
        constexpr int NITEMS = 2 * I_GU + 2 * I_D + I_IN + I_GLU + 3 * I_SQ + I_KV;
        for (int it = gw; it < NITEMS; it += NGW) {
            int r = it;
            if (r < I_GU) { sb::transpose_job_item<1>(in[12], in[13], in[11], Wgu1, D, 2 * FF, FF, r, scr, lane); continue; } r -= I_GU;
            if (r < I_GU) { sb::transpose_job_item<1>(in[35], in[36], in[34], Wgu2, D, 2 * FF, FF, r, scr, lane); continue; } r -= I_GU;
            if (r < I_D) { sb::transpose_job_item<0>(in[14], nullptr, nullptr, Wd1, FF, D, D, r, scr, lane); continue; } r -= I_D;
            if (r < I_D) { sb::transpose_job_item<0>(in[37], nullptr, nullptr, Wd2, FF, D, D, r, scr, lane); continue; } r -= I_D;
            if (r < I_IN) { sb::transpose_job_item<2>(in[16], nullptr, in[15], Win, D, 1536, 1536, r, scr, lane); continue; } r -= I_IN;
            if (r < I_GLU) { sb::transpose_job_item<0>(in[25], nullptr, nullptr, Wglu, SSM, SSM, SSM, r, scr, lane); continue; } r -= I_GLU;
            if (r < I_SQ) { sb::transpose_job_item<0>(in[30], nullptr, nullptr, Wout, D, D, D, r, scr, lane); continue; } r -= I_SQ;
            if (r < I_SQ) { sb::transpose_job_item<0>(in[32], nullptr, in[31], Wq, D, D, D, r, scr, lane); continue; } r -= I_SQ;
            if (r < I_SQ) { sb::transpose_job_item<0>(in[33], nullptr, nullptr, Wo, D, D, D, r, scr, lane); continue; } r -= I_SQ;
            sb::transpose_job_item<3>(in[9], in[10], in[8], Wkv, D, 2048, D, r, scr, lane);
        }
        for (int m = gw; m < M; m += NGW) sb::row_bf16_ss(m < MP ? in[0] + (size_t)m * D : in[1] + (size_t)(m - MP) * D, xb + (size_t)m * D, ss0 + (size_t)m * 16, nullptr, lane);
        for (int m = gw; m < MMEM; m += NGW) sb::row_bf16_ss(in[7] + (size_t)m * D, memb + (size_t)m * D, ssm + (size_t)m * 16, rstdm + m, lane);
        if (BOTH(PH_PRO)) GRID_BAR();
    }

    if (IN(PH_GU1)) {
        { pg8::Gemm g{memb, Wkv, MMEM, D, D}; pg8::StaticOrder S; S.init(MMEM, D, G, bx); fx::EpiK E{rstdm, kb, out};
          pg8::gemm_phase<fx::EpiK, pg8::StaticOrder, true, true>(L + RING_OFF, g, S, E); }
        { pg8::Gemm g{Wkv + (size_t)D * D, memb, D, MMEM, D}; pg8::StaticOrder S; S.init(D, MMEM, G, (bx + 128) % G); fx::EpiVT E{rstdm, vT, out};
          pg8::gemm_phase<fx::EpiVT, pg8::StaticOrder, true, true>(L + RING_OFF, g, S, E); }
        { pg8::Gemm g{xb, Wgu1, M, 2 * FF, D}; pg8::StaticOrder S; S.init(M, 2 * FF, G, bx); fx::EpiSwiglu E{ss0, hb};
          pg8::gemm_phase<fx::EpiSwiglu, pg8::StaticOrder, true, true>(L + RING_OFF, g, S, E); }
        if (BOTH(PH_GU1)) GRID_BAR();
    }
    if (IN(PH_D1)) {
        pg8::Gemm g{hb, Wd1, M, D, FF}; pg8::StaticOrder S; S.init(M, D, G, bx); fx::EpiRes E{args.in[0], args.in[1] - (size_t)MP * D, xres, xb, ss1, 0.5f};
        pg8::gemm_phase<fx::EpiRes, pg8::StaticOrder, true, true>(L + RING_OFF, g, S, E);
        if (BOTH(PH_D1)) GRID_BAR();
    }
    if (IN(PH_IN)) {
        pg8::Gemm g{xb, Win, M, 1536, D}; pg8::StaticOrder S; S.init(M, 1536, G, bx); fx::EpiIn E{ss1, ug, vb, out};
        pg8::gemm_phase<fx::EpiIn, pg8::StaticOrder, true, true>(L + RING_OFF, g, S, E);
        if (BOTH(PH_IN)) GRID_BAR();
    }
    if (IN(PH_MIX)) {
        for (int unit = bx; unit < NBATCH * NG; unit += G) s5f::prompt_unit(unit >> 5, unit & 31, ug, Ktab, Ptab, Qtab, ALtab, in[24], gb, out, L + RING_OFF, tid, wave, lane);
        for (int task = NBATCH * NG + wave * G + bx; task < (NBATCH + DECB) * NG; task += G * NWAVES)
            sb::s5_task(task, ug, in[2], in[3], in[17], in[18], in[19], in[20], in[21], in[22], in[23], in[24], gb, out, lane);
        __syncthreads();
        LAS float* ybuf = (LAS float*)(L + RING_OFF);
        for (int tile = bx; tile < NBATCH * (SEQ / 64); tile += G) cvx::prompt_tile(tile >> 5, (tile & 31) * 64, vb, in[26], in[27], in[28], in[29], mixb, ybuf, tid, wave, lane);
        for (int b = bx; b < DECB; b += G) cvx::sample_batch(b, vb, in[4], in[26], in[27], in[28], in[29], mixb, out, ybuf, tid, wave, lane);
        if (BOTH(PH_MIX)) GRID_BAR();
    }

    if (IN(PH_GLU)) {
        pg8::Gemm g{gb, Wglu, M, SSM, SSM}; pg8::StaticOrder S; S.init(M, SSM, G, bx); fx::EpiGlu E{gb, mixb};
        pg8::gemm_phase<fx::EpiGlu, pg8::StaticOrder, true, true>(L + RING_OFF, g, S, E);
        if (BOTH(PH_GLU)) GRID_BAR();
    }
    if (IN(PH_OUT)) {
        pg8::Gemm g{mixb, Wout, M, D, D}; pg8::StaticOrder S; S.init(M, D, G, bx); fx::EpiRes E{xres, xres, xres, xb, ss2, 1.f};
        pg8::gemm_phase<fx::EpiRes, pg8::StaticOrder, true, true>(L + RING_OFF, g, S, E);
        if (BOTH(PH_OUT)) GRID_BAR();
    }
    if (IN(PH_Q)) {
        pg8::Gemm g{xb, Wq, M, D, D}; pg8::StaticOrder S; S.init(M, D, G, bx); fx::EpiQ E{ss2, qb};
        pg8::gemm_phase<fx::EpiQ, pg8::StaticOrder, true, true>(L + RING_OFF, g, S, E);
        if (BOTH(PH_Q)) GRID_BAR();
    }
    if (IN(PH_ATT)) {
        LAS float* wsf = (LAS float*)(L + XTRA_OFF) + wave * 32;
        const int vcu = (G % 8 == 0) ? (bx % 8) * (G / 8) + bx / 8 : bx;
        for (int unit = vcu; unit < NBATCH * NH * 8; unit += G) att::prompt_unit(unit >> 5, (unit >> 3) & 3, unit & 7, qb, kb, vT, ob, L + RING_OFF, wsf, tid, wave, lane);
        for (int unit = bx; unit < DECB * 2; unit += G) att::sample_unit(unit >> 1, unit & 1, qb, in[5], in[6], ob, L + RING_OFF, tid, wave, lane);
        if (BOTH(PH_ATT)) GRID_BAR();
    }

    if (IN(PH_O)) {
        pg8::Gemm g{ob, Wo, M, D, D}; pg8::StaticOrder S; S.init(M, D, G, bx); fx::EpiRes E{xres, xres, xres, xb, ss3, 1.f};
        pg8::gemm_phase<fx::EpiRes, pg8::StaticOrder, true, true>(L + RING_OFF, g, S, E);
        if (BOTH(PH_O)) GRID_BAR();
    }
    if (IN(PH_GU2)) {
        pg8::Gemm g{xb, Wgu2, M, 2 * FF, D}; pg8::StaticOrder S; S.init(M, 2 * FF, G, bx); fx::EpiSwiglu E{ss3, hb};
        pg8::gemm_phase<fx::EpiSwiglu, pg8::StaticOrder, true, true>(L + RING_OFF, g, S, E);
        if (BOTH(PH_GU2)) GRID_BAR();
    }
    if (IN(PH_D2)) {
        pg8::Gemm g{hb, Wd2, M, D, FF}; pg8::StaticOrder S; S.init(M, D, G, bx); fx::EpiRes E{xres, xres, out + O_Y, nullptr, ss4, 0.5f};
        pg8::gemm_phase<fx::EpiRes, pg8::StaticOrder, true, true>(L + RING_OFF, g, S, E);
        if (BOTH(PH_D2)) GRID_BAR();
    }

    if (IN(PH_FIN)) {
        float* y = out + O_Y; const float* gfin = in[38];
        for (int m = bx * NWAVES + wave; m < M; m += G * NWAVES) { const float r = rstd_from_ss(ss4, m);
#pragma unroll
            for (int j = 0; j < 4; ++j) { f32x4* p = (f32x4*)(y + (size_t)m * D + j * 256 + lane * 4); const f32x4 gg = *(const f32x4*)(gfin + j * 256 + lane * 4); f32x4 v = *p; v = v * r * gg; *p = v; } }
    }
#undef IN
#undef BOTH
#undef GRID_BAR
}

#ifndef FAST_MERGE
#define FAST_MERGE 1
#endif
extern "C" void kernel_launch(void* const* d_in, const int* in_sizes, int n_in, void* d_out, int out_size, void* d_ws, size_t ws_size, hipStream_t stream) {
    if (n_in != 39 || out_size != (int)O_END || ws_size < WS_END) { fprintf(stderr, "kernel_launch: unexpected shapes n_in %d out %d ws %zu\n", n_in, out_size, ws_size); return; }
    static int grid = 0;
    if (grid == 0) {
        int dev = 0, cus = 0;
        if (hipGetDevice(&dev) != hipSuccess || hipDeviceGetAttribute(&cus, hipDeviceAttributeMultiprocessorCount, dev) != hipSuccess) { grid = -1; return; }
        if (hipFuncSetAttribute((const void*)mk_fwd, hipFuncAttributeMaxDynamicSharedMemorySize, LDS_BYTES) != hipSuccess) { fprintf(stderr, "kernel_launch: hipFuncSetAttribute failed\n"); grid = -1; return; }
        int per_cu = 0;
        if (hipOccupancyMaxActiveBlocksPerMultiprocessor(&per_cu, (const void*)mk_fwd, NWAVES * 64, LDS_BYTES) != hipSuccess || per_cu < 1) { fprintf(stderr, "kernel_launch: occupancy query says %d\n", per_cu); }
        (void)hipGetLastError();
        grid = cus;
    }
    if (grid < 0) return;
    const float* const* in = (const float* const*)d_in;
    const float *x_p = in[0], *x_s = in[1], *st_re = in[2], *st_im = in[3], *cconv = in[4], *cmk = in[5], *cmv = in[6], *memp = in[7], *g_mem = in[8], *w_k = in[9], *w_v = in[10],
                *g_ffn1 = in[11], *w1g = in[12], *w1u = in[13], *w1d = in[14], *g_mix = in[15], *w_in = in[16], *a_re = in[17], *a_im = in[18], *log_dt = in[19], *b_re = in[20], *b_im = in[21],
                *c_re = in[22], *c_im = in[23], *ssm_d = in[24], *w_glu = in[25], *conv_w = in[26], *conv_b = in[27], *ln_g = in[28], *ln_b = in[29], *w_out = in[30], *g_xattn = in[31],
                *w_q = in[32], *w_o = in[33], *g_ffn2 = in[34], *w2g = in[35], *w2u = in[36], *w2d = in[37], *g_final = in[38];
    (void)x_p; (void)x_s;
    unsigned char* ws = (unsigned char*)d_ws; float* out = (float*)d_out;
    bf16_t *Wgu1 = (bf16_t*)(ws + WS_WGU1), *Wgu2 = (bf16_t*)(ws + WS_WGU2), *Wd1 = (bf16_t*)(ws + WS_WD1), *Wd2 = (bf16_t*)(ws + WS_WD2), *Win = (bf16_t*)(ws + WS_WIN), *Wglu = (bf16_t*)(ws + WS_WGLU),
           *Wout = (bf16_t*)(ws + WS_WOUT), *Wq = (bf16_t*)(ws + WS_WQ), *Wo = (bf16_t*)(ws + WS_WO), *Wkv = (bf16_t*)(ws + WS_WKV);
    bf16_t *xb = (bf16_t*)(ws + WS_XB), *memb = (bf16_t*)(ws + WS_MEMB), *kb = (bf16_t*)(ws + WS_KB), *vb2 = (bf16_t*)(ws + WS_VB2), *ug = (bf16_t*)(ws + WS_UG),
           *vb = (bf16_t*)(ws + WS_VB), *gb = (bf16_t*)(ws + WS_GB), *mixb = (bf16_t*)(ws + WS_MIXB), *qb = (bf16_t*)(ws + WS_QB), *ob = (bf16_t*)(ws + WS_OB);
    float *ss0 = (float*)(ws + WS_SS0), *ss4 = (float*)(ws + WS_SS4), *ssm = (float*)(ws + WS_SSM);

    if (hipMemsetAsync(ws + WS_CTL, 0, CTL_ZERO_BYTES, stream) != hipSuccess) return;
    Args a{};
    for (int i = 0; i < 39; ++i) a.in[i] = in[i];
    a.out = out; a.ws = ws;
    int li = 0;
    auto run = [&](int lo, int hi) {
        if (FAST_MERGE) { a.ph_lo = lo; a.ph_hi = hi; a.li = li++; hipLaunchKernelGGL(mk_fwd, dim3(grid), dim3(NWAVES * 64), LDS_BYTES, stream, a); }
        else for (int p = lo; p < hi; ++p) { a.ph_lo = p; a.ph_hi = p + 1; a.li = li; hipLaunchKernelGGL(mk_fwd, dim3(grid), dim3(NWAVES * 64), LDS_BYTES, stream, a); }
    };

    run(PH_PRO, PH_N);
}
```

```cpp
#include <hip/hip_runtime.h>
#include <cstdint>
#include <cstdio>

typedef unsigned short bf16_t;
typedef float f32x4 __attribute__((ext_vector_type(4)));

constexpr int D = 1024, FF = 2816, MP = 16384, MS = 1024, M = MP + MS;
constexpr int SEQ = 2048, DECB = 128, DECS = 8, NBATCH = 8;
constexpr int SSM = 512, CONVD = 512, NG = 32, GC = 16, NST = 64, CWID = 31, NMEM = 256, NH = 4, HD = 256;
constexpr int MMEM = NBATCH * NMEM;
constexpr float EPS = 1e-6f;
constexpr float QSCALE = 0.0625f * 1.4426950408889634f;

constexpr size_t O_Y = 0;
constexpr size_t O_SRP = (size_t)M * D;
constexpr size_t O_SIP = O_SRP + 16384;
constexpr size_t O_CVP = O_SIP + 16384;
constexpr size_t O_MKP = O_CVP + 122880;
constexpr size_t O_MVP = O_MKP + 2097152;
constexpr size_t O_SRS = O_MVP + 2097152;
constexpr size_t O_SIS = O_SRS + 262144;
constexpr size_t O_CVS = O_SIS + 262144;
constexpr size_t O_END = O_CVS + 1966080;

constexpr size_t MiB = 1u << 20;
constexpr size_t WS_CTL = 0;
constexpr size_t WS_WGU1 = 2 * MiB, WS_WGU2 = 13 * MiB, WS_WD1 = 24 * MiB, WS_WD2 = 30 * MiB, WS_WIN = 36 * MiB, WS_WGLU = 39 * MiB,
                 WS_WOUT = 40 * MiB, WS_WQ = 42 * MiB, WS_WO = 44 * MiB, WS_WKV = 46 * MiB;
constexpr size_t WS_TAB = 50 * MiB;
constexpr size_t WS_XB = 72 * MiB, WS_MEMB = 106 * MiB, WS_KB = 110 * MiB, WS_VB2 = 114 * MiB;
constexpr size_t WS_SS0 = 118 * MiB, WS_SS1 = 120 * MiB, WS_SS2 = 122 * MiB, WS_SS3 = 124 * MiB, WS_SS4 = 126 * MiB, WS_SSM = 127 * MiB + 512 * 1024;
constexpr size_t WS_XRES = 128 * MiB, WS_H = 196 * MiB, WS_UG = 290 * MiB, WS_VB = 307 * MiB, WS_GB = 324 * MiB, WS_MIXB = 342 * MiB,
                 WS_QB = 376 * MiB, WS_OB = 410 * MiB, WS_END = 444 * MiB;

__device__ __forceinline__ unsigned f2bf(float f) { unsigned u = __builtin_bit_cast(unsigned, f); return (u + 0x7fffu + ((u >> 16) & 1u)) >> 16; }
__device__ __forceinline__ float bf2f(bf16_t b) { return __builtin_bit_cast(float, (unsigned)b << 16); }
__device__ __forceinline__ float sigmoidf_(float x) { return 1.f / (1.f + __expf(-x)); }
__device__ __forceinline__ float siluf_(float x) { return x * sigmoidf_(x); }
__device__ __forceinline__ float gelu_tanh(float x) { const float u = 0.7978845608028654f * (x + 0.044715f * x * x * x); return 0.5f * x * (1.f + tanhf(u)); }
__device__ __forceinline__ float wave_sum(float v) {
#pragma unroll
    for (int o = 1; o < 64; o <<= 1) v += __shfl_xor(v, o);
    return v;
}
__device__ __forceinline__ float rstd_from_ss(const float* ss, int row) {
    float s = 0.f;
#pragma unroll
    for (int i = 0; i < 16; ++i) s += ss[(size_t)row * 16 + i];
    return rsqrtf(s * (1.f / D) + EPS);
}

template <int MAP>
__global__ void k_wt(const float* W0, const float* W1, const float* gain, bf16_t* WT, int K, int N, int ldw) {
    __shared__ float tile[32][33];
    const int n0 = blockIdx.x * 32, k0 = blockIdx.y * 32, tx = threadIdx.x & 31, ty = threadIdx.x >> 5;
    const float* W = W0; int c0 = n0;
    if (MAP == 1) { const int pn = n0 / 256, half = (n0 % 256) / 128, jj = n0 % 128; W = half ? W1 : W0; c0 = pn * 128 + jj; }
    if (MAP == 2) { if (n0 >= 512) { const int m = n0 - 512, pc = m / 256, half = (m % 256) / 128, jj = m % 128; c0 = 512 + half * 512 + pc * 128 + jj; } }
    if (MAP == 3) { if (n0 >= 1024) { W = W1; c0 = n0 - 1024; } }
    for (int i = ty; i < 32; i += 8) { const int k = k0 + i; tile[i][tx] = W[(size_t)k * ldw + c0 + tx] * (gain ? gain[k] : 1.f); }
    __syncthreads();
    for (int i = ty; i < 32; i += 8) WT[(size_t)(n0 + i) * K + k0 + tx] = (bf16_t)f2bf(tile[tx][i]);
}
__global__ void k_rows_bf16_ss(const float* x0, int rows0, const float* x1, int rows1, bf16_t* xb, float* ss) {
    const int row = blockIdx.x * 4 + (threadIdx.x >> 6), lane = threadIdx.x & 63;
    if (row >= rows0 + rows1) return;
    const float* xr = row < rows0 ? x0 + (size_t)row * D : x1 + (size_t)(row - rows0) * D;
    float s = 0.f;
    for (int j = 0; j < 4; ++j) { const f32x4 v = *(const f32x4*)(xr + j * 256 + lane * 4); s += v.x * v.x + v.y * v.y + v.z * v.z + v.w * v.w;
        uint2 o; o.x = f2bf(v.x) | (f2bf(v.y) << 16); o.y = f2bf(v.z) | (f2bf(v.w) << 16); *(uint2*)(xb + (size_t)row * D + j * 256 + lane * 4) = o; }
    s = wave_sum(s);
    if (lane < 16) ss[(size_t)row * 16 + lane] = lane == 0 ? s : 0.f;
}
__global__ void k_rows_ss(const float* x, int rows, float* ss) {
    const int row = blockIdx.x * 4 + (threadIdx.x >> 6), lane = threadIdx.x & 63;
    if (row >= rows) return;
    float s = 0.f;
    for (int j = 0; j < 4; ++j) { const f32x4 v = *(const f32x4*)(x + (size_t)row * D + j * 256 + lane * 4); s += v.x * v.x + v.y * v.y + v.z * v.z + v.w * v.w; }
    s = wave_sum(s);
    if (lane < 16) ss[(size_t)row * 16 + lane] = lane == 0 ? s : 0.f;
}

enum { E_KV = 1, E_SWIGLU = 2, E_RES = 3, E_U = 4, E_V = 5, E_GLU = 6, E_Q = 7 };
struct EpiP {
    const float* ss;
    const float* resin;
    float* resout;
    bf16_t* ob;
    bf16_t* ob2;
    const bf16_t* gb;
    float* out;
    float alpha;
    int pad;
};
template <int MODE>
__device__ __forceinline__ void epi_elem(const EpiP& P, int row, int c, float a0, float a1, float rstd) {
    if (MODE == E_KV) {
        const float v = a0 * rstd;
        if (c < 1024) { P.out[O_MKP + (size_t)row * 1024 + c] = v; P.ob[(size_t)row * 1024 + c] = (bf16_t)f2bf(v); }
        else { P.out[O_MVP + (size_t)row * 1024 + c - 1024] = v; P.ob2[(size_t)row * 1024 + c - 1024] = (bf16_t)f2bf(v); }
    } else if (MODE == E_SWIGLU) {
        const float g = a0 * rstd, u = a1 * rstd; P.ob[(size_t)row * FF + c] = (bf16_t)f2bf(siluf_(g) * u);
    } else if (MODE == E_RES) {
        const float v = P.resin[(size_t)row * D + c] + P.alpha * a0; P.resout[(size_t)row * D + c] = v; if (P.ob) P.ob[(size_t)row * D + c] = (bf16_t)f2bf(v);
    } else if (MODE == E_U) {
        P.ob[((size_t)(c >> 4) * M + row) * 16 + (c & 15)] = (bf16_t)f2bf(a0 * rstd);
    } else if (MODE == E_V) {
        const float v = (a0 * rstd) * sigmoidf_(a1 * rstd); P.ob[(size_t)row * CONVD + c] = (bf16_t)f2bf(v);
        if (row < MP) { const int b = row / SEQ, t = row % SEQ; if (t >= SEQ - 30) P.out[O_CVP + ((size_t)b * 30 + (t - (SEQ - 30))) * CONVD + c] = v; }
        else { const int rs = row - MP, b = rs / DECS, t = rs % DECS; P.out[O_CVS + ((size_t)b * 30 + 22 + t) * CONVD + c] = v; }
    } else if (MODE == E_GLU) {
        const float g = bf2f(P.gb[(size_t)row * SSM + c]); P.ob[(size_t)row * D + c] = (bf16_t)f2bf(g * sigmoidf_(a0));
    } else if (MODE == E_Q) {
        P.ob[(size_t)row * D + c] = (bf16_t)f2bf(a0 * rstd * QSCALE);
    }
}
template <int MODE> struct ModeTraits { static constexpr bool PAIRED = (MODE == E_SWIGLU || MODE == E_V); static constexpr bool RSTD = (MODE == E_KV || MODE == E_SWIGLU || MODE == E_U || MODE == E_V || MODE == E_Q); };

template <int MODE>
__global__ void __launch_bounds__(256) k_ref_gemm(const bf16_t* A, const bf16_t* BT, int K, EpiP P) {
    constexpr bool PAIRED = ModeTraits<MODE>::PAIRED;
    __shared__ float As[32][65], B0[32][65], B1[PAIRED ? 32 : 1][65];
    const int tid = threadIdx.x, tx = tid & 15, ty = tid >> 4;
    const int m0 = blockIdx.y * 64, p0 = blockIdx.x * 64;
    const int cb0 = PAIRED ? (p0 / 128) * 256 + (p0 % 128) : p0;
    float acc0[4][4], acc1[4][4];
    for (int i = 0; i < 4; ++i) for (int j = 0; j < 4; ++j) { acc0[i][j] = 0.f; acc1[i][j] = 0.f; }
    for (int k0 = 0; k0 < K; k0 += 32) {
        for (int e = tid; e < 64 * 32; e += 256) { const int r = e >> 5, k = e & 31;
            As[k][r] = bf2f(A[(size_t)(m0 + r) * K + k0 + k]); B0[k][r] = bf2f(BT[(size_t)(cb0 + r) * K + k0 + k]);
            if (PAIRED) B1[k][r] = bf2f(BT[(size_t)(cb0 + 128 + r) * K + k0 + k]); }
        __syncthreads();
        for (int k = 0; k < 32; ++k) {
            float a[4], b0[4], b1[4];
            for (int i = 0; i < 4; ++i) a[i] = As[k][ty * 4 + i];
            for (int j = 0; j < 4; ++j) { b0[j] = B0[k][tx * 4 + j]; b1[j] = PAIRED ? B1[k][tx * 4 + j] : 0.f; }
            for (int i = 0; i < 4; ++i) for (int j = 0; j < 4; ++j) { acc0[i][j] += a[i] * b0[j]; if (PAIRED) acc1[i][j] += a[i] * b1[j]; }
        }
        __syncthreads();
    }
    for (int i = 0; i < 4; ++i) { const int row = m0 + ty * 4 + i; const float rstd = ModeTraits<MODE>::RSTD ? rstd_from_ss(P.ss, row) : 1.f;
        for (int j = 0; j < 4; ++j) epi_elem<MODE>(P, row, p0 + tx * 4 + j, acc0[i][j], acc1[i][j], rstd); }
}

__global__ void __launch_bounds__(64) k_ref_s5(const bf16_t* ug, const float* h0re, const float* h0im, const float* a_re, const float* a_im, const float* log_dt,
                                               const float* b_re, const float* b_im, const float* c_re, const float* c_im, const float* dskip, bf16_t* gb, float* out) {
    const int g = blockIdx.x % NG, sq = blockIdx.x / NG, n = threadIdx.x;
    const bool prompt = sq < NBATCH; const int b = prompt ? sq : sq - NBATCH, T = prompt ? SEQ : DECS, row0 = prompt ? b * SEQ : MP + b * DECS;
    const float dt = expf(log_dt[g]), lr = a_re[g * NST + n], li = a_im[g * NST + n];
    const float mag = expf(lr * dt), abr = mag * cosf(li * dt), abi = mag * sinf(li * dt);
    const float den = lr * lr + li * li, nr = abr - 1.f, ni = abi, cr = (nr * lr + ni * li) / den, ci = (ni * lr - nr * li) / den;
    float Br[16], Bi[16], Cr[16], Ci[16];
    for (int c = 0; c < 16; ++c) { const float br = b_re[((size_t)g * NST + n) * 16 + c], bi = b_im[((size_t)g * NST + n) * 16 + c];
        Br[c] = cr * br - ci * bi; Bi[c] = cr * bi + ci * br; Cr[c] = c_re[((size_t)g * 16 + c) * NST + n]; Ci[c] = c_im[((size_t)g * 16 + c) * NST + n]; }
    float hr = 0.f, hi = 0.f;
    if (!prompt) { hr = h0re[((size_t)b * NG + g) * NST + n]; hi = h0im[((size_t)b * NG + g) * NST + n]; }
    const float dsk = dskip[g * 16 + (n & 15)];
    for (int t = 0; t < T; ++t) {
        const bf16_t* up = ug + ((size_t)g * M + row0 + t) * 16;
        float u[16], xr = 0.f, xi = 0.f;
#pragma unroll
        for (int c = 0; c < 16; ++c) { u[c] = bf2f(up[c]); xr += Br[c] * u[c]; xi += Bi[c] * u[c]; }
        const float nhr = abr * hr - abi * hi + xr, nhi = abr * hi + abi * hr + xi; hr = nhr; hi = nhi;
        float ymine = 0.f;
#pragma unroll
        for (int c = 0; c < 16; ++c) { const float y = wave_sum(Cr[c] * hr - Ci[c] * hi); if ((n & 15) == c) ymine = y + dsk * u[c]; }
        if (n < 16) gb[(size_t)(row0 + t) * SSM + g * 16 + n] = (bf16_t)f2bf(gelu_tanh(ymine));
    }
    if (prompt) { out[O_SRP + ((size_t)b * NG + g) * NST + n] = hr; out[O_SIP + ((size_t)b * NG + g) * NST + n] = hi; }
    else { out[O_SRS + ((size_t)b * NG + g) * NST + n] = hr; out[O_SIS + ((size_t)b * NG + g) * NST + n] = hi; }
}

__global__ void __launch_bounds__(512) k_ref_conv(const bf16_t* vb, const float* cache, const float* w, const float* bias, const float* lg, const float* lb, bf16_t* mixb, float* out) {
    __shared__ float red[2][8];
    const int row = blockIdx.x, c = threadIdx.x;
    float y = bias[c];
    if (row < MP) { const int t = row % SEQ;
        for (int k = 0; k < CWID; ++k) { const int tt = t - 30 + k; if (tt >= 0) y += w[k * CONVD + c] * bf2f(vb[(size_t)(row - 30 + k) * CONVD + c]); }
    } else { const int rs = row - MP, b = rs / DECS, t = rs % DECS;
        for (int k = 0; k < CWID; ++k) { const int idx = t + k; const float xv = idx < 30 ? cache[((size_t)b * 30 + idx) * CONVD + c] : bf2f(vb[(size_t)(MP + b * DECS + idx - 30) * CONVD + c]); y += w[k * CONVD + c] * xv; }
        if (t == 0) for (int j = 0; j < 22; ++j) out[O_CVS + ((size_t)b * 30 + j) * CONVD + c] = cache[((size_t)b * 30 + j + 8) * CONVD + c];
    }
    float s = wave_sum(y); if ((c & 63) == 0) red[0][c >> 6] = s; __syncthreads();
    float mu = 0.f; for (int i = 0; i < 8; ++i) mu += red[0][i]; mu *= (1.f / CONVD);
    const float d = y - mu; float q = wave_sum(d * d); if ((c & 63) == 0) red[1][c >> 6] = q; __syncthreads();
    float var = 0.f; for (int i = 0; i < 8; ++i) var += red[1][i]; var *= (1.f / CONVD);
    const float z = d * rsqrtf(var + EPS) * lg[c] + lb[c];
    mixb[(size_t)row * D + SSM + c] = (bf16_t)f2bf(siluf_(z));
}

__global__ void __launch_bounds__(256) k_ref_attn(const bf16_t* qb, const bf16_t* kb, const bf16_t* vb2, const float* ck, const float* cv, bf16_t* ob) {
    __shared__ float q[256], p[256], red[4];
    const int row = blockIdx.x >> 2, h = blockIdx.x & 3, tid = threadIdx.x;
    q[tid] = bf2f(qb[(size_t)row * D + h * HD + tid]);
    __syncthreads();
    float s = 0.f;
    if (row < MP) { const int b = row / SEQ; const bf16_t* kr = kb + ((size_t)b * NMEM + tid) * D + h * HD; for (int d = 0; d < HD; ++d) s += q[d] * bf2f(kr[d]); }
    else { const int b = (row - MP) / DECS; const float* kr = ck + ((size_t)b * NMEM + tid) * D + h * HD; for (int d = 0; d < HD; ++d) s += q[d] * kr[d]; }
    float mx = s; for (int o = 1; o < 64; o <<= 1) mx = fmaxf(mx, __shfl_xor(mx, o));
    if ((tid & 63) == 0) red[tid >> 6] = mx; __syncthreads();
    mx = fmaxf(fmaxf(red[0], red[1]), fmaxf(red[2], red[3])); __syncthreads();
    const float e = exp2f(s - mx); float sm = wave_sum(e);
    if ((tid & 63) == 0) red[tid >> 6] = sm; __syncthreads();
    sm = red[0] + red[1] + red[2] + red[3];
    p[tid] = e / sm; __syncthreads();
    float o = 0.f;
    if (row < MP) { const int b = row / SEQ; const bf16_t* vr = vb2 + (size_t)b * NMEM * D + h * HD + tid; for (int m = 0; m < NMEM; ++m) o += p[m] * bf2f(vr[(size_t)m * D]); }
    else { const int b = (row - MP) / DECS; const float* vr = cv + (size_t)b * NMEM * D + h * HD + tid; for (int m = 0; m < NMEM; ++m) o += p[m] * vr[(size_t)m * D]; }
    ob[(size_t)row * D + h * HD + tid] = (bf16_t)f2bf(o);
}

__global__ void k_final(float* y, const float* ss, const float* g) {
    const int row = blockIdx.x * 4 + (threadIdx.x >> 6), lane = threadIdx.x & 63;
    const float r = rstd_from_ss(ss, row);
    for (int j = 0; j < 4; ++j) { f32x4* p = (f32x4*)(y + (size_t)row * D + j * 256 + lane * 4); const f32x4 gg = *(const f32x4*)(g + j * 256 + lane * 4); f32x4 v = *p; v = v * r * gg; *p = v; }
}


namespace pg8 {
#define PG8_LAS __attribute__((address_space(3)))
typedef unsigned short bf16_t;
typedef short bf16x8 __attribute__((ext_vector_type(8)));
typedef float f32x4 __attribute__((ext_vector_type(4)));
typedef unsigned u32x4 __attribute__((ext_vector_type(4)));
constexpr int BM = 256, BK = 64, HALF = 128, HTB = HALF * BK * 2  , STAGE_BYTES = 8 * HTB, NXCD = 8, WGM = 8;

__host__ __device__ __forceinline__ int lds_byte(int r, int c) { const int st = (r >> 4) * 2 + (c >> 5), rr = r & 15, cc = c & 31, ob = rr * 64 + cc * 2; return st * 1024 + (ob ^ (((ob >> 9) & 1) << 5)); }
__host__ __device__ __forceinline__ void stage_rc(int b, int& R, int& C) { const int st = b / 1024, sb = b % 1024, swz = sb ^ (((sb >> 9) & 1) << 5); R = (st >> 1) * 16 + swz / 64; C = (st & 1) * 32 + (swz % 64) / 2; }
__host__ __device__ __forceinline__ int perm32(int rho) { const int n = rho >> 4, i = rho & 15; return 8 * (i >> 2) + 4 * n + (i & 3); }

struct Unit { int pm, pn; };
struct Gemm { const bf16_t* A; const bf16_t* Bt; int M, N, K; };

struct StaticOrder {
    int nM, nN, nwg, G, c;
    __host__ __device__ void init(int M, int N, int G_, int c_) { nM = M / BM; nN = N / BM; nwg = nM * nN; G = G_; c = c_; }
    __host__ __device__ bool next(int i, Unit& u) const {
        const long L = (long)i * G + c; if (L >= nwg) return false;
        int wgid = (int)L; { const int q = nwg / NXCD, r = nwg % NXCD, xcd = wgid % NXCD, off = wgid / NXCD; wgid = (xcd < r ? xcd * (q + 1) : r * (q + 1) + (xcd - r) * q) + off; }
        const int nig = WGM * nN, gid = wgid / nig, fm = gid * WGM, gsz = (nM - fm) < WGM ? (nM - fm) : WGM;
        u.pm = fm + ((wgid % nig) % gsz); u.pn = (wgid % nig) / gsz; return true;
    }
    __device__ __forceinline__ void a_ready(const Unit&) const {}
    __device__ __forceinline__ void done(const Unit&) const {}
};
__device__ __forceinline__ unsigned cvt_pk_bf16(float lo, float hi) { unsigned r; asm volatile("v_cvt_pk_bf16_f32 %0, %1, %2" : "=v"(r) : "v"(lo), "v"(hi)); return r; }
typedef float f32x2 __attribute__((ext_vector_type(2)));
template <class Epi, class Sched, bool ALIGN_EPI = false, bool SP2 = false>
__device__ __forceinline__ void gemm_phase(PG8_LAS unsigned char* lds, const Gemm g, const Sched& S, const Epi& E) {
    const int tid = threadIdx.x, wid = __builtin_amdgcn_readfirstlane(tid >> 6), lane = tid & 63, wr = wid >> 2, wc = wid & 3, fr = lane & 15, fq = lane >> 4;
    const int K = g.K, nt = K / BK;
    unsigned voffA[2], voffB[2];
#pragma unroll
    for (int i = 0; i < 2; ++i) { int R, C; stage_rc(tid * 16 + i * 8192, R, C); const int Rb = Epi::PERM ? ((R & ~31) + perm32(R & 31)) : R;
        voffA[i] = (unsigned)(R * K + C) * 2u; voffB[i] = (unsigned)(Rb * K + C) * 2u; }
    const size_t kstep = (size_t)(BK * 2);
    const size_t hstep = (size_t)HALF * K * 2;
    const size_t tstep = 2 * hstep;
    const unsigned ldsw = (unsigned)wid * 1024u;
    const int aoff = lds_byte(wr * 64 + fr, fq * 8), boff = lds_byte(wc * 32 + fr, fq * 8);
#define PG8_SA(b, h) (((b) * 2 + (h)) * HTB)
#define PG8_SB(b, h) ((4 + (b) * 2 + (h)) * HTB)
#define PG8_STAGE(bufoff, gbase, voff) do { _Pragma("unroll") for (int _i = 0; _i < 2; ++_i) \
        __builtin_amdgcn_global_load_lds((const unsigned*)((const char*)(gbase) + (voff)[_i]), (PG8_LAS unsigned*)(lds + (bufoff) + ldsw + _i * 8192), 16, 0, 0); } while (0)
#define PG8_LDA(dst, b, h) do { _Pragma("unroll") for (int m = 0; m < 4; ++m) _Pragma("unroll") for (int k = 0; k < 2; ++k) dst[m][k] = *(const PG8_LAS bf16x8*)(lds + PG8_SA(b, h) + aoff + m * 2048 + k * 1024); } while (0)
#define PG8_LDB(dst, b, h) do { _Pragma("unroll") for (int n = 0; n < 2; ++n) _Pragma("unroll") for (int k = 0; k < 2; ++k) dst[n][k] = *(const PG8_LAS bf16x8*)(lds + PG8_SB(b, h) + boff + n * 2048 + k * 1024); } while (0)
#define PG8_MMA(ai, bj, At, Bt) do { __builtin_amdgcn_s_setprio(1); _Pragma("unroll") for (int m = 0; m < 4; ++m) _Pragma("unroll") for (int n = 0; n < 2; ++n) _Pragma("unroll") for (int k = 0; k < 2; ++k) \
        acc[ai][bj][m][n] = __builtin_amdgcn_mfma_f32_16x16x32_bf16(Bt[n][k], At[m][k], acc[ai][bj][m][n], 0, 0, 0); __builtin_amdgcn_s_setprio(0); } while (0)
#define PG8_WAIT_V(n) asm volatile("s_waitcnt vmcnt(" #n ")" ::: "memory")
#define PG8_WAIT_L(n) asm volatile("s_waitcnt lgkmcnt(" #n ")" ::: "memory")
#define PG8_BAR __builtin_amdgcn_s_barrier()
#define PG8_SCHED __builtin_amdgcn_sched_barrier(0)
    Unit cur, nxt; int ui = 0;
    if (!S.next(0, cur)) return;
    f32x4 acc[2][2][4][2];
#pragma unroll
    for (int a = 0; a < 2; ++a)
#pragma unroll
        for (int b = 0; b < 2; ++b)
#pragma unroll
            for (int m = 0; m < 4; ++m)
#pragma unroll
                for (int n = 0; n < 2; ++n) acc[a][b][m][n] = (f32x4){0.f, 0.f, 0.f, 0.f};
    bf16x8 At[4][2], B0[2][2], B1[2][2];
    const char* cA = (const char*)g.A + (size_t)cur.pm * tstep; const char* cB = (const char*)g.Bt + (size_t)cur.pn * tstep;
    S.a_ready(cur);
    if constexpr (SP2) {
        PG8_STAGE(PG8_SB(0, 0), cB, voffB); PG8_STAGE(PG8_SB(0, 1), cB + hstep, voffB); PG8_STAGE(PG8_SA(0, 0), cA, voffA); PG8_STAGE(PG8_SA(0, 1), cA + hstep, voffA);
        if (wr == 1) PG8_BAR;
        PG8_WAIT_V(2); PG8_BAR;
        PG8_STAGE(PG8_SB(1, 0), cB + kstep, voffB); PG8_STAGE(PG8_SA(1, 0), cA + kstep, voffA); PG8_STAGE(PG8_SB(1, 1), cB + hstep + kstep, voffB);
        PG8_WAIT_V(6); PG8_BAR;
    } else {
        PG8_STAGE(PG8_SB(0, 0), cB, voffB); PG8_STAGE(PG8_SA(0, 0), cA, voffA); PG8_STAGE(PG8_SB(0, 1), cB + hstep, voffB); PG8_STAGE(PG8_SA(0, 1), cA + hstep, voffA);
        if (wr == 1) PG8_BAR;
        PG8_WAIT_V(4); PG8_BAR;
        PG8_STAGE(PG8_SB(1, 0), cB + kstep, voffB); PG8_STAGE(PG8_SA(1, 0), cA + kstep, voffA); PG8_STAGE(PG8_SB(1, 1), cB + hstep + kstep, voffB);
        PG8_WAIT_V(6); PG8_BAR;
    }
    for (;;) {
        const bool has_next = S.next(ui + 1, nxt);
        const char* nA = has_next ? (const char*)g.A + (size_t)nxt.pm * tstep : cA; const char* nB = has_next ? (const char*)g.Bt + (size_t)nxt.pn * tstep : cB;
        for (int t = 0; t < nt; t += 2) {
            const bool last = (t == nt - 2);
            const char* a1 = cA + (size_t)(t + 1) * kstep;
            const char* a2 = last ? nA : cA + (size_t)(t + 2) * kstep; const char* b2 = last ? nB : cB + (size_t)(t + 2) * kstep;
            const char* a3 = a2 + kstep; const char* b3 = b2 + kstep;
            if (last && has_next) S.a_ready(nxt);
            if constexpr (SP2) {
            PG8_LDB(B0, 0, 0); PG8_LDB(B1, 0, 1); PG8_SCHED; PG8_LDA(At, 0, 0); PG8_STAGE(PG8_SA(1, 1), a1 + hstep, voffA);
            PG8_WAIT_V(8); PG8_WAIT_L(0); PG8_BAR; PG8_MMA(0, 0, At, B0); PG8_MMA(0, 1, At, B1); PG8_BAR; PG8_SCHED;
            PG8_LDA(At, 0, 1); PG8_STAGE(PG8_SB(0, 0), b2, voffB); PG8_STAGE(PG8_SB(0, 1), b2 + hstep, voffB); PG8_STAGE(PG8_SA(0, 0), a2, voffA);
            PG8_WAIT_V(8); PG8_WAIT_L(0); PG8_BAR; PG8_MMA(1, 0, At, B0); PG8_MMA(1, 1, At, B1); PG8_BAR; PG8_SCHED;
            PG8_LDB(B0, 1, 0); PG8_LDB(B1, 1, 1); PG8_SCHED; PG8_LDA(At, 1, 0); PG8_STAGE(PG8_SA(0, 1), a2 + hstep, voffA);
            PG8_WAIT_V(8); PG8_WAIT_L(0); PG8_BAR; PG8_MMA(0, 0, At, B0); PG8_MMA(0, 1, At, B1); PG8_BAR; PG8_SCHED;
            PG8_LDA(At, 1, 1); PG8_STAGE(PG8_SB(1, 0), b3, voffB); PG8_STAGE(PG8_SB(1, 1), b3 + hstep, voffB); PG8_STAGE(PG8_SA(1, 0), a3, voffA);
            PG8_WAIT_V(8); PG8_WAIT_L(0); PG8_BAR; PG8_MMA(1, 0, At, B0); PG8_MMA(1, 1, At, B1); PG8_BAR; PG8_SCHED;
            } else {
            PG8_LDB(B0, 0, 0); PG8_SCHED; PG8_LDA(At, 0, 0); PG8_STAGE(PG8_SA(1, 1), a1 + hstep, voffA);
            PG8_WAIT_L(8); PG8_BAR; PG8_WAIT_L(0); PG8_MMA(0, 0, At, B0); PG8_BAR; PG8_SCHED;
            PG8_LDB(B1, 0, 1); PG8_STAGE(PG8_SB(0, 0), b2, voffB);
            PG8_BAR; PG8_WAIT_L(0); PG8_MMA(0, 1, At, B1); PG8_BAR;
            PG8_LDA(At, 0, 1); PG8_STAGE(PG8_SA(0, 0), a2, voffA);
            PG8_BAR; PG8_WAIT_L(0); PG8_MMA(1, 0, At, B0); PG8_BAR; PG8_SCHED;
            PG8_STAGE(PG8_SB(0, 1), b2 + hstep, voffB);
            PG8_WAIT_V(6); PG8_BAR; PG8_MMA(1, 1, At, B1); PG8_BAR;
            PG8_LDB(B0, 1, 0); PG8_SCHED; PG8_LDA(At, 1, 0); PG8_STAGE(PG8_SA(0, 1), a2 + hstep, voffA);
            PG8_WAIT_L(8); PG8_BAR; PG8_WAIT_L(0); PG8_MMA(0, 0, At, B0); PG8_BAR; PG8_SCHED;
            PG8_LDB(B1, 1, 1); PG8_STAGE(PG8_SB(1, 0), b3, voffB);
            PG8_BAR; PG8_WAIT_L(0); PG8_MMA(0, 1, At, B1); PG8_BAR;
            PG8_LDA(At, 1, 1); PG8_STAGE(PG8_SA(1, 0), a3, voffA);
            PG8_BAR; PG8_WAIT_L(0); PG8_MMA(1, 0, At, B0); PG8_BAR; PG8_SCHED;
            PG8_STAGE(PG8_SB(1, 1), b3 + hstep, voffB);
            PG8_WAIT_V(6); PG8_BAR; PG8_MMA(1, 1, At, B1); PG8_BAR;
            }
        }
        if constexpr (ALIGN_EPI) { if (wr == 0) PG8_BAR; }
        if constexpr (!Epi::AFTER_DRAIN) { E(acc, cur, wr, wc, fr, fq); S.done(cur); }
        if (!has_next) break;
#pragma unroll
        for (int a = 0; a < 2; ++a)
#pragma unroll
            for (int b = 0; b < 2; ++b)
#pragma unroll
                for (int m = 0; m < 4; ++m)
#pragma unroll
                    for (int n = 0; n < 2; ++n) acc[a][b][m][n] = (f32x4){0.f, 0.f, 0.f, 0.f};
        cur = nxt; cA = nA; cB = nB; ++ui;
        if constexpr (ALIGN_EPI) { if (wr == 1) PG8_BAR; }
    }
    PG8_WAIT_V(0);
    if constexpr (!ALIGN_EPI) { if (wr == 0) PG8_BAR; }
    PG8_BAR;
    if constexpr (Epi::AFTER_DRAIN) { E.fused(acc, cur, wr, wc, fr, fq, lds, wid, lane); S.done(cur); }
#undef PG8_SA
#undef PG8_SB
#undef PG8_STAGE
#undef PG8_LDA
#undef PG8_LDB
#undef PG8_MMA
#undef PG8_WAIT_V
#undef PG8_WAIT_L
#undef PG8_BAR
#undef PG8_SCHED
}
}

namespace fx {
using pg8::f32x4; using pg8::u32x4; using pg8::Unit; using pg8::HALF; using pg8::BM; using pg8::cvt_pk_bf16;
__device__ __forceinline__ float rstd_row(const float* ss, int row) {
    const f32x4* p = (const f32x4*)(ss + (size_t)row * 16); const f32x4 a = p[0], b = p[1], c = p[2], d = p[3];
    const float s = ((a.x + a.y) + (a.z + a.w)) + ((b.x + b.y) + (b.z + b.w)) + ((c.x + c.y) + (c.z + c.w)) + ((d.x + d.y) + (d.z + d.w));
    return rsqrtf(s * (1.f / D) + EPS);
}
__device__ __forceinline__ float fsig(float x) { return __builtin_amdgcn_rcpf(1.f + __builtin_amdgcn_exp2f(-1.4426950408889634f * x)); }
__device__ __forceinline__ u32x4 pack8(const f32x4 a, const f32x4 b) { u32x4 w; w.x = cvt_pk_bf16(a[0], a[1]); w.y = cvt_pk_bf16(a[2], a[3]); w.z = cvt_pk_bf16(b[0], b[1]); w.w = cvt_pk_bf16(b[2], b[3]); return w; }
__device__ __forceinline__ f32x4 sig4(const f32x4 x) { return (f32x4){fsig(x[0]), fsig(x[1]), fsig(x[2]), fsig(x[3])}; }

struct EpiKV { static constexpr bool PERM = true, AFTER_DRAIN = false; const float* ss; bf16_t* kb; bf16_t* vb2; float* out;
    __device__ __forceinline__ void operator()(const f32x4 (&acc)[2][2][4][2], const Unit& u, int wr, int wc, int fr, int fq) const {
        const int row0 = u.pm * BM + wr * 64 + fr; const bool isv = u.pn >= 4; const int colt = (isv ? u.pn - 4 : u.pn) * BM + wc * 32 + 8 * fq;
        float* of = out + (isv ? O_MVP : O_MKP); bf16_t* ob = isv ? vb2 : kb;
#pragma unroll
        for (int ai = 0; ai < 2; ++ai)
#pragma unroll
            for (int m = 0; m < 4; ++m) { const int row = row0 + ai * HALF + m * 16; const float r = rstd_row(ss, row);
#pragma unroll
                for (int bj = 0; bj < 2; ++bj) { const f32x4 v0 = acc[ai][bj][m][0] * r, v1 = acc[ai][bj][m][1] * r; const size_t o = (size_t)row * D + colt + bj * HALF;
                    *(f32x4*)(of + o) = v0; *(f32x4*)(of + o + 4) = v1; *(u32x4*)(ob + o) = pack8(v0, v1); } }
    }
};

struct EpiK { static constexpr bool PERM = true, AFTER_DRAIN = false; const float* rstdm; bf16_t* kb; float* out;
    __device__ __forceinline__ void operator()(const f32x4 (&acc)[2][2][4][2], const Unit& u, int wr, int wc, int fr, int fq) const {
        const int row0 = u.pm * BM + wr * 64 + fr, colt = u.pn * BM + wc * 32 + 8 * fq;
#pragma unroll
        for (int ai = 0; ai < 2; ++ai)
#pragma unroll
            for (int m = 0; m < 4; ++m) { const int row = row0 + ai * HALF + m * 16; const float r = rstdm[row];
#pragma unroll
                for (int bj = 0; bj < 2; ++bj) { const f32x4 v0 = acc[ai][bj][m][0] * r, v1 = acc[ai][bj][m][1] * r; const size_t o = (size_t)row * D + colt + bj * HALF;
                    *(f32x4*)(out + O_MKP + o) = v0; *(f32x4*)(out + O_MKP + o + 4) = v1; *(u32x4*)(kb + o) = pack8(v0, v1); } }
    }
};
struct EpiVT { static constexpr bool PERM = true, AFTER_DRAIN = false; const float* rstdm; bf16_t* vT; float* out;
    __device__ __forceinline__ void operator()(const f32x4 (&acc)[2][2][4][2], const Unit& u, int wr, int wc, int fr, int fq) const {
        const int row0 = u.pm * BM + wr * 64 + fr;
#pragma unroll
        for (int bj = 0; bj < 2; ++bj) { const int cl = bj * HALF + wc * 32 + 8 * fq, c0 = u.pn * BM + cl;
            const f32x4 r0 = *(const f32x4*)(rstdm + c0), r1 = *(const f32x4*)(rstdm + c0 + 4);
            const int pos0 = (cl & ~15) + 4 * ((cl >> 3) & 1);
#pragma unroll
            for (int ai = 0; ai < 2; ++ai)
#pragma unroll
                for (int m = 0; m < 4; ++m) { const int row = row0 + ai * HALF + m * 16; const f32x4 v0 = acc[ai][bj][m][0] * r0, v1 = acc[ai][bj][m][1] * r1;
                    bf16_t* vp = vT + (size_t)row * MMEM + u.pn * BM;
                    typedef unsigned u32x2 __attribute__((ext_vector_type(2)));
                    *(u32x2*)(vp + pos0) = (u32x2){cvt_pk_bf16(v0[0], v0[1]), cvt_pk_bf16(v0[2], v0[3])}; *(u32x2*)(vp + pos0 + 8) = (u32x2){cvt_pk_bf16(v1[0], v1[1]), cvt_pk_bf16(v1[2], v1[3])};
                    float* op = out + O_MVP + (size_t)c0 * D + row;
                    op[0] = v0[0]; op[D] = v0[1]; op[2 * D] = v0[2]; op[3 * D] = v0[3]; op[4 * D] = v1[0]; op[5 * D] = v1[1]; op[6 * D] = v1[2]; op[7 * D] = v1[3]; } }
    }
};
struct EpiSwiglu { static constexpr bool PERM = true, AFTER_DRAIN = false; const float* ss; bf16_t* H;
    __device__ __forceinline__ void operator()(const f32x4 (&acc)[2][2][4][2], const Unit& u, int wr, int wc, int fr, int fq) const {
        const int row0 = u.pm * BM + wr * 64 + fr, col0 = u.pn * HALF + wc * 32 + 8 * fq;
#pragma unroll
        for (int ai = 0; ai < 2; ++ai)
#pragma unroll
            for (int m = 0; m < 4; ++m) { const int row = row0 + ai * HALF + m * 16; const float r = rstd_row(ss, row);
                const f32x4 g0 = acc[ai][0][m][0] * r, g1 = acc[ai][0][m][1] * r, u0 = acc[ai][1][m][0] * r, u1 = acc[ai][1][m][1] * r;
                *(u32x4*)(H + (size_t)row * FF + col0) = pack8(g0 * sig4(g0) * u0, g1 * sig4(g1) * u1); }
    }
};
struct EpiRes { static constexpr bool PERM = true, AFTER_DRAIN = false; const float* rin0; const float* rin1; float* rout; bf16_t* xb; float* ss; float alpha;
    __device__ __forceinline__ void operator()(const f32x4 (&acc)[2][2][4][2], const Unit& u, int wr, int wc, int fr, int fq) const {
        const int row0 = u.pm * BM + wr * 64 + fr, col0 = u.pn * BM + wc * 32 + 8 * fq; const float* rin = u.pm >= MP / BM ? rin1 : rin0;
#pragma unroll
        for (int ai = 0; ai < 2; ++ai)
#pragma unroll
            for (int m = 0; m < 4; ++m) { const int row = row0 + ai * HALF + m * 16; float sq = 0.f;
#pragma unroll
                for (int bj = 0; bj < 2; ++bj) { const size_t o = (size_t)row * D + col0 + bj * HALF;
                    const f32x4 v0 = *(const f32x4*)(rin + o) + acc[ai][bj][m][0] * alpha, v1 = *(const f32x4*)(rin + o + 4) + acc[ai][bj][m][1] * alpha;
                    *(f32x4*)(rout + o) = v0; *(f32x4*)(rout + o + 4) = v1; if (xb) *(u32x4*)(xb + o) = pack8(v0, v1);
                    sq += (v0[0] * v0[0] + v0[1] * v0[1]) + (v0[2] * v0[2] + v0[3] * v0[3]) + (v1[0] * v1[0] + v1[1] * v1[1]) + (v1[2] * v1[2] + v1[3] * v1[3]); }
                sq += __shfl_xor(sq, 16); sq += __shfl_xor(sq, 32);
                if (fq == 0) ss[(size_t)row * 16 + u.pn * 4 + wc] = sq;
                if (m & 1) asm volatile("" ::: "memory"); }
    }
};
struct EpiIn { static constexpr bool PERM = true, AFTER_DRAIN = false; const float* ss; bf16_t* ug; bf16_t* vb; float* out;
    __device__ __forceinline__ void operator()(const f32x4 (&acc)[2][2][4][2], const Unit& u, int wr, int wc, int fr, int fq) const {
        const int row0 = u.pm * BM + wr * 64 + fr;
        if (u.pn < 2) {
#pragma unroll
            for (int ai = 0; ai < 2; ++ai)
#pragma unroll
                for (int m = 0; m < 4; ++m) { const int row = row0 + ai * HALF + m * 16; const float r = rstd_row(ss, row);
#pragma unroll
                    for (int bj = 0; bj < 2; ++bj) { const int c0 = u.pn * BM + bj * HALF + wc * 32 + 8 * fq;
                        *(u32x4*)(ug + ((size_t)(c0 >> 4) * M + row) * 16 + (c0 & 15)) = pack8(acc[ai][bj][m][0] * r, acc[ai][bj][m][1] * r); } }
        } else {
            const int p0 = (u.pn - 2) * HALF + wc * 32 + 8 * fq;
#pragma unroll
            for (int ai = 0; ai < 2; ++ai)
#pragma unroll
                for (int m = 0; m < 4; ++m) { const int row = row0 + ai * HALF + m * 16; const float r = rstd_row(ss, row);
                    const f32x4 a0 = acc[ai][0][m][0] * r, a1 = acc[ai][0][m][1] * r, g0 = acc[ai][1][m][0] * r, g1 = acc[ai][1][m][1] * r;
                    const f32x4 v0 = a0 * sig4(g0), v1 = a1 * sig4(g1);
                    *(u32x4*)(vb + (size_t)row * CONVD + p0) = pack8(v0, v1);
                    float* o = nullptr;
                    if (row >= MP) { const int rs = row - MP; o = out + O_CVS + ((size_t)(rs >> 3) * 30 + 22 + (rs & 7)) * CONVD + p0; }
                    else { const int t = row & (SEQ - 1); if (t >= SEQ - 30) o = out + O_CVP + ((size_t)(row >> 11) * 30 + (t - (SEQ - 30))) * CONVD + p0; }
                    if (o) { *(f32x4*)o = v0; *(f32x4*)(o + 4) = v1; } }
        }
    }
};
struct EpiGlu { static constexpr bool PERM = true, AFTER_DRAIN = false; const bf16_t* gb; bf16_t* mixb;
    __device__ __forceinline__ void operator()(const f32x4 (&acc)[2][2][4][2], const Unit& u, int wr, int wc, int fr, int fq) const {
        const int row0 = u.pm * BM + wr * 64 + fr, col0 = u.pn * BM + wc * 32 + 8 * fq;
#pragma unroll
        for (int ai = 0; ai < 2; ++ai)
#pragma unroll
            for (int m = 0; m < 4; ++m) { const int row = row0 + ai * HALF + m * 16;
#pragma unroll
                for (int bj = 0; bj < 2; ++bj) { const int c0 = col0 + bj * HALF; const u32x4 gw = *(const u32x4*)(gb + (size_t)row * SSM + c0);
                    const f32x4 ga = {__builtin_bit_cast(float, gw.x << 16), __builtin_bit_cast(float, gw.x & 0xffff0000u), __builtin_bit_cast(float, gw.y << 16), __builtin_bit_cast(float, gw.y & 0xffff0000u)};
                    const f32x4 gc = {__builtin_bit_cast(float, gw.z << 16), __builtin_bit_cast(float, gw.z & 0xffff0000u), __builtin_bit_cast(float, gw.w << 16), __builtin_bit_cast(float, gw.w & 0xffff0000u)};
                    *(u32x4*)(mixb + (size_t)row * D + c0) = pack8(ga * sig4(acc[ai][bj][m][0]), gc * sig4(acc[ai][bj][m][1])); } }
    }
};
struct EpiQ { static constexpr bool PERM = true, AFTER_DRAIN = false; const float* ss; bf16_t* qb;
    __device__ __forceinline__ void operator()(const f32x4 (&acc)[2][2][4][2], const Unit& u, int wr, int wc, int fr, int fq) const {
        const int row0 = u.pm * BM + wr * 64 + fr, col0 = u.pn * BM + wc * 32 + 8 * fq;
#pragma unroll
        for (int ai = 0; ai < 2; ++ai)
#pragma unroll
            for (int m = 0; m < 4; ++m) { const int row = row0 + ai * HALF + m * 16; const float r = rstd_row(ss, row) * QSCALE;
#pragma unroll
                for (int bj = 0; bj < 2; ++bj) *(u32x4*)(qb + (size_t)row * D + col0 + bj * HALF) = pack8(acc[ai][bj][m][0] * r, acc[ai][bj][m][1] * r); }
    }
};
}

#define GAS __attribute__((address_space(1)))
#define LAS __attribute__((address_space(3)))
typedef unsigned v4u __attribute__((ext_vector_type(4)));
typedef float f32x4 __attribute__((ext_vector_type(4)));
typedef short bf16x8 __attribute__((ext_vector_type(8)));
typedef GAS unsigned gu32;
typedef GAS unsigned long long gu64;
#define RLX_AGENT __ATOMIC_RELAXED, __HIP_MEMORY_SCOPE_AGENT
#define LDS_WAIT() asm volatile("s_waitcnt lgkmcnt(0)" ::: "memory")
#define VM_WAIT() asm volatile("s_waitcnt vmcnt(0)" ::: "memory")
__device__ __forceinline__ unsigned long long rt() { return __builtin_amdgcn_s_memrealtime(); }
__device__ __forceinline__ unsigned pk2(float lo, float hi) { return f2bf(lo) | (f2bf(hi) << 16); }

#define XB_TMO      128
#define XB_XCNT(j)  (256  + 64 * (j))
#define XB_XSUB(j)  (1280 + 64 * (j))
#define XB_XGEN(j)  (2304 + 64 * (j))
#define XB_TOP      3328
#define XB_TOPGEN   3392
#define XCD_BAR_WORDS 3456
#define XB_SPIN_CAP (1u << 18)

__device__ __forceinline__ unsigned xb_ld(unsigned* p)              { return __hip_atomic_load(p, __ATOMIC_RELAXED, __HIP_MEMORY_SCOPE_AGENT); }
__device__ __forceinline__ unsigned xb_add(unsigned* p, unsigned v) { return __hip_atomic_fetch_add(p, v, __ATOMIC_RELAXED, __HIP_MEMORY_SCOPE_AGENT); }
__device__ __forceinline__ unsigned xb_xcc_id() { return (unsigned)__builtin_amdgcn_s_getreg((3 << 11) | 20) & 0xFu; }
#define XB_SPIN(cond, bar) do { unsigned _sp = 0; while (cond) { __builtin_amdgcn_s_sleep(1); \
    if ((++_sp & 255u) == 0u) { if (xb_ld(&(bar)[XB_TMO])) break; if (_sp > XB_SPIN_CAP) { atomicAdd(&(bar)[XB_TMO], 1u); break; } } } } while (0)

struct XcdBarrier {
    unsigned* bar; unsigned x;
    volatile LAS unsigned* st;
};

__device__ __forceinline__ XcdBarrier xcd_barrier_post(unsigned* bar, volatile LAS unsigned* st) {
    XcdBarrier b; b.bar = bar; b.x = xb_xcc_id(); b.st = st;
    if (threadIdx.x == 0) (void)xb_add(&bar[XB_XCNT(b.x)], 1u);
    return b;
}
__device__ __forceinline__ void xcd_barrier_complete(unsigned* bar, unsigned x, unsigned& nloc, unsigned& nx) {
    const unsigned G = gridDim.x * gridDim.y * gridDim.z;
    unsigned sum, cnt, mine, sp = 0u;
    for (;;) {
        sum = 0u; cnt = 0u; mine = 0u;
#pragma unroll
        for (unsigned j = 0; j < 16; ++j) { const unsigned c = xb_ld(&bar[XB_XCNT(j)]); sum += c; cnt += (c > 0u) ? 1u : 0u; mine = (j == x) ? c : mine; }
        if (sum == G) break;
        __builtin_amdgcn_s_sleep(1);
        if ((++sp & 255u) == 0u) { if (xb_ld(&bar[XB_TMO])) break; if (sp > XB_SPIN_CAP) { atomicAdd(&bar[XB_TMO], 1u); break; } }
    }
    nloc = mine > 0u ? mine : 1u; nx = cnt > 0u ? cnt : 1u;
}

__device__ __forceinline__ void xcd_barrier(const XcdBarrier& b) {
    asm volatile("s_waitcnt vmcnt(0)" ::: "memory");
    __syncthreads();
    if (threadIdx.x == 0) {
        unsigned* bar = b.bar;
        __builtin_amdgcn_s_waitcnt(0);
        unsigned nloc = b.st[0], nx = b.st[1];
        if (nloc == 0u) { xcd_barrier_complete(bar, b.x, nloc, nx); b.st[0] = nloc; b.st[1] = nx; }
        const unsigned old = xb_add(&bar[XB_XSUB(b.x)], 1u);
        const unsigned gen = old / nloc;
        if (old + 1u == (gen + 1u) * nloc) {
            __builtin_amdgcn_fence(__ATOMIC_RELEASE, "agent");
            asm volatile("s_waitcnt vmcnt(0)" ::: "memory");
            const unsigned og = xb_add(&bar[XB_TOP], 1u);
            const unsigned tg = og / nx;
            if (og + 1u == (tg + 1u) * nx) xb_add(&bar[XB_TOPGEN], 1u);
            else XB_SPIN(xb_ld(&bar[XB_TOPGEN]) == tg, bar);
            __builtin_amdgcn_fence(__ATOMIC_ACQUIRE, "agent");
            xb_add(&bar[XB_XGEN(b.x)], 1u);
            asm volatile("s_waitcnt vmcnt(0)" ::: "memory");
        } else {
            XB_SPIN(xb_ld(&bar[XB_XGEN(b.x)]) == gen, bar);
            __builtin_amdgcn_fence(__ATOMIC_ACQUIRE, "agent");
            asm volatile("s_waitcnt vmcnt(0)" ::: "memory");
        }
    }
    __syncthreads();
}

namespace sb {
__device__ __forceinline__ void transpose_item(const float* W, int ldw, int c0, const float* gain, bf16_t* WT, int K, int n0, int k0, LAS float* scr, int lane) {
#pragma unroll 8
    for (int i = 0; i < 32; ++i) { const int kk = 2 * i + (lane >> 5); float v = W[(size_t)(k0 + kk) * ldw + c0 + (lane & 31)]; if (gain) v *= gain[k0 + kk]; scr[kk * 33 + (lane & 31)] = v; }
    LDS_WAIT(); asm volatile("" ::: "memory");
    const int c = lane & 7;
#pragma unroll
    for (int j = 0; j < 4; ++j) { const int n = (lane >> 3) + 8 * j; const LAS float* s = scr + (8 * c) * 33 + n;
        v4u o; o.x = pk2(s[0 * 33], s[1 * 33]); o.y = pk2(s[2 * 33], s[3 * 33]); o.z = pk2(s[4 * 33], s[5 * 33]); o.w = pk2(s[6 * 33], s[7 * 33]);
        *(GAS v4u*)(WT + (size_t)(n0 + n) * K + k0 + 8 * c) = o; }
    LDS_WAIT(); asm volatile("" ::: "memory");
}
template <int MAP>
__device__ __forceinline__ void transpose_job_item(const float* W0, const float* W1, const float* gain, bf16_t* WT, int K, int N, int ldw, int item, LAS float* scr, int lane) {
    const int nblk = N / 32, kb = item / nblk, nb = item % nblk, n0 = 32 * nb, k0 = 64 * kb;
    const float* W = W0; int c0 = n0;
    if (MAP == 1) { const int pn = n0 / 256, half = (n0 % 256) / 128, jj = n0 % 128; W = half ? W1 : W0; c0 = pn * 128 + jj; }
    if (MAP == 2) { if (n0 >= 512) { const int m = n0 - 512, pc = m / 256, half = (m % 256) / 128, jj = m % 128; c0 = 512 + half * 512 + pc * 128 + jj; } }
    if (MAP == 3) { if (n0 >= 1024) { W = W1; c0 = n0 - 1024; } }
    transpose_item(W, ldw, c0, gain, WT, K, n0, k0, scr, lane);
}
__device__ __forceinline__ void row_bf16_ss(const float* xr, bf16_t* orow, float* ssrow, float* rstd1, int lane) {
    float s = 0.f;
#pragma unroll
    for (int j = 0; j < 4; ++j) { const f32x4 v = *(const f32x4*)(xr + j * 256 + lane * 4); s += (v.x * v.x + v.y * v.y) + (v.z * v.z + v.w * v.w);
        uint2 o; o.x = pk2(v.x, v.y); o.y = pk2(v.z, v.w); *(uint2*)(orow + j * 256 + lane * 4) = o; }
    s = wave_sum(s);
    if (lane < 16) ssrow[lane] = lane == 0 ? s : 0.f;
    if (rstd1 && lane == 0) *rstd1 = rsqrtf(s * (1.f / D) + EPS);
}

__device__ __forceinline__ void s5_task(int task, const bf16_t* ug, const float* h0re, const float* h0im, const float* a_re, const float* a_im, const float* log_dt,
                                        const float* b_re, const float* b_im, const float* c_re, const float* c_im, const float* dskip, bf16_t* gb, float* out, int n) {
    const int g = task % NG, sq = task / NG;
    const bool prompt = sq < NBATCH; const int b = prompt ? sq : sq - NBATCH, T = prompt ? SEQ : DECS, row0 = prompt ? b * SEQ : MP + b * DECS;
    const float dt = expf(log_dt[g]), lr = a_re[g * NST + n], li = a_im[g * NST + n];
    const float mag = expf(lr * dt), abr = mag * cosf(li * dt), abi = mag * sinf(li * dt);
    const float den = lr * lr + li * li, nr = abr - 1.f, ni = abi, cr = (nr * lr + ni * li) / den, ci = (ni * lr - nr * li) / den;
    float Br[16], Bi[16], Cr[16], Ci[16];
#pragma unroll
    for (int c = 0; c < 16; ++c) { const float br = b_re[((size_t)g * NST + n) * 16 + c], bi = b_im[((size_t)g * NST + n) * 16 + c];
        Br[c] = cr * br - ci * bi; Bi[c] = cr * bi + ci * br; Cr[c] = c_re[((size_t)g * 16 + c) * NST + n]; Ci[c] = c_im[((size_t)g * 16 + c) * NST + n]; }
    float hr = 0.f, hi = 0.f;
    if (!prompt) { hr = h0re[((size_t)b * NG + g) * NST + n]; hi = h0im[((size_t)b * NG + g) * NST + n]; }
    const float dsk = dskip[g * 16 + (n & 15)];
    for (int t = 0; t < T; ++t) {
        const bf16_t* up = ug + ((size_t)g * M + row0 + t) * 16;
        const v4u w0 = *(const v4u*)up, w1 = *(const v4u*)(up + 8);
        float u[16];
        u[0] = __builtin_bit_cast(float, w0.x << 16); u[1] = __builtin_bit_cast(float, w0.x & 0xffff0000u); u[2] = __builtin_bit_cast(float, w0.y << 16); u[3] = __builtin_bit_cast(float, w0.y & 0xffff0000u);
        u[4] = __builtin_bit_cast(float, w0.z << 16); u[5] = __builtin_bit_cast(float, w0.z & 0xffff0000u); u[6] = __builtin_bit_cast(float, w0.w << 16); u[7] = __builtin_bit_cast(float, w0.w & 0xffff0000u);
        u[8] = __builtin_bit_cast(float, w1.x << 16); u[9] = __builtin_bit_cast(float, w1.x & 0xffff0000u); u[10] = __builtin_bit_cast(float, w1.y << 16); u[11] = __builtin_bit_cast(float, w1.y & 0xffff0000u);
        u[12] = __builtin_bit_cast(float, w1.z << 16); u[13] = __builtin_bit_cast(float, w1.z & 0xffff0000u); u[14] = __builtin_bit_cast(float, w1.w << 16); u[15] = __builtin_bit_cast(float, w1.w & 0xffff0000u);
        float xr = 0.f, xi = 0.f;
#pragma unroll
        for (int c = 0; c < 16; ++c) { xr += Br[c] * u[c]; xi += Bi[c] * u[c]; }
        const float nhr = abr * hr - abi * hi + xr, nhi = abr * hi + abi * hr + xi; hr = nhr; hi = nhi;
        float ymine = 0.f;
#pragma unroll
        for (int c = 0; c < 16; ++c) { const float y = wave_sum(Cr[c] * hr - Ci[c] * hi); if ((n & 15) == c) ymine = y + dsk * u[c]; }
        if (n < 16) gb[(size_t)(row0 + t) * SSM + g * 16 + n] = (bf16_t)f2bf(gelu_tanh(ymine));
    }
    if (prompt) { out[O_SRP + ((size_t)b * NG + g) * NST + n] = hr; out[O_SIP + ((size_t)b * NG + g) * NST + n] = hi; }
    else { out[O_SRS + ((size_t)b * NG + g) * NST + n] = hr; out[O_SIS + ((size_t)b * NG + g) * NST + n] = hi; }
}

__device__ __forceinline__ void conv_row(int row, const bf16_t* vb, const float* cache, const float* w, const float* bias, const float* lg, const float* lb, bf16_t* mixb, float* out, LAS float* red, int c) {
    float y = bias[c];
    if (row < MP) { const int t = row % SEQ;
        for (int k = 0; k < CWID; ++k) { const int tt = t - 30 + k; if (tt >= 0) y += w[k * CONVD + c] * bf2f(vb[(size_t)(row - 30 + k) * CONVD + c]); }
    } else { const int rs = row - MP, b = rs / DECS, t = rs % DECS;
        for (int k = 0; k < CWID; ++k) { const int idx = t + k; const float xv = idx < 30 ? cache[((size_t)b * 30 + idx) * CONVD + c] : bf2f(vb[(size_t)(MP + b * DECS + idx - 30) * CONVD + c]); y += w[k * CONVD + c] * xv; }
        if (t == 0) for (int j = 0; j < 22; ++j) out[O_CVS + ((size_t)b * 30 + j) * CONVD + c] = cache[((size_t)b * 30 + j + 8) * CONVD + c];
    }
    float s = wave_sum(y); if ((c & 63) == 0) red[c >> 6] = s; __syncthreads();
    float mu = 0.f;
#pragma unroll
    for (int i = 0; i < 8; ++i) mu += red[i];
    mu *= (1.f / CONVD);
    const float d = y - mu; float q = wave_sum(d * d); if ((c & 63) == 0) red[8 + (c >> 6)] = q; __syncthreads();
    float var = 0.f;
#pragma unroll
    for (int i = 0; i < 8; ++i) var += red[8 + i];
    var *= (1.f / CONVD);
    const float z = d * rsqrtf(var + EPS) * lg[c] + lb[c];
    mixb[(size_t)row * D + SSM + c] = (bf16_t)f2bf(siluf_(z));
}

__device__ __forceinline__ void attn_task(int task, const bf16_t* qb, const bf16_t* kb, const bf16_t* vb2, const float* ck, const float* cv, bf16_t* ob, LAS float* scr, int t256) {
    LAS float* q = scr; LAS float* p = scr + 2048; LAS float* red = scr + 4096;
    const int rg = task >> 2, h = task & 3, row0 = rg * 8; const bool prompt = row0 < MP; const int b = prompt ? row0 / SEQ : (row0 - MP) / DECS;
#pragma unroll
    for (int r = 0; r < 8; ++r) q[r * 256 + t256] = bf2f(qb[(size_t)(row0 + r) * D + h * HD + t256]);
    __syncthreads();
    float s[8];
#pragma unroll
    for (int r = 0; r < 8; ++r) s[r] = 0.f;
    if (prompt) { const bf16_t* kr = kb + ((size_t)b * NMEM + t256) * D + h * HD;
        for (int d = 0; d < HD; d += 8) { const v4u w = *(const v4u*)(kr + d); float kv[8];
            kv[0] = __builtin_bit_cast(float, w.x << 16); kv[1] = __builtin_bit_cast(float, w.x & 0xffff0000u); kv[2] = __builtin_bit_cast(float, w.y << 16); kv[3] = __builtin_bit_cast(float, w.y & 0xffff0000u);
            kv[4] = __builtin_bit_cast(float, w.z << 16); kv[5] = __builtin_bit_cast(float, w.z & 0xffff0000u); kv[6] = __builtin_bit_cast(float, w.w << 16); kv[7] = __builtin_bit_cast(float, w.w & 0xffff0000u);
#pragma unroll
            for (int r = 0; r < 8; ++r)
#pragma unroll
                for (int j = 0; j < 8; ++j) s[r] += q[r * 256 + d + j] * kv[j]; }
    } else { const float* kr = ck + ((size_t)b * NMEM + t256) * D + h * HD;
        for (int d = 0; d < HD; d += 4) { const f32x4 kv = *(const f32x4*)(kr + d);
#pragma unroll
            for (int r = 0; r < 8; ++r) s[r] += (q[r * 256 + d] * kv.x + q[r * 256 + d + 1] * kv.y) + (q[r * 256 + d + 2] * kv.z + q[r * 256 + d + 3] * kv.w); }
    }
    const int w4 = t256 >> 6;
#pragma unroll
    for (int r = 0; r < 8; ++r) { float mx = s[r];
#pragma unroll
        for (int o = 1; o < 64; o <<= 1) mx = fmaxf(mx, __shfl_xor(mx, o));
        if ((t256 & 63) == 0) red[r * 4 + w4] = mx; }
    __syncthreads();
    float e[8];
#pragma unroll
    for (int r = 0; r < 8; ++r) { const float mx = fmaxf(fmaxf(red[r * 4], red[r * 4 + 1]), fmaxf(red[r * 4 + 2], red[r * 4 + 3])); e[r] = exp2f(s[r] - mx); }
    __syncthreads();
#pragma unroll
    for (int r = 0; r < 8; ++r) { const float sm = wave_sum(e[r]); if ((t256 & 63) == 0) red[r * 4 + w4] = sm; }
    __syncthreads();
#pragma unroll
    for (int r = 0; r < 8; ++r) { const float sm = (red[r * 4] + red[r * 4 + 1]) + (red[r * 4 + 2] + red[r * 4 + 3]); p[r * 256 + t256] = e[r] / sm; }
    __syncthreads();
    float o[8];
#pragma unroll
    for (int r = 0; r < 8; ++r) o[r] = 0.f;
    if (prompt) { const bf16_t* vr = vb2 + (size_t)b * NMEM * D + h * HD + t256;
        for (int m = 0; m < NMEM; ++m) { const float vv = bf2f(vr[(size_t)m * D]);
#pragma unroll
            for (int r = 0; r < 8; ++r) o[r] += p[r * 256 + m] * vv; }
    } else { const float* vr = cv + (size_t)b * NMEM * D + h * HD + t256;
        for (int m = 0; m < NMEM; ++m) { const float vv = vr[(size_t)m * D];
#pragma unroll
            for (int r = 0; r < 8; ++r) o[r] += p[r * 256 + m] * vv; }
    }
#pragma unroll
    for (int r = 0; r < 8; ++r) ob[(size_t)(row0 + r) * D + h * HD + t256] = (bf16_t)f2bf(o[r]);
    __syncthreads();
}
}

namespace s5f {
typedef short bf16x8 __attribute__((ext_vector_type(8)));
constexpr int KT_OFF = 0, KT_BYTES = 65 * 256 * 2, U_OFF = 33792, U_CSTR = 2064, S_OFF = U_OFF + 32 * U_CSTR, H_OFF = S_OFF + 32 * 128 * 4, H_RSTR = 272, END_OFF = H_OFF + 32 * H_RSTR;
static_assert(KT_BYTES <= U_OFF && END_OFF <= 131072, "S5 LDS map");
constexpr size_t TAB_KT = 0, TAB_P = 2 * MiB, TAB_Q = 10 * MiB, TAB_AL = 18 * MiB;
struct cf { float re, im; };
typedef float f32x2v __attribute__((ext_vector_type(2)));
typedef unsigned u32x2v __attribute__((ext_vector_type(2)));
__device__ __forceinline__ f32x2v tov(cf a) { return (f32x2v){a.re, a.im}; }
__device__ __forceinline__ cf toc(f32x2v a) { return cf{a.x, a.y}; }
__device__ __forceinline__ cf cmul(cf a, cf b) { return cf{a.re * b.re - a.im * b.im, a.re * b.im + a.im * b.re}; }
__device__ __forceinline__ cf cpow_a(float lr, float li, float dt, float p) { const float mag = expf(lr * dt * p); float s, c; sincosf(li * dt * p, &s, &c); return cf{mag * c, mag * s}; }
__device__ __forceinline__ cf coef_of(float lr, float li, float dt) { const cf a = cpow_a(lr, li, dt, 1.f); const float den = lr * lr + li * li, nr = a.re - 1.f, ni = a.im; return cf{(nr * lr + ni * li) / den, (ni * lr - nr * li) / den}; }

__device__ __forceinline__ void kt_task(int task, const float* a_re, const float* a_im, const float* log_dt, const float* b_re, const float* b_im, const float* c_re, const float* c_im,
                                        bf16_t* Ktab, LAS unsigned char* scr, int tid) {
    const int g = task >> 3, tb = task & 7;
    LAS f32x2v* Wb = (LAS f32x2v*)scr; LAS f32x2v* Bb = (LAS f32x2v*)(scr + 4096); LAS f32x2v* Cc = (LAS f32x2v*)(scr + 4096 + 8192);
    const float dt = expf(log_dt[g]);
    { const int tl = tid >> 6, n = tid & 63; Wb[tl * 64 + n] = tov(cpow_a(a_re[g * NST + n], a_im[g * NST + n], dt, (float)(8 * tb + tl))); }
#pragma unroll
    for (int e = tid; e < 1024; e += 512) { const int n = e >> 4, c = e & 15; const cf co = coef_of(a_re[g * NST + n], a_im[g * NST + n], dt);
        Bb[e] = tov(cmul(co, cf{b_re[((size_t)g * NST + n) * 16 + c], b_im[((size_t)g * NST + n) * 16 + c]})); }
#pragma unroll
    for (int e = tid; e < 1024; e += 512) Cc[e] = (f32x2v){c_re[(size_t)g * 1024 + e], c_im[(size_t)g * 1024 + e]};
    __syncthreads();
    { const int tl = tid >> 6, cc = tid & 63, c = cc >> 2, c0 = 4 * (cc & 3); float acc[4] = {0.f, 0.f, 0.f, 0.f};
        for (int n = 0; n < 64; ++n) { const cf T = cmul(toc(Cc[c * 64 + n]), toc(Wb[tl * 64 + n]));
#pragma unroll
            for (int k = 0; k < 4; ++k) { const cf E = toc(Bb[n * 16 + c0 + k]); acc[k] += T.re * E.re - T.im * E.im; } }
        uint2 o; o.x = pk2(acc[0], acc[1]); o.y = pk2(acc[2], acc[3]);
        *(uint2*)(Ktab + (((size_t)g * 65 + 8 * tb + tl + 1) * 16 + c) * 16 + c0) = o; }
    if (tb == 0 && tid < 32) *(v4u*)(Ktab + (size_t)g * 65 * 256 + tid * 8) = (v4u){0u, 0u, 0u, 0u};
    __syncthreads();
}
__device__ __forceinline__ void pq_entry(int e, const float* a_re, const float* a_im, const float* log_dt, const float* b_re, const float* b_im, const float* c_re, const float* c_im,
                                         bf16_t* Ptab, bf16_t* Qtab, float* ALtab) {
    {
        const int n = e & 63, j = (e >> 6) & 63, g = e >> 12; const float dt = expf(log_dt[g]);
        const cf W = cpow_a(a_re[g * NST + n], a_im[g * NST + n], dt, (float)(j + 1));
#pragma unroll
        for (int c = 0; c < 16; ++c) { const cf w = cmul(cf{c_re[((size_t)g * 16 + c) * NST + n], c_im[((size_t)g * 16 + c) * NST + n]}, W);
            bf16_t* p = Ptab + (((size_t)g * 64 + j) * 16 + c) * 128; p[n] = (bf16_t)f2bf(w.re); p[64 + n] = (bf16_t)f2bf(-w.im); }
        if (j == 0) { const cf al = cpow_a(a_re[g * NST + n], a_im[g * NST + n], dt, 64.f); ALtab[(g * NST + n) * 2] = al.re; ALtab[(g * NST + n) * 2 + 1] = al.im; }
    }
    {
        const int i = e & 63, n = (e >> 6) & 63, g = e >> 12; const float dt = expf(log_dt[g]);
        const float lr = a_re[g * NST + n], li = a_im[g * NST + n];
        const cf V = cmul(cpow_a(lr, li, dt, (float)(63 - i)), coef_of(lr, li, dt));
        unsigned wr[8], wi[8];
#pragma unroll
        for (int c = 0; c < 16; c += 2) { const cf v0 = cmul(V, cf{b_re[((size_t)g * NST + n) * 16 + c], b_im[((size_t)g * NST + n) * 16 + c]}), v1 = cmul(V, cf{b_re[((size_t)g * NST + n) * 16 + c + 1], b_im[((size_t)g * NST + n) * 16 + c + 1]});
            wr[c >> 1] = pk2(v0.re, v1.re); wi[c >> 1] = pk2(v0.im, v1.im); }
        v4u* qr = (v4u*)(Qtab + ((size_t)g * 128 + n) * 1024 + i * 16); v4u* qi = (v4u*)(Qtab + ((size_t)g * 128 + 64 + n) * 1024 + i * 16);
        qr[0] = (v4u){wr[0], wr[1], wr[2], wr[3]}; qr[1] = (v4u){wr[4], wr[5], wr[6], wr[7]}; qi[0] = (v4u){wi[0], wi[1], wi[2], wi[3]}; qi[1] = (v4u){wi[4], wi[5], wi[6], wi[7]};
    }
}
__device__ __forceinline__ float gelu_fast(float x) { const float u = 1.5957691216057308f * (x + 0.044715f * x * x * x); return x * __builtin_amdgcn_rcpf(1.f + __builtin_amdgcn_exp2f(-1.4426950408889634f * u)); }

__device__ __forceinline__ void prompt_unit(int b, int g, const bf16_t* ug, const bf16_t* Ktab, const bf16_t* Ptab, const bf16_t* Qtab, const float* ALtab, const float* dskip, bf16_t* gb, float* out,
                                            LAS unsigned char* L, int tid, int wave, int lane) {
    {
        const v4u* src = (const v4u*)(Ktab + (size_t)g * 65 * 256);
        for (int q = tid; q < KT_BYTES / 16; q += 512) *(LAS v4u*)(L + KT_OFF + q * 16) = src[q];
        const v4u* us = (const v4u*)(ug + ((size_t)g * M + (size_t)b * SEQ) * 16);
#pragma unroll
        for (int p = 0; p < 8; ++p) { const int q = p * 512 + tid; *(LAS v4u*)(L + U_OFF + (q >> 7) * U_CSTR + (q & 127) * 16) = us[q]; }
    }
    __syncthreads();
    const int fr = lane & 15, kq = lane >> 4;
    const LAS unsigned char* ub0 = L + U_OFF + fr * U_CSTR + kq * 16; const LAS unsigned char* ub1 = ub0 + 16 * U_CSTR;
    {
        f32x4 a0 = {0.f, 0.f, 0.f, 0.f}, a1 = {0.f, 0.f, 0.f, 0.f};
        const bf16_t* qrow = Qtab + ((size_t)g * 128 + wave * 16 + fr) * 1024 + kq * 8;
#pragma unroll 4
        for (int s = 0; s < 32; ++s) { const bf16x8 a = *(const bf16x8*)(qrow + s * 32);
            a0 = __builtin_amdgcn_mfma_f32_16x16x32_bf16(a, *(const LAS bf16x8*)(ub0 + s * 64), a0, 0, 0, 0);
            a1 = __builtin_amdgcn_mfma_f32_16x16x32_bf16(a, *(const LAS bf16x8*)(ub1 + s * 64), a1, 0, 0, 0); }
        *(LAS f32x4*)(L + S_OFF + (fr * 128 + wave * 16 + kq * 4) * 4) = a0;
        *(LAS f32x4*)(L + S_OFF + ((16 + fr) * 128 + wave * 16 + kq * 4) * 4) = a1;
    }
    __syncthreads();
    if (tid < 64) {
        const int n = tid; const float alr = ALtab[(g * NST + n) * 2], ali = ALtab[(g * NST + n) * 2 + 1]; float hr = 0.f, hi = 0.f;
        const LAS float* Sb = (const LAS float*)(L + S_OFF);
        for (int c = 0; c < 32; ++c) { LAS bf16_t* hb = (LAS bf16_t*)(L + H_OFF + c * H_RSTR); hb[n] = (bf16_t)f2bf(hr); hb[64 + n] = (bf16_t)f2bf(hi);
            const float sr = Sb[c * 128 + n], si = Sb[c * 128 + 64 + n]; const float nhr = alr * hr - ali * hi + sr, nhi = alr * hi + ali * hr + si; hr = nhr; hi = nhi; }
        out[O_SRP + ((size_t)b * NG + g) * NST + n] = hr; out[O_SIP + ((size_t)b * NG + g) * NST + n] = hi;
    }
    __syncthreads();
    f32x4 acc[8][2];
#pragma unroll
    for (int q = 0; q < 8; ++q) { acc[q][0] = (f32x4){0.f, 0.f, 0.f, 0.f}; acc[q][1] = (f32x4){0.f, 0.f, 0.f, 0.f}; }
    {
        const LAS unsigned char* kt = L + KT_OFF + (fr * 16 + (kq & 1) * 8) * 2 + (wave + 1 - (kq >> 1)) * 512;
        const int smax = (wave + 56) >> 1;
        for (int s = 0; s <= smax; ++s) {
            const bf16x8 b0 = *(const LAS bf16x8*)(ub0 + s * 64), b1 = *(const LAS bf16x8*)(ub1 + s * 64);
#pragma unroll
            for (int q = 0; q < 8; ++q) if (wave + 8 * q >= 2 * s) { const bf16x8 a = *(const LAS bf16x8*)(kt + (8 * q - 2 * s) * 512);
                acc[q][0] = __builtin_amdgcn_mfma_f32_16x16x32_bf16(a, b0, acc[q][0], 0, 0, 0); acc[q][1] = __builtin_amdgcn_mfma_f32_16x16x32_bf16(a, b1, acc[q][1], 0, 0, 0); }
        }
    }
    {
        const LAS unsigned char* hb0 = L + H_OFF + fr * H_RSTR + kq * 16; const LAS unsigned char* hb1 = hb0 + 16 * H_RSTR;
        const bf16_t* prow = Ptab + (((size_t)g * 64 + wave) * 16 + fr) * 128 + kq * 8;
#pragma unroll
        for (int s2 = 0; s2 < 4; ++s2) { const bf16x8 b0 = *(const LAS bf16x8*)(hb0 + s2 * 64), b1 = *(const LAS bf16x8*)(hb1 + s2 * 64);
#pragma unroll
            for (int q = 0; q < 8; ++q) { const bf16x8 a = *(const bf16x8*)(prow + (size_t)q * 8 * 16 * 128 + s2 * 32);
                acc[q][0] = __builtin_amdgcn_mfma_f32_16x16x32_bf16(a, b0, acc[q][0], 0, 0, 0); acc[q][1] = __builtin_amdgcn_mfma_f32_16x16x32_bf16(a, b1, acc[q][1], 0, 0, 0); } }
    }
    {
        const f32x4 dsk = *(const f32x4*)(dskip + g * 16 + kq * 4);
#pragma unroll
        for (int q = 0; q < 8; ++q)
#pragma unroll
            for (int nb = 0; nb < 2; ++nb) { const int chunk = nb * 16 + fr, j = wave + 8 * q;
                const u32x2v uw = *(const LAS u32x2v*)(L + U_OFF + chunk * U_CSTR + (j * 16 + kq * 4) * 2);
                const f32x4 u4 = {__builtin_bit_cast(float, uw.x << 16), __builtin_bit_cast(float, uw.x & 0xffff0000u), __builtin_bit_cast(float, uw.y << 16), __builtin_bit_cast(float, uw.y & 0xffff0000u)};
                const f32x4 y = acc[q][nb] + dsk * u4;
                uint2 o; o.x = pk2(gelu_fast(y[0]), gelu_fast(y[1])); o.y = pk2(gelu_fast(y[2]), gelu_fast(y[3]));
                *(uint2*)(gb + ((size_t)b * SEQ + chunk * 64 + j) * SSM + g * 16 + kq * 4) = o; }
    }
    __syncthreads();
}
}

namespace att {
typedef short bf16x8 __attribute__((ext_vector_type(8)));
typedef float f32x16 __attribute__((ext_vector_type(16)));
typedef float f32x2v __attribute__((ext_vector_type(2)));
typedef unsigned u32x2v __attribute__((ext_vector_type(2)));
__device__ __forceinline__ int crow(int r, int hi) { return (r & 3) + 8 * (r >> 2) + 4 * hi; }
__device__ __forceinline__ unsigned cvtpk(float lo, float hi) { return pg8::cvt_pk_bf16(lo, hi); }

__device__ __forceinline__ void prompt_unit(int b, int h, int qblk, const bf16_t* qb, const bf16_t* kb, const bf16_t* vT, bf16_t* ob, LAS unsigned char* L, LAS float* wsf, int tid, int wave, int lane) {
    const int r32 = lane & 31, hh = lane >> 5, x = r32 & 15;
    const bf16_t* Kg = kb + (size_t)b * NMEM * D + h * HD;
    for (int half = 0; half < 2; ++half)
#pragma unroll 4
        for (int p = 0; p < 8; ++p) { const int q = p * 512 + tid, mem = q >> 4, c16 = q & 15;
            *(LAS v4u*)(L + half * 65536 + mem * 256 + ((c16 ^ (mem & 15)) << 4)) = *(const v4u*)(Kg + (size_t)mem * D + half * 128 + c16 * 8); }
    const size_t qrow = (size_t)b * SEQ + qblk * 256 + wave * 32 + r32;
    const bf16_t* Qg = qb + qrow * D + h * HD + hh * 8;
    unsigned koff[8];
#pragma unroll
    for (int ks = 0; ks < 8; ++ks) koff[ks] = (unsigned)(((2 * ks + hh) ^ x) << 4);
    __syncthreads();
    f32x16 S[8];
#pragma unroll
    for (int mb = 0; mb < 8; ++mb)
#pragma unroll
        for (int r = 0; r < 16; ++r) S[mb][r] = 0.f;
#pragma unroll
    for (int half = 0; half < 2; ++half) {
        bf16x8 qf[8];
#pragma unroll
        for (int ks = 0; ks < 8; ++ks) qf[ks] = *(const bf16x8*)(Qg + half * 128 + ks * 16);
        const LAS unsigned char* kbase = L + half * 65536 + r32 * 256;
#pragma unroll
        for (int mb = 0; mb < 8; ++mb) {
#pragma unroll
            for (int ks = 0; ks < 8; ++ks) S[mb] = __builtin_amdgcn_mfma_f32_32x32x16_bf16(*(const LAS bf16x8*)(kbase + mb * 8192 + koff[ks]), qf[ks], S[mb], 0, 0, 0);
            asm volatile("" : "+v"(S[mb])); __builtin_amdgcn_sched_barrier(0); }
    }
    __syncthreads();
    const bf16_t* Vg = vT + (size_t)h * HD * MMEM + (size_t)b * NMEM;
    for (int dh = 0; dh < 2; ++dh)
#pragma unroll 4
        for (int p = 0; p < 8; ++p) { const int q = p * 512 + tid, dd = q >> 5, c32 = q & 31;
            *(LAS v4u*)(L + dh * 65536 + dd * 512 + ((c32 ^ (dd & 15)) << 4)) = *(const v4u*)(Vg + (size_t)(dh * 128 + dd) * MMEM + c32 * 8); }
    float mx = S[0][0];
#pragma unroll
    for (int mb = 0; mb < 8; ++mb)
#pragma unroll
        for (int r = 0; r < 16; ++r) mx = fmaxf(mx, S[mb][r]);
    mx = fmaxf(mx, __shfl_xor(mx, 32));
    float lsum = 0.f;
    v4u pa[8][2];
#pragma unroll
    for (int mb = 0; mb < 8; ++mb) {
#pragma unroll
        for (int r = 0; r < 16; ++r) { const float e = __builtin_amdgcn_exp2f(S[mb][r] - mx); S[mb][r] = e; lsum += e; }
#pragma unroll
        for (int s = 0; s < 2; ++s) pa[mb][s] = (v4u){cvtpk(S[mb][8 * s], S[mb][8 * s + 1]), cvtpk(S[mb][8 * s + 2], S[mb][8 * s + 3]), cvtpk(S[mb][8 * s + 4], S[mb][8 * s + 5]), cvtpk(S[mb][8 * s + 6], S[mb][8 * s + 7])};
    }
    lsum += __shfl_xor(lsum, 32);
    if (hh == 0) wsf[r32] = lsum;
    __syncthreads();
    unsigned voff[2][4];
#pragma unroll
    for (int s = 0; s < 2; ++s)
#pragma unroll
        for (int ml = 0; ml < 4; ++ml) voff[s][ml] = (unsigned)(((4 * ml + 2 * s) ^ (hh ^ x)) << 4);
    bf16_t* Og = ob + ((size_t)b * SEQ + qblk * 256 + wave * 32 + 4 * hh) * D + h * HD + r32;
#pragma unroll
    for (int dh = 0; dh < 2; ++dh) {
        f32x16 O[4];
#pragma unroll
        for (int db = 0; db < 4; ++db)
#pragma unroll
            for (int r = 0; r < 16; ++r) O[db][r] = 0.f;
        const LAS unsigned char* vbase = L + dh * 65536 + r32 * 512;
#pragma unroll
        for (int mb = 0; mb < 8; ++mb)
#pragma unroll
            for (int s = 0; s < 2; ++s) { const bf16x8 a = __builtin_bit_cast(bf16x8, pa[mb][s]);
#pragma unroll
                for (int db = 0; db < 4; ++db)
                    O[db] = __builtin_amdgcn_mfma_f32_32x32x16_bf16(a, *(const LAS bf16x8*)(vbase + db * 16384 + (mb >> 2) * 256 + voff[s][mb & 3]), O[db], 0, 0, 0);
                asm volatile("" : "+v"(O[0]), "+v"(O[1]), "+v"(O[2]), "+v"(O[3])); __builtin_amdgcn_sched_barrier(0); }
#pragma unroll
        for (int r = 0; r < 16; ++r) { const float rl = __builtin_amdgcn_rcpf(wsf[crow(r, hh)]);
#pragma unroll
            for (int db = 0; db < 4; ++db) Og[(size_t)((r & 3) + 8 * (r >> 2)) * D + dh * 128 + db * 32] = (bf16_t)f2bf(O[db][r] * rl);
            __builtin_amdgcn_sched_barrier(0); }
    }
    __syncthreads();
}

__device__ __forceinline__ void sample_unit(int b, int hp, const bf16_t* qb, const float* ck, const float* cv, bf16_t* ob, LAS unsigned char* L, int tid, int wave, int lane) {
    const int hsel = wave >> 2, mq = wave & 3, head = 2 * hp + hsel;
    LAS float* sbuf = (LAS float*)L; LAS float* pT = (LAS float*)(L + 16384); LAS float* obuf = (LAS float*)(L + 32768);
    float q[8][4];
#pragma unroll
    for (int t = 0; t < 8; ++t) { const u32x2v w = *(const u32x2v*)(qb + ((size_t)MP + b * DECS + t) * D + head * HD + lane * 4);
        q[t][0] = __builtin_bit_cast(float, w.x << 16); q[t][1] = __builtin_bit_cast(float, w.x & 0xffff0000u); q[t][2] = __builtin_bit_cast(float, w.y << 16); q[t][3] = __builtin_bit_cast(float, w.y & 0xffff0000u); }
    const float* Kr = ck + (((size_t)b * NMEM + mq * 64) * NH + head) * HD + lane * 4;
    for (int m0 = 0; m0 < 64; m0 += 4) {
        f32x4 k4[4];
#pragma unroll
        for (int i = 0; i < 4; ++i) k4[i] = *(const f32x4*)(Kr + (size_t)(m0 + i) * NH * HD);
#pragma unroll
        for (int i = 0; i < 4; ++i) {
            float v[8];
#pragma unroll
            for (int t = 0; t < 8; ++t) v[t] = (q[t][0] * k4[i].x + q[t][1] * k4[i].y) + (q[t][2] * k4[i].z + q[t][3] * k4[i].w);
            float r4[4], r2[2], r1;
#pragma unroll
            for (int j = 0; j < 4; ++j) { const bool up = lane & 32; const float send = up ? v[j] : v[j + 4], keep = up ? v[j + 4] : v[j]; r4[j] = keep + __shfl_xor(send, 32); }
#pragma unroll
            for (int j = 0; j < 2; ++j) { const bool up = lane & 16; const float send = up ? r4[j] : r4[j + 2], keep = up ? r4[j + 2] : r4[j]; r2[j] = keep + __shfl_xor(send, 16); }
            { const bool up = lane & 8; const float send = up ? r2[0] : r2[1], keep = up ? r2[1] : r2[0]; r1 = keep + __shfl_xor(send, 8); }
            r1 += __shfl_xor(r1, 4); r1 += __shfl_xor(r1, 2); r1 += __shfl_xor(r1, 1);
            const int t = ((lane >> 5) & 1) * 4 + ((lane >> 4) & 1) * 2 + ((lane >> 3) & 1);
            if ((lane & 7) == 0) sbuf[(hsel * 8 + t) * 256 + mq * 64 + m0 + i] = r1;
        }
    }
    __syncthreads();
#pragma unroll
    for (int rr = 0; rr < 2; ++rr) { const int row = wave * 2 + rr;
        const f32x4 s4 = *(const LAS f32x4*)(sbuf + row * 256 + lane * 4);
        float mx = fmaxf(fmaxf(s4.x, s4.y), fmaxf(s4.z, s4.w));
#pragma unroll
        for (int o = 1; o < 64; o <<= 1) mx = fmaxf(mx, __shfl_xor(mx, o));
        const float e0 = exp2f(s4.x - mx), e1 = exp2f(s4.y - mx), e2 = exp2f(s4.z - mx), e3 = exp2f(s4.w - mx);
        const float inv = 1.f / wave_sum((e0 + e1) + (e2 + e3));
        LAS float* pp = pT + ((row >> 3) * 256 + lane * 4) * 8 + (row & 7);
        pp[0] = e0 * inv; pp[8] = e1 * inv; pp[16] = e2 * inv; pp[24] = e3 * inv; }
    __syncthreads();
    float o[8][4];
#pragma unroll
    for (int t = 0; t < 8; ++t) { o[t][0] = 0.f; o[t][1] = 0.f; o[t][2] = 0.f; o[t][3] = 0.f; }
    const float* Vr = cv + (((size_t)b * NMEM + mq * 64) * NH + head) * HD + lane * 4;
    for (int m0 = 0; m0 < 64; m0 += 4) {
        f32x4 v4[4];
#pragma unroll
        for (int i = 0; i < 4; ++i) v4[i] = *(const f32x4*)(Vr + (size_t)(m0 + i) * NH * HD);
#pragma unroll
        for (int i = 0; i < 4; ++i) { const LAS f32x4* pp = (const LAS f32x4*)(pT + (hsel * 256 + mq * 64 + m0 + i) * 8); const f32x4 pa = pp[0], pb = pp[1];
            const float pv[8] = {pa.x, pa.y, pa.z, pa.w, pb.x, pb.y, pb.z, pb.w};
#pragma unroll
            for (int t = 0; t < 8; ++t) { o[t][0] += pv[t] * v4[i].x; o[t][1] += pv[t] * v4[i].y; o[t][2] += pv[t] * v4[i].z; o[t][3] += pv[t] * v4[i].w; } }
    }
#pragma unroll
    for (int t = 0; t < 8; ++t) *(LAS f32x4*)(obuf + ((hsel * 4 + mq) * 8 + t) * 256 + lane * 4) = (f32x4){o[t][0], o[t][1], o[t][2], o[t][3]};
    __syncthreads();
    { const int hs = tid >> 8, t = (tid >> 5) & 7, d8 = tid & 31;
        f32x4 a0 = {0.f, 0.f, 0.f, 0.f}, a1 = {0.f, 0.f, 0.f, 0.f};
#pragma unroll
        for (int m = 0; m < 4; ++m) { const LAS f32x4* pp = (const LAS f32x4*)(obuf + ((hs * 4 + m) * 8 + t) * 256 + d8 * 8); a0 = a0 + pp[0]; a1 = a1 + pp[1]; }
        *(v4u*)(ob + ((size_t)MP + b * DECS + t) * D + (2 * hp + hs) * HD + d8 * 8) = (v4u){pk2(a0.x, a0.y), pk2(a0.z, a0.w), pk2(a1.x, a1.y), pk2(a1.z, a1.w)};
    }
    __syncthreads();
}
}

namespace cvx {
template <int NT>
__device__ __forceinline__ void ln_swish_rows(const LAS float* ybuf, int row0, const float* lg, const float* lb, bf16_t* mixb, int wave, int lane) {
    const f32x4 g0 = *(const f32x4*)(lg + lane * 4), g1 = *(const f32x4*)(lg + 256 + lane * 4), b0 = *(const f32x4*)(lb + lane * 4), b1 = *(const f32x4*)(lb + 256 + lane * 4);
    for (int j = wave; j < NT; j += 8) {
        const f32x4 a = *(const LAS f32x4*)(ybuf + j * 512 + lane * 4), b = *(const LAS f32x4*)(ybuf + j * 512 + 256 + lane * 4);
        const float s = wave_sum(((a.x + a.y) + (a.z + a.w)) + ((b.x + b.y) + (b.z + b.w)));
        const float mu = s * (1.f / CONVD); const f32x4 da = a - mu, db = b - mu;
        const float q = wave_sum(((da.x * da.x + da.y * da.y) + (da.z * da.z + da.w * da.w)) + ((db.x * db.x + db.y * db.y) + (db.z * db.z + db.w * db.w)));
        const float rs = rsqrtf(q * (1.f / CONVD) + EPS);
        const f32x4 za = da * rs * g0 + b0, zb = db * rs * g1 + b1;
        typedef unsigned u32x2 __attribute__((ext_vector_type(2)));
        bf16_t* o = mixb + (size_t)(row0 + j) * D + SSM + lane * 4;
        *(u32x2*)o = (u32x2){pk2(za.x * fx::fsig(za.x), za.y * fx::fsig(za.y)), pk2(za.z * fx::fsig(za.z), za.w * fx::fsig(za.w))};
        *(u32x2*)(o + 256) = (u32x2){pk2(zb.x * fx::fsig(zb.x), zb.y * fx::fsig(zb.y)), pk2(zb.z * fx::fsig(zb.z), zb.w * fx::fsig(zb.w))};
    }
}
__device__ __forceinline__ void prompt_tile(int b, int t0, const bf16_t* vb, const float* w, const float* bias, const float* lg, const float* lb, bf16_t* mixb, LAS float* ybuf, int tid, int wave, int lane) {
    const int c = tid;
    float wk[31];
#pragma unroll
    for (int k = 0; k < 31; ++k) wk[k] = w[k * CONVD + c];
    const float bs = bias[c];
    const bf16_t* vp = vb + (size_t)b * SEQ * CONVD + c;
#pragma unroll 1
    for (int pass = 0; pass < 4; ++pass) {
        const int tb = t0 + pass * 16;
        float xin[46];
#pragma unroll
        for (int ii = 0; ii < 46; ++ii) { const int tt = tb - 30 + ii; const int tc = tt < 0 ? 0 : tt; const float v = bf2f(vp[(size_t)tc * CONVD]); xin[ii] = tt < 0 ? 0.f : v; }
#pragma unroll
        for (int j = 0; j < 16; ++j) { float y = bs;
#pragma unroll
            for (int k = 0; k < 31; ++k) y += wk[k] * xin[j + k];
            ybuf[(pass * 16 + j) * 512 + c] = y; }
    }
    __syncthreads();
    ln_swish_rows<64>(ybuf, b * SEQ + t0, lg, lb, mixb, wave, lane);
    __syncthreads();
}
__device__ __forceinline__ void sample_batch(int b, const bf16_t* vb, const float* cache, const float* w, const float* bias, const float* lg, const float* lb, bf16_t* mixb, float* out, LAS float* ybuf, int tid, int wave, int lane) {
    const int c = tid;
    float xp[38];
#pragma unroll
    for (int i = 0; i < 30; ++i) xp[i] = cache[((size_t)b * 30 + i) * CONVD + c];
#pragma unroll
    for (int i = 0; i < 8; ++i) xp[30 + i] = bf2f(vb[((size_t)MP + b * DECS + i) * CONVD + c]);
#pragma unroll
    for (int j = 0; j < 22; ++j) out[O_CVS + ((size_t)b * 30 + j) * CONVD + c] = xp[j + 8];
    float y[8];
    const float bs = bias[c];
#pragma unroll
    for (int j = 0; j < 8; ++j) y[j] = bs;
#pragma unroll
    for (int k = 0; k < 31; ++k) { const float wv = w[k * CONVD + c];
#pragma unroll
        for (int j = 0; j < 8; ++j) y[j] += wv * xp[j + k]; }
#pragma unroll
    for (int j = 0; j < 8; ++j) ybuf[j * 512 + c] = y[j];
    __syncthreads();
    ln_swish_rows<8>(ybuf, MP + b * DECS, lg, lb, mixb, wave, lane);
    __syncthreads();
}
}

namespace sg {
typedef short bf16x8 __attribute__((ext_vector_type(8)));
constexpr int PSTR = 68, PBYTES = 64 * PSTR * 4;
template <class Epi>
__device__ __forceinline__ void tile(const bf16_t* A, const bf16_t* Bt, int K, int tm, int tn, const Epi& E, LAS unsigned char* L, int tid, int wave, int lane) {
    const int fr = lane & 15, kq = lane >> 4, kw = K >> 3, ns = kw >> 5;
    const bf16_t* a0 = A + (size_t)(tm * 64 + fr) * K + wave * kw + kq * 8;
    const bf16_t* b0 = Bt + (size_t)(tn * 64 + fr) * K + wave * kw + kq * 8;
    f32x4 acc[4][4];
#pragma unroll
    for (int i = 0; i < 4; ++i)
#pragma unroll
        for (int j = 0; j < 4; ++j) acc[i][j] = (f32x4){0.f, 0.f, 0.f, 0.f};
#pragma unroll 2
    for (int s = 0; s < ns; ++s) {
        bf16x8 af[4], bf[4];
#pragma unroll
        for (int i = 0; i < 4; ++i) { af[i] = *(const bf16x8*)(a0 + (size_t)i * 16 * K + s * 32); bf[i] = *(const bf16x8*)(b0 + (size_t)i * 16 * K + s * 32); }
#pragma unroll
        for (int i = 0; i < 4; ++i)
#pragma unroll
            for (int j = 0; j < 4; ++j) acc[i][j] = __builtin_amdgcn_mfma_f32_16x16x32_bf16(af[i], bf[j], acc[i][j], 0, 0, 0);
    }
    LAS float* P = (LAS float*)(L + (wave & 3) * PBYTES) + (4 * kq) * PSTR + fr;
    if (wave >= 4) {
#pragma unroll
        for (int i = 0; i < 4; ++i)
#pragma unroll
            for (int j = 0; j < 4; ++j)
#pragma unroll
                for (int r = 0; r < 4; ++r) P[(16 * i + r) * PSTR + 16 * j] = acc[i][j][r];
    }
    __syncthreads();
    if (wave < 4) {
#pragma unroll
        for (int i = 0; i < 4; ++i)
#pragma unroll
            for (int j = 0; j < 4; ++j)
#pragma unroll
                for (int r = 0; r < 4; ++r) acc[i][j][r] += P[(16 * i + r) * PSTR + 16 * j];
    }
    __syncthreads();
    if (wave < 4) {
#pragma unroll
        for (int i = 0; i < 4; ++i)
#pragma unroll
            for (int j = 0; j < 4; ++j)
#pragma unroll
                for (int r = 0; r < 4; ++r) P[(16 * i + r) * PSTR + 16 * j] = acc[i][j][r];
    }
    __syncthreads();
    { const int row = tid >> 3, c8 = (tid & 7) * 8; f32x4 v0 = {0.f, 0.f, 0.f, 0.f}, v1 = {0.f, 0.f, 0.f, 0.f};
#pragma unroll
        for (int w = 0; w < 4; ++w) { const LAS f32x4* p = (const LAS f32x4*)(L + w * PBYTES + (row * PSTR + c8) * 4); v0 = v0 + p[0]; v1 = v1 + p[1]; }
        E(tm * 64 + row, tn * 64 + c8, tn, v0, v1, lane); }
    __syncthreads();
}
struct SRes { const float* rin; float* rout; bf16_t* xb; float* ss; float alpha;
    __device__ __forceinline__ void operator()(int row, int col0, int slot, f32x4 a0, f32x4 a1, int lane) const {
        const size_t o = (size_t)row * D + col0;
        const f32x4 v0 = *(const f32x4*)(rin + o) + a0 * alpha, v1 = *(const f32x4*)(rin + o + 4) + a1 * alpha;
        *(f32x4*)(rout + o) = v0; *(f32x4*)(rout + o + 4) = v1; if (xb) *(fx::u32x4*)(xb + o) = fx::pack8(v0, v1);
        float sq = ((v0[0] * v0[0] + v0[1] * v0[1]) + (v0[2] * v0[2] + v0[3] * v0[3])) + ((v1[0] * v1[0] + v1[1] * v1[1]) + (v1[2] * v1[2] + v1[3] * v1[3]));
        sq += __shfl_xor(sq, 1); sq += __shfl_xor(sq, 2); sq += __shfl_xor(sq, 4);
        if ((lane & 7) == 0) ss[(size_t)row * 16 + slot] = sq;
    }
};
struct SQ { const float* ss; bf16_t* qb;
    __device__ __forceinline__ void operator()(int row, int col0, int slot, f32x4 a0, f32x4 a1, int lane) const {
        const float r = fx::rstd_row(ss, row) * QSCALE; *(fx::u32x4*)(qb + (size_t)row * D + col0) = fx::pack8(a0 * r, a1 * r);
    }
};
}

#ifndef DBL_MASK
#define DBL_MASK 0
#endif
constexpr int NWAVES = 8;
constexpr int RING_OFF = 0, RING_BYTES = 131072;
constexpr int LDSCTL_OFF = RING_BYTES, MISC_OFF = LDSCTL_OFF + 320, XTRA_OFF = RING_BYTES + 1024;
constexpr int LDS_BYTES = 147456;
constexpr size_t CTL_ZERO_BYTES = 1 * MiB;
constexpr int CW_TMO = 0, CW_CODE = 1, CW_BAR = 4096;
constexpr int MAX_LAUNCHES = 8;
static_assert((CW_BAR + MAX_LAUNCHES * XCD_BAR_WORDS) * 4 <= (int)CTL_ZERO_BYTES, "barrier words inside the memset region");

enum Phase { PH_PRO = 0, PH_GU1 = 1, PH_D1 = 2, PH_IN = 3, PH_MIX = 4, PH_GLU = 5, PH_OUT = 6, PH_Q = 7, PH_ATT = 8, PH_O = 9, PH_GU2 = 10, PH_D2 = 11, PH_FIN = 12, PH_N = 13 };

struct Args { const float* in[39]; float* out; unsigned char* ws; int ph_lo, ph_hi, li, pad; };

__global__ void __launch_bounds__(NWAVES * 64, 2) mk_fwd(Args args) {
    extern __shared__ __attribute__((aligned(16))) unsigned char lds[];
    LAS unsigned char* L = (LAS unsigned char*)lds;
    volatile LAS unsigned* MISC = (volatile LAS unsigned*)(L + MISC_OFF);
    const int tid = threadIdx.x;
    const int G = gridDim.x, bx = blockIdx.x;
    unsigned char* ws = args.ws; float* out = args.out;
    gu32* ctl = (gu32*)(ws + WS_CTL);
    for (int u = tid; u < (LDS_BYTES - LDSCTL_OFF) / 4; u += NWAVES * 64) ((LAS unsigned*)(L + LDSCTL_OFF))[u] = 0u;
    __syncthreads();
    XcdBarrier bar = xcd_barrier_post((unsigned*)(ctl + CW_BAR) + args.li * XCD_BAR_WORDS, MISC + 8);
    const int lo = args.ph_lo, hi = args.ph_hi;
#define IN(k) (lo <= (k) && (k) < hi)
#define BOTH(k) (IN(k) && IN((k) + 1))
#define GRID_BAR() xcd_barrier(bar)
    bf16_t *Wgu1 = (bf16_t*)(ws + WS_WGU1), *Wgu2 = (bf16_t*)(ws + WS_WGU2), *Wd1 = (bf16_t*)(ws + WS_WD1), *Wd2 = (bf16_t*)(ws + WS_WD2), *Win = (bf16_t*)(ws + WS_WIN), *Wglu = (bf16_t*)(ws + WS_WGLU),
           *Wout = (bf16_t*)(ws + WS_WOUT), *Wq = (bf16_t*)(ws + WS_WQ), *Wo = (bf16_t*)(ws + WS_WO), *Wkv = (bf16_t*)(ws + WS_WKV);
    bf16_t *xb = (bf16_t*)(ws + WS_XB), *memb = (bf16_t*)(ws + WS_MEMB), *kb = (bf16_t*)(ws + WS_KB), *vb2 = (bf16_t*)(ws + WS_VB2), *hb = (bf16_t*)(ws + WS_H), *ug = (bf16_t*)(ws + WS_UG),
           *vb = (bf16_t*)(ws + WS_VB), *gb = (bf16_t*)(ws + WS_GB), *mixb = (bf16_t*)(ws + WS_MIXB), *qb = (bf16_t*)(ws + WS_QB), *ob = (bf16_t*)(ws + WS_OB);
    bf16_t *Ktab = (bf16_t*)(ws + WS_TAB + s5f::TAB_KT), *Ptab = (bf16_t*)(ws + WS_TAB + s5f::TAB_P), *Qtab = (bf16_t*)(ws + WS_TAB + s5f::TAB_Q); float* ALtab = (float*)(ws + WS_TAB + s5f::TAB_AL);
    float *ss0 = (float*)(ws + WS_SS0), *ss1 = (float*)(ws + WS_SS1), *ss2 = (float*)(ws + WS_SS2), *ss3 = (float*)(ws + WS_SS3), *ss4 = (float*)(ws + WS_SS4), *ssm = (float*)(ws + WS_SSM), *xres = (float*)(ws + WS_XRES);
    float* rstdm = ssm + (size_t)MMEM * 16; bf16_t* vT = vb2;

    const int wave = __builtin_amdgcn_readfirstlane(tid >> 6), lane = tid & 63;
    const float* const* in = args.in;
    if (IN(PH_PRO)) {
      for (int rep_ = 0; rep_ <= ((DBL_MASK >> PH_PRO) & 1); ++rep_) {
        for (int task = bx; task < 256; task += G) s5f::kt_task(task, in[17], in[18], in[19], in[20], in[21], in[22], in[23], Ktab, L + RING_OFF, tid);
        for (int e = bx * 512 + tid; e < 131072; e += G * 512) s5f::pq_entry(e, in[17], in[18], in[19], in[20], in[21], in[22], in[23], Ptab, Qtab, ALtab);
        LAS float* scr = (LAS float*)(L + RING_OFF + wave * 16384);
        const int gw = bx * NWAVES + wave, NGW = G * NWAVES;
        constexpr int I_GU = (D / 64) * (2 * FF / 32), I_D = (FF / 64) * (D / 32), I_IN = (D / 64) * (1536 / 32), I_GLU = (SSM / 64) * (SSM / 32), I_SQ = (D / 64) * (D / 32), I_KV = (D / 64) * (2048 / 32);
        constexpr int NITEMS = 2 * I_GU + 2 * I_D + I_IN + I_GLU + 3 * I_SQ + I_KV;
        for (int it = gw; it < NITEMS; it += NGW) {
            int r = it;
            if (r < I_GU) { sb::transpose_job_item<1>(in[12], in[13], in[11], Wgu1, D, 2 * FF, FF, r, scr, lane); continue; } r -= I_GU;
            if (r < I_GU) { sb::transpose_job_item<1>(in[35], in[36], in[34], Wgu2, D, 2 * FF, FF, r, scr, lane); continue; } r -= I_GU;
            if (r < I_D) { sb::transpose_job_item<0>(in[14], nullptr, nullptr, Wd1, FF, D, D, r, scr, lane); continue; } r -= I_D;
            if (r < I_D) { sb::transpose_job_item<0>(in[37], nullptr, nullptr, Wd2, FF, D, D, r, scr, lane); continue; } r -= I_D;
            if (r < I_IN) { sb::transpose_job_item<2>(in[16], nullptr, in[15], Win, D, 1536, 1536, r, scr, lane); continue; } r -= I_IN;
            if (r < I_GLU) { sb::transpose_job_item<0>(in[25], nullptr, nullptr, Wglu, SSM, SSM, SSM, r, scr, lane); continue; } r -= I_GLU;
            if (r < I_SQ) { sb::transpose_job_item<0>(in[30], nullptr, nullptr, Wout, D, D, D, r, scr, lane); continue; } r -= I_SQ;
            if (r < I_SQ) { sb::transpose_job_item<0>(in[32], nullptr, in[31], Wq, D, D, D, r, scr, lane); continue; } r -= I_SQ;
            if (r < I_SQ) { sb::transpose_job_item<0>(in[33], nullptr, nullptr, Wo, D, D, D, r, scr, lane); continue; } r -= I_SQ;
            sb::transpose_job_item<3>(in[9], in[10], in[8], Wkv, D, 2048, D, r, scr, lane);
        }
        for (int m = gw; m < M; m += NGW) sb::row_bf16_ss(m < MP ? in[0] + (size_t)m * D : in[1] + (size_t)(m - MP) * D, xb + (size_t)m * D, ss0 + (size_t)m * 16, nullptr, lane);
        for (int m = gw; m < MMEM; m += NGW) sb::row_bf16_ss(in[7] + (size_t)m * D, memb + (size_t)m * D, ssm + (size_t)m * 16, rstdm + m, lane);
        if (rep_ < ((DBL_MASK >> PH_PRO) & 1)) GRID_BAR();
      }
        if (BOTH(PH_PRO)) GRID_BAR();
    }

    if (IN(PH_GU1)) {
      for (int rep_ = 0; rep_ <= ((DBL_MASK >> PH_GU1) & 1); ++rep_) {
        { pg8::Gemm g{memb, Wkv, MMEM, D, D}; pg8::StaticOrder S; S.init(MMEM, D, G, (bx + G - 216 % G) % G); fx::EpiK E{rstdm, kb, out};
          pg8::gemm_phase<fx::EpiK, pg8::StaticOrder, true, true>(L + RING_OFF, g, S, E); }
        { pg8::Gemm g{xb, Wgu1, M, 2 * FF, D}; pg8::StaticOrder S; S.init(M, 2 * FF, G, bx); fx::EpiSwiglu E{ss0, hb};
          pg8::gemm_phase<fx::EpiSwiglu, pg8::StaticOrder, true, true>(L + RING_OFF, g, S, E); }
        if (rep_ < ((DBL_MASK >> PH_GU1) & 1)) GRID_BAR();
      }
        if (BOTH(PH_GU1)) GRID_BAR();
    }
    if (IN(PH_D1)) {
      for (int rep_ = 0; rep_ <= ((DBL_MASK >> PH_D1) & 1); ++rep_) {
        pg8::Gemm g{hb, Wd1, MP, D, FF}; pg8::StaticOrder S; S.init(MP, D, G, bx); fx::EpiRes E{args.in[0], args.in[0], xres, xb, ss1, 0.5f};
        pg8::gemm_phase<fx::EpiRes, pg8::StaticOrder, true, true>(L + RING_OFF, g, S, E);
        { sg::SRes Es{args.in[1], xres + (size_t)MP * D, xb + (size_t)MP * D, ss1 + (size_t)MP * 16, 0.5f};
          for (int t = bx; t < 256; t += G) sg::tile(hb + (size_t)MP * FF, Wd1, FF, t >> 4, t & 15, Es, L + RING_OFF, tid, wave, lane); }
        if (rep_ < ((DBL_MASK >> PH_D1) & 1)) GRID_BAR();
      }
        if (BOTH(PH_D1)) GRID_BAR();
    }
    if (IN(PH_IN)) {
      for (int rep_ = 0; rep_ <= ((DBL_MASK >> PH_IN) & 1); ++rep_) {
        { pg8::Gemm g{xb, Win, M, 1536, D}; pg8::StaticOrder S; S.init(M, 1536, G, bx); fx::EpiIn E{ss1, ug, vb, out};
          pg8::gemm_phase<fx::EpiIn, pg8::StaticOrder, true, true>(L + RING_OFF, g, S, E); }
        { pg8::Gemm g{Wkv + (size_t)D * D, memb, D, MMEM, D}; pg8::StaticOrder S; S.init(D, MMEM, G, (bx + G - 152 % G) % G); fx::EpiVT E{rstdm, vT, out};
          pg8::gemm_phase<fx::EpiVT, pg8::StaticOrder, true, true>(L + RING_OFF, g, S, E); }
        if (rep_ < ((DBL_MASK >> PH_IN) & 1)) GRID_BAR();
      }
        if (BOTH(PH_IN)) GRID_BAR();
    }
    if (IN(PH_MIX)) {
      for (int rep_ = 0; rep_ <= ((DBL_MASK >> PH_MIX) & 1); ++rep_) {
        for (int unit = bx; unit < NBATCH * NG; unit += G) s5f::prompt_unit(unit >> 5, unit & 31, ug, Ktab, Ptab, Qtab, ALtab, in[24], gb, out, L + RING_OFF, tid, wave, lane);
        for (int task = NBATCH * NG + wave * G + bx; task < (NBATCH + DECB) * NG; task += G * NWAVES)
            sb::s5_task(task, ug, in[2], in[3], in[17], in[18], in[19], in[20], in[21], in[22], in[23], in[24], gb, out, lane);
        __syncthreads();
        LAS float* ybuf = (LAS float*)(L + RING_OFF);
        for (int tile = bx; tile < NBATCH * (SEQ / 64); tile += G) cvx::prompt_tile(tile >> 5, (tile & 31) * 64, vb, in[26], in[27], in[28], in[29], mixb, ybuf, tid, wave, lane);
        for (int b = bx; b < DECB; b += G) cvx::sample_batch(b, vb, in[4], in[26], in[27], in[28], in[29], mixb, out, ybuf, tid, wave, lane);
        if (rep_ < ((DBL_MASK >> PH_MIX) & 1)) GRID_BAR();
      }
        if (BOTH(PH_MIX)) GRID_BAR();
    }

    if (IN(PH_GLU)) {
      for (int rep_ = 0; rep_ <= ((DBL_MASK >> PH_GLU) & 1); ++rep_) {
        pg8::Gemm g{gb, Wglu, M, SSM, SSM}; pg8::StaticOrder S; S.init(M, SSM, G, bx); fx::EpiGlu E{gb, mixb};
        pg8::gemm_phase<fx::EpiGlu, pg8::StaticOrder, true, true>(L + RING_OFF, g, S, E);
        if (rep_ < ((DBL_MASK >> PH_GLU) & 1)) GRID_BAR();
      }
        if (BOTH(PH_GLU)) GRID_BAR();
    }
    if (IN(PH_OUT)) {
      for (int rep_ = 0; rep_ <= ((DBL_MASK >> PH_OUT) & 1); ++rep_) {
        pg8::Gemm g{mixb, Wout, MP, D, D}; pg8::StaticOrder S; S.init(MP, D, G, bx); fx::EpiRes E{xres, xres, xres, xb, ss2, 1.f};
        pg8::gemm_phase<fx::EpiRes, pg8::StaticOrder, true, true>(L + RING_OFF, g, S, E);
        { sg::SRes Es{xres + (size_t)MP * D, xres + (size_t)MP * D, xb + (size_t)MP * D, ss2 + (size_t)MP * 16, 1.f};
          for (int t = bx; t < 256; t += G) sg::tile(mixb + (size_t)MP * D, Wout, D, t >> 4, t & 15, Es, L + RING_OFF, tid, wave, lane); }
        if (rep_ < ((DBL_MASK >> PH_OUT) & 1)) GRID_BAR();
      }
        if (BOTH(PH_OUT)) GRID_BAR();
    }
    if (IN(PH_Q)) {
      for (int rep_ = 0; rep_ <= ((DBL_MASK >> PH_Q) & 1); ++rep_) {
        pg8::Gemm g{xb, Wq, MP, D, D}; pg8::StaticOrder S; S.init(MP, D, G, bx); fx::EpiQ E{ss2, qb};
        pg8::gemm_phase<fx::EpiQ, pg8::StaticOrder, true, true>(L + RING_OFF, g, S, E);
        { sg::SQ Es{ss2 + (size_t)MP * 16, qb + (size_t)MP * D};
          for (int t = bx; t < 256; t += G) sg::tile(xb + (size_t)MP * D, Wq, D, t >> 4, t & 15, Es, L + RING_OFF, tid, wave, lane); }
        if (rep_ < ((DBL_MASK >> PH_Q) & 1)) GRID_BAR();
      }
        if (BOTH(PH_Q)) GRID_BAR();
    }
    if (IN(PH_ATT)) {
      for (int rep_ = 0; rep_ <= ((DBL_MASK >> PH_ATT) & 1); ++rep_) {
        LAS float* wsf = (LAS float*)(L + XTRA_OFF) + wave * 32;
        const int vcu = (G % 8 == 0) ? (bx % 8) * (G / 8) + bx / 8 : bx;
        for (int unit = vcu; unit < NBATCH * NH * 8; unit += G) att::prompt_unit(unit >> 5, (unit >> 3) & 3, unit & 7, qb, kb, vT, ob, L + RING_OFF, wsf, tid, wave, lane);
        for (int unit = bx; unit < DECB * 2; unit += G) att::sample_unit(unit >> 1, unit & 1, qb, in[5], in[6], ob, L + RING_OFF, tid, wave, lane);
        if (rep_ < ((DBL_MASK >> PH_ATT) & 1)) GRID_BAR();
      }
        if (BOTH(PH_ATT)) GRID_BAR();
    }

    if (IN(PH_O)) {
      for (int rep_ = 0; rep_ <= ((DBL_MASK >> PH_O) & 1); ++rep_) {
        pg8::Gemm g{ob, Wo, MP, D, D}; pg8::StaticOrder S; S.init(MP, D, G, bx); fx::EpiRes E{xres, xres, xres, xb, ss3, 1.f};
        pg8::gemm_phase<fx::EpiRes, pg8::StaticOrder, true, true>(L + RING_OFF, g, S, E);
        { sg::SRes Es{xres + (size_t)MP * D, xres + (size_t)MP * D, xb + (size_t)MP * D, ss3 + (size_t)MP * 16, 1.f};
          for (int t = bx; t < 256; t += G) sg::tile(ob + (size_t)MP * D, Wo, D, t >> 4, t & 15, Es, L + RING_OFF, tid, wave, lane); }
        if (rep_ < ((DBL_MASK >> PH_O) & 1)) GRID_BAR();
      }
        if (BOTH(PH_O)) GRID_BAR();
    }
    if (IN(PH_GU2)) {
      for (int rep_ = 0; rep_ <= ((DBL_MASK >> PH_GU2) & 1); ++rep_) {
        pg8::Gemm g{xb, Wgu2, M, 2 * FF, D}; pg8::StaticOrder S; S.init(M, 2 * FF, G, bx); fx::EpiSwiglu E{ss3, hb};
        pg8::gemm_phase<fx::EpiSwiglu, pg8::StaticOrder, true, true>(L + RING_OFF, g, S, E);
        if (rep_ < ((DBL_MASK >> PH_GU2) & 1)) GRID_BAR();
      }
        if (BOTH(PH_GU2)) GRID_BAR();
    }
    if (IN(PH_D2)) {
      for (int rep_ = 0; rep_ <= ((DBL_MASK >> PH_D2) & 1); ++rep_) {
        pg8::Gemm g{hb, Wd2, MP, D, FF}; pg8::StaticOrder S; S.init(MP, D, G, bx); fx::EpiRes E{xres, xres, out + O_Y, nullptr, ss4, 0.5f};
        pg8::gemm_phase<fx::EpiRes, pg8::StaticOrder, true, true>(L + RING_OFF, g, S, E);
        { sg::SRes Es{xres + (size_t)MP * D, out + O_Y + (size_t)MP * D, nullptr, ss4 + (size_t)MP * 16, 0.5f};
          for (int t = bx; t < 256; t += G) sg::tile(hb + (size_t)MP * FF, Wd2, FF, t >> 4, t & 15, Es, L + RING_OFF, tid, wave, lane); }
        if (rep_ < ((DBL_MASK >> PH_D2) & 1)) GRID_BAR();
      }
        if (BOTH(PH_D2)) GRID_BAR();
    }

    if (IN(PH_FIN)) {
        float* y = out + O_Y; const float* gfin = in[38];
        for (int m = bx * NWAVES + wave; m < M; m += G * NWAVES) { const float r = rstd_from_ss(ss4, m);
#pragma unroll
            for (int j = 0; j < 4; ++j) { f32x4* p = (f32x4*)(y + (size_t)m * D + j * 256 + lane * 4); const f32x4 gg = *(const f32x4*)(gfin + j * 256 + lane * 4); f32x4 v = *p; v = v * r * gg; *p = v; } }
    }
#undef IN
#undef BOTH
#undef GRID_BAR
}

#ifndef FAST_MERGE
#define FAST_MERGE 1
#endif
extern "C" void kernel_launch(void* const* d_in, const int* in_sizes, int n_in, void* d_out, int out_size, void* d_ws, size_t ws_size, hipStream_t stream) {
    if (n_in != 39 || out_size != (int)O_END || ws_size < WS_END) { fprintf(stderr, "kernel_launch: unexpected shapes n_in %d out %d ws %zu\n", n_in, out_size, ws_size); return; }
    static int grid = 0;
    if (grid == 0) {
        int dev = 0, cus = 0;
        if (hipGetDevice(&dev) != hipSuccess || hipDeviceGetAttribute(&cus, hipDeviceAttributeMultiprocessorCount, dev) != hipSuccess) { grid = -1; return; }
        if (hipFuncSetAttribute((const void*)mk_fwd, hipFuncAttributeMaxDynamicSharedMemorySize, LDS_BYTES) != hipSuccess) { fprintf(stderr, "kernel_launch: hipFuncSetAttribute failed\n"); grid = -1; return; }
        int per_cu = 0;
        if (hipOccupancyMaxActiveBlocksPerMultiprocessor(&per_cu, (const void*)mk_fwd, NWAVES * 64, LDS_BYTES) != hipSuccess || per_cu < 1) { fprintf(stderr, "kernel_launch: occupancy query says %d\n", per_cu); }
        (void)hipGetLastError();
        grid = cus;
    }
    if (grid < 0) return;
    const float* const* in = (const float* const*)d_in;
    const float *x_p = in[0], *x_s = in[1], *st_re = in[2], *st_im = in[3], *cconv = in[4], *cmk = in[5], *cmv = in[6], *memp = in[7], *g_mem = in[8], *w_k = in[9], *w_v = in[10],
                *g_ffn1 = in[11], *w1g = in[12], *w1u = in[13], *w1d = in[14], *g_mix = in[15], *w_in = in[16], *a_re = in[17], *a_im = in[18], *log_dt = in[19], *b_re = in[20], *b_im = in[21],
                *c_re = in[22], *c_im = in[23], *ssm_d = in[24], *w_glu = in[25], *conv_w = in[26], *conv_b = in[27], *ln_g = in[28], *ln_b = in[29], *w_out = in[30], *g_xattn = in[31],
                *w_q = in[32], *w_o = in[33], *g_ffn2 = in[34], *w2g = in[35], *w2u = in[36], *w2d = in[37], *g_final = in[38];
    (void)x_p; (void)x_s;
    unsigned char* ws = (unsigned char*)d_ws; float* out = (float*)d_out;
    bf16_t *Wgu1 = (bf16_t*)(ws + WS_WGU1), *Wgu2 = (bf16_t*)(ws + WS_WGU2), *Wd1 = (bf16_t*)(ws + WS_WD1), *Wd2 = (bf16_t*)(ws + WS_WD2), *Win = (bf16_t*)(ws + WS_WIN), *Wglu = (bf16_t*)(ws + WS_WGLU),
           *Wout = (bf16_t*)(ws + WS_WOUT), *Wq = (bf16_t*)(ws + WS_WQ), *Wo = (bf16_t*)(ws + WS_WO), *Wkv = (bf16_t*)(ws + WS_WKV);
    bf16_t *xb = (bf16_t*)(ws + WS_XB), *memb = (bf16_t*)(ws + WS_MEMB), *kb = (bf16_t*)(ws + WS_KB), *vb2 = (bf16_t*)(ws + WS_VB2), *ug = (bf16_t*)(ws + WS_UG),
           *vb = (bf16_t*)(ws + WS_VB), *gb = (bf16_t*)(ws + WS_GB), *mixb = (bf16_t*)(ws + WS_MIXB), *qb = (bf16_t*)(ws + WS_QB), *ob = (bf16_t*)(ws + WS_OB);
    float *ss0 = (float*)(ws + WS_SS0), *ss4 = (float*)(ws + WS_SS4), *ssm = (float*)(ws + WS_SSM);

    if (hipMemsetAsync(ws + WS_CTL, 0, CTL_ZERO_BYTES, stream) != hipSuccess) return;
    Args a{};
    for (int i = 0; i < 39; ++i) a.in[i] = in[i];
    a.out = out; a.ws = ws;
    int li = 0;
    auto run = [&](int lo, int hi) {
        if (FAST_MERGE) { a.ph_lo = lo; a.ph_hi = hi; a.li = li++; hipLaunchKernelGGL(mk_fwd, dim3(grid), dim3(NWAVES * 64), LDS_BYTES, stream, a); }
        else for (int p = lo; p < hi; ++p) { a.ph_lo = p; a.ph_hi = p + 1; a.li = li; hipLaunchKernelGGL(mk_fwd, dim3(grid), dim3(NWAVES * 64), LDS_BYTES, stream, a); }
    };

    run(PH_PRO, PH_N);
}
```

```cpp
#include <hip/hip_runtime.h>
#include <cstdint>
#include <cstdio>

typedef unsigned short bf16_t;
typedef float f32x4 __attribute__((ext_vector_type(4)));

constexpr int D = 1024, FF = 2816, MP = 16384, MS = 1024, M = MP + MS;
constexpr int SEQ = 2048, DECB = 128, DECS = 8, NBATCH = 8;
constexpr int SSM = 512, CONVD = 512, NG = 32, GC = 16, NST = 64, CWID = 31, NMEM = 256, NH = 4, HD = 256;
constexpr int MMEM = NBATCH * NMEM;
constexpr float EPS = 1e-6f;
constexpr float QSCALE = 0.0625f * 1.4426950408889634f;

constexpr size_t O_Y = 0;
constexpr size_t O_SRP = (size_t)M * D;
constexpr size_t O_SIP = O_SRP + 16384;
constexpr size_t O_CVP = O_SIP + 16384;
constexpr size_t O_MKP = O_CVP + 122880;
constexpr size_t O_MVP = O_MKP + 2097152;
constexpr size_t O_SRS = O_MVP + 2097152;
constexpr size_t O_SIS = O_SRS + 262144;
constexpr size_t O_CVS = O_SIS + 262144;
constexpr size_t O_END = O_CVS + 1966080;

constexpr size_t MiB = 1u << 20;
constexpr size_t WS_CTL = 0;
constexpr size_t WS_WGU1 = 2 * MiB, WS_WGU2 = 13 * MiB, WS_WD1 = 24 * MiB, WS_WD2 = 30 * MiB, WS_WIN = 36 * MiB, WS_WGLU = 39 * MiB,
                 WS_WOUT = 40 * MiB, WS_WQ = 42 * MiB, WS_WO = 44 * MiB, WS_WKV = 46 * MiB;
constexpr size_t WS_TAB = 50 * MiB;
constexpr size_t WS_XB = 72 * MiB, WS_MEMB = 106 * MiB, WS_KB = 110 * MiB, WS_VB2 = 114 * MiB;
constexpr size_t WS_SS0 = 118 * MiB, WS_SS1 = 120 * MiB, WS_SS2 = 122 * MiB, WS_SS3 = 124 * MiB, WS_SS4 = 126 * MiB, WS_SSM = 127 * MiB + 512 * 1024;
constexpr size_t WS_XRES = 128 * MiB, WS_H = 196 * MiB, WS_UG = 290 * MiB, WS_VB = 307 * MiB, WS_GB = 324 * MiB, WS_MIXB = 342 * MiB,
                 WS_QB = 376 * MiB, WS_OB = 410 * MiB, WS_END = 444 * MiB;

__device__ __forceinline__ unsigned f2bf(float f) { unsigned u = __builtin_bit_cast(unsigned, f); return (u + 0x7fffu + ((u >> 16) & 1u)) >> 16; }
__device__ __forceinline__ float bf2f(bf16_t b) { return __builtin_bit_cast(float, (unsigned)b << 16); }
__device__ __forceinline__ float sigmoidf_(float x) { return 1.f / (1.f + __expf(-x)); }
__device__ __forceinline__ float siluf_(float x) { return x * sigmoidf_(x); }
__device__ __forceinline__ float gelu_tanh(float x) { const float u = 0.7978845608028654f * (x + 0.044715f * x * x * x); return 0.5f * x * (1.f + tanhf(u)); }
__device__ __forceinline__ float wave_sum(float v) {
#pragma unroll
    for (int o = 1; o < 64; o <<= 1) v += __shfl_xor(v, o);
    return v;
}
__device__ __forceinline__ float rstd_from_ss(const float* ss, int row) {
    float s = 0.f;
#pragma unroll
    for (int i = 0; i < 16; ++i) s += ss[(size_t)row * 16 + i];
    return rsqrtf(s * (1.f / D) + EPS);
}

template <int MAP>
__global__ void k_wt(const float* W0, const float* W1, const float* gain, bf16_t* WT, int K, int N, int ldw) {
    __shared__ float tile[32][33];
    const int n0 = blockIdx.x * 32, k0 = blockIdx.y * 32, tx = threadIdx.x & 31, ty = threadIdx.x >> 5;
    const float* W = W0; int c0 = n0;
    if (MAP == 1) { const int pn = n0 / 256, half = (n0 % 256) / 128, jj = n0 % 128; W = half ? W1 : W0; c0 = pn * 128 + jj; }
    if (MAP == 2) { if (n0 >= 512) { const int m = n0 - 512, pc = m / 256, half = (m % 256) / 128, jj = m % 128; c0 = 512 + half * 512 + pc * 128 + jj; } }
    if (MAP == 3) { if (n0 >= 1024) { W = W1; c0 = n0 - 1024; } }
    for (int i = ty; i < 32; i += 8) { const int k = k0 + i; tile[i][tx] = W[(size_t)k * ldw + c0 + tx] * (gain ? gain[k] : 1.f); }
    __syncthreads();
    for (int i = ty; i < 32; i += 8) WT[(size_t)(n0 + i) * K + k0 + tx] = (bf16_t)f2bf(tile[tx][i]);
}
__global__ void k_rows_bf16_ss(const float* x0, int rows0, const float* x1, int rows1, bf16_t* xb, float* ss) {
    const int row = blockIdx.x * 4 + (threadIdx.x >> 6), lane = threadIdx.x & 63;
    if (row >= rows0 + rows1) return;
    const float* xr = row < rows0 ? x0 + (size_t)row * D : x1 + (size_t)(row - rows0) * D;
    float s = 0.f;
    for (int j = 0; j < 4; ++j) { const f32x4 v = *(const f32x4*)(xr + j * 256 + lane * 4); s += v.x * v.x + v.y * v.y + v.z * v.z + v.w * v.w;
        uint2 o; o.x = f2bf(v.x) | (f2bf(v.y) << 16); o.y = f2bf(v.z) | (f2bf(v.w) << 16); *(uint2*)(xb + (size_t)row * D + j * 256 + lane * 4) = o; }
    s = wave_sum(s);
    if (lane < 16) ss[(size_t)row * 16 + lane] = lane == 0 ? s : 0.f;
}
__global__ void k_rows_ss(const float* x, int rows, float* ss) {
    const int row = blockIdx.x * 4 + (threadIdx.x >> 6), lane = threadIdx.x & 63;
    if (row >= rows) return;
    float s = 0.f;
    for (int j = 0; j < 4; ++j) { const f32x4 v = *(const f32x4*)(x + (size_t)row * D + j * 256 + lane * 4); s += v.x * v.x + v.y * v.y + v.z * v.z + v.w * v.w; }
    s = wave_sum(s);
    if (lane < 16) ss[(size_t)row * 16 + lane] = lane == 0 ? s : 0.f;
}

enum { E_KV = 1, E_SWIGLU = 2, E_RES = 3, E_U = 4, E_V = 5, E_GLU = 6, E_Q = 7 };
struct EpiP {
    const float* ss;
    const float* resin;
    float* resout;
    bf16_t* ob;
    bf16_t* ob2;
    const bf16_t* gb;
    float* out;
    float alpha;
    int pad;
};
template <int MODE>
__device__ __forceinline__ void epi_elem(const EpiP& P, int row, int c, float a0, float a1, float rstd) {
    if (MODE == E_KV) {
        const float v = a0 * rstd;
        if (c < 1024) { P.out[O_MKP + (size_t)row * 1024 + c] = v; P.ob[(size_t)row * 1024 + c] = (bf16_t)f2bf(v); }
        else { P.out[O_MVP + (size_t)row * 1024 + c - 1024] = v; P.ob2[(size_t)row * 1024 + c - 1024] = (bf16_t)f2bf(v); }
    } else if (MODE == E_SWIGLU) {
        const float g = a0 * rstd, u = a1 * rstd; P.ob[(size_t)row * FF + c] = (bf16_t)f2bf(siluf_(g) * u);
    } else if (MODE == E_RES) {
        const float v = P.resin[(size_t)row * D + c] + P.alpha * a0; P.resout[(size_t)row * D + c] = v; if (P.ob) P.ob[(size_t)row * D + c] = (bf16_t)f2bf(v);
    } else if (MODE == E_U) {
        P.ob[((size_t)(c >> 4) * M + row) * 16 + (c & 15)] = (bf16_t)f2bf(a0 * rstd);
    } else if (MODE == E_V) {
        const float v = (a0 * rstd) * sigmoidf_(a1 * rstd); P.ob[(size_t)row * CONVD + c] = (bf16_t)f2bf(v);
        if (row < MP) { const int b = row / SEQ, t = row % SEQ; if (t >= SEQ - 30) P.out[O_CVP + ((size_t)b * 30 + (t - (SEQ - 30))) * CONVD + c] = v; }
        else { const int rs = row - MP, b = rs / DECS, t = rs % DECS; P.out[O_CVS + ((size_t)b * 30 + 22 + t) * CONVD + c] = v; }
    } else if (MODE == E_GLU) {
        const float g = bf2f(P.gb[(size_t)row * SSM + c]); P.ob[(size_t)row * D + c] = (bf16_t)f2bf(g * sigmoidf_(a0));
    } else if (MODE == E_Q) {
        P.ob[(size_t)row * D + c] = (bf16_t)f2bf(a0 * rstd * QSCALE);
    }
}
template <int MODE> struct ModeTraits { static constexpr bool PAIRED = (MODE == E_SWIGLU || MODE == E_V); static constexpr bool RSTD = (MODE == E_KV || MODE == E_SWIGLU || MODE == E_U || MODE == E_V || MODE == E_Q); };

template <int MODE>
__global__ void __launch_bounds__(256) k_ref_gemm(const bf16_t* A, const bf16_t* BT, int K, EpiP P) {
    constexpr bool PAIRED = ModeTraits<MODE>::PAIRED;
    __shared__ float As[32][65], B0[32][65], B1[PAIRED ? 32 : 1][65];
    const int tid = threadIdx.x, tx = tid & 15, ty = tid >> 4;
    const int m0 = blockIdx.y * 64, p0 = blockIdx.x * 64;
    const int cb0 = PAIRED ? (p0 / 128) * 256 + (p0 % 128) : p0;
    float acc0[4][4], acc1[4][4];
    for (int i = 0; i < 4; ++i) for (int j = 0; j < 4; ++j) { acc0[i][j] = 0.f; acc1[i][j] = 0.f; }
    for (int k0 = 0; k0 < K; k0 += 32) {
        for (int e = tid; e < 64 * 32; e += 256) { const int r = e >> 5, k = e & 31;
            As[k][r] = bf2f(A[(size_t)(m0 + r) * K + k0 + k]); B0[k][r] = bf2f(BT[(size_t)(cb0 + r) * K + k0 + k]);
            if (PAIRED) B1[k][r] = bf2f(BT[(size_t)(cb0 + 128 + r) * K + k0 + k]); }
        __syncthreads();
        for (int k = 0; k < 32; ++k) {
            float a[4], b0[4], b1[4];
            for (int i = 0; i < 4; ++i) a[i] = As[k][ty * 4 + i];
            for (int j = 0; j < 4; ++j) { b0[j] = B0[k][tx * 4 + j]; b1[j] = PAIRED ? B1[k][tx * 4 + j] : 0.f; }
            for (int i = 0; i < 4; ++i) for (int j = 0; j < 4; ++j) { acc0[i][j] += a[i] * b0[j]; if (PAIRED) acc1[i][j] += a[i] * b1[j]; }
        }
        __syncthreads();
    }
    for (int i = 0; i < 4; ++i) { const int row = m0 + ty * 4 + i; const float rstd = ModeTraits<MODE>::RSTD ? rstd_from_ss(P.ss, row) : 1.f;
        for (int j = 0; j < 4; ++j) epi_elem<MODE>(P, row, p0 + tx * 4 + j, acc0[i][j], acc1[i][j], rstd); }
}

__global__ void __launch_bounds__(64) k_ref_s5(const bf16_t* ug, const float* h0re, const float* h0im, const float* a_re, const float* a_im, const float* log_dt,
                                               const float* b_re, const float* b_im, const float* c_re, const float* c_im, const float* dskip, bf16_t* gb, float* out) {
    const int g = blockIdx.x % NG, sq = blockIdx.x / NG, n = threadIdx.x;
    const bool prompt = sq < NBATCH; const int b = prompt ? sq : sq - NBATCH, T = prompt ? SEQ : DECS, row0 = prompt ? b * SEQ : MP + b * DECS;
    const float dt = expf(log_dt[g]), lr = a_re[g * NST + n], li = a_im[g * NST + n];
    const float mag = expf(lr * dt), abr = mag * cosf(li * dt), abi = mag * sinf(li * dt);
    const float den = lr * lr + li * li, nr = abr - 1.f, ni = abi, cr = (nr * lr + ni * li) / den, ci = (ni * lr - nr * li) / den;
    float Br[16], Bi[16], Cr[16], Ci[16];
    for (int c = 0; c < 16; ++c) { const float br = b_re[((size_t)g * NST + n) * 16 + c], bi = b_im[((size_t)g * NST + n) * 16 + c];
        Br[c] = cr * br - ci * bi; Bi[c] = cr * bi + ci * br; Cr[c] = c_re[((size_t)g * 16 + c) * NST + n]; Ci[c] = c_im[((size_t)g * 16 + c) * NST + n]; }
    float hr = 0.f, hi = 0.f;
    if (!prompt) { hr = h0re[((size_t)b * NG + g) * NST + n]; hi = h0im[((size_t)b * NG + g) * NST + n]; }
    const float dsk = dskip[g * 16 + (n & 15)];
    for (int t = 0; t < T; ++t) {
        const bf16_t* up = ug + ((size_t)g * M + row0 + t) * 16;
        float u[16], xr = 0.f, xi = 0.f;
#pragma unroll
        for (int c = 0; c < 16; ++c) { u[c] = bf2f(up[c]); xr += Br[c] * u[c]; xi += Bi[c] * u[c]; }
        const float nhr = abr * hr - abi * hi + xr, nhi = abr * hi + abi * hr + xi; hr = nhr; hi = nhi;
        float ymine = 0.f;
#pragma unroll
        for (int c = 0; c < 16; ++c) { const float y = wave_sum(Cr[c] * hr - Ci[c] * hi); if ((n & 15) == c) ymine = y + dsk * u[c]; }
        if (n < 16) gb[(size_t)(row0 + t) * SSM + g * 16 + n] = (bf16_t)f2bf(gelu_tanh(ymine));
    }
    if (prompt) { out[O_SRP + ((size_t)b * NG + g) * NST + n] = hr; out[O_SIP + ((size_t)b * NG + g) * NST + n] = hi; }
    else { out[O_SRS + ((size_t)b * NG + g) * NST + n] = hr; out[O_SIS + ((size_t)b * NG + g) * NST + n] = hi; }
}

__global__ void __launch_bounds__(512) k_ref_conv(const bf16_t* vb, const float* cache, const float* w, const float* bias, const float* lg, const float* lb, bf16_t* mixb, float* out) {
    __shared__ float red[2][8];
    const int row = blockIdx.x, c = threadIdx.x;
    float y = bias[c];
    if (row < MP) { const int t = row % SEQ;
        for (int k = 0; k < CWID; ++k) { const int tt = t - 30 + k; if (tt >= 0) y += w[k * CONVD + c] * bf2f(vb[(size_t)(row - 30 + k) * CONVD + c]); }
    } else { const int rs = row - MP, b = rs / DECS, t = rs % DECS;
        for (int k = 0; k < CWID; ++k) { const int idx = t + k; const float xv = idx < 30 ? cache[((size_t)b * 30 + idx) * CONVD + c] : bf2f(vb[(size_t)(MP + b * DECS + idx - 30) * CONVD + c]); y += w[k * CONVD + c] * xv; }
        if (t == 0) for (int j = 0; j < 22; ++j) out[O_CVS + ((size_t)b * 30 + j) * CONVD + c] = cache[((size_t)b * 30 + j + 8) * CONVD + c];
    }
    float s = wave_sum(y); if ((c & 63) == 0) red[0][c >> 6] = s; __syncthreads();
    float mu = 0.f; for (int i = 0; i < 8; ++i) mu += red[0][i]; mu *= (1.f / CONVD);
    const float d = y - mu; float q = wave_sum(d * d); if ((c & 63) == 0) red[1][c >> 6] = q; __syncthreads();
    float var = 0.f; for (int i = 0; i < 8; ++i) var += red[1][i]; var *= (1.f / CONVD);
    const float z = d * rsqrtf(var + EPS) * lg[c] + lb[c];
    mixb[(size_t)row * D + SSM + c] = (bf16_t)f2bf(siluf_(z));
}

__global__ void __launch_bounds__(256) k_ref_attn(const bf16_t* qb, const bf16_t* kb, const bf16_t* vb2, const float* ck, const float* cv, bf16_t* ob) {
    __shared__ float q[256], p[256], red[4];
    const int row = blockIdx.x >> 2, h = blockIdx.x & 3, tid = threadIdx.x;
    q[tid] = bf2f(qb[(size_t)row * D + h * HD + tid]);
    __syncthreads();
    float s = 0.f;
    if (row < MP) { const int b = row / SEQ; const bf16_t* kr = kb + ((size_t)b * NMEM + tid) * D + h * HD; for (int d = 0; d < HD; ++d) s += q[d] * bf2f(kr[d]); }
    else { const int b = (row - MP) / DECS; const float* kr = ck + ((size_t)b * NMEM + tid) * D + h * HD; for (int d = 0; d < HD; ++d) s += q[d] * kr[d]; }
    float mx = s; for (int o = 1; o < 64; o <<= 1) mx = fmaxf(mx, __shfl_xor(mx, o));
    if ((tid & 63) == 0) red[tid >> 6] = mx; __syncthreads();
    mx = fmaxf(fmaxf(red[0], red[1]), fmaxf(red[2], red[3])); __syncthreads();
    const float e = exp2f(s - mx); float sm = wave_sum(e);
    if ((tid & 63) == 0) red[tid >> 6] = sm; __syncthreads();
    sm = red[0] + red[1] + red[2] + red[3];
    p[tid] = e / sm; __syncthreads();
    float o = 0.f;
    if (row < MP) { const int b = row / SEQ; const bf16_t* vr = vb2 + (size_t)b * NMEM * D + h * HD + tid; for (int m = 0; m < NMEM; ++m) o += p[m] * bf2f(vr[(size_t)m * D]); }
    else { const int b = (row - MP) / DECS; const float* vr = cv + (size_t)b * NMEM * D + h * HD + tid; for (int m = 0; m < NMEM; ++m) o += p[m] * vr[(size_t)m * D]; }
    ob[(size_t)row * D + h * HD + tid] = (bf16_t)f2bf(o);
}

__global__ void k_final(float* y, const float* ss, const float* g) {
    const int row = blockIdx.x * 4 + (threadIdx.x >> 6), lane = threadIdx.x & 63;
    const float r = rstd_from_ss(ss, row);
    for (int j = 0; j < 4; ++j) { f32x4* p = (f32x4*)(y + (size_t)row * D + j * 256 + lane * 4); const f32x4 gg = *(const f32x4*)(g + j * 256 + lane * 4); f32x4 v = *p; v = v * r * gg; *p = v; }
}


namespace pg8 {
#define PG8_LAS __attribute__((address_space(3)))
typedef unsigned short bf16_t;
typedef short bf16x8 __attribute__((ext_vector_type(8)));
typedef float f32x4 __attribute__((ext_vector_type(4)));
typedef unsigned u32x4 __attribute__((ext_vector_type(4)));
constexpr int BM = 256, BK = 64, HALF = 128, HTB = HALF * BK * 2  , STAGE_BYTES = 8 * HTB, NXCD = 8, WGM = 8;

__host__ __device__ __forceinline__ int lds_byte(int r, int c) { const int st = (r >> 4) * 2 + (c >> 5), rr = r & 15, cc = c & 31, ob = rr * 64 + cc * 2; return st * 1024 + (ob ^ (((ob >> 9) & 1) << 5)); }
__host__ __device__ __forceinline__ void stage_rc(int b, int& R, int& C) { const int st = b / 1024, sb = b % 1024, swz = sb ^ (((sb >> 9) & 1) << 5); R = (st >> 1) * 16 + swz / 64; C = (st & 1) * 32 + (swz % 64) / 2; }
__host__ __device__ __forceinline__ int perm32(int rho) { const int n = rho >> 4, i = rho & 15; return 8 * (i >> 2) + 4 * n + (i & 3); }

struct Unit { int pm, pn; };
struct Gemm { const bf16_t* A; const bf16_t* Bt; int M, N, K; };

struct StaticOrder {
    int nM, nN, nwg, G, c;
    __host__ __device__ void init(int M, int N, int G_, int c_) { nM = M / BM; nN = N / BM; nwg = nM * nN; G = G_; c = c_; }
    __host__ __device__ bool next(int i, Unit& u) const {
        const long L = (long)i * G + c; if (L >= nwg) return false;
        int wgid = (int)L; { const int q = nwg / NXCD, r = nwg % NXCD, xcd = wgid % NXCD, off = wgid / NXCD; wgid = (xcd < r ? xcd * (q + 1) : r * (q + 1) + (xcd - r) * q) + off; }
        const int nig = WGM * nN, gid = wgid / nig, fm = gid * WGM, gsz = (nM - fm) < WGM ? (nM - fm) : WGM;
        u.pm = fm + ((wgid % nig) % gsz); u.pn = (wgid % nig) / gsz; return true;
    }
    __device__ __forceinline__ void a_ready(const Unit&) const {}
    __device__ __forceinline__ void done(const Unit&) const {}
};
__device__ __forceinline__ unsigned cvt_pk_bf16(float lo, float hi) { unsigned r; asm volatile("v_cvt_pk_bf16_f32 %0, %1, %2" : "=v"(r) : "v"(lo), "v"(hi)); return r; }
typedef float f32x2 __attribute__((ext_vector_type(2)));
template <class Epi, class Sched, bool ALIGN_EPI = false, bool SP2 = false>
__device__ __forceinline__ void gemm_phase(PG8_LAS unsigned char* lds, const Gemm g, const Sched& S, const Epi& E) {
    const int tid = threadIdx.x, wid = __builtin_amdgcn_readfirstlane(tid >> 6), lane = tid & 63, wr = wid >> 2, wc = wid & 3, fr = lane & 15, fq = lane >> 4;
    const int K = g.K, nt = K / BK;
    unsigned voffA[2], voffB[2];
#pragma unroll
    for (int i = 0; i < 2; ++i) { int R, C; stage_rc(tid * 16 + i * 8192, R, C); const int Rb = Epi::PERM ? ((R & ~31) + perm32(R & 31)) : R;
        voffA[i] = (unsigned)(R * K + C) * 2u; voffB[i] = (unsigned)(Rb * K + C) * 2u; }
    const size_t kstep = (size_t)(BK * 2);
    const size_t hstep = (size_t)HALF * K * 2;
    const size_t tstep = 2 * hstep;
    const unsigned ldsw = (unsigned)wid * 1024u;
    const int aoff = lds_byte(wr * 64 + fr, fq * 8), boff = lds_byte(wc * 32 + fr, fq * 8);
#define PG8_SA(b, h) (((b) * 2 + (h)) * HTB)
#define PG8_SB(b, h) ((4 + (b) * 2 + (h)) * HTB)
#define PG8_STAGE(bufoff, gbase, voff) do { _Pragma("unroll") for (int _i = 0; _i < 2; ++_i) \
        __builtin_amdgcn_global_load_lds((const unsigned*)((const char*)(gbase) + (voff)[_i]), (PG8_LAS unsigned*)(lds + (bufoff) + ldsw + _i * 8192), 16, 0, 0); } while (0)
#define PG8_LDA(dst, b, h) do { _Pragma("unroll") for (int m = 0; m < 4; ++m) _Pragma("unroll") for (int k = 0; k < 2; ++k) dst[m][k] = *(const PG8_LAS bf16x8*)(lds + PG8_SA(b, h) + aoff + m * 2048 + k * 1024); } while (0)
#define PG8_LDB(dst, b, h) do { _Pragma("unroll") for (int n = 0; n < 2; ++n) _Pragma("unroll") for (int k = 0; k < 2; ++k) dst[n][k] = *(const PG8_LAS bf16x8*)(lds + PG8_SB(b, h) + boff + n * 2048 + k * 1024); } while (0)
#define PG8_MMA(ai, bj, At, Bt) do { __builtin_amdgcn_s_setprio(1); _Pragma("unroll") for (int m = 0; m < 4; ++m) _Pragma("unroll") for (int n = 0; n < 2; ++n) _Pragma("unroll") for (int k = 0; k < 2; ++k) \
        acc[ai][bj][m][n] = __builtin_amdgcn_mfma_f32_16x16x32_bf16(Bt[n][k], At[m][k], acc[ai][bj][m][n], 0, 0, 0); __builtin_amdgcn_s_setprio(0); } while (0)
#define PG8_WAIT_V(n) asm volatile("s_waitcnt vmcnt(" #n ")" ::: "memory")
#define PG8_WAIT_L(n) asm volatile("s_waitcnt lgkmcnt(" #n ")" ::: "memory")
#define PG8_BAR __builtin_amdgcn_s_barrier()
#define PG8_SCHED __builtin_amdgcn_sched_barrier(0)
    Unit cur, nxt; int ui = 0;
    if (!S.next(0, cur)) return;
    f32x4 acc[2][2][4][2];
#pragma unroll
    for (int a = 0; a < 2; ++a)
#pragma unroll
        for (int b = 0; b < 2; ++b)
#pragma unroll
            for (int m = 0; m < 4; ++m)
#pragma unroll
                for (int n = 0; n < 2; ++n) acc[a][b][m][n] = (f32x4){0.f, 0.f, 0.f, 0.f};
    bf16x8 At[4][2], B0[2][2], B1[2][2];
    const char* cA = (const char*)g.A + (size_t)cur.pm * tstep; const char* cB = (const char*)g.Bt + (size_t)cur.pn * tstep;
    S.a_ready(cur);
    if constexpr (SP2) {
        PG8_STAGE(PG8_SB(0, 0), cB, voffB); PG8_STAGE(PG8_SB(0, 1), cB + hstep, voffB); PG8_STAGE(PG8_SA(0, 0), cA, voffA); PG8_STAGE(PG8_SA(0, 1), cA + hstep, voffA);
        if (wr == 1) PG8_BAR;
        PG8_WAIT_V(2); PG8_BAR;
        PG8_STAGE(PG8_SB(1, 0), cB + kstep, voffB); PG8_STAGE(PG8_SA(1, 0), cA + kstep, voffA); PG8_STAGE(PG8_SB(1, 1), cB + hstep + kstep, voffB);
        PG8_WAIT_V(6); PG8_BAR;
    } else {
        PG8_STAGE(PG8_SB(0, 0), cB, voffB); PG8_STAGE(PG8_SA(0, 0), cA, voffA); PG8_STAGE(PG8_SB(0, 1), cB + hstep, voffB); PG8_STAGE(PG8_SA(0, 1), cA + hstep, voffA);
        if (wr == 1) PG8_BAR;
        PG8_WAIT_V(4); PG8_BAR;
        PG8_STAGE(PG8_SB(1, 0), cB + kstep, voffB); PG8_STAGE(PG8_SA(1, 0), cA + kstep, voffA); PG8_STAGE(PG8_SB(1, 1), cB + hstep + kstep, voffB);
        PG8_WAIT_V(6); PG8_BAR;
    }
    for (;;) {
        const bool has_next = S.next(ui + 1, nxt);
        const char* nA = has_next ? (const char*)g.A + (size_t)nxt.pm * tstep : cA; const char* nB = has_next ? (const char*)g.Bt + (size_t)nxt.pn * tstep : cB;
        for (int t = 0; t < nt; t += 2) {
            const bool last = (t == nt - 2);
            const char* a1 = cA + (size_t)(t + 1) * kstep;
            const char* a2 = last ? nA : cA + (size_t)(t + 2) * kstep; const char* b2 = last ? nB : cB + (size_t)(t + 2) * kstep;
            const char* a3 = a2 + kstep; const char* b3 = b2 + kstep;
            if (last && has_next) S.a_ready(nxt);
            if constexpr (SP2) {
            PG8_LDB(B0, 0, 0); PG8_LDB(B1, 0, 1); PG8_SCHED; PG8_LDA(At, 0, 0); PG8_STAGE(PG8_SA(1, 1), a1 + hstep, voffA);
            PG8_WAIT_V(8); PG8_WAIT_L(0); PG8_BAR; PG8_MMA(0, 0, At, B0); PG8_MMA(0, 1, At, B1); PG8_BAR; PG8_SCHED;
            PG8_LDA(At, 0, 1); PG8_STAGE(PG8_SB(0, 0), b2, voffB); PG8_STAGE(PG8_SB(0, 1), b2 + hstep, voffB); PG8_STAGE(PG8_SA(0, 0), a2, voffA);
            PG8_WAIT_V(8); PG8_WAIT_L(0); PG8_BAR; PG8_MMA(1, 0, At, B0); PG8_MMA(1, 1, At, B1); PG8_BAR; PG8_SCHED;
            PG8_LDB(B0, 1, 0); PG8_LDB(B1, 1, 1); PG8_SCHED; PG8_LDA(At, 1, 0); PG8_STAGE(PG8_SA(0, 1), a2 + hstep, voffA);
            PG8_WAIT_V(8); PG8_WAIT_L(0); PG8_BAR; PG8_MMA(0, 0, At, B0); PG8_MMA(0, 1, At, B1); PG8_BAR; PG8_SCHED;
            PG8_LDA(At, 1, 1); PG8_STAGE(PG8_SB(1, 0), b3, voffB); PG8_STAGE(PG8_SB(1, 1), b3 + hstep, voffB); PG8_STAGE(PG8_SA(1, 0), a3, voffA);
            PG8_WAIT_V(8); PG8_WAIT_L(0); PG8_BAR; PG8_MMA(1, 0, At, B0); PG8_MMA(1, 1, At, B1); PG8_BAR; PG8_SCHED;
            } else {
            PG8_LDB(B0, 0, 0); PG8_SCHED; PG8_LDA(At, 0, 0); PG8_STAGE(PG8_SA(1, 1), a1 + hstep, voffA);
            PG8_WAIT_L(8); PG8_BAR; PG8_WAIT_L(0); PG8_MMA(0, 0, At, B0); PG8_BAR; PG8_SCHED;
            PG8_LDB(B1, 0, 1); PG8_STAGE(PG8_SB(0, 0), b2, voffB);
            PG8_BAR; PG8_WAIT_L(0); PG8_MMA(0, 1, At, B1); PG8_BAR;
            PG8_LDA(At, 0, 1); PG8_STAGE(PG8_SA(0, 0), a2, voffA);
            PG8_BAR; PG8_WAIT_L(0); PG8_MMA(1, 0, At, B0); PG8_BAR; PG8_SCHED;
            PG8_STAGE(PG8_SB(0, 1), b2 + hstep, voffB);
            PG8_WAIT_V(6); PG8_BAR; PG8_MMA(1, 1, At, B1); PG8_BAR;
            PG8_LDB(B0, 1, 0); PG8_SCHED; PG8_LDA(At, 1, 0); PG8_STAGE(PG8_SA(0, 1), a2 + hstep, voffA);
            PG8_WAIT_L(8); PG8_BAR; PG8_WAIT_L(0); PG8_MMA(0, 0, At, B0); PG8_BAR; PG8_SCHED;
            PG8_LDB(B1, 1, 1); PG8_STAGE(PG8_SB(1, 0), b3, voffB);
            PG8_BAR; PG8_WAIT_L(0); PG8_MMA(0, 1, At, B1); PG8_BAR;
            PG8_LDA(At, 1, 1); PG8_STAGE(PG8_SA(1, 0), a3, voffA);
            PG8_BAR; PG8_WAIT_L(0); PG8_MMA(1, 0, At, B0); PG8_BAR; PG8_SCHED;
            PG8_STAGE(PG8_SB(1, 1), b3 + hstep, voffB);
            PG8_WAIT_V(6); PG8_BAR; PG8_MMA(1, 1, At, B1); PG8_BAR;
            }
        }
        if constexpr (ALIGN_EPI) { if (wr == 0) PG8_BAR; }
        if constexpr (!Epi::AFTER_DRAIN) { E(acc, cur, wr, wc, fr, fq); S.done(cur); }
        if (!has_next) break;
#pragma unroll
        for (int a = 0; a < 2; ++a)
#pragma unroll
            for (int b = 0; b < 2; ++b)
#pragma unroll
                for (int m = 0; m < 4; ++m)
#pragma unroll
                    for (int n = 0; n < 2; ++n) acc[a][b][m][n] = (f32x4){0.f, 0.f, 0.f, 0.f};
        cur = nxt; cA = nA; cB = nB; ++ui;
        if constexpr (ALIGN_EPI) { if (wr == 1) PG8_BAR; }
    }
    PG8_WAIT_V(0);
    if constexpr (!ALIGN_EPI) { if (wr == 0) PG8_BAR; }
    PG8_BAR;
    if constexpr (Epi::AFTER_DRAIN) { E.fused(acc, cur, wr, wc, fr, fq, lds, wid, lane); S.done(cur); }
#undef PG8_SA
#undef PG8_SB
#undef PG8_STAGE
#undef PG8_LDA
#undef PG8_LDB
#undef PG8_MMA
#undef PG8_WAIT_V
#undef PG8_WAIT_L
#undef PG8_BAR
#undef PG8_SCHED
}
}

namespace fx {
using pg8::f32x4; using pg8::u32x4; using pg8::Unit; using pg8::HALF; using pg8::BM; using pg8::cvt_pk_bf16;
__device__ __forceinline__ float rstd_row(const float* ss, int row) {
    const f32x4* p = (const f32x4*)(ss + (size_t)row * 16); const f32x4 a = p[0], b = p[1], c = p[2], d = p[3];
    const float s = ((a.x + a.y) + (a.z + a.w)) + ((b.x + b.y) + (b.z + b.w)) + ((c.x + c.y) + (c.z + c.w)) + ((d.x + d.y) + (d.z + d.w));
    return rsqrtf(s * (1.f / D) + EPS);
}
__device__ __forceinline__ float fsig(float x) { return __builtin_amdgcn_rcpf(1.f + __builtin_amdgcn_exp2f(-1.4426950408889634f * x)); }
__device__ __forceinline__ u32x4 pack8(const f32x4 a, const f32x4 b) { u32x4 w; w.x = cvt_pk_bf16(a[0], a[1]); w.y = cvt_pk_bf16(a[2], a[3]); w.z = cvt_pk_bf16(b[0], b[1]); w.w = cvt_pk_bf16(b[2], b[3]); return w; }
__device__ __forceinline__ f32x4 sig4(const f32x4 x) { return (f32x4){fsig(x[0]), fsig(x[1]), fsig(x[2]), fsig(x[3])}; }

struct EpiKV { static constexpr bool PERM = true, AFTER_DRAIN = false; const float* ss; bf16_t* kb; bf16_t* vb2; float* out;
    __device__ __forceinline__ void operator()(const f32x4 (&acc)[2][2][4][2], const Unit& u, int wr, int wc, int fr, int fq) const {
        const int row0 = u.pm * BM + wr * 64 + fr; const bool isv = u.pn >= 4; const int colt = (isv ? u.pn - 4 : u.pn) * BM + wc * 32 + 8 * fq;
        float* of = out + (isv ? O_MVP : O_MKP); bf16_t* ob = isv ? vb2 : kb;
#pragma unroll
        for (int ai = 0; ai < 2; ++ai)
#pragma unroll
            for (int m = 0; m < 4; ++m) { const int row = row0 + ai * HALF + m * 16; const float r = rstd_row(ss, row);
#pragma unroll
                for (int bj = 0; bj < 2; ++bj) { const f32x4 v0 = acc[ai][bj][m][0] * r, v1 = acc[ai][bj][m][1] * r; const size_t o = (size_t)row * D + colt + bj * HALF;
                    *(f32x4*)(of + o) = v0; *(f32x4*)(of + o + 4) = v1; *(u32x4*)(ob + o) = pack8(v0, v1); } }
    }
};

struct EpiK { static constexpr bool PERM = true, AFTER_DRAIN = false; const float* rstdm; bf16_t* kb; float* out;
    __device__ __forceinline__ void operator()(const f32x4 (&acc)[2][2][4][2], const Unit& u, int wr, int wc, int fr, int fq) const {
        const int row0 = u.pm * BM + wr * 64 + fr, colt = u.pn * BM + wc * 32 + 8 * fq;
#pragma unroll
        for (int ai = 0; ai < 2; ++ai)
#pragma unroll
            for (int m = 0; m < 4; ++m) { const int row = row0 + ai * HALF + m * 16; const float r = rstdm[row];
#pragma unroll
                for (int bj = 0; bj < 2; ++bj) { const f32x4 v0 = acc[ai][bj][m][0] * r, v1 = acc[ai][bj][m][1] * r; const size_t o = (size_t)row * D + colt + bj * HALF;
                    *(f32x4*)(out + O_MKP + o) = v0; *(f32x4*)(out + O_MKP + o + 4) = v1; *(u32x4*)(kb + o) = pack8(v0, v1); } }
    }
};
struct EpiVT { static constexpr bool PERM = true, AFTER_DRAIN = false; const float* rstdm; bf16_t* vT; float* out;
    __device__ __forceinline__ void operator()(const f32x4 (&acc)[2][2][4][2], const Unit& u, int wr, int wc, int fr, int fq) const {
        const int row0 = u.pm * BM + wr * 64 + fr;
#pragma unroll
        for (int bj = 0; bj < 2; ++bj) { const int cl = bj * HALF + wc * 32 + 8 * fq, c0 = u.pn * BM + cl;
            const f32x4 r0 = *(const f32x4*)(rstdm + c0), r1 = *(const f32x4*)(rstdm + c0 + 4);
            const int pos0 = (cl & ~15) + 4 * ((cl >> 3) & 1);
#pragma unroll
            for (int ai = 0; ai < 2; ++ai)
#pragma unroll
                for (int m = 0; m < 4; ++m) { const int row = row0 + ai * HALF + m * 16; const f32x4 v0 = acc[ai][bj][m][0] * r0, v1 = acc[ai][bj][m][1] * r1;
                    bf16_t* vp = vT + (size_t)row * MMEM + u.pn * BM;
                    typedef unsigned u32x2 __attribute__((ext_vector_type(2)));
                    *(u32x2*)(vp + pos0) = (u32x2){cvt_pk_bf16(v0[0], v0[1]), cvt_pk_bf16(v0[2], v0[3])}; *(u32x2*)(vp + pos0 + 8) = (u32x2){cvt_pk_bf16(v1[0], v1[1]), cvt_pk_bf16(v1[2], v1[3])};
                    float* op = out + O_MVP + (size_t)c0 * D + row;
                    op[0] = v0[0]; op[D] = v0[1]; op[2 * D] = v0[2]; op[3 * D] = v0[3]; op[4 * D] = v1[0]; op[5 * D] = v1[1]; op[6 * D] = v1[2]; op[7 * D] = v1[3]; } }
    }
};
struct EpiSwiglu { static constexpr bool PERM = true, AFTER_DRAIN = false; const float* ss; bf16_t* H;
    __device__ __forceinline__ void operator()(const f32x4 (&acc)[2][2][4][2], const Unit& u, int wr, int wc, int fr, int fq) const {
        const int row0 = u.pm * BM + wr * 64 + fr, col0 = u.pn * HALF + wc * 32 + 8 * fq;
#pragma unroll
        for (int ai = 0; ai < 2; ++ai)
#pragma unroll
            for (int m = 0; m < 4; ++m) { const int row = row0 + ai * HALF + m * 16; const float r = rstd_row(ss, row);
                const f32x4 g0 = acc[ai][0][m][0] * r, g1 = acc[ai][0][m][1] * r, u0 = acc[ai][1][m][0] * r, u1 = acc[ai][1][m][1] * r;
                *(u32x4*)(H + (size_t)row * FF + col0) = pack8(g0 * sig4(g0) * u0, g1 * sig4(g1) * u1); }
    }
};
struct EpiRes { static constexpr bool PERM = true, AFTER_DRAIN = false; const float* rin0; const float* rin1; float* rout; bf16_t* xb; float* ss; float alpha;
    __device__ __forceinline__ void operator()(const f32x4 (&acc)[2][2][4][2], const Unit& u, int wr, int wc, int fr, int fq) const {
        const int row0 = u.pm * BM + wr * 64 + fr, col0 = u.pn * BM + wc * 32 + 8 * fq; const float* rin = u.pm >= MP / BM ? rin1 : rin0;
#pragma unroll
        for (int ai = 0; ai < 2; ++ai)
#pragma unroll
            for (int m = 0; m < 4; ++m) { const int row = row0 + ai * HALF + m * 16; float sq = 0.f;
#pragma unroll
                for (int bj = 0; bj < 2; ++bj) { const size_t o = (size_t)row * D + col0 + bj * HALF;
                    const f32x4 v0 = *(const f32x4*)(rin + o) + acc[ai][bj][m][0] * alpha, v1 = *(const f32x4*)(rin + o + 4) + acc[ai][bj][m][1] * alpha;
                    *(f32x4*)(rout + o) = v0; *(f32x4*)(rout + o + 4) = v1; if (xb) *(u32x4*)(xb + o) = pack8(v0, v1);
                    sq += (v0[0] * v0[0] + v0[1] * v0[1]) + (v0[2] * v0[2] + v0[3] * v0[3]) + (v1[0] * v1[0] + v1[1] * v1[1]) + (v1[2] * v1[2] + v1[3] * v1[3]); }
                sq += __shfl_xor(sq, 16); sq += __shfl_xor(sq, 32);
                if (fq == 0) ss[(size_t)row * 16 + u.pn * 4 + wc] = sq;
                if (m & 1) asm volatile("" ::: "memory"); }
    }
};
struct EpiIn { static constexpr bool PERM = true, AFTER_DRAIN = false; const float* ss; bf16_t* ug; bf16_t* vb; float* out;
    __device__ __forceinline__ void operator()(const f32x4 (&acc)[2][2][4][2], const Unit& u, int wr, int wc, int fr, int fq) const {
        const int row0 = u.pm * BM + wr * 64 + fr;
        if (u.pn < 2) {
#pragma unroll
            for (int ai = 0; ai < 2; ++ai)
#pragma unroll
                for (int m = 0; m < 4; ++m) { const int row = row0 + ai * HALF + m * 16; const float r = rstd_row(ss, row);
#pragma unroll
                    for (int bj = 0; bj < 2; ++bj) { const int c0 = u.pn * BM + bj * HALF + wc * 32 + 8 * fq;
                        *(u32x4*)(ug + ((size_t)(c0 >> 4) * M + row) * 16 + (c0 & 15)) = pack8(acc[ai][bj][m][0] * r, acc[ai][bj][m][1] * r); } }
        } else {
            const int p0 = (u.pn - 2) * HALF + wc * 32 + 8 * fq;
#pragma unroll
            for (int ai = 0; ai < 2; ++ai)
#pragma unroll
                for (int m = 0; m < 4; ++m) { const int row = row0 + ai * HALF + m * 16; const float r = rstd_row(ss, row);
                    const f32x4 a0 = acc[ai][0][m][0] * r, a1 = acc[ai][0][m][1] * r, g0 = acc[ai][1][m][0] * r, g1 = acc[ai][1][m][1] * r;
                    const f32x4 v0 = a0 * sig4(g0), v1 = a1 * sig4(g1);
                    *(u32x4*)(vb + (size_t)row * CONVD + p0) = pack8(v0, v1);
                    float* o = nullptr;
                    if (row >= MP) { const int rs = row - MP; o = out + O_CVS + ((size_t)(rs >> 3) * 30 + 22 + (rs & 7)) * CONVD + p0; }
                    else { const int t = row & (SEQ - 1); if (t >= SEQ - 30) o = out + O_CVP + ((size_t)(row >> 11) * 30 + (t - (SEQ - 30))) * CONVD + p0; }
                    if (o) { *(f32x4*)o = v0; *(f32x4*)(o + 4) = v1; } }
        }
    }
};
struct EpiGlu { static constexpr bool PERM = true, AFTER_DRAIN = false; const bf16_t* gb; bf16_t* mixb;
    __device__ __forceinline__ void operator()(const f32x4 (&acc)[2][2][4][2], const Unit& u, int wr, int wc, int fr, int fq) const {
        const int row0 = u.pm * BM + wr * 64 + fr, col0 = u.pn * BM + wc * 32 + 8 * fq;
#pragma unroll
        for (int ai = 0; ai < 2; ++ai)
#pragma unroll
            for (int m = 0; m < 4; ++m) { const int row = row0 + ai * HALF + m * 16;
#pragma unroll
                for (int bj = 0; bj < 2; ++bj) { const int c0 = col0 + bj * HALF; const u32x4 gw = *(const u32x4*)(gb + (size_t)row * SSM + c0);
                    const f32x4 ga = {__builtin_bit_cast(float, gw.x << 16), __builtin_bit_cast(float, gw.x & 0xffff0000u), __builtin_bit_cast(float, gw.y << 16), __builtin_bit_cast(float, gw.y & 0xffff0000u)};
                    const f32x4 gc = {__builtin_bit_cast(float, gw.z << 16), __builtin_bit_cast(float, gw.z & 0xffff0000u), __builtin_bit_cast(float, gw.w << 16), __builtin_bit_cast(float, gw.w & 0xffff0000u)};
                    *(u32x4*)(mixb + (size_t)row * D + c0) = pack8(ga * sig4(acc[ai][bj][m][0]), gc * sig4(acc[ai][bj][m][1])); } }
    }
};
struct EpiQ { static constexpr bool PERM = true, AFTER_DRAIN = false; const float* ss; bf16_t* qb;
    __device__ __forceinline__ void operator()(const f32x4 (&acc)[2][2][4][2], const Unit& u, int wr, int wc, int fr, int fq) const {
        const int row0 = u.pm * BM + wr * 64 + fr, col0 = u.pn * BM + wc * 32 + 8 * fq;
#pragma unroll
        for (int ai = 0; ai < 2; ++ai)
#pragma unroll
            for (int m = 0; m < 4; ++m) { const int row = row0 + ai * HALF + m * 16; const float r = rstd_row(ss, row) * QSCALE;
#pragma unroll
                for (int bj = 0; bj < 2; ++bj) *(u32x4*)(qb + (size_t)row * D + col0 + bj * HALF) = pack8(acc[ai][bj][m][0] * r, acc[ai][bj][m][1] * r); }
    }
};
}

#define GAS __attribute__((address_space(1)))
#define LAS __attribute__((address_space(3)))
typedef unsigned v4u __attribute__((ext_vector_type(4)));
typedef float f32x4 __attribute__((ext_vector_type(4)));
typedef short bf16x8 __attribute__((ext_vector_type(8)));
typedef GAS unsigned gu32;
typedef GAS unsigned long long gu64;
#define RLX_AGENT __ATOMIC_RELAXED, __HIP_MEMORY_SCOPE_AGENT
#define LDS_WAIT() asm volatile("s_waitcnt lgkmcnt(0)" ::: "memory")
#define VM_WAIT() asm volatile("s_waitcnt vmcnt(0)" ::: "memory")
__device__ __forceinline__ unsigned long long rt() { return __builtin_amdgcn_s_memrealtime(); }
__device__ __forceinline__ unsigned pk2(float lo, float hi) { return f2bf(lo) | (f2bf(hi) << 16); }

#define XB_TMO      128
#define XB_XCNT(j)  (256  + 64 * (j))
#define XB_XSUB(j)  (1280 + 64 * (j))
#define XB_XGEN(j)  (2304 + 64 * (j))
#define XB_TOP      3328
#define XB_TOPGEN   3392
#define XCD_BAR_WORDS 3456
#define XB_SPIN_CAP (1u << 18)

__device__ __forceinline__ unsigned xb_ld(unsigned* p)              { return __hip_atomic_load(p, __ATOMIC_RELAXED, __HIP_MEMORY_SCOPE_AGENT); }
__device__ __forceinline__ unsigned xb_add(unsigned* p, unsigned v) { return __hip_atomic_fetch_add(p, v, __ATOMIC_RELAXED, __HIP_MEMORY_SCOPE_AGENT); }
__device__ __forceinline__ unsigned xb_xcc_id() { return (unsigned)__builtin_amdgcn_s_getreg((3 << 11) | 20) & 0xFu; }
#define XB_SPIN(cond, bar) do { unsigned _sp = 0; while (cond) { __builtin_amdgcn_s_sleep(1); \
    if ((++_sp & 255u) == 0u) { if (xb_ld(&(bar)[XB_TMO])) break; if (_sp > XB_SPIN_CAP) { atomicAdd(&(bar)[XB_TMO], 1u); break; } } } } while (0)

struct XcdBarrier {
    unsigned* bar; unsigned x;
    volatile LAS unsigned* st;
};

__device__ __forceinline__ XcdBarrier xcd_barrier_post(unsigned* bar, volatile LAS unsigned* st) {
    XcdBarrier b; b.bar = bar; b.x = xb_xcc_id(); b.st = st;
    if (threadIdx.x == 0) (void)xb_add(&bar[XB_XCNT(b.x)], 1u);
    return b;
}
__device__ __forceinline__ void xcd_barrier_complete(unsigned* bar, unsigned x, unsigned& nloc, unsigned& nx) {
    const unsigned G = gridDim.x * gridDim.y * gridDim.z;
    unsigned sum, cnt, mine, sp = 0u;
    for (;;) {
        sum = 0u; cnt = 0u; mine = 0u;
#pragma unroll
        for (unsigned j = 0; j < 16; ++j) { const unsigned c = xb_ld(&bar[XB_XCNT(j)]); sum += c; cnt += (c > 0u) ? 1u : 0u; mine = (j == x) ? c : mine; }
        if (sum == G) break;
        __builtin_amdgcn_s_sleep(1);
        if ((++sp & 255u) == 0u) { if (xb_ld(&bar[XB_TMO])) break; if (sp > XB_SPIN_CAP) { atomicAdd(&bar[XB_TMO], 1u); break; } }
    }
    nloc = mine > 0u ? mine : 1u; nx = cnt > 0u ? cnt : 1u;
}

__device__ __forceinline__ void xcd_barrier(const XcdBarrier& b) {
    asm volatile("s_waitcnt vmcnt(0)" ::: "memory");
    __syncthreads();
    if (threadIdx.x == 0) {
        unsigned* bar = b.bar;
        __builtin_amdgcn_s_waitcnt(0);
        unsigned nloc = b.st[0], nx = b.st[1];
        if (nloc == 0u) { xcd_barrier_complete(bar, b.x, nloc, nx); b.st[0] = nloc; b.st[1] = nx; }
        const unsigned old = xb_add(&bar[XB_XSUB(b.x)], 1u);
        const unsigned gen = old / nloc;
        if (old + 1u == (gen + 1u) * nloc) {
            __builtin_amdgcn_fence(__ATOMIC_RELEASE, "agent");
            asm volatile("s_waitcnt vmcnt(0)" ::: "memory");
            const unsigned og = xb_add(&bar[XB_TOP], 1u);
            const unsigned tg = og / nx;
            if (og + 1u == (tg + 1u) * nx) xb_add(&bar[XB_TOPGEN], 1u);
            else XB_SPIN(xb_ld(&bar[XB_TOPGEN]) == tg, bar);
            __builtin_amdgcn_fence(__ATOMIC_ACQUIRE, "agent");
            xb_add(&bar[XB_XGEN(b.x)], 1u);
            asm volatile("s_waitcnt vmcnt(0)" ::: "memory");
        } else {
            XB_SPIN(xb_ld(&bar[XB_XGEN(b.x)]) == gen, bar);
            __builtin_amdgcn_fence(__ATOMIC_ACQUIRE, "agent");
            asm volatile("s_waitcnt vmcnt(0)" ::: "memory");
        }
    }
    __syncthreads();
}

namespace sb {
__device__ __forceinline__ void transpose_item(const float* W, int ldw, int c0, const float* gain, bf16_t* WT, int K, int n0, int k0, LAS float* scr, int lane) {
#pragma unroll 8
    for (int i = 0; i < 32; ++i) { const int kk = 2 * i + (lane >> 5); float v = W[(size_t)(k0 + kk) * ldw + c0 + (lane & 31)]; if (gain) v *= gain[k0 + kk]; scr[kk * 33 + (lane & 31)] = v; }
    LDS_WAIT(); asm volatile("" ::: "memory");
    const int c = lane & 7;
#pragma unroll
    for (int j = 0; j < 4; ++j) { const int n = (lane >> 3) + 8 * j; const LAS float* s = scr + (8 * c) * 33 + n;
        v4u o; o.x = pk2(s[0 * 33], s[1 * 33]); o.y = pk2(s[2 * 33], s[3 * 33]); o.z = pk2(s[4 * 33], s[5 * 33]); o.w = pk2(s[6 * 33], s[7 * 33]);
        *(GAS v4u*)(WT + (size_t)(n0 + n) * K + k0 + 8 * c) = o; }
    LDS_WAIT(); asm volatile("" ::: "memory");
}
template <int MAP>
__device__ __forceinline__ void transpose_job_item(const float* W0, const float* W1, const float* gain, bf16_t* WT, int K, int N, int ldw, int item, LAS float* scr, int lane) {
    const int nblk = N / 32, kb = item / nblk, nb = item % nblk, n0 = 32 * nb, k0 = 64 * kb;
    const float* W = W0; int c0 = n0;
    if (MAP == 1) { const int pn = n0 / 256, half = (n0 % 256) / 128, jj = n0 % 128; W = half ? W1 : W0; c0 = pn * 128 + jj; }
    if (MAP == 2) { if (n0 >= 512) { const int m = n0 - 512, pc = m / 256, half = (m % 256) / 128, jj = m % 128; c0 = 512 + half * 512 + pc * 128 + jj; } }
    if (MAP == 3) { if (n0 >= 1024) { W = W1; c0 = n0 - 1024; } }
    transpose_item(W, ldw, c0, gain, WT, K, n0, k0, scr, lane);
}
__device__ __forceinline__ void row_bf16_ss(const float* xr, bf16_t* orow, float* ssrow, float* rstd1, int lane) {
    float s = 0.f;
#pragma unroll
    for (int j = 0; j < 4; ++j) { const f32x4 v = *(const f32x4*)(xr + j * 256 + lane * 4); s += (v.x * v.x + v.y * v.y) + (v.z * v.z + v.w * v.w);
        uint2 o; o.x = pk2(v.x, v.y); o.y = pk2(v.z, v.w); *(uint2*)(orow + j * 256 + lane * 4) = o; }
    s = wave_sum(s);
    if (lane < 16) ssrow[lane] = lane == 0 ? s : 0.f;
    if (rstd1 && lane == 0) *rstd1 = rsqrtf(s * (1.f / D) + EPS);
}

__device__ __forceinline__ void s5_task(int task, const bf16_t* ug, const float* h0re, const float* h0im, const float* a_re, const float* a_im, const float* log_dt,
                                        const float* b_re, const float* b_im, const float* c_re, const float* c_im, const float* dskip, bf16_t* gb, float* out, int n) {
    const int g = task % NG, sq = task / NG;
    const bool prompt = sq < NBATCH; const int b = prompt ? sq : sq - NBATCH, T = prompt ? SEQ : DECS, row0 = prompt ? b * SEQ : MP + b * DECS;
    const float dt = expf(log_dt[g]), lr = a_re[g * NST + n], li = a_im[g * NST + n];
    const float mag = expf(lr * dt), abr = mag * cosf(li * dt), abi = mag * sinf(li * dt);
    const float den = lr * lr + li * li, nr = abr - 1.f, ni = abi, cr = (nr * lr + ni * li) / den, ci = (ni * lr - nr * li) / den;
    float Br[16], Bi[16], Cr[16], Ci[16];
#pragma unroll
    for (int c = 0; c < 16; ++c) { const float br = b_re[((size_t)g * NST + n) * 16 + c], bi = b_im[((size_t)g * NST + n) * 16 + c];
        Br[c] = cr * br - ci * bi; Bi[c] = cr * bi + ci * br; Cr[c] = c_re[((size_t)g * 16 + c) * NST + n]; Ci[c] = c_im[((size_t)g * 16 + c) * NST + n]; }
    float hr = 0.f, hi = 0.f;
    if (!prompt) { hr = h0re[((size_t)b * NG + g) * NST + n]; hi = h0im[((size_t)b * NG + g) * NST + n]; }
    const float dsk = dskip[g * 16 + (n & 15)];
    for (int t = 0; t < T; ++t) {
        const bf16_t* up = ug + ((size_t)g * M + row0 + t) * 16;
        const v4u w0 = *(const v4u*)up, w1 = *(const v4u*)(up + 8);
        float u[16];
        u[0] = __builtin_bit_cast(float, w0.x << 16); u[1] = __builtin_bit_cast(float, w0.x & 0xffff0000u); u[2] = __builtin_bit_cast(float, w0.y << 16); u[3] = __builtin_bit_cast(float, w0.y & 0xffff0000u);
        u[4] = __builtin_bit_cast(float, w0.z << 16); u[5] = __builtin_bit_cast(float, w0.z & 0xffff0000u); u[6] = __builtin_bit_cast(float, w0.w << 16); u[7] = __builtin_bit_cast(float, w0.w & 0xffff0000u);
        u[8] = __builtin_bit_cast(float, w1.x << 16); u[9] = __builtin_bit_cast(float, w1.x & 0xffff0000u); u[10] = __builtin_bit_cast(float, w1.y << 16); u[11] = __builtin_bit_cast(float, w1.y & 0xffff0000u);
        u[12] = __builtin_bit_cast(float, w1.z << 16); u[13] = __builtin_bit_cast(float, w1.z & 0xffff0000u); u[14] = __builtin_bit_cast(float, w1.w << 16); u[15] = __builtin_bit_cast(float, w1.w & 0xffff0000u);
        float xr = 0.f, xi = 0.f;
#pragma unroll
        for (int c = 0; c < 16; ++c) { xr += Br[c] * u[c]; xi += Bi[c] * u[c]; }
        const float nhr = abr * hr - abi * hi + xr, nhi = abr * hi + abi * hr + xi; hr = nhr; hi = nhi;
        float ymine = 0.f;
#pragma unroll
        for (int c = 0; c < 16; ++c) { const float y = wave_sum(Cr[c] * hr - Ci[c] * hi); if ((n & 15) == c) ymine = y + dsk * u[c]; }
        if (n < 16) gb[(size_t)(row0 + t) * SSM + g * 16 + n] = (bf16_t)f2bf(gelu_tanh(ymine));
    }
    if (prompt) { out[O_SRP + ((size_t)b * NG + g) * NST + n] = hr; out[O_SIP + ((size_t)b * NG + g) * NST + n] = hi; }
    else { out[O_SRS + ((size_t)b * NG + g) * NST + n] = hr; out[O_SIS + ((size_t)b * NG + g) * NST + n] = hi; }
}

__device__ __forceinline__ void conv_row(int row, const bf16_t* vb, const float* cache, const float* w, const float* bias, const float* lg, const float* lb, bf16_t* mixb, float* out, LAS float* red, int c) {
    float y = bias[c];
    if (row < MP) { const int t = row % SEQ;
        for (int k = 0; k < CWID; ++k) { const int tt = t - 30 + k; if (tt >= 0) y += w[k * CONVD + c] * bf2f(vb[(size_t)(row - 30 + k) * CONVD + c]); }
    } else { const int rs = row - MP, b = rs / DECS, t = rs % DECS;
        for (int k = 0; k < CWID; ++k) { const int idx = t + k; const float xv = idx < 30 ? cache[((size_t)b * 30 + idx) * CONVD + c] : bf2f(vb[(size_t)(MP + b * DECS + idx - 30) * CONVD + c]); y += w[k * CONVD + c] * xv; }
        if (t == 0) for (int j = 0; j < 22; ++j) out[O_CVS + ((size_t)b * 30 + j) * CONVD + c] = cache[((size_t)b * 30 + j + 8) * CONVD + c];
    }
    float s = wave_sum(y); if ((c & 63) == 0) red[c >> 6] = s; __syncthreads();
    float mu = 0.f;
#pragma unroll
    for (int i = 0; i < 8; ++i) mu += red[i];
    mu *= (1.f / CONVD);
    const float d = y - mu; float q = wave_sum(d * d); if ((c & 63) == 0) red[8 + (c >> 6)] = q; __syncthreads();
    float var = 0.f;
#pragma unroll
    for (int i = 0; i < 8; ++i) var += red[8 + i];
    var *= (1.f / CONVD);
    const float z = d * rsqrtf(var + EPS) * lg[c] + lb[c];
    mixb[(size_t)row * D + SSM + c] = (bf16_t)f2bf(siluf_(z));
}

__device__ __forceinline__ void attn_task(int task, const bf16_t* qb, const bf16_t* kb, const bf16_t* vb2, const float* ck, const float* cv, bf16_t* ob, LAS float* scr, int t256) {
    LAS float* q = scr; LAS float* p = scr + 2048; LAS float* red = scr + 4096;
    const int rg = task >> 2, h = task & 3, row0 = rg * 8; const bool prompt = row0 < MP; const int b = prompt ? row0 / SEQ : (row0 - MP) / DECS;
#pragma unroll
    for (int r = 0; r < 8; ++r) q[r * 256 + t256] = bf2f(qb[(size_t)(row0 + r) * D + h * HD + t256]);
    __syncthreads();
    float s[8];
#pragma unroll
    for (int r = 0; r < 8; ++r) s[r] = 0.f;
    if (prompt) { const bf16_t* kr = kb + ((size_t)b * NMEM + t256) * D + h * HD;
        for (int d = 0; d < HD; d += 8) { const v4u w = *(const v4u*)(kr + d); float kv[8];
            kv[0] = __builtin_bit_cast(float, w.x << 16); kv[1] = __builtin_bit_cast(float, w.x & 0xffff0000u); kv[2] = __builtin_bit_cast(float, w.y << 16); kv[3] = __builtin_bit_cast(float, w.y & 0xffff0000u);
            kv[4] = __builtin_bit_cast(float, w.z << 16); kv[5] = __builtin_bit_cast(float, w.z & 0xffff0000u); kv[6] = __builtin_bit_cast(float, w.w << 16); kv[7] = __builtin_bit_cast(float, w.w & 0xffff0000u);
#pragma unroll
            for (int r = 0; r < 8; ++r)
#pragma unroll
                for (int j = 0; j < 8; ++j) s[r] += q[r * 256 + d + j] * kv[j]; }
    } else { const float* kr = ck + ((size_t)b * NMEM + t256) * D + h * HD;
        for (int d = 0; d < HD; d += 4) { const f32x4 kv = *(const f32x4*)(kr + d);
#pragma unroll
            for (int r = 0; r < 8; ++r) s[r] += (q[r * 256 + d] * kv.x + q[r * 256 + d + 1] * kv.y) + (q[r * 256 + d + 2] * kv.z + q[r * 256 + d + 3] * kv.w); }
    }
    const int w4 = t256 >> 6;
#pragma unroll
    for (int r = 0; r < 8; ++r) { float mx = s[r];
#pragma unroll
        for (int o = 1; o < 64; o <<= 1) mx = fmaxf(mx, __shfl_xor(mx, o));
        if ((t256 & 63) == 0) red[r * 4 + w4] = mx; }
    __syncthreads();
    float e[8];
#pragma unroll
    for (int r = 0; r < 8; ++r) { const float mx = fmaxf(fmaxf(red[r * 4], red[r * 4 + 1]), fmaxf(red[r * 4 + 2], red[r * 4 + 3])); e[r] = exp2f(s[r] - mx); }
    __syncthreads();
#pragma unroll
    for (int r = 0; r < 8; ++r) { const float sm = wave_sum(e[r]); if ((t256 & 63) == 0) red[r * 4 + w4] = sm; }
    __syncthreads();
#pragma unroll
    for (int r = 0; r < 8; ++r) { const float sm = (red[r * 4] + red[r * 4 + 1]) + (red[r * 4 + 2] + red[r * 4 + 3]); p[r * 256 + t256] = e[r] / sm; }
    __syncthreads();
    float o[8];
#pragma unroll
    for (int r = 0; r < 8; ++r) o[r] = 0.f;
    if (prompt) { const bf16_t* vr = vb2 + (size_t)b * NMEM * D + h * HD + t256;
        for (int m = 0; m < NMEM; ++m) { const float vv = bf2f(vr[(size_t)m * D]);
#pragma unroll
            for (int r = 0; r < 8; ++r) o[r] += p[r * 256 + m] * vv; }
    } else { const float* vr = cv + (size_t)b * NMEM * D + h * HD + t256;
        for (int m = 0; m < NMEM; ++m) { const float vv = vr[(size_t)m * D];
#pragma unroll
            for (int r = 0; r < 8; ++r) o[r] += p[r * 256 + m] * vv; }
    }
#pragma unroll
    for (int r = 0; r < 8; ++r) ob[(size_t)(row0 + r) * D + h * HD + t256] = (bf16_t)f2bf(o[r]);
    __syncthreads();
}
}

namespace s5f {
typedef short bf16x8 __attribute__((ext_vector_type(8)));
constexpr int KT_OFF = 0, KT_BYTES = 65 * 256 * 2, U_OFF = 33792, U_CSTR = 2064, S_OFF = U_OFF + 32 * U_CSTR, H_OFF = S_OFF + 32 * 128 * 4, H_RSTR = 272, END_OFF = H_OFF + 32 * H_RSTR;
static_assert(KT_BYTES <= U_OFF && END_OFF <= 131072, "S5 LDS map");
constexpr size_t TAB_KT = 0, TAB_P = 2 * MiB, TAB_Q = 10 * MiB, TAB_AL = 18 * MiB;
struct cf { float re, im; };
typedef float f32x2v __attribute__((ext_vector_type(2)));
typedef unsigned u32x2v __attribute__((ext_vector_type(2)));
__device__ __forceinline__ f32x2v tov(cf a) { return (f32x2v){a.re, a.im}; }
__device__ __forceinline__ cf toc(f32x2v a) { return cf{a.x, a.y}; }
__device__ __forceinline__ cf cmul(cf a, cf b) { return cf{a.re * b.re - a.im * b.im, a.re * b.im + a.im * b.re}; }
__device__ __forceinline__ cf cpow_a(float lr, float li, float dt, float p) { const float mag = expf(lr * dt * p); float s, c; sincosf(li * dt * p, &s, &c); return cf{mag * c, mag * s}; }
__device__ __forceinline__ cf coef_of(float lr, float li, float dt) { const cf a = cpow_a(lr, li, dt, 1.f); const float den = lr * lr + li * li, nr = a.re - 1.f, ni = a.im; return cf{(nr * lr + ni * li) / den, (ni * lr - nr * li) / den}; }

__device__ __forceinline__ void kt_task(int task, const float* a_re, const float* a_im, const float* log_dt, const float* b_re, const float* b_im, const float* c_re, const float* c_im,
                                        bf16_t* Ktab, LAS unsigned char* scr, int tid) {
    const int g = task >> 3, tb = task & 7;
    LAS f32x2v* Wb = (LAS f32x2v*)scr; LAS f32x2v* Bb = (LAS f32x2v*)(scr + 4096); LAS f32x2v* Cc = (LAS f32x2v*)(scr + 4096 + 8192);
    const float dt = expf(log_dt[g]);
    { const int tl = tid >> 6, n = tid & 63; Wb[tl * 64 + n] = tov(cpow_a(a_re[g * NST + n], a_im[g * NST + n], dt, (float)(8 * tb + tl))); }
#pragma unroll
    for (int e = tid; e < 1024; e += 512) { const int n = e >> 4, c = e & 15; const cf co = coef_of(a_re[g * NST + n], a_im[g * NST + n], dt);
        Bb[e] = tov(cmul(co, cf{b_re[((size_t)g * NST + n) * 16 + c], b_im[((size_t)g * NST + n) * 16 + c]})); }
#pragma unroll
    for (int e = tid; e < 1024; e += 512) Cc[e] = (f32x2v){c_re[(size_t)g * 1024 + e], c_im[(size_t)g * 1024 + e]};
    __syncthreads();
    { const int tl = tid >> 6, cc = tid & 63, c = cc >> 2, c0 = 4 * (cc & 3); float acc[4] = {0.f, 0.f, 0.f, 0.f};
        for (int n = 0; n < 64; ++n) { const cf T = cmul(toc(Cc[c * 64 + n]), toc(Wb[tl * 64 + n]));
#pragma unroll
            for (int k = 0; k < 4; ++k) { const cf E = toc(Bb[n * 16 + c0 + k]); acc[k] += T.re * E.re - T.im * E.im; } }
        uint2 o; o.x = pk2(acc[0], acc[1]); o.y = pk2(acc[2], acc[3]);
        *(uint2*)(Ktab + (((size_t)g * 65 + 8 * tb + tl + 1) * 16 + c) * 16 + c0) = o; }
    if (tb == 0 && tid < 32) *(v4u*)(Ktab + (size_t)g * 65 * 256 + tid * 8) = (v4u){0u, 0u, 0u, 0u};
    __syncthreads();
}
__device__ __forceinline__ void pq_entry(int e, const float* a_re, const float* a_im, const float* log_dt, const float* b_re, const float* b_im, const float* c_re, const float* c_im,
                                         bf16_t* Ptab, bf16_t* Qtab, float* ALtab) {
    {
        const int n = e & 63, j = (e >> 6) & 63, g = e >> 12; const float dt = expf(log_dt[g]);
        const cf W = cpow_a(a_re[g * NST + n], a_im[g * NST + n], dt, (float)(j + 1));
#pragma unroll
        for (int c = 0; c < 16; ++c) { const cf w = cmul(cf{c_re[((size_t)g * 16 + c) * NST + n], c_im[((size_t)g * 16 + c) * NST + n]}, W);
            bf16_t* p = Ptab + (((size_t)g * 64 + j) * 16 + c) * 128; p[n] = (bf16_t)f2bf(w.re); p[64 + n] = (bf16_t)f2bf(-w.im); }
        if (j == 0) { const cf al = cpow_a(a_re[g * NST + n], a_im[g * NST + n], dt, 64.f); ALtab[(g * NST + n) * 2] = al.re; ALtab[(g * NST + n) * 2 + 1] = al.im; }
    }
    {
        const int i = e & 63, n = (e >> 6) & 63, g = e >> 12; const float dt = expf(log_dt[g]);
        const float lr = a_re[g * NST + n], li = a_im[g * NST + n];
        const cf V = cmul(cpow_a(lr, li, dt, (float)(63 - i)), coef_of(lr, li, dt));
        unsigned wr[8], wi[8];
#pragma unroll
        for (int c = 0; c < 16; c += 2) { const cf v0 = cmul(V, cf{b_re[((size_t)g * NST + n) * 16 + c], b_im[((size_t)g * NST + n) * 16 + c]}), v1 = cmul(V, cf{b_re[((size_t)g * NST + n) * 16 + c + 1], b_im[((size_t)g * NST + n) * 16 + c + 1]});
            wr[c >> 1] = pk2(v0.re, v1.re); wi[c >> 1] = pk2(v0.im, v1.im); }
        v4u* qr = (v4u*)(Qtab + ((size_t)g * 128 + n) * 1024 + i * 16); v4u* qi = (v4u*)(Qtab + ((size_t)g * 128 + 64 + n) * 1024 + i * 16);
        qr[0] = (v4u){wr[0], wr[1], wr[2], wr[3]}; qr[1] = (v4u){wr[4], wr[5], wr[6], wr[7]}; qi[0] = (v4u){wi[0], wi[1], wi[2], wi[3]}; qi[1] = (v4u){wi[4], wi[5], wi[6], wi[7]};
    }
}
__device__ __forceinline__ float gelu_fast(float x) { const float u = 1.5957691216057308f * (x + 0.044715f * x * x * x); return x * __builtin_amdgcn_rcpf(1.f + __builtin_amdgcn_exp2f(-1.4426950408889634f * u)); }

__device__ __forceinline__ void prompt_unit(int b, int g, const bf16_t* ug, const bf16_t* Ktab, const bf16_t* Ptab, const bf16_t* Qtab, const float* ALtab, const float* dskip, bf16_t* gb, float* out,
                                            LAS unsigned char* L, int tid, int wave, int lane) {
    {
        const v4u* src = (const v4u*)(Ktab + (size_t)g * 65 * 256);
        for (int q = tid; q < KT_BYTES / 16; q += 512) *(LAS v4u*)(L + KT_OFF + q * 16) = src[q];
        const v4u* us = (const v4u*)(ug + ((size_t)g * M + (size_t)b * SEQ) * 16);
#pragma unroll
        for (int p = 0; p < 8; ++p) { const int q = p * 512 + tid; *(LAS v4u*)(L + U_OFF + (q >> 7) * U_CSTR + (q & 127) * 16) = us[q]; }
    }
    __syncthreads();
    const int fr = lane & 15, kq = lane >> 4;
    const LAS unsigned char* ub0 = L + U_OFF + fr * U_CSTR + kq * 16; const LAS unsigned char* ub1 = ub0 + 16 * U_CSTR;
    {
        f32x4 a0 = {0.f, 0.f, 0.f, 0.f}, a1 = {0.f, 0.f, 0.f, 0.f};
        const bf16_t* qrow = Qtab + ((size_t)g * 128 + wave * 16 + fr) * 1024 + kq * 8;
#pragma unroll 4
        for (int s = 0; s < 32; ++s) { const bf16x8 a = *(const bf16x8*)(qrow + s * 32);
            a0 = __builtin_amdgcn_mfma_f32_16x16x32_bf16(a, *(const LAS bf16x8*)(ub0 + s * 64), a0, 0, 0, 0);
            a1 = __builtin_amdgcn_mfma_f32_16x16x32_bf16(a, *(const LAS bf16x8*)(ub1 + s * 64), a1, 0, 0, 0); }
        *(LAS f32x4*)(L + S_OFF + (fr * 128 + wave * 16 + kq * 4) * 4) = a0;
        *(LAS f32x4*)(L + S_OFF + ((16 + fr) * 128 + wave * 16 + kq * 4) * 4) = a1;
    }
    __syncthreads();
    if (tid < 64) {
        const int n = tid; const float alr = ALtab[(g * NST + n) * 2], ali = ALtab[(g * NST + n) * 2 + 1]; float hr = 0.f, hi = 0.f;
        const LAS float* Sb = (const LAS float*)(L + S_OFF);
        for (int c = 0; c < 32; ++c) { LAS bf16_t* hb = (LAS bf16_t*)(L + H_OFF + c * H_RSTR); hb[n] = (bf16_t)f2bf(hr); hb[64 + n] = (bf16_t)f2bf(hi);
            const float sr = Sb[c * 128 + n], si = Sb[c * 128 + 64 + n]; const float nhr = alr * hr - ali * hi + sr, nhi = alr * hi + ali * hr + si; hr = nhr; hi = nhi; }
        out[O_SRP + ((size_t)b * NG + g) * NST + n] = hr; out[O_SIP + ((size_t)b * NG + g) * NST + n] = hi;
    }
    __syncthreads();
    f32x4 acc[8][2];
#pragma unroll
    for (int q = 0; q < 8; ++q) { acc[q][0] = (f32x4){0.f, 0.f, 0.f, 0.f}; acc[q][1] = (f32x4){0.f, 0.f, 0.f, 0.f}; }
    {
        const LAS unsigned char* kt = L + KT_OFF + (fr * 16 + (kq & 1) * 8) * 2 + (wave + 1 - (kq >> 1)) * 512;
        const int smax = (wave + 56) >> 1;
        for (int s = 0; s <= smax; ++s) {
            const bf16x8 b0 = *(const LAS bf16x8*)(ub0 + s * 64), b1 = *(const LAS bf16x8*)(ub1 + s * 64);
#pragma unroll
            for (int q = 0; q < 8; ++q) if (wave + 8 * q >= 2 * s) { const bf16x8 a = *(const LAS bf16x8*)(kt + (8 * q - 2 * s) * 512);
                acc[q][0] = __builtin_amdgcn_mfma_f32_16x16x32_bf16(a, b0, acc[q][0], 0, 0, 0); acc[q][1] = __builtin_amdgcn_mfma_f32_16x16x32_bf16(a, b1, acc[q][1], 0, 0, 0); }
        }
    }
    {
        const LAS unsigned char* hb0 = L + H_OFF + fr * H_RSTR + kq * 16; const LAS unsigned char* hb1 = hb0 + 16 * H_RSTR;
        const bf16_t* prow = Ptab + (((size_t)g * 64 + wave) * 16 + fr) * 128 + kq * 8;
#pragma unroll
        for (int s2 = 0; s2 < 4; ++s2) { const bf16x8 b0 = *(const LAS bf16x8*)(hb0 + s2 * 64), b1 = *(const LAS bf16x8*)(hb1 + s2 * 64);
#pragma unroll
            for (int q = 0; q < 8; ++q) { const bf16x8 a = *(const bf16x8*)(prow + (size_t)q * 8 * 16 * 128 + s2 * 32);
                acc[q][0] = __builtin_amdgcn_mfma_f32_16x16x32_bf16(a, b0, acc[q][0], 0, 0, 0); acc[q][1] = __builtin_amdgcn_mfma_f32_16x16x32_bf16(a, b1, acc[q][1], 0, 0, 0); } }
    }
    {
        const f32x4 dsk = *(const f32x4*)(dskip + g * 16 + kq * 4);
#pragma unroll
        for (int q = 0; q < 8; ++q)
#pragma unroll
            for (int nb = 0; nb < 2; ++nb) { const int chunk = nb * 16 + fr, j = wave + 8 * q;
                const u32x2v uw = *(const LAS u32x2v*)(L + U_OFF + chunk * U_CSTR + (j * 16 + kq * 4) * 2);
                const f32x4 u4 = {__builtin_bit_cast(float, uw.x << 16), __builtin_bit_cast(float, uw.x & 0xffff0000u), __builtin_bit_cast(float, uw.y << 16), __builtin_bit_cast(float, uw.y & 0xffff0000u)};
                const f32x4 y = acc[q][nb] + dsk * u4;
                uint2 o; o.x = pk2(gelu_fast(y[0]), gelu_fast(y[1])); o.y = pk2(gelu_fast(y[2]), gelu_fast(y[3]));
                *(uint2*)(gb + ((size_t)b * SEQ + chunk * 64 + j) * SSM + g * 16 + kq * 4) = o; }
    }
    __syncthreads();
}
}

namespace att {
typedef short bf16x8 __attribute__((ext_vector_type(8)));
typedef float f32x16 __attribute__((ext_vector_type(16)));
typedef float f32x2v __attribute__((ext_vector_type(2)));
typedef unsigned u32x2v __attribute__((ext_vector_type(2)));
__device__ __forceinline__ int crow(int r, int hi) { return (r & 3) + 8 * (r >> 2) + 4 * hi; }
__device__ __forceinline__ unsigned cvtpk(float lo, float hi) { return pg8::cvt_pk_bf16(lo, hi); }

__device__ __forceinline__ void prompt_unit(int b, int h, int qblk, const bf16_t* qb, const bf16_t* kb, const bf16_t* vT, bf16_t* ob, LAS unsigned char* L, LAS float* wsf, int tid, int wave, int lane) {
    const int r32 = lane & 31, hh = lane >> 5, x = r32 & 15;
    const bf16_t* Kg = kb + (size_t)b * NMEM * D + h * HD;
    for (int half = 0; half < 2; ++half)
#pragma unroll 4
        for (int p = 0; p < 8; ++p) { const int q = p * 512 + tid, mem = q >> 4, c16 = q & 15;
            *(LAS v4u*)(L + half * 65536 + mem * 256 + ((c16 ^ (mem & 15)) << 4)) = *(const v4u*)(Kg + (size_t)mem * D + half * 128 + c16 * 8); }
    const size_t qrow = (size_t)b * SEQ + qblk * 256 + wave * 32 + r32;
    const bf16_t* Qg = qb + qrow * D + h * HD + hh * 8;
    unsigned koff[8];
#pragma unroll
    for (int ks = 0; ks < 8; ++ks) koff[ks] = (unsigned)(((2 * ks + hh) ^ x) << 4);
    __syncthreads();
    f32x16 S[8];
#pragma unroll
    for (int mb = 0; mb < 8; ++mb)
#pragma unroll
        for (int r = 0; r < 16; ++r) S[mb][r] = 0.f;
#pragma unroll
    for (int half = 0; half < 2; ++half) {
        bf16x8 qf[8];
#pragma unroll
        for (int ks = 0; ks < 8; ++ks) qf[ks] = *(const bf16x8*)(Qg + half * 128 + ks * 16);
        const LAS unsigned char* kbase = L + half * 65536 + r32 * 256;
#pragma unroll
        for (int mb = 0; mb < 8; ++mb) {
#pragma unroll
            for (int ks = 0; ks < 8; ++ks) S[mb] = __builtin_amdgcn_mfma_f32_32x32x16_bf16(*(const LAS bf16x8*)(kbase + mb * 8192 + koff[ks]), qf[ks], S[mb], 0, 0, 0);
            asm volatile("" : "+v"(S[mb])); __builtin_amdgcn_sched_barrier(0); }
    }
    __syncthreads();
    const bf16_t* Vg = vT + (size_t)h * HD * MMEM + (size_t)b * NMEM;
    for (int dh = 0; dh < 2; ++dh)
#pragma unroll 4
        for (int p = 0; p < 8; ++p) { const int q = p * 512 + tid, dd = q >> 5, c32 = q & 31;
            *(LAS v4u*)(L + dh * 65536 + dd * 512 + ((c32 ^ (dd & 15)) << 4)) = *(const v4u*)(Vg + (size_t)(dh * 128 + dd) * MMEM + c32 * 8); }
    float mx = S[0][0];
#pragma unroll
    for (int mb = 0; mb < 8; ++mb)
#pragma unroll
        for (int r = 0; r < 16; ++r) mx = fmaxf(mx, S[mb][r]);
    mx = fmaxf(mx, __shfl_xor(mx, 32));
    float lsum = 0.f;
    v4u pa[8][2];
#pragma unroll
    for (int mb = 0; mb < 8; ++mb) {
#pragma unroll
        for (int r = 0; r < 16; ++r) { const float e = __builtin_amdgcn_exp2f(S[mb][r] - mx); S[mb][r] = e; lsum += e; }
#pragma unroll
        for (int s = 0; s < 2; ++s) pa[mb][s] = (v4u){cvtpk(S[mb][8 * s], S[mb][8 * s + 1]), cvtpk(S[mb][8 * s + 2], S[mb][8 * s + 3]), cvtpk(S[mb][8 * s + 4], S[mb][8 * s + 5]), cvtpk(S[mb][8 * s + 6], S[mb][8 * s + 7])};
    }
    lsum += __shfl_xor(lsum, 32);
    if (hh == 0) wsf[r32] = lsum;
    __syncthreads();
    unsigned voff[2][4];
#pragma unroll
    for (int s = 0; s < 2; ++s)
#pragma unroll
        for (int ml = 0; ml < 4; ++ml) voff[s][ml] = (unsigned)(((4 * ml + 2 * s) ^ (hh ^ x)) << 4);
    bf16_t* Og = ob + ((size_t)b * SEQ + qblk * 256 + wave * 32 + 4 * hh) * D + h * HD + r32;
#pragma unroll
    for (int dh = 0; dh < 2; ++dh) {
        f32x16 O[4];
#pragma unroll
        for (int db = 0; db < 4; ++db)
#pragma unroll
            for (int r = 0; r < 16; ++r) O[db][r] = 0.f;
        const LAS unsigned char* vbase = L + dh * 65536 + r32 * 512;
#pragma unroll
        for (int mb = 0; mb < 8; ++mb)
#pragma unroll
            for (int s = 0; s < 2; ++s) { const bf16x8 a = __builtin_bit_cast(bf16x8, pa[mb][s]);
#pragma unroll
                for (int db = 0; db < 4; ++db)
                    O[db] = __builtin_amdgcn_mfma_f32_32x32x16_bf16(a, *(const LAS bf16x8*)(vbase + db * 16384 + (mb >> 2) * 256 + voff[s][mb & 3]), O[db], 0, 0, 0);
                asm volatile("" : "+v"(O[0]), "+v"(O[1]), "+v"(O[2]), "+v"(O[3])); __builtin_amdgcn_sched_barrier(0); }
#pragma unroll
        for (int r = 0; r < 16; ++r) { const float rl = __builtin_amdgcn_rcpf(wsf[crow(r, hh)]);
#pragma unroll
            for (int db = 0; db < 4; ++db) Og[(size_t)((r & 3) + 8 * (r >> 2)) * D + dh * 128 + db * 32] = (bf16_t)f2bf(O[db][r] * rl);
            __builtin_amdgcn_sched_barrier(0); }
    }
    __syncthreads();
}

__device__ __forceinline__ void sample_unit(int b, int hp, const bf16_t* qb, const float* ck, const float* cv, bf16_t* ob, LAS unsigned char* L, int tid, int wave, int lane) {
    const int hsel = wave >> 2, mq = wave & 3, head = 2 * hp + hsel;
    LAS float* sbuf = (LAS float*)L; LAS float* pT = (LAS float*)(L + 16384); LAS float* obuf = (LAS float*)(L + 32768);
    float q[8][4];
#pragma unroll
    for (int t = 0; t < 8; ++t) { const u32x2v w = *(const u32x2v*)(qb + ((size_t)MP + b * DECS + t) * D + head * HD + lane * 4);
        q[t][0] = __builtin_bit_cast(float, w.x << 16); q[t][1] = __builtin_bit_cast(float, w.x & 0xffff0000u); q[t][2] = __builtin_bit_cast(float, w.y << 16); q[t][3] = __builtin_bit_cast(float, w.y & 0xffff0000u); }
    const float* Kr = ck + (((size_t)b * NMEM + mq * 64) * NH + head) * HD + lane * 4;
    for (int m0 = 0; m0 < 64; m0 += 4) {
        f32x4 k4[4];
#pragma unroll
        for (int i = 0; i < 4; ++i) k4[i] = *(const f32x4*)(Kr + (size_t)(m0 + i) * NH * HD);
#pragma unroll
        for (int i = 0; i < 4; ++i) {
            float v[8];
#pragma unroll
            for (int t = 0; t < 8; ++t) v[t] = (q[t][0] * k4[i].x + q[t][1] * k4[i].y) + (q[t][2] * k4[i].z + q[t][3] * k4[i].w);
            float r4[4], r2[2], r1;
#pragma unroll
            for (int j = 0; j < 4; ++j) { const bool up = lane & 32; const float send = up ? v[j] : v[j + 4], keep = up ? v[j + 4] : v[j]; r4[j] = keep + __shfl_xor(send, 32); }
#pragma unroll
            for (int j = 0; j < 2; ++j) { const bool up = lane & 16; const float send = up ? r4[j] : r4[j + 2], keep = up ? r4[j + 2] : r4[j]; r2[j] = keep + __shfl_xor(send, 16); }
            { const bool up = lane & 8; const float send = up ? r2[0] : r2[1], keep = up ? r2[1] : r2[0]; r1 = keep + __shfl_xor(send, 8); }
            r1 += __shfl_xor(r1, 4); r1 += __shfl_xor(r1, 2); r1 += __shfl_xor(r1, 1);
            const int t = ((lane >> 5) & 1) * 4 + ((lane >> 4) & 1) * 2 + ((lane >> 3) & 1);
            if ((lane & 7) == 0) sbuf[(hsel * 8 + t) * 256 + mq * 64 + m0 + i] = r1;
        }
    }
    __syncthreads();
#pragma unroll
    for (int rr = 0; rr < 2; ++rr) { const int row = wave * 2 + rr;
        const f32x4 s4 = *(const LAS f32x4*)(sbuf + row * 256 + lane * 4);
        float mx = fmaxf(fmaxf(s4.x, s4.y), fmaxf(s4.z, s4.w));
#pragma unroll
        for (int o = 1; o < 64; o <<= 1) mx = fmaxf(mx, __shfl_xor(mx, o));
        const float e0 = exp2f(s4.x - mx), e1 = exp2f(s4.y - mx), e2 = exp2f(s4.z - mx), e3 = exp2f(s4.w - mx);
        const float inv = 1.f / wave_sum((e0 + e1) + (e2 + e3));
        LAS float* pp = pT + ((row >> 3) * 256 + lane * 4) * 8 + (row & 7);
        pp[0] = e0 * inv; pp[8] = e1 * inv; pp[16] = e2 * inv; pp[24] = e3 * inv; }
    __syncthreads();
    float o[8][4];
#pragma unroll
    for (int t = 0; t < 8; ++t) { o[t][0] = 0.f; o[t][1] = 0.f; o[t][2] = 0.f; o[t][3] = 0.f; }
    const float* Vr = cv + (((size_t)b * NMEM + mq * 64) * NH + head) * HD + lane * 4;
    for (int m0 = 0; m0 < 64; m0 += 4) {
        f32x4 v4[4];
#pragma unroll
        for (int i = 0; i < 4; ++i) v4[i] = *(const f32x4*)(Vr + (size_t)(m0 + i) * NH * HD);
#pragma unroll
        for (int i = 0; i < 4; ++i) { const LAS f32x4* pp = (const LAS f32x4*)(pT + (hsel * 256 + mq * 64 + m0 + i) * 8); const f32x4 pa = pp[0], pb = pp[1];
            const float pv[8] = {pa.x, pa.y, pa.z, pa.w, pb.x, pb.y, pb.z, pb.w};
#pragma unroll
            for (int t = 0; t < 8; ++t) { o[t][0] += pv[t] * v4[i].x; o[t][1] += pv[t] * v4[i].y; o[t][2] += pv[t] * v4[i].z; o[t][3] += pv[t] * v4[i].w; } }
    }
#pragma unroll
    for (int t = 0; t < 8; ++t) *(LAS f32x4*)(obuf + ((hsel * 4 + mq) * 8 + t) * 256 + lane * 4) = (f32x4){o[t][0], o[t][1], o[t][2], o[t][3]};
    __syncthreads();
    { const int hs = tid >> 8, t = (tid >> 5) & 7, d8 = tid & 31;
        f32x4 a0 = {0.f, 0.f, 0.f, 0.f}, a1 = {0.f, 0.f, 0.f, 0.f};
#pragma unroll
        for (int m = 0; m < 4; ++m) { const LAS f32x4* pp = (const LAS f32x4*)(obuf + ((hs * 4 + m) * 8 + t) * 256 + d8 * 8); a0 = a0 + pp[0]; a1 = a1 + pp[1]; }
        *(v4u*)(ob + ((size_t)MP + b * DECS + t) * D + (2 * hp + hs) * HD + d8 * 8) = (v4u){pk2(a0.x, a0.y), pk2(a0.z, a0.w), pk2(a1.x, a1.y), pk2(a1.z, a1.w)};
    }
    __syncthreads();
}
}

namespace cvx {
template <int NT>
__device__ __forceinline__ void ln_swish_rows(const LAS float* ybuf, int row0, const float* lg, const float* lb, bf16_t* mixb, int wave, int lane) {
    const f32x4 g0 = *(const f32x4*)(lg + lane * 4), g1 = *(const f32x4*)(lg + 256 + lane * 4), b0 = *(const f32x4*)(lb + lane * 4), b1 = *(const f32x4*)(lb + 256 + lane * 4);
    for (int j = wave; j < NT; j += 8) {
        const f32x4 a = *(const LAS f32x4*)(ybuf + j * 512 + lane * 4), b = *(const LAS f32x4*)(ybuf + j * 512 + 256 + lane * 4);
        const float s = wave_sum(((a.x + a.y) + (a.z + a.w)) + ((b.x + b.y) + (b.z + b.w)));
        const float mu = s * (1.f / CONVD); const f32x4 da = a - mu, db = b - mu;
        const float q = wave_sum(((da.x * da.x + da.y * da.y) + (da.z * da.z + da.w * da.w)) + ((db.x * db.x + db.y * db.y) + (db.z * db.z + db.w * db.w)));
        const float rs = rsqrtf(q * (1.f / CONVD) + EPS);
        const f32x4 za = da * rs * g0 + b0, zb = db * rs * g1 + b1;
        typedef unsigned u32x2 __attribute__((ext_vector_type(2)));
        bf16_t* o = mixb + (size_t)(row0 + j) * D + SSM + lane * 4;
        *(u32x2*)o = (u32x2){pk2(za.x * fx::fsig(za.x), za.y * fx::fsig(za.y)), pk2(za.z * fx::fsig(za.z), za.w * fx::fsig(za.w))};
        *(u32x2*)(o + 256) = (u32x2){pk2(zb.x * fx::fsig(zb.x), zb.y * fx::fsig(zb.y)), pk2(zb.z * fx::fsig(zb.z), zb.w * fx::fsig(zb.w))};
    }
}
__device__ __forceinline__ void prompt_tile(int b, int t0, const bf16_t* vb, const float* w, const float* bias, const float* lg, const float* lb, bf16_t* mixb, LAS float* ybuf, int tid, int wave, int lane) {
    const int c = tid;
    float wk[31];
#pragma unroll
    for (int k = 0; k < 31; ++k) wk[k] = w[k * CONVD + c];
    const float bs = bias[c];
    const bf16_t* vp = vb + (size_t)b * SEQ * CONVD + c;
#pragma unroll 1
    for (int pass = 0; pass < 4; ++pass) {
        const int tb = t0 + pass * 16;
        float xin[46];
#pragma unroll
        for (int ii = 0; ii < 46; ++ii) { const int tt = tb - 30 + ii; const int tc = tt < 0 ? 0 : tt; const float v = bf2f(vp[(size_t)tc * CONVD]); xin[ii] = tt < 0 ? 0.f : v; }
#pragma unroll
        for (int j = 0; j < 16; ++j) { float y = bs;
#pragma unroll
            for (int k = 0; k < 31; ++k) y += wk[k] * xin[j + k];
            ybuf[(pass * 16 + j) * 512 + c] = y; }
    }
    __syncthreads();
    ln_swish_rows<64>(ybuf, b * SEQ + t0, lg, lb, mixb, wave, lane);
    __syncthreads();
}
__device__ __forceinline__ void sample_batch(int b, const bf16_t* vb, const float* cache, const float* w, const float* bias, const float* lg, const float* lb, bf16_t* mixb, float* out, LAS float* ybuf, int tid, int wave, int lane) {
    const int c = tid;
    float xp[38];
#pragma unroll
    for (int i = 0; i < 30; ++i) xp[i] = cache[((size_t)b * 30 + i) * CONVD + c];
#pragma unroll
    for (int i = 0; i < 8; ++i) xp[30 + i] = bf2f(vb[((size_t)MP + b * DECS + i) * CONVD + c]);
#pragma unroll
    for (int j = 0; j < 22; ++j) out[O_CVS + ((size_t)b * 30 + j) * CONVD + c] = xp[j + 8];
    float y[8];
    const float bs = bias[c];
#pragma unroll
    for (int j = 0; j < 8; ++j) y[j] = bs;
#pragma unroll
    for (int k = 0; k < 31; ++k) { const float wv = w[k * CONVD + c];
#pragma unroll
        for (int j = 0; j < 8; ++j) y[j] += wv * xp[j + k]; }
#pragma unroll
    for (int j = 0; j < 8; ++j) ybuf[j * 512 + c] = y[j];
    __syncthreads();
    ln_swish_rows<8>(ybuf, MP + b * DECS, lg, lb, mixb, wave, lane);
    __syncthreads();
}
}

namespace sg {
typedef short bf16x8 __attribute__((ext_vector_type(8)));
constexpr int PSTR = 68, PBYTES = 64 * PSTR * 4;
template <class Epi>
__device__ __forceinline__ void tile(const bf16_t* A, const bf16_t* Bt, int K, int tm, int tn, const Epi& E, LAS unsigned char* L, int tid, int wave, int lane) {
    const int fr = lane & 15, kq = lane >> 4, kw = K >> 3, ns = kw >> 5;
    const bf16_t* a0 = A + (size_t)(tm * 64 + fr) * K + wave * kw + kq * 8;
    const bf16_t* b0 = Bt + (size_t)(tn * 64 + fr) * K + wave * kw + kq * 8;
    f32x4 acc[4][4];
#pragma unroll
    for (int i = 0; i < 4; ++i)
#pragma unroll
        for (int j = 0; j < 4; ++j) acc[i][j] = (f32x4){0.f, 0.f, 0.f, 0.f};
#pragma unroll 2
    for (int s = 0; s < ns; ++s) {
        bf16x8 af[4], bf[4];
#pragma unroll
        for (int i = 0; i < 4; ++i) { af[i] = *(const bf16x8*)(a0 + (size_t)i * 16 * K + s * 32); bf[i] = *(const bf16x8*)(b0 + (size_t)i * 16 * K + s * 32); }
#pragma unroll
        for (int i = 0; i < 4; ++i)
#pragma unroll
            for (int j = 0; j < 4; ++j) acc[i][j] = __builtin_amdgcn_mfma_f32_16x16x32_bf16(af[i], bf[j], acc[i][j], 0, 0, 0);
    }
    LAS float* P = (LAS float*)(L + (wave & 3) * PBYTES) + (4 * kq) * PSTR + fr;
    if (wave >= 4) {
#pragma unroll
        for (int i = 0; i < 4; ++i)
#pragma unroll
            for (int j = 0; j < 4; ++j)
#pragma unroll
                for (int r = 0; r < 4; ++r) P[(16 * i + r) * PSTR + 16 * j] = acc[i][j][r];
    }
    __syncthreads();
    if (wave < 4) {
#pragma unroll
        for (int i = 0; i < 4; ++i)
#pragma unroll
            for (int j = 0; j < 4; ++j)
#pragma unroll
                for (int r = 0; r < 4; ++r) acc[i][j][r] += P[(16 * i + r) * PSTR + 16 * j];
    }
    __syncthreads();
    if (wave < 4) {
#pragma unroll
        for (int i = 0; i < 4; ++i)
#pragma unroll
            for (int j = 0; j < 4; ++j)
#pragma unroll
                for (int r = 0; r < 4; ++r) P[(16 * i + r) * PSTR + 16 * j] = acc[i][j][r];
    }
    __syncthreads();
    { const int row = tid >> 3, c8 = (tid & 7) * 8; f32x4 v0 = {0.f, 0.f, 0.f, 0.f}, v1 = {0.f, 0.f, 0.f, 0.f};
#pragma unroll
        for (int w = 0; w < 4; ++w) { const LAS f32x4* p = (const LAS f32x4*)(L + w * PBYTES + (row * PSTR + c8) * 4); v0 = v0 + p[0]; v1 = v1 + p[1]; }
        E(tm * 64 + row, tn * 64 + c8, tn, v0, v1, lane); }
    __syncthreads();
}
struct SRes { const float* rin; float* rout; bf16_t* xb; float* ss; float alpha;
    __device__ __forceinline__ void operator()(int row, int col0, int slot, f32x4 a0, f32x4 a1, int lane) const {
        const size_t o = (size_t)row * D + col0;
        const f32x4 v0 = *(const f32x4*)(rin + o) + a0 * alpha, v1 = *(const f32x4*)(rin + o + 4) + a1 * alpha;
        *(f32x4*)(rout + o) = v0; *(f32x4*)(rout + o + 4) = v1; if (xb) *(fx::u32x4*)(xb + o) = fx::pack8(v0, v1);
        float sq = ((v0[0] * v0[0] + v0[1] * v0[1]) + (v0[2] * v0[2] + v0[3] * v0[3])) + ((v1[0] * v1[0] + v1[1] * v1[1]) + (v1[2] * v1[2] + v1[3] * v1[3]));
        sq += __shfl_xor(sq, 1); sq += __shfl_xor(sq, 2); sq += __shfl_xor(sq, 4);
        if ((lane & 7) == 0) ss[(size_t)row * 16 + slot] = sq;
    }
};
struct SQ { const float* ss; bf16_t* qb;
    __device__ __forceinline__ void operator()(int row, int col0, int slot, f32x4 a0, f32x4 a1, int lane) const {
        const float r = fx::rstd_row(ss, row) * QSCALE; *(fx::u32x4*)(qb + (size_t)row * D + col0) = fx::pack8(a0 * r, a1 * r);
    }
};
}

namespace pro {
using s5f::cf; using s5f::cmul; using s5f::cpow_a; using s5f::coef_of;
__device__ __forceinline__ void transpose_item(const float* W, int ldw, int c0, const float* gain, bf16_t* WT, int K, int n0, int k0, LAS float* scr, int lane) {
    const int r8 = lane >> 3, c4 = (lane & 7) * 4;
    f32x4 v[8];
#pragma unroll
    for (int i = 0; i < 8; ++i) v[i] = *(const f32x4*)(W + (size_t)(k0 + 8 * i + r8) * ldw + c0 + c4);
    if (gain) {
#pragma unroll
        for (int i = 0; i < 8; ++i) v[i] = v[i] * gain[k0 + 8 * i + r8]; }
#pragma unroll
    for (int i = 0; i < 8; ++i) *(LAS f32x4*)(scr + (8 * i + r8) * 36 + c4) = v[i];
    LDS_WAIT(); asm volatile("" ::: "memory");
    const int c = lane & 7;
#pragma unroll
    for (int j = 0; j < 4; ++j) { const int n = (lane >> 3) + 8 * j; const LAS float* s = scr + (8 * c) * 36 + n;
        v4u o; o.x = pk2(s[0 * 36], s[1 * 36]); o.y = pk2(s[2 * 36], s[3 * 36]); o.z = pk2(s[4 * 36], s[5 * 36]); o.w = pk2(s[6 * 36], s[7 * 36]);
        *(GAS v4u*)(WT + (size_t)(n0 + n) * K + k0 + 8 * c) = o; }
    LDS_WAIT(); asm volatile("" ::: "memory");
}
template <int MAP>
__device__ __forceinline__ void transpose_job_item(const float* W0, const float* W1, const float* gain, bf16_t* WT, int K, int N, int ldw, int item, LAS float* scr, int lane) {
    const int nblk = N / 32, kb = item / nblk, nb = item % nblk, n0 = 32 * nb, k0 = 64 * kb;
    const float* W = W0; int c0 = n0;
    if (MAP == 1) { const int pn = n0 / 256, half = (n0 % 256) / 128, jj = n0 % 128; W = half ? W1 : W0; c0 = pn * 128 + jj; }
    if (MAP == 2) { if (n0 >= 512) { const int m = n0 - 512, pc = m / 256, half = (m % 256) / 128, jj = m % 128; c0 = 512 + half * 512 + pc * 128 + jj; } }
    if (MAP == 3) { if (n0 >= 1024) { W = W1; c0 = n0 - 1024; } }
    transpose_item(W, ldw, c0, gain, WT, K, n0, k0, scr, lane);
}
__device__ __forceinline__ void rows2_bf16_ss(const float* xa, const float* xb_, bf16_t* oa, bf16_t* ob_, float* ssa, float* ssb, float* ra, float* rb, int lane) {
    f32x4 va[4], vb[4];
#pragma unroll
    for (int j = 0; j < 4; ++j) { va[j] = *(const f32x4*)(xa + j * 256 + lane * 4); vb[j] = *(const f32x4*)(xb_ + j * 256 + lane * 4); }
    float sa = 0.f, sb_ = 0.f;
#pragma unroll
    for (int j = 0; j < 4; ++j) { sa += (va[j].x * va[j].x + va[j].y * va[j].y) + (va[j].z * va[j].z + va[j].w * va[j].w); sb_ += (vb[j].x * vb[j].x + vb[j].y * vb[j].y) + (vb[j].z * vb[j].z + vb[j].w * vb[j].w);
        uint2 o; o.x = pk2(va[j].x, va[j].y); o.y = pk2(va[j].z, va[j].w); *(uint2*)(oa + j * 256 + lane * 4) = o;
        uint2 p; p.x = pk2(vb[j].x, vb[j].y); p.y = pk2(vb[j].z, vb[j].w); *(uint2*)(ob_ + j * 256 + lane * 4) = p; }
    sa = wave_sum(sa); sb_ = wave_sum(sb_);
    if (lane < 16) { ssa[lane] = lane == 0 ? sa : 0.f; ssb[lane] = lane == 0 ? sb_ : 0.f; }
    if (ra && lane == 0) { *ra = rsqrtf(sa * (1.f / D) + EPS); *rb = rsqrtf(sb_ * (1.f / D) + EPS); }
}
__device__ __forceinline__ void kt_wave_task(int task, const float* a_re, const float* a_im, const float* log_dt, const float* b_re, const float* b_im, const float* c_re, const float* c_im,
                                             bf16_t* Ktab, LAS float* scr, int lane) {
    const int g = task >> 6, tau = task & 63, n = lane;
    const float dt = expf(log_dt[g]), lr = a_re[g * NST + n], li = a_im[g * NST + n];
    const cf W = cpow_a(lr, li, dt, (float)tau), co = coef_of(lr, li, dt);
    LAS float* T = scr; LAS float* E = scr + 64 * 32;
#pragma unroll
    for (int c = 0; c < 16; ++c) { const cf t = cmul(cf{c_re[((size_t)g * 16 + c) * NST + n], c_im[((size_t)g * 16 + c) * NST + n]}, W); T[n * 32 + 2 * c] = t.re; T[n * 32 + 2 * c + 1] = t.im;
        const cf e = cmul(co, cf{b_re[((size_t)g * NST + n) * 16 + c], b_im[((size_t)g * NST + n) * 16 + c]}); E[n * 32 + 2 * c] = e.re; E[n * 32 + 2 * c + 1] = e.im; }
    LDS_WAIT(); asm volatile("" ::: "memory");
    const int c = lane >> 2, c0 = 4 * (lane & 3); float acc[4] = {0.f, 0.f, 0.f, 0.f};
    for (int m = 0; m < 64; ++m) { const float tr = T[m * 32 + 2 * c], ti = T[m * 32 + 2 * c + 1];
#pragma unroll
        for (int k = 0; k < 4; ++k) acc[k] += tr * E[m * 32 + 2 * (c0 + k)] - ti * E[m * 32 + 2 * (c0 + k) + 1]; }
    uint2 o; o.x = pk2(acc[0], acc[1]); o.y = pk2(acc[2], acc[3]);
    *(uint2*)(Ktab + (((size_t)g * 65 + tau + 1) * 16 + c) * 16 + c0) = o;
    if (tau == 0 && lane < 32) *(v4u*)(Ktab + (size_t)g * 65 * 256 + lane * 8) = (v4u){0u, 0u, 0u, 0u};
    LDS_WAIT(); asm volatile("" ::: "memory");
}
}

#ifndef DBL_MASK
#define DBL_MASK 0
#endif
constexpr int NWAVES = 8;
constexpr int RING_OFF = 0, RING_BYTES = 131072;
constexpr int LDSCTL_OFF = RING_BYTES, MISC_OFF = LDSCTL_OFF + 320, XTRA_OFF = RING_BYTES + 1024;
constexpr int LDS_BYTES = 147456;
constexpr size_t CTL_ZERO_BYTES = 1 * MiB;
constexpr int CW_TMO = 0, CW_CODE = 1, CW_BAR = 4096;
constexpr int MAX_LAUNCHES = 8;
static_assert((CW_BAR + MAX_LAUNCHES * XCD_BAR_WORDS) * 4 <= (int)CTL_ZERO_BYTES, "barrier words inside the memset region");

enum Phase { PH_PRO = 0, PH_GU1 = 1, PH_D1 = 2, PH_IN = 3, PH_MIX = 4, PH_GLU = 5, PH_OUT = 6, PH_Q = 7, PH_ATT = 8, PH_O = 9, PH_GU2 = 10, PH_D2 = 11, PH_FIN = 12, PH_N = 13 };

struct Args { const float* in[39]; float* out; unsigned char* ws; int ph_lo, ph_hi, li, pad; };

__global__ void __launch_bounds__(NWAVES * 64, 2) mk_fwd(Args args) {
    extern __shared__ __attribute__((aligned(16))) unsigned char lds[];
    LAS unsigned char* L = (LAS unsigned char*)lds;
    volatile LAS unsigned* MISC = (volatile LAS unsigned*)(L + MISC_OFF);
    const int tid = threadIdx.x;
    const int G = gridDim.x, bx = blockIdx.x;
    unsigned char* ws = args.ws; float* out = args.out;
    gu32* ctl = (gu32*)(ws + WS_CTL);
    for (int u = tid; u < (LDS_BYTES - LDSCTL_OFF) / 4; u += NWAVES * 64) ((LAS unsigned*)(L + LDSCTL_OFF))[u] = 0u;
    __syncthreads();
    XcdBarrier bar = xcd_barrier_post((unsigned*)(ctl + CW_BAR) + args.li * XCD_BAR_WORDS, MISC + 8);
    const int lo = args.ph_lo, hi = args.ph_hi;
#define IN(k) (lo <= (k) && (k) < hi)
#define BOTH(k) (IN(k) && IN((k) + 1))
#define GRID_BAR() xcd_barrier(bar)
    bf16_t *Wgu1 = (bf16_t*)(ws + WS_WGU1), *Wgu2 = (bf16_t*)(ws + WS_WGU2), *Wd1 = (bf16_t*)(ws + WS_WD1), *Wd2 = (bf16_t*)(ws + WS_WD2), *Win = (bf16_t*)(ws + WS_WIN), *Wglu = (bf16_t*)(ws + WS_WGLU),
           *Wout = (bf16_t*)(ws + WS_WOUT), *Wq = (bf16_t*)(ws + WS_WQ), *Wo = (bf16_t*)(ws + WS_WO), *Wkv = (bf16_t*)(ws + WS_WKV);
    bf16_t *xb = (bf16_t*)(ws + WS_XB), *memb = (bf16_t*)(ws + WS_MEMB), *kb = (bf16_t*)(ws + WS_KB), *vb2 = (bf16_t*)(ws + WS_VB2), *hb = (bf16_t*)(ws + WS_H), *ug = (bf16_t*)(ws + WS_UG),
           *vb = (bf16_t*)(ws + WS_VB), *gb = (bf16_t*)(ws + WS_GB), *mixb = (bf16_t*)(ws + WS_MIXB), *qb = (bf16_t*)(ws + WS_QB), *ob = (bf16_t*)(ws + WS_OB);
    bf16_t *Ktab = (bf16_t*)(ws + WS_TAB + s5f::TAB_KT), *Ptab = (bf16_t*)(ws + WS_TAB + s5f::TAB_P), *Qtab = (bf16_t*)(ws + WS_TAB + s5f::TAB_Q); float* ALtab = (float*)(ws + WS_TAB + s5f::TAB_AL);
    float *ss0 = (float*)(ws + WS_SS0), *ss1 = (float*)(ws + WS_SS1), *ss2 = (float*)(ws + WS_SS2), *ss3 = (float*)(ws + WS_SS3), *ss4 = (float*)(ws + WS_SS4), *ssm = (float*)(ws + WS_SSM), *xres = (float*)(ws + WS_XRES);
    float* rstdm = ssm + (size_t)MMEM * 16; bf16_t* vT = vb2;

    const int wave = __builtin_amdgcn_readfirstlane(tid >> 6), lane = tid & 63;
    const float* const* in = args.in;
    if (IN(PH_PRO)) {
      for (int rep_ = 0; rep_ <= ((DBL_MASK >> PH_PRO) & 1); ++rep_) {
        {
            LAS float* scr = (LAS float*)(L + RING_OFF + wave * 16384);
            const int NGW = G * NWAVES;
            constexpr int I_GU = (D / 64) * (2 * FF / 32), I_D = (FF / 64) * (D / 32), I_IN = (D / 64) * (1536 / 32), I_GLU = (SSM / 64) * (SSM / 32), I_SQ = (D / 64) * (D / 32), I_KV = (D / 64) * (2048 / 32);
            constexpr int NITEMS = 2 * I_GU + 2 * I_D + I_IN + I_GLU + 3 * I_SQ + I_KV;
            constexpr int T_KT = NG * 64, T_PQ = 131072 / 64, T_ROW = M / 2, T_MEM = MMEM / 2, NTASK = T_KT + T_PQ + NITEMS + T_ROW + T_MEM;
            const bool rev = wave & 1; constexpr int NEV = (NTASK + 1) / 2, NOD = NTASK / 2;
            for (int ti = (wave >> 1) * G + bx; ti < (rev ? NOD : NEV); ti += NGW / 2) {
                int r = rev ? 2 * (NOD - 1 - ti) + 1 : 2 * ti;
                if (r < T_KT) { pro::kt_wave_task(r, in[17], in[18], in[19], in[20], in[21], in[22], in[23], Ktab, scr, lane); continue; } r -= T_KT;
                if (r < T_PQ) { s5f::pq_entry(r * 64 + lane, in[17], in[18], in[19], in[20], in[21], in[22], in[23], Ptab, Qtab, ALtab); continue; } r -= T_PQ;
                if (r < NITEMS) {
                    if (r < I_GU) { pro::transpose_job_item<1>(in[12], in[13], in[11], Wgu1, D, 2 * FF, FF, r, scr, lane); continue; } r -= I_GU;
                    if (r < I_GU) { pro::transpose_job_item<1>(in[35], in[36], in[34], Wgu2, D, 2 * FF, FF, r, scr, lane); continue; } r -= I_GU;
                    if (r < I_D) { pro::transpose_job_item<0>(in[14], nullptr, nullptr, Wd1, FF, D, D, r, scr, lane); continue; } r -= I_D;
                    if (r < I_D) { pro::transpose_job_item<0>(in[37], nullptr, nullptr, Wd2, FF, D, D, r, scr, lane); continue; } r -= I_D;
                    if (r < I_IN) { pro::transpose_job_item<2>(in[16], nullptr, in[15], Win, D, 1536, 1536, r, scr, lane); continue; } r -= I_IN;
                    if (r < I_GLU) { pro::transpose_job_item<0>(in[25], nullptr, nullptr, Wglu, SSM, SSM, SSM, r, scr, lane); continue; } r -= I_GLU;
                    if (r < I_SQ) { pro::transpose_job_item<0>(in[30], nullptr, nullptr, Wout, D, D, D, r, scr, lane); continue; } r -= I_SQ;
                    if (r < I_SQ) { pro::transpose_job_item<0>(in[32], nullptr, in[31], Wq, D, D, D, r, scr, lane); continue; } r -= I_SQ;
                    if (r < I_SQ) { pro::transpose_job_item<0>(in[33], nullptr, nullptr, Wo, D, D, D, r, scr, lane); continue; } r -= I_SQ;
                    pro::transpose_job_item<3>(in[9], in[10], in[8], Wkv, D, 2048, D, r, scr, lane); continue;
                }
                r -= NITEMS;
                if (r < T_ROW) { const int m0 = 2 * r, m1 = m0 + 1;
                    pro::rows2_bf16_ss(m0 < MP ? in[0] + (size_t)m0 * D : in[1] + (size_t)(m0 - MP) * D, m1 < MP ? in[0] + (size_t)m1 * D : in[1] + (size_t)(m1 - MP) * D,
                                       xb + (size_t)m0 * D, xb + (size_t)m1 * D, ss0 + (size_t)m0 * 16, ss0 + (size_t)m1 * 16, nullptr, nullptr, lane); continue; }
                r -= T_ROW;
                { const int m0 = 2 * r, m1 = m0 + 1; pro::rows2_bf16_ss(in[7] + (size_t)m0 * D, in[7] + (size_t)m1 * D, memb + (size_t)m0 * D, memb + (size_t)m1 * D, ssm + (size_t)m0 * 16, ssm + (size_t)m1 * 16, rstdm + m0, rstdm + m1, lane); }
            }
        }
        if (rep_ < ((DBL_MASK >> PH_PRO) & 1)) GRID_BAR();
      }
        if (BOTH(PH_PRO)) GRID_BAR();
    }

    if (IN(PH_GU1)) {
      for (int rep_ = 0; rep_ <= ((DBL_MASK >> PH_GU1) & 1); ++rep_) {
        { pg8::Gemm g{memb, Wkv, MMEM, D, D}; pg8::StaticOrder S; S.init(MMEM, D, G, (bx + G - 216 % G) % G); fx::EpiK E{rstdm, kb, out};
          pg8::gemm_phase<fx::EpiK, pg8::StaticOrder, true, true>(L + RING_OFF, g, S, E); }
        { pg8::Gemm g{xb, Wgu1, M, 2 * FF, D}; pg8::StaticOrder S; S.init(M, 2 * FF, G, bx); fx::EpiSwiglu E{ss0, hb};
          pg8::gemm_phase<fx::EpiSwiglu, pg8::StaticOrder, true, true>(L + RING_OFF, g, S, E); }
        if (rep_ < ((DBL_MASK >> PH_GU1) & 1)) GRID_BAR();
      }
        if (BOTH(PH_GU1)) GRID_BAR();
    }
    if (IN(PH_D1)) {
      for (int rep_ = 0; rep_ <= ((DBL_MASK >> PH_D1) & 1); ++rep_) {
        pg8::Gemm g{hb, Wd1, MP, D, FF}; pg8::StaticOrder S; S.init(MP, D, G, bx); fx::EpiRes E{args.in[0], args.in[0], xres, xb, ss1, 0.5f};
        pg8::gemm_phase<fx::EpiRes, pg8::StaticOrder, true, true>(L + RING_OFF, g, S, E);
        { sg::SRes Es{args.in[1], xres + (size_t)MP * D, xb + (size_t)MP * D, ss1 + (size_t)MP * 16, 0.5f};
          for (int t = bx; t < 256; t += G) sg::tile(hb + (size_t)MP * FF, Wd1, FF, t >> 4, t & 15, Es, L + RING_OFF, tid, wave, lane); }
        if (rep_ < ((DBL_MASK >> PH_D1) & 1)) GRID_BAR();
      }
        if (BOTH(PH_D1)) GRID_BAR();
    }
    if (IN(PH_IN)) {
      for (int rep_ = 0; rep_ <= ((DBL_MASK >> PH_IN) & 1); ++rep_) {
        { pg8::Gemm g{xb, Win, M, 1536, D}; pg8::StaticOrder S; S.init(M, 1536, G, bx); fx::EpiIn E{ss1, ug, vb, out};
          pg8::gemm_phase<fx::EpiIn, pg8::StaticOrder, true, true>(L + RING_OFF, g, S, E); }
        { pg8::Gemm g{Wkv + (size_t)D * D, memb, D, MMEM, D}; pg8::StaticOrder S; S.init(D, MMEM, G, (bx + G - 152 % G) % G); fx::EpiVT E{rstdm, vT, out};
          pg8::gemm_phase<fx::EpiVT, pg8::StaticOrder, true, true>(L + RING_OFF, g, S, E); }
        if (rep_ < ((DBL_MASK >> PH_IN) & 1)) GRID_BAR();
      }
        if (BOTH(PH_IN)) GRID_BAR();
    }
    if (IN(PH_MIX)) {
      for (int rep_ = 0; rep_ <= ((DBL_MASK >> PH_MIX) & 1); ++rep_) {
        for (int unit = bx; unit < NBATCH * NG; unit += G) s5f::prompt_unit(unit >> 5, unit & 31, ug, Ktab, Ptab, Qtab, ALtab, in[24], gb, out, L + RING_OFF, tid, wave, lane);
        for (int task = NBATCH * NG + wave * G + bx; task < (NBATCH + DECB) * NG; task += G * NWAVES)
            sb::s5_task(task, ug, in[2], in[3], in[17], in[18], in[19], in[20], in[21], in[22], in[23], in[24], gb, out, lane);
        __syncthreads();
        LAS float* ybuf = (LAS float*)(L + RING_OFF);
        for (int tile = bx; tile < NBATCH * (SEQ / 64); tile += G) cvx::prompt_tile(tile >> 5, (tile & 31) * 64, vb, in[26], in[27], in[28], in[29], mixb, ybuf, tid, wave, lane);
        for (int b = bx; b < DECB; b += G) cvx::sample_batch(b, vb, in[4], in[26], in[27], in[28], in[29], mixb, out, ybuf, tid, wave, lane);
        if (rep_ < ((DBL_MASK >> PH_MIX) & 1)) GRID_BAR();
      }
        if (BOTH(PH_MIX)) GRID_BAR();
    }

    if (IN(PH_GLU)) {
      for (int rep_ = 0; rep_ <= ((DBL_MASK >> PH_GLU) & 1); ++rep_) {
        pg8::Gemm g{gb, Wglu, M, SSM, SSM}; pg8::StaticOrder S; S.init(M, SSM, G, bx); fx::EpiGlu E{gb, mixb};
        pg8::gemm_phase<fx::EpiGlu, pg8::StaticOrder, true, true>(L + RING_OFF, g, S, E);
        if (rep_ < ((DBL_MASK >> PH_GLU) & 1)) GRID_BAR();
      }
        if (BOTH(PH_GLU)) GRID_BAR();
    }
    if (IN(PH_OUT)) {
      for (int rep_ = 0; rep_ <= ((DBL_MASK >> PH_OUT) & 1); ++rep_) {
        pg8::Gemm g{mixb, Wout, MP, D, D}; pg8::StaticOrder S; S.init(MP, D, G, bx); fx::EpiRes E{xres, xres, xres, xb, ss2, 1.f};
        pg8::gemm_phase<fx::EpiRes, pg8::StaticOrder, true, true>(L + RING_OFF, g, S, E);
        { sg::SRes Es{xres + (size_t)MP * D, xres + (size_t)MP * D, xb + (size_t)MP * D, ss2 + (size_t)MP * 16, 1.f};
          for (int t = bx; t < 256; t += G) sg::tile(mixb + (size_t)MP * D, Wout, D, t >> 4, t & 15, Es, L + RING_OFF, tid, wave, lane); }
        if (rep_ < ((DBL_MASK >> PH_OUT) & 1)) GRID_BAR();
      }
        if (BOTH(PH_OUT)) GRID_BAR();
    }
    if (IN(PH_Q)) {
      for (int rep_ = 0; rep_ <= ((DBL_MASK >> PH_Q) & 1); ++rep_) {
        pg8::Gemm g{xb, Wq, MP, D, D}; pg8::StaticOrder S; S.init(MP, D, G, bx); fx::EpiQ E{ss2, qb};
        pg8::gemm_phase<fx::EpiQ, pg8::StaticOrder, true, true>(L + RING_OFF, g, S, E);
        { sg::SQ Es{ss2 + (size_t)MP * 16, qb + (size_t)MP * D};
          for (int t = bx; t < 256; t += G) sg::tile(xb + (size_t)MP * D, Wq, D, t >> 4, t & 15, Es, L + RING_OFF, tid, wave, lane); }
        if (rep_ < ((DBL_MASK >> PH_Q) & 1)) GRID_BAR();
      }
        if (BOTH(PH_Q)) GRID_BAR();
    }
    if (IN(PH_ATT)) {
      for (int rep_ = 0; rep_ <= ((DBL_MASK >> PH_ATT) & 1); ++rep_) {
        LAS float* wsf = (LAS float*)(L + XTRA_OFF) + wave * 32;
        const int vcu = (G % 8 == 0) ? (bx % 8) * (G / 8) + bx / 8 : bx;
        for (int unit = vcu; unit < NBATCH * NH * 8; unit += G) att::prompt_unit(unit >> 5, (unit >> 3) & 3, unit & 7, qb, kb, vT, ob, L + RING_OFF, wsf, tid, wave, lane);
        for (int unit = bx; unit < DECB * 2; unit += G) att::sample_unit(unit >> 1, unit & 1, qb, in[5], in[6], ob, L + RING_OFF, tid, wave, lane);
        if (rep_ < ((DBL_MASK >> PH_ATT) & 1)) GRID_BAR();
      }
        if (BOTH(PH_ATT)) GRID_BAR();
    }

    if (IN(PH_O)) {
      for (int rep_ = 0; rep_ <= ((DBL_MASK >> PH_O) & 1); ++rep_) {
        pg8::Gemm g{ob, Wo, MP, D, D}; pg8::StaticOrder S; S.init(MP, D, G, bx); fx::EpiRes E{xres, xres, xres, xb, ss3, 1.f};
        pg8::gemm_phase<fx::EpiRes, pg8::StaticOrder, true, true>(L + RING_OFF, g, S, E);
        { sg::SRes Es{xres + (size_t)MP * D, xres + (size_t)MP * D, xb + (size_t)MP * D, ss3 + (size_t)MP * 16, 1.f};
          for (int t = bx; t < 256; t += G) sg::tile(ob + (size_t)MP * D, Wo, D, t >> 4, t & 15, Es, L + RING_OFF, tid, wave, lane); }
        if (rep_ < ((DBL_MASK >> PH_O) & 1)) GRID_BAR();
      }
        if (BOTH(PH_O)) GRID_BAR();
    }
    if (IN(PH_GU2)) {
      for (int rep_ = 0; rep_ <= ((DBL_MASK >> PH_GU2) & 1); ++rep_) {
        pg8::Gemm g{xb, Wgu2, M, 2 * FF, D}; pg8::StaticOrder S; S.init(M, 2 * FF, G, bx); fx::EpiSwiglu E{ss3, hb};
        pg8::gemm_phase<fx::EpiSwiglu, pg8::StaticOrder, true, true>(L + RING_OFF, g, S, E);
        if (rep_ < ((DBL_MASK >> PH_GU2) & 1)) GRID_BAR();
      }
        if (BOTH(PH_GU2)) GRID_BAR();
    }
    if (IN(PH_D2)) {
      for (int rep_ = 0; rep_ <= ((DBL_MASK >> PH_D2) & 1); ++rep_) {
        pg8::Gemm g{hb, Wd2, MP, D, FF}; pg8::StaticOrder S; S.init(MP, D, G, bx); fx::EpiRes E{xres, xres, out + O_Y, nullptr, ss4, 0.5f};
        pg8::gemm_phase<fx::EpiRes, pg8::StaticOrder, true, true>(L + RING_OFF, g, S, E);
        { sg::SRes Es{xres + (size_t)MP * D, out + O_Y + (size_t)MP * D, nullptr, ss4 + (size_t)MP * 16, 0.5f};
          for (int t = bx; t < 256; t += G) sg::tile(hb + (size_t)MP * FF, Wd2, FF, t >> 4, t & 15, Es, L + RING_OFF, tid, wave, lane); }
        if (rep_ < ((DBL_MASK >> PH_D2) & 1)) GRID_BAR();
      }
        if (BOTH(PH_D2)) GRID_BAR();
    }

    if (IN(PH_FIN)) {
        float* y = out + O_Y; const float* gfin = in[38];
        for (int m = bx * NWAVES + wave; m < M; m += G * NWAVES) { const float r = rstd_from_ss(ss4, m);
#pragma unroll
            for (int j = 0; j < 4; ++j) { f32x4* p = (f32x4*)(y + (size_t)m * D + j * 256 + lane * 4); const f32x4 gg = *(const f32x4*)(gfin + j * 256 + lane * 4); f32x4 v = *p; v = v * r * gg; *p = v; } }
    }
    if (IN(13)) { for (int unit = bx; unit < NBATCH * NG; unit += G) s5f::prompt_unit(unit >> 5, unit & 31, ug, Ktab, Ptab, Qtab, ALtab, in[24], gb, out, L + RING_OFF, tid, wave, lane); }
    if (IN(14)) { for (int task = NBATCH * NG + wave * G + bx; task < (NBATCH + DECB) * NG; task += G * NWAVES)
            sb::s5_task(task, ug, in[2], in[3], in[17], in[18], in[19], in[20], in[21], in[22], in[23], in[24], gb, out, lane); }
    if (IN(15)) { LAS float* ybuf = (LAS float*)(L + RING_OFF);
        for (int tile = bx; tile < NBATCH * (SEQ / 64); tile += G) cvx::prompt_tile(tile >> 5, (tile & 31) * 64, vb, in[26], in[27], in[28], in[29], mixb, ybuf, tid, wave, lane);
        for (int b = bx; b < DECB; b += G) cvx::sample_batch(b, vb, in[4], in[26], in[27], in[28], in[29], mixb, out, ybuf, tid, wave, lane); }
#undef IN
#undef BOTH
#undef GRID_BAR
}

#ifndef FAST_MERGE
#define FAST_MERGE 1
#endif
extern "C" void kernel_launch(void* const* d_in, const int* in_sizes, int n_in, void* d_out, int out_size, void* d_ws, size_t ws_size, hipStream_t stream) {
    if (n_in != 39 || out_size != (int)O_END || ws_size < WS_END) { fprintf(stderr, "kernel_launch: unexpected shapes n_in %d out %d ws %zu\n", n_in, out_size, ws_size); return; }
    static int grid = 0;
    if (grid == 0) {
        int dev = 0, cus = 0;
        if (hipGetDevice(&dev) != hipSuccess || hipDeviceGetAttribute(&cus, hipDeviceAttributeMultiprocessorCount, dev) != hipSuccess) { grid = -1; return; }
        if (hipFuncSetAttribute((const void*)mk_fwd, hipFuncAttributeMaxDynamicSharedMemorySize, LDS_BYTES) != hipSuccess) { fprintf(stderr, "kernel_launch: hipFuncSetAttribute failed\n"); grid = -1; return; }
        int per_cu = 0;
        if (hipOccupancyMaxActiveBlocksPerMultiprocessor(&per_cu, (const void*)mk_fwd, NWAVES * 64, LDS_BYTES) != hipSuccess || per_cu < 1) { fprintf(stderr, "kernel_launch: occupancy query says %d\n", per_cu); }
        (void)hipGetLastError();
        grid = cus;
    }
    if (grid < 0) return;
    const float* const* in = (const float* const*)d_in;
    const float *x_p = in[0], *x_s = in[1], *st_re = in[2], *st_im = in[3], *cconv = in[4], *cmk = in[5], *cmv = in[6], *memp = in[7], *g_mem = in[8], *w_k = in[9], *w_v = in[10],
                *g_ffn1 = in[11], *w1g = in[12], *w1u = in[13], *w1d = in[14], *g_mix = in[15], *w_in = in[16], *a_re = in[17], *a_im = in[18], *log_dt = in[19], *b_re = in[20], *b_im = in[21],
                *c_re = in[22], *c_im = in[23], *ssm_d = in[24], *w_glu = in[25], *conv_w = in[26], *conv_b = in[27], *ln_g = in[28], *ln_b = in[29], *w_out = in[30], *g_xattn = in[31],
                *w_q = in[32], *w_o = in[33], *g_ffn2 = in[34], *w2g = in[35], *w2u = in[36], *w2d = in[37], *g_final = in[38];
    (void)x_p; (void)x_s;
    unsigned char* ws = (unsigned char*)d_ws; float* out = (float*)d_out;
    bf16_t *Wgu1 = (bf16_t*)(ws + WS_WGU1), *Wgu2 = (bf16_t*)(ws + WS_WGU2), *Wd1 = (bf16_t*)(ws + WS_WD1), *Wd2 = (bf16_t*)(ws + WS_WD2), *Win = (bf16_t*)(ws + WS_WIN), *Wglu = (bf16_t*)(ws + WS_WGLU),
           *Wout = (bf16_t*)(ws + WS_WOUT), *Wq = (bf16_t*)(ws + WS_WQ), *Wo = (bf16_t*)(ws + WS_WO), *Wkv = (bf16_t*)(ws + WS_WKV);
    bf16_t *xb = (bf16_t*)(ws + WS_XB), *memb = (bf16_t*)(ws + WS_MEMB), *kb = (bf16_t*)(ws + WS_KB), *vb2 = (bf16_t*)(ws + WS_VB2), *ug = (bf16_t*)(ws + WS_UG),
           *vb = (bf16_t*)(ws + WS_VB), *gb = (bf16_t*)(ws + WS_GB), *mixb = (bf16_t*)(ws + WS_MIXB), *qb = (bf16_t*)(ws + WS_QB), *ob = (bf16_t*)(ws + WS_OB);
    float *ss0 = (float*)(ws + WS_SS0), *ss4 = (float*)(ws + WS_SS4), *ssm = (float*)(ws + WS_SSM);

    if (hipMemsetAsync(ws + WS_CTL, 0, CTL_ZERO_BYTES, stream) != hipSuccess) return;
    Args a{};
    for (int i = 0; i < 39; ++i) a.in[i] = in[i];
    a.out = out; a.ws = ws;
    int li = 0;
    auto run = [&](int lo, int hi) {
        if (FAST_MERGE) { a.ph_lo = lo; a.ph_hi = hi; a.li = li++; hipLaunchKernelGGL(mk_fwd, dim3(grid), dim3(NWAVES * 64), LDS_BYTES, stream, a); }
        else for (int p = lo; p < hi; ++p) { a.ph_lo = p; a.ph_hi = p + 1; a.li = li; hipLaunchKernelGGL(mk_fwd, dim3(grid), dim3(NWAVES * 64), LDS_BYTES, stream, a); }
    };

    run(PH_PRO, PH_N);
#ifdef PROBE_PHASE
    run(PROBE_PHASE, PROBE_PHASE + 1);
#endif
}
```

```cpp
#include <hip/hip_runtime.h>
#include <cstdint>
#include <cstdio>

typedef unsigned short bf16_t;
typedef float f32x4 __attribute__((ext_vector_type(4)));

constexpr int D = 1024, FF = 2816, MP = 16384, MS = 1024, M = MP + MS;
constexpr int SEQ = 2048, DECB = 128, DECS = 8, NBATCH = 8;
constexpr int SSM = 512, CONVD = 512, NG = 32, GC = 16, NST = 64, CWID = 31, NMEM = 256, NH = 4, HD = 256;
constexpr int MMEM = NBATCH * NMEM;
constexpr float EPS = 1e-6f;
constexpr float QSCALE = 0.0625f * 1.4426950408889634f;

constexpr size_t O_Y = 0;
constexpr size_t O_SRP = (size_t)M * D;
constexpr size_t O_SIP = O_SRP + 16384;
constexpr size_t O_CVP = O_SIP + 16384;
constexpr size_t O_MKP = O_CVP + 122880;
constexpr size_t O_MVP = O_MKP + 2097152;
constexpr size_t O_SRS = O_MVP + 2097152;
constexpr size_t O_SIS = O_SRS + 262144;
constexpr size_t O_CVS = O_SIS + 262144;
constexpr size_t O_END = O_CVS + 1966080;

constexpr size_t MiB = 1u << 20;
constexpr size_t WS_CTL = 0;
constexpr size_t WS_WGU1 = 2 * MiB, WS_WGU2 = 13 * MiB, WS_WD1 = 24 * MiB, WS_WD2 = 30 * MiB, WS_WIN = 36 * MiB, WS_WGLU = 39 * MiB,
                 WS_WOUT = 40 * MiB, WS_WQ = 42 * MiB, WS_WO = 44 * MiB, WS_WKV = 46 * MiB;
constexpr size_t WS_TAB = 50 * MiB;
constexpr size_t WS_XB = 72 * MiB, WS_MEMB = 106 * MiB, WS_KB = 110 * MiB, WS_VB2 = 114 * MiB;
constexpr size_t WS_SS0 = 118 * MiB, WS_SS1 = 120 * MiB, WS_SS2 = 122 * MiB, WS_SS3 = 124 * MiB, WS_SS4 = 126 * MiB, WS_SSM = 127 * MiB + 512 * 1024;
constexpr size_t WS_XRES = 128 * MiB, WS_H = 196 * MiB, WS_UG = 290 * MiB, WS_VB = 307 * MiB, WS_GB = 324 * MiB, WS_MIXB = 342 * MiB,
                 WS_QB = 376 * MiB, WS_OB = 410 * MiB, WS_END = 444 * MiB;

__device__ __forceinline__ unsigned f2bf(float f) { unsigned u = __builtin_bit_cast(unsigned, f); return (u + 0x7fffu + ((u >> 16) & 1u)) >> 16; }
__device__ __forceinline__ float bf2f(bf16_t b) { return __builtin_bit_cast(float, (unsigned)b << 16); }
__device__ __forceinline__ float sigmoidf_(float x) { return 1.f / (1.f + __expf(-x)); }
__device__ __forceinline__ float siluf_(float x) { return x * sigmoidf_(x); }
__device__ __forceinline__ float gelu_tanh(float x) { const float u = 0.7978845608028654f * (x + 0.044715f * x * x * x); return 0.5f * x * (1.f + tanhf(u)); }
__device__ __forceinline__ float wave_sum(float v) {
#pragma unroll
    for (int o = 1; o < 64; o <<= 1) v += __shfl_xor(v, o);
    return v;
}
__device__ __forceinline__ float rstd_from_ss(const float* ss, int row) {
    float s = 0.f;
#pragma unroll
    for (int i = 0; i < 16; ++i) s += ss[(size_t)row * 16 + i];
    return rsqrtf(s * (1.f / D) + EPS);
}

template <int MAP>
__global__ void k_wt(const float* W0, const float* W1, const float* gain, bf16_t* WT, int K, int N, int ldw) {
    __shared__ float tile[32][33];
    const int n0 = blockIdx.x * 32, k0 = blockIdx.y * 32, tx = threadIdx.x & 31, ty = threadIdx.x >> 5;
    const float* W = W0; int c0 = n0;
    if (MAP == 1) { const int pn = n0 / 256, half = (n0 % 256) / 128, jj = n0 % 128; W = half ? W1 : W0; c0 = pn * 128 + jj; }
    if (MAP == 2) { if (n0 >= 512) { const int m = n0 - 512, pc = m / 256, half = (m % 256) / 128, jj = m % 128; c0 = 512 + half * 512 + pc * 128 + jj; } }
    if (MAP == 3) { if (n0 >= 1024) { W = W1; c0 = n0 - 1024; } }
    for (int i = ty; i < 32; i += 8) { const int k = k0 + i; tile[i][tx] = W[(size_t)k * ldw + c0 + tx] * (gain ? gain[k] : 1.f); }
    __syncthreads();
    for (int i = ty; i < 32; i += 8) WT[(size_t)(n0 + i) * K + k0 + tx] = (bf16_t)f2bf(tile[tx][i]);
}
__global__ void k_rows_bf16_ss(const float* x0, int rows0, const float* x1, int rows1, bf16_t* xb, float* ss) {
    const int row = blockIdx.x * 4 + (threadIdx.x >> 6), lane = threadIdx.x & 63;
    if (row >= rows0 + rows1) return;
    const float* xr = row < rows0 ? x0 + (size_t)row * D : x1 + (size_t)(row - rows0) * D;
    float s = 0.f;
    for (int j = 0; j < 4; ++j) { const f32x4 v = *(const f32x4*)(xr + j * 256 + lane * 4); s += v.x * v.x + v.y * v.y + v.z * v.z + v.w * v.w;
        uint2 o; o.x = f2bf(v.x) | (f2bf(v.y) << 16); o.y = f2bf(v.z) | (f2bf(v.w) << 16); *(uint2*)(xb + (size_t)row * D + j * 256 + lane * 4) = o; }
    s = wave_sum(s);
    if (lane < 16) ss[(size_t)row * 16 + lane] = lane == 0 ? s : 0.f;
}
__global__ void k_rows_ss(const float* x, int rows, float* ss) {
    const int row = blockIdx.x * 4 + (threadIdx.x >> 6), lane = threadIdx.x & 63;
    if (row >= rows) return;
    float s = 0.f;
    for (int j = 0; j < 4; ++j) { const f32x4 v = *(const f32x4*)(x + (size_t)row * D + j * 256 + lane * 4); s += v.x * v.x + v.y * v.y + v.z * v.z + v.w * v.w; }
    s = wave_sum(s);
    if (lane < 16) ss[(size_t)row * 16 + lane] = lane == 0 ? s : 0.f;
}

enum { E_KV = 1, E_SWIGLU = 2, E_RES = 3, E_U = 4, E_V = 5, E_GLU = 6, E_Q = 7 };
struct EpiP {
    const float* ss;
    const float* resin;
    float* resout;
    bf16_t* ob;
    bf16_t* ob2;
    const bf16_t* gb;
    float* out;
    float alpha;
    int pad;
};
template <int MODE>
__device__ __forceinline__ void epi_elem(const EpiP& P, int row, int c, float a0, float a1, float rstd) {
    if (MODE == E_KV) {
        const float v = a0 * rstd;
        if (c < 1024) { P.out[O_MKP + (size_t)row * 1024 + c] = v; P.ob[(size_t)row * 1024 + c] = (bf16_t)f2bf(v); }
        else { P.out[O_MVP + (size_t)row * 1024 + c - 1024] = v; P.ob2[(size_t)row * 1024 + c - 1024] = (bf16_t)f2bf(v); }
    } else if (MODE == E_SWIGLU) {
        const float g = a0 * rstd, u = a1 * rstd; P.ob[(size_t)row * FF + c] = (bf16_t)f2bf(siluf_(g) * u);
    } else if (MODE == E_RES) {
        const float v = P.resin[(size_t)row * D + c] + P.alpha * a0; P.resout[(size_t)row * D + c] = v; if (P.ob) P.ob[(size_t)row * D + c] = (bf16_t)f2bf(v);
    } else if (MODE == E_U) {
        P.ob[((size_t)(c >> 4) * M + row) * 16 + (c & 15)] = (bf16_t)f2bf(a0 * rstd);
    } else if (MODE == E_V) {
        const float v = (a0 * rstd) * sigmoidf_(a1 * rstd); P.ob[(size_t)row * CONVD + c] = (bf16_t)f2bf(v);
        if (row < MP) { const int b = row / SEQ, t = row % SEQ; if (t >= SEQ - 30) P.out[O_CVP + ((size_t)b * 30 + (t - (SEQ - 30))) * CONVD + c] = v; }
        else { const int rs = row - MP, b = rs / DECS, t = rs % DECS; P.out[O_CVS + ((size_t)b * 30 + 22 + t) * CONVD + c] = v; }
    } else if (MODE == E_GLU) {
        const float g = bf2f(P.gb[(size_t)row * SSM + c]); P.ob[(size_t)row * D + c] = (bf16_t)f2bf(g * sigmoidf_(a0));
    } else if (MODE == E_Q) {
        P.ob[(size_t)row * D + c] = (bf16_t)f2bf(a0 * rstd * QSCALE);
    }
}
template <int MODE> struct ModeTraits { static constexpr bool PAIRED = (MODE == E_SWIGLU || MODE == E_V); static constexpr bool RSTD = (MODE == E_KV || MODE == E_SWIGLU || MODE == E_U || MODE == E_V || MODE == E_Q); };

template <int MODE>
__global__ void __launch_bounds__(256) k_ref_gemm(const bf16_t* A, const bf16_t* BT, int K, EpiP P) {
    constexpr bool PAIRED = ModeTraits<MODE>::PAIRED;
    __shared__ float As[32][65], B0[32][65], B1[PAIRED ? 32 : 1][65];
    const int tid = threadIdx.x, tx = tid & 15, ty = tid >> 4;
    const int m0 = blockIdx.y * 64, p0 = blockIdx.x * 64;
    const int cb0 = PAIRED ? (p0 / 128) * 256 + (p0 % 128) : p0;
    float acc0[4][4], acc1[4][4];
    for (int i = 0; i < 4; ++i) for (int j = 0; j < 4; ++j) { acc0[i][j] = 0.f; acc1[i][j] = 0.f; }
    for (int k0 = 0; k0 < K; k0 += 32) {
        for (int e = tid; e < 64 * 32; e += 256) { const int r = e >> 5, k = e & 31;
            As[k][r] = bf2f(A[(size_t)(m0 + r) * K + k0 + k]); B0[k][r] = bf2f(BT[(size_t)(cb0 + r) * K + k0 + k]);
            if (PAIRED) B1[k][r] = bf2f(BT[(size_t)(cb0 + 128 + r) * K + k0 + k]); }
        __syncthreads();
        for (int k = 0; k < 32; ++k) {
            float a[4], b0[4], b1[4];
            for (int i = 0; i < 4; ++i) a[i] = As[k][ty * 4 + i];
            for (int j = 0; j < 4; ++j) { b0[j] = B0[k][tx * 4 + j]; b1[j] = PAIRED ? B1[k][tx * 4 + j] : 0.f; }
            for (int i = 0; i < 4; ++i) for (int j = 0; j < 4; ++j) { acc0[i][j] += a[i] * b0[j]; if (PAIRED) acc1[i][j] += a[i] * b1[j]; }
        }
        __syncthreads();
    }
    for (int i = 0; i < 4; ++i) { const int row = m0 + ty * 4 + i; const float rstd = ModeTraits<MODE>::RSTD ? rstd_from_ss(P.ss, row) : 1.f;
        for (int j = 0; j < 4; ++j) epi_elem<MODE>(P, row, p0 + tx * 4 + j, acc0[i][j], acc1[i][j], rstd); }
}

__global__ void __launch_bounds__(64) k_ref_s5(const bf16_t* ug, const float* h0re, const float* h0im, const float* a_re, const float* a_im, const float* log_dt,
                                               const float* b_re, const float* b_im, const float* c_re, const float* c_im, const float* dskip, bf16_t* gb, float* out) {
    const int g = blockIdx.x % NG, sq = blockIdx.x / NG, n = threadIdx.x;
    const bool prompt = sq < NBATCH; const int b = prompt ? sq : sq - NBATCH, T = prompt ? SEQ : DECS, row0 = prompt ? b * SEQ : MP + b * DECS;
    const float dt = expf(log_dt[g]), lr = a_re[g * NST + n], li = a_im[g * NST + n];
    const float mag = expf(lr * dt), abr = mag * cosf(li * dt), abi = mag * sinf(li * dt);
    const float den = lr * lr + li * li, nr = abr - 1.f, ni = abi, cr = (nr * lr + ni * li) / den, ci = (ni * lr - nr * li) / den;
    float Br[16], Bi[16], Cr[16], Ci[16];
    for (int c = 0; c < 16; ++c) { const float br = b_re[((size_t)g * NST + n) * 16 + c], bi = b_im[((size_t)g * NST + n) * 16 + c];
        Br[c] = cr * br - ci * bi; Bi[c] = cr * bi + ci * br; Cr[c] = c_re[((size_t)g * 16 + c) * NST + n]; Ci[c] = c_im[((size_t)g * 16 + c) * NST + n]; }
    float hr = 0.f, hi = 0.f;
    if (!prompt) { hr = h0re[((size_t)b * NG + g) * NST + n]; hi = h0im[((size_t)b * NG + g) * NST + n]; }
    const float dsk = dskip[g * 16 + (n & 15)];
    for (int t = 0; t < T; ++t) {
        const bf16_t* up = ug + ((size_t)g * M + row0 + t) * 16;
        float u[16], xr = 0.f, xi = 0.f;
#pragma unroll
        for (int c = 0; c < 16; ++c) { u[c] = bf2f(up[c]); xr += Br[c] * u[c]; xi += Bi[c] * u[c]; }
        const float nhr = abr * hr - abi * hi + xr, nhi = abr * hi + abi * hr + xi; hr = nhr; hi = nhi;
        float ymine = 0.f;
#pragma unroll
        for (int c = 0; c < 16; ++c) { const float y = wave_sum(Cr[c] * hr - Ci[c] * hi); if ((n & 15) == c) ymine = y + dsk * u[c]; }
        if (n < 16) gb[(size_t)(row0 + t) * SSM + g * 16 + n] = (bf16_t)f2bf(gelu_tanh(ymine));
    }
    if (prompt) { out[O_SRP + ((size_t)b * NG + g) * NST + n] = hr; out[O_SIP + ((size_t)b * NG + g) * NST + n] = hi; }
    else { out[O_SRS + ((size_t)b * NG + g) * NST + n] = hr; out[O_SIS + ((size_t)b * NG + g) * NST + n] = hi; }
}

__global__ void __launch_bounds__(512) k_ref_conv(const bf16_t* vb, const float* cache, const float* w, const float* bias, const float* lg, const float* lb, bf16_t* mixb, float* out) {
    __shared__ float red[2][8];
    const int row = blockIdx.x, c = threadIdx.x;
    float y = bias[c];
    if (row < MP) { const int t = row % SEQ;
        for (int k = 0; k < CWID; ++k) { const int tt = t - 30 + k; if (tt >= 0) y += w[k * CONVD + c] * bf2f(vb[(size_t)(row - 30 + k) * CONVD + c]); }
    } else { const int rs = row - MP, b = rs / DECS, t = rs % DECS;
        for (int k = 0; k < CWID; ++k) { const int idx = t + k; const float xv = idx < 30 ? cache[((size_t)b * 30 + idx) * CONVD + c] : bf2f(vb[(size_t)(MP + b * DECS + idx - 30) * CONVD + c]); y += w[k * CONVD + c] * xv; }
        if (t == 0) for (int j = 0; j < 22; ++j) out[O_CVS + ((size_t)b * 30 + j) * CONVD + c] = cache[((size_t)b * 30 + j + 8) * CONVD + c];
    }
    float s = wave_sum(y); if ((c & 63) == 0) red[0][c >> 6] = s; __syncthreads();
    float mu = 0.f; for (int i = 0; i < 8; ++i) mu += red[0][i]; mu *= (1.f / CONVD);
    const float d = y - mu; float q = wave_sum(d * d); if ((c & 63) == 0) red[1][c >> 6] = q; __syncthreads();
    float var = 0.f; for (int i = 0; i < 8; ++i) var += red[1][i]; var *= (1.f / CONVD);
    const float z = d * rsqrtf(var + EPS) * lg[c] + lb[c];
    mixb[(size_t)row * D + SSM + c] = (bf16_t)f2bf(siluf_(z));
}

__global__ void __launch_bounds__(256) k_ref_attn(const bf16_t* qb, const bf16_t* kb, const bf16_t* vb2, const float* ck, const float* cv, bf16_t* ob) {
    __shared__ float q[256], p[256], red[4];
    const int row = blockIdx.x >> 2, h = blockIdx.x & 3, tid = threadIdx.x;
    q[tid] = bf2f(qb[(size_t)row * D + h * HD + tid]);
    __syncthreads();
    float s = 0.f;
    if (row < MP) { const int b = row / SEQ; const bf16_t* kr = kb + ((size_t)b * NMEM + tid) * D + h * HD; for (int d = 0; d < HD; ++d) s += q[d] * bf2f(kr[d]); }
    else { const int b = (row - MP) / DECS; const float* kr = ck + ((size_t)b * NMEM + tid) * D + h * HD; for (int d = 0; d < HD; ++d) s += q[d] * kr[d]; }
    float mx = s; for (int o = 1; o < 64; o <<= 1) mx = fmaxf(mx, __shfl_xor(mx, o));
    if ((tid & 63) == 0) red[tid >> 6] = mx; __syncthreads();
    mx = fmaxf(fmaxf(red[0], red[1]), fmaxf(red[2], red[3])); __syncthreads();
    const float e = exp2f(s - mx); float sm = wave_sum(e);
    if ((tid & 63) == 0) red[tid >> 6] = sm; __syncthreads();
    sm = red[0] + red[1] + red[2] + red[3];
    p[tid] = e / sm; __syncthreads();
    float o = 0.f;
    if (row < MP) { const int b = row / SEQ; const bf16_t* vr = vb2 + (size_t)b * NMEM * D + h * HD + tid; for (int m = 0; m < NMEM; ++m) o += p[m] * bf2f(vr[(size_t)m * D]); }
    else { const int b = (row - MP) / DECS; const float* vr = cv + (size_t)b * NMEM * D + h * HD + tid; for (int m = 0; m < NMEM; ++m) o += p[m] * vr[(size_t)m * D]; }
    ob[(size_t)row * D + h * HD + tid] = (bf16_t)f2bf(o);
}

__global__ void k_final(float* y, const float* ss, const float* g) {
    const int row = blockIdx.x * 4 + (threadIdx.x >> 6), lane = threadIdx.x & 63;
    const float r = rstd_from_ss(ss, row);
    for (int j = 0; j < 4; ++j) { f32x4* p = (f32x4*)(y + (size_t)row * D + j * 256 + lane * 4); const f32x4 gg = *(const f32x4*)(g + j * 256 + lane * 4); f32x4 v = *p; v = v * r * gg; *p = v; }
}


namespace pg8 {
#define PG8_LAS __attribute__((address_space(3)))
typedef unsigned short bf16_t;
typedef short bf16x8 __attribute__((ext_vector_type(8)));
typedef float f32x4 __attribute__((ext_vector_type(4)));
typedef unsigned u32x4 __attribute__((ext_vector_type(4)));
constexpr int BM = 256, BK = 64, HALF = 128, HTB = HALF * BK * 2  , STAGE_BYTES = 8 * HTB, NXCD = 8, WGM = 8;

__host__ __device__ __forceinline__ int lds_byte(int r, int c) { const int st = (r >> 4) * 2 + (c >> 5), rr = r & 15, cc = c & 31, ob = rr * 64 + cc * 2; return st * 1024 + (ob ^ (((ob >> 9) & 1) << 5)); }
__host__ __device__ __forceinline__ void stage_rc(int b, int& R, int& C) { const int st = b / 1024, sb = b % 1024, swz = sb ^ (((sb >> 9) & 1) << 5); R = (st >> 1) * 16 + swz / 64; C = (st & 1) * 32 + (swz % 64) / 2; }
__host__ __device__ __forceinline__ int perm32(int rho) { const int n = rho >> 4, i = rho & 15; return 8 * (i >> 2) + 4 * n + (i & 3); }

struct Unit { int pm, pn; };
struct Gemm { const bf16_t* A; const bf16_t* Bt; int M, N, K; };

struct StaticOrder {
    int nM, nN, nwg, G, c;
    __host__ __device__ void init(int M, int N, int G_, int c_) { nM = M / BM; nN = N / BM; nwg = nM * nN; G = G_; c = c_; }
    __host__ __device__ bool next(int i, Unit& u) const {
        const long L = (long)i * G + c; if (L >= nwg) return false;
        int wgid = (int)L; { const int q = nwg / NXCD, r = nwg % NXCD, xcd = wgid % NXCD, off = wgid / NXCD; wgid = (xcd < r ? xcd * (q + 1) : r * (q + 1) + (xcd - r) * q) + off; }
        const int nig = WGM * nN, gid = wgid / nig, fm = gid * WGM, gsz = (nM - fm) < WGM ? (nM - fm) : WGM;
        u.pm = fm + ((wgid % nig) % gsz); u.pn = (wgid % nig) / gsz; return true;
    }
    __device__ __forceinline__ void a_ready(const Unit&) const {}
    __device__ __forceinline__ void done(const Unit&) const {}
};
__device__ __forceinline__ unsigned cvt_pk_bf16(float lo, float hi) { unsigned r; asm volatile("v_cvt_pk_bf16_f32 %0, %1, %2" : "=v"(r) : "v"(lo), "v"(hi)); return r; }
typedef float f32x2 __attribute__((ext_vector_type(2)));
template <class Epi, class Sched, bool ALIGN_EPI = false, bool SP2 = false>
__device__ __forceinline__ void gemm_phase(PG8_LAS unsigned char* lds, const Gemm g, const Sched& S, const Epi& E) {
    const int tid = threadIdx.x, wid = __builtin_amdgcn_readfirstlane(tid >> 6), lane = tid & 63, wr = wid >> 2, wc = wid & 3, fr = lane & 15, fq = lane >> 4;
    const int K = g.K, nt = K / BK;
    unsigned voffA[2], voffB[2];
#pragma unroll
    for (int i = 0; i < 2; ++i) { int R, C; stage_rc(tid * 16 + i * 8192, R, C); const int Rb = Epi::PERM ? ((R & ~31) + perm32(R & 31)) : R;
        voffA[i] = (unsigned)(R * K + C) * 2u; voffB[i] = (unsigned)(Rb * K + C) * 2u; }
    const size_t kstep = (size_t)(BK * 2);
    const size_t hstep = (size_t)HALF * K * 2;
    const size_t tstep = 2 * hstep;
    const unsigned ldsw = (unsigned)wid * 1024u;
    const int aoff = lds_byte(wr * 64 + fr, fq * 8), boff = lds_byte(wc * 32 + fr, fq * 8);
#define PG8_SA(b, h) (((b) * 2 + (h)) * HTB)
#define PG8_SB(b, h) ((4 + (b) * 2 + (h)) * HTB)
#define PG8_STAGE(bufoff, gbase, voff) do { _Pragma("unroll") for (int _i = 0; _i < 2; ++_i) \
        __builtin_amdgcn_global_load_lds((const unsigned*)((const char*)(gbase) + (voff)[_i]), (PG8_LAS unsigned*)(lds + (bufoff) + ldsw + _i * 8192), 16, 0, 0); } while (0)
#define PG8_LDA(dst, b, h) do { _Pragma("unroll") for (int m = 0; m < 4; ++m) _Pragma("unroll") for (int k = 0; k < 2; ++k) dst[m][k] = *(const PG8_LAS bf16x8*)(lds + PG8_SA(b, h) + aoff + m * 2048 + k * 1024); } while (0)
#define PG8_LDB(dst, b, h) do { _Pragma("unroll") for (int n = 0; n < 2; ++n) _Pragma("unroll") for (int k = 0; k < 2; ++k) dst[n][k] = *(const PG8_LAS bf16x8*)(lds + PG8_SB(b, h) + boff + n * 2048 + k * 1024); } while (0)
#define PG8_MMA(ai, bj, At, Bt) do { __builtin_amdgcn_s_setprio(1); _Pragma("unroll") for (int m = 0; m < 4; ++m) _Pragma("unroll") for (int n = 0; n < 2; ++n) _Pragma("unroll") for (int k = 0; k < 2; ++k) \
        acc[ai][bj][m][n] = __builtin_amdgcn_mfma_f32_16x16x32_bf16(Bt[n][k], At[m][k], acc[ai][bj][m][n], 0, 0, 0); __builtin_amdgcn_s_setprio(0); } while (0)
#define PG8_WAIT_V(n) asm volatile("s_waitcnt vmcnt(" #n ")" ::: "memory")
#define PG8_WAIT_L(n) asm volatile("s_waitcnt lgkmcnt(" #n ")" ::: "memory")
#define PG8_BAR __builtin_amdgcn_s_barrier()
#define PG8_SCHED __builtin_amdgcn_sched_barrier(0)
    Unit cur, nxt; int ui = 0;
    if (!S.next(0, cur)) return;
    f32x4 acc[2][2][4][2];
#pragma unroll
    for (int a = 0; a < 2; ++a)
#pragma unroll
        for (int b = 0; b < 2; ++b)
#pragma unroll
            for (int m = 0; m < 4; ++m)
#pragma unroll
                for (int n = 0; n < 2; ++n) acc[a][b][m][n] = (f32x4){0.f, 0.f, 0.f, 0.f};
    bf16x8 At[4][2], B0[2][2], B1[2][2];
    const char* cA = (const char*)g.A + (size_t)cur.pm * tstep; const char* cB = (const char*)g.Bt + (size_t)cur.pn * tstep;
    S.a_ready(cur);
    if constexpr (SP2) {
        PG8_STAGE(PG8_SB(0, 0), cB, voffB); PG8_STAGE(PG8_SB(0, 1), cB + hstep, voffB); PG8_STAGE(PG8_SA(0, 0), cA, voffA); PG8_STAGE(PG8_SA(0, 1), cA + hstep, voffA);
        if (wr == 1) PG8_BAR;
        PG8_WAIT_V(2); PG8_BAR;
        PG8_STAGE(PG8_SB(1, 0), cB + kstep, voffB); PG8_STAGE(PG8_SA(1, 0), cA + kstep, voffA); PG8_STAGE(PG8_SB(1, 1), cB + hstep + kstep, voffB);
        PG8_WAIT_V(6); PG8_BAR;
    } else {
        PG8_STAGE(PG8_SB(0, 0), cB, voffB); PG8_STAGE(PG8_SA(0, 0), cA, voffA); PG8_STAGE(PG8_SB(0, 1), cB + hstep, voffB); PG8_STAGE(PG8_SA(0, 1), cA + hstep, voffA);
        if (wr == 1) PG8_BAR;
        PG8_WAIT_V(4); PG8_BAR;
        PG8_STAGE(PG8_SB(1, 0), cB + kstep, voffB); PG8_STAGE(PG8_SA(1, 0), cA + kstep, voffA); PG8_STAGE(PG8_SB(1, 1), cB + hstep + kstep, voffB);
        PG8_WAIT_V(6); PG8_BAR;
    }
    for (;;) {
        const bool has_next = S.next(ui + 1, nxt);
        const char* nA = has_next ? (const char*)g.A + (size_t)nxt.pm * tstep : cA; const char* nB = has_next ? (const char*)g.Bt + (size_t)nxt.pn * tstep : cB;
        for (int t = 0; t < nt; t += 2) {
            const bool last = (t == nt - 2);
            const char* a1 = cA + (size_t)(t + 1) * kstep;
            const char* a2 = last ? nA : cA + (size_t)(t + 2) * kstep; const char* b2 = last ? nB : cB + (size_t)(t + 2) * kstep;
            const char* a3 = a2 + kstep; const char* b3 = b2 + kstep;
            if (last && has_next) S.a_ready(nxt);
            if constexpr (SP2) {
            PG8_LDB(B0, 0, 0); PG8_LDB(B1, 0, 1); PG8_SCHED; PG8_LDA(At, 0, 0); PG8_STAGE(PG8_SA(1, 1), a1 + hstep, voffA);
            PG8_WAIT_V(8); PG8_WAIT_L(0); PG8_BAR; PG8_MMA(0, 0, At, B0); PG8_MMA(0, 1, At, B1); PG8_BAR; PG8_SCHED;
            PG8_LDA(At, 0, 1); PG8_STAGE(PG8_SB(0, 0), b2, voffB); PG8_STAGE(PG8_SB(0, 1), b2 + hstep, voffB); PG8_STAGE(PG8_SA(0, 0), a2, voffA);
            PG8_WAIT_V(8); PG8_WAIT_L(0); PG8_BAR; PG8_MMA(1, 0, At, B0); PG8_MMA(1, 1, At, B1); PG8_BAR; PG8_SCHED;
            PG8_LDB(B0, 1, 0); PG8_LDB(B1, 1, 1); PG8_SCHED; PG8_LDA(At, 1, 0); PG8_STAGE(PG8_SA(0, 1), a2 + hstep, voffA);
            PG8_WAIT_V(8); PG8_WAIT_L(0); PG8_BAR; PG8_MMA(0, 0, At, B0); PG8_MMA(0, 1, At, B1); PG8_BAR; PG8_SCHED;
            PG8_LDA(At, 1, 1); PG8_STAGE(PG8_SB(1, 0), b3, voffB); PG8_STAGE(PG8_SB(1, 1), b3 + hstep, voffB); PG8_STAGE(PG8_SA(1, 0), a3, voffA);
            PG8_WAIT_V(8); PG8_WAIT_L(0); PG8_BAR; PG8_MMA(1, 0, At, B0); PG8_MMA(1, 1, At, B1); PG8_BAR; PG8_SCHED;
            } else {
            PG8_LDB(B0, 0, 0); PG8_SCHED; PG8_LDA(At, 0, 0); PG8_STAGE(PG8_SA(1, 1), a1 + hstep, voffA);
            PG8_WAIT_L(8); PG8_BAR; PG8_WAIT_L(0); PG8_MMA(0, 0, At, B0); PG8_BAR; PG8_SCHED;
            PG8_LDB(B1, 0, 1); PG8_STAGE(PG8_SB(0, 0), b2, voffB);
            PG8_BAR; PG8_WAIT_L(0); PG8_MMA(0, 1, At, B1); PG8_BAR;
            PG8_LDA(At, 0, 1); PG8_STAGE(PG8_SA(0, 0), a2, voffA);
            PG8_BAR; PG8_WAIT_L(0); PG8_MMA(1, 0, At, B0); PG8_BAR; PG8_SCHED;
            PG8_STAGE(PG8_SB(0, 1), b2 + hstep, voffB);
            PG8_WAIT_V(6); PG8_BAR; PG8_MMA(1, 1, At, B1); PG8_BAR;
            PG8_LDB(B0, 1, 0); PG8_SCHED; PG8_LDA(At, 1, 0); PG8_STAGE(PG8_SA(0, 1), a2 + hstep, voffA);
            PG8_WAIT_L(8); PG8_BAR; PG8_WAIT_L(0); PG8_MMA(0, 0, At, B0); PG8_BAR; PG8_SCHED;
            PG8_LDB(B1, 1, 1); PG8_STAGE(PG8_SB(1, 0), b3, voffB);
            PG8_BAR; PG8_WAIT_L(0); PG8_MMA(0, 1, At, B1); PG8_BAR;
            PG8_LDA(At, 1, 1); PG8_STAGE(PG8_SA(1, 0), a3, voffA);
            PG8_BAR; PG8_WAIT_L(0); PG8_MMA(1, 0, At, B0); PG8_BAR; PG8_SCHED;
            PG8_STAGE(PG8_SB(1, 1), b3 + hstep, voffB);
            PG8_WAIT_V(6); PG8_BAR; PG8_MMA(1, 1, At, B1); PG8_BAR;
            }
        }
        if constexpr (ALIGN_EPI) { if (wr == 0) PG8_BAR; }
        if constexpr (!Epi::AFTER_DRAIN) { E(acc, cur, wr, wc, fr, fq); S.done(cur); }
        if (!has_next) break;
#pragma unroll
        for (int a = 0; a < 2; ++a)
#pragma unroll
            for (int b = 0; b < 2; ++b)
#pragma unroll
                for (int m = 0; m < 4; ++m)
#pragma unroll
                    for (int n = 0; n < 2; ++n) acc[a][b][m][n] = (f32x4){0.f, 0.f, 0.f, 0.f};
        cur = nxt; cA = nA; cB = nB; ++ui;
        if constexpr (ALIGN_EPI) { if (wr == 1) PG8_BAR; }
    }
    PG8_WAIT_V(0);
    if constexpr (!ALIGN_EPI) { if (wr == 0) PG8_BAR; }
    PG8_BAR;
    if constexpr (Epi::AFTER_DRAIN) { E.fused(acc, cur, wr, wc, fr, fq, lds, wid, lane); S.done(cur); }
#undef PG8_SA
#undef PG8_SB
#undef PG8_STAGE
#undef PG8_LDA
#undef PG8_LDB
#undef PG8_MMA
#undef PG8_WAIT_V
#undef PG8_WAIT_L
#undef PG8_BAR
#undef PG8_SCHED
}
}

namespace fx {
using pg8::f32x4; using pg8::u32x4; using pg8::Unit; using pg8::HALF; using pg8::BM; using pg8::cvt_pk_bf16;
__device__ __forceinline__ float rstd_row(const float* ss, int row) {
    const f32x4* p = (const f32x4*)(ss + (size_t)row * 16); const f32x4 a = p[0], b = p[1], c = p[2], d = p[3];
    const float s = ((a.x + a.y) + (a.z + a.w)) + ((b.x + b.y) + (b.z + b.w)) + ((c.x + c.y) + (c.z + c.w)) + ((d.x + d.y) + (d.z + d.w));
    return rsqrtf(s * (1.f / D) + EPS);
}
__device__ __forceinline__ float fsig(float x) { return __builtin_amdgcn_rcpf(1.f + __builtin_amdgcn_exp2f(-1.4426950408889634f * x)); }
__device__ __forceinline__ u32x4 pack8(const f32x4 a, const f32x4 b) { u32x4 w; w.x = cvt_pk_bf16(a[0], a[1]); w.y = cvt_pk_bf16(a[2], a[3]); w.z = cvt_pk_bf16(b[0], b[1]); w.w = cvt_pk_bf16(b[2], b[3]); return w; }
__device__ __forceinline__ f32x4 sig4(const f32x4 x) { return (f32x4){fsig(x[0]), fsig(x[1]), fsig(x[2]), fsig(x[3])}; }

struct EpiKV { static constexpr bool PERM = true, AFTER_DRAIN = false; const float* ss; bf16_t* kb; bf16_t* vb2; float* out;
    __device__ __forceinline__ void operator()(const f32x4 (&acc)[2][2][4][2], const Unit& u, int wr, int wc, int fr, int fq) const {
        const int row0 = u.pm * BM + wr * 64 + fr; const bool isv = u.pn >= 4; const int colt = (isv ? u.pn - 4 : u.pn) * BM + wc * 32 + 8 * fq;
        float* of = out + (isv ? O_MVP : O_MKP); bf16_t* ob = isv ? vb2 : kb;
#pragma unroll
        for (int ai = 0; ai < 2; ++ai)
#pragma unroll
            for (int m = 0; m < 4; ++m) { const int row = row0 + ai * HALF + m * 16; const float r = rstd_row(ss, row);
#pragma unroll
                for (int bj = 0; bj < 2; ++bj) { const f32x4 v0 = acc[ai][bj][m][0] * r, v1 = acc[ai][bj][m][1] * r; const size_t o = (size_t)row * D + colt + bj * HALF;
                    *(f32x4*)(of + o) = v0; *(f32x4*)(of + o + 4) = v1; *(u32x4*)(ob + o) = pack8(v0, v1); } }
    }
};

struct EpiK { static constexpr bool PERM = true, AFTER_DRAIN = false; const float* rstdm; bf16_t* kb; float* out;
    __device__ __forceinline__ void operator()(const f32x4 (&acc)[2][2][4][2], const Unit& u, int wr, int wc, int fr, int fq) const {
        const int row0 = u.pm * BM + wr * 64 + fr, colt = u.pn * BM + wc * 32 + 8 * fq;
#pragma unroll
        for (int ai = 0; ai < 2; ++ai)
#pragma unroll
            for (int m = 0; m < 4; ++m) { const int row = row0 + ai * HALF + m * 16; const float r = rstdm[row];
#pragma unroll
                for (int bj = 0; bj < 2; ++bj) { const f32x4 v0 = acc[ai][bj][m][0] * r, v1 = acc[ai][bj][m][1] * r; const size_t o = (size_t)row * D + colt + bj * HALF;
                    *(f32x4*)(out + O_MKP + o) = v0; *(f32x4*)(out + O_MKP + o + 4) = v1; *(u32x4*)(kb + o) = pack8(v0, v1); } }
    }
};
struct EpiVT { static constexpr bool PERM = true, AFTER_DRAIN = false; const float* rstdm; bf16_t* vT; float* out;
    __device__ __forceinline__ void operator()(const f32x4 (&acc)[2][2][4][2], const Unit& u, int wr, int wc, int fr, int fq) const {
        const int row0 = u.pm * BM + wr * 64 + fr;
#pragma unroll
        for (int bj = 0; bj < 2; ++bj) { const int cl = bj * HALF + wc * 32 + 8 * fq, c0 = u.pn * BM + cl;
            const f32x4 r0 = *(const f32x4*)(rstdm + c0), r1 = *(const f32x4*)(rstdm + c0 + 4);
            const int pos0 = (cl & ~15) + 4 * ((cl >> 3) & 1);
#pragma unroll
            for (int ai = 0; ai < 2; ++ai)
#pragma unroll
                for (int m = 0; m < 4; ++m) { const int row = row0 + ai * HALF + m * 16; const f32x4 v0 = acc[ai][bj][m][0] * r0, v1 = acc[ai][bj][m][1] * r1;
                    bf16_t* vp = vT + (size_t)row * MMEM + u.pn * BM;
                    typedef unsigned u32x2 __attribute__((ext_vector_type(2)));
                    *(u32x2*)(vp + pos0) = (u32x2){cvt_pk_bf16(v0[0], v0[1]), cvt_pk_bf16(v0[2], v0[3])}; *(u32x2*)(vp + pos0 + 8) = (u32x2){cvt_pk_bf16(v1[0], v1[1]), cvt_pk_bf16(v1[2], v1[3])};
                    float* op = out + O_MVP + (size_t)c0 * D + row;
                    op[0] = v0[0]; op[D] = v0[1]; op[2 * D] = v0[2]; op[3 * D] = v0[3]; op[4 * D] = v1[0]; op[5 * D] = v1[1]; op[6 * D] = v1[2]; op[7 * D] = v1[3]; } }
    }
};
struct EpiSwiglu { static constexpr bool PERM = true, AFTER_DRAIN = false; const float* ss; bf16_t* H;
    __device__ __forceinline__ void operator()(const f32x4 (&acc)[2][2][4][2], const Unit& u, int wr, int wc, int fr, int fq) const {
        const int row0 = u.pm * BM + wr * 64 + fr, col0 = u.pn * HALF + wc * 32 + 8 * fq;
#pragma unroll
        for (int ai = 0; ai < 2; ++ai)
#pragma unroll
            for (int m = 0; m < 4; ++m) { const int row = row0 + ai * HALF + m * 16; const float r = rstd_row(ss, row);
                const f32x4 g0 = acc[ai][0][m][0] * r, g1 = acc[ai][0][m][1] * r, u0 = acc[ai][1][m][0] * r, u1 = acc[ai][1][m][1] * r;
                *(u32x4*)(H + (size_t)row * FF + col0) = pack8(g0 * sig4(g0) * u0, g1 * sig4(g1) * u1); }
    }
};
struct EpiRes { static constexpr bool PERM = true, AFTER_DRAIN = false; const float* rin0; const float* rin1; float* rout; bf16_t* xb; float* ss; float alpha;
    __device__ __forceinline__ void operator()(const f32x4 (&acc)[2][2][4][2], const Unit& u, int wr, int wc, int fr, int fq) const {
        const int row0 = u.pm * BM + wr * 64 + fr, col0 = u.pn * BM + wc * 32 + 8 * fq; const float* rin = u.pm >= MP / BM ? rin1 : rin0;
#pragma unroll
        for (int ai = 0; ai < 2; ++ai)
#pragma unroll
            for (int m = 0; m < 4; ++m) { const int row = row0 + ai * HALF + m * 16; float sq = 0.f;
#pragma unroll
                for (int bj = 0; bj < 2; ++bj) { const size_t o = (size_t)row * D + col0 + bj * HALF;
                    const f32x4 v0 = *(const f32x4*)(rin + o) + acc[ai][bj][m][0] * alpha, v1 = *(const f32x4*)(rin + o + 4) + acc[ai][bj][m][1] * alpha;
                    *(f32x4*)(rout + o) = v0; *(f32x4*)(rout + o + 4) = v1; if (xb) *(u32x4*)(xb + o) = pack8(v0, v1);
                    sq += (v0[0] * v0[0] + v0[1] * v0[1]) + (v0[2] * v0[2] + v0[3] * v0[3]) + (v1[0] * v1[0] + v1[1] * v1[1]) + (v1[2] * v1[2] + v1[3] * v1[3]); }
                sq += __shfl_xor(sq, 16); sq += __shfl_xor(sq, 32);
                if (fq == 0) ss[(size_t)row * 16 + u.pn * 4 + wc] = sq;
                if (m & 1) asm volatile("" ::: "memory"); }
    }
};
struct EpiIn { static constexpr bool PERM = true, AFTER_DRAIN = false; const float* ss; bf16_t* ug; bf16_t* vb; float* out;
    __device__ __forceinline__ void operator()(const f32x4 (&acc)[2][2][4][2], const Unit& u, int wr, int wc, int fr, int fq) const {
        const int row0 = u.pm * BM + wr * 64 + fr;
        if (u.pn < 2) {
#pragma unroll
            for (int ai = 0; ai < 2; ++ai)
#pragma unroll
                for (int m = 0; m < 4; ++m) { const int row = row0 + ai * HALF + m * 16; const float r = rstd_row(ss, row);
#pragma unroll
                    for (int bj = 0; bj < 2; ++bj) { const int c0 = u.pn * BM + bj * HALF + wc * 32 + 8 * fq;
                        *(u32x4*)(ug + ((size_t)(c0 >> 4) * M + row) * 16 + (c0 & 15)) = pack8(acc[ai][bj][m][0] * r, acc[ai][bj][m][1] * r); } }
        } else {
            const int p0 = (u.pn - 2) * HALF + wc * 32 + 8 * fq;
#pragma unroll
            for (int ai = 0; ai < 2; ++ai)
#pragma unroll
                for (int m = 0; m < 4; ++m) { const int row = row0 + ai * HALF + m * 16; const float r = rstd_row(ss, row);
                    const f32x4 a0 = acc[ai][0][m][0] * r, a1 = acc[ai][0][m][1] * r, g0 = acc[ai][1][m][0] * r, g1 = acc[ai][1][m][1] * r;
                    const f32x4 v0 = a0 * sig4(g0), v1 = a1 * sig4(g1);
                    *(u32x4*)(vb + (size_t)row * CONVD + p0) = pack8(v0, v1);
                    float* o = nullptr;
                    if (row >= MP) { const int rs = row - MP; o = out + O_CVS + ((size_t)(rs >> 3) * 30 + 22 + (rs & 7)) * CONVD + p0; }
                    else { const int t = row & (SEQ - 1); if (t >= SEQ - 30) o = out + O_CVP + ((size_t)(row >> 11) * 30 + (t - (SEQ - 30))) * CONVD + p0; }
                    if (o) { *(f32x4*)o = v0; *(f32x4*)(o + 4) = v1; } }
        }
    }
};
struct EpiGlu { static constexpr bool PERM = true, AFTER_DRAIN = false; const bf16_t* gb; bf16_t* mixb;
    __device__ __forceinline__ void operator()(const f32x4 (&acc)[2][2][4][2], const Unit& u, int wr, int wc, int fr, int fq) const {
        const int row0 = u.pm * BM + wr * 64 + fr, col0 = u.pn * BM + wc * 32 + 8 * fq;
#pragma unroll
        for (int ai = 0; ai < 2; ++ai)
#pragma unroll
            for (int m = 0; m < 4; ++m) { const int row = row0 + ai * HALF + m * 16;
#pragma unroll
                for (int bj = 0; bj < 2; ++bj) { const int c0 = col0 + bj * HALF; const u32x4 gw = *(const u32x4*)(gb + (size_t)row * SSM + c0);
                    const f32x4 ga = {__builtin_bit_cast(float, gw.x << 16), __builtin_bit_cast(float, gw.x & 0xffff0000u), __builtin_bit_cast(float, gw.y << 16), __builtin_bit_cast(float, gw.y & 0xffff0000u)};
                    const f32x4 gc = {__builtin_bit_cast(float, gw.z << 16), __builtin_bit_cast(float, gw.z & 0xffff0000u), __builtin_bit_cast(float, gw.w << 16), __builtin_bit_cast(float, gw.w & 0xffff0000u)};
                    *(u32x4*)(mixb + (size_t)row * D + c0) = pack8(ga * sig4(acc[ai][bj][m][0]), gc * sig4(acc[ai][bj][m][1])); } }
    }
};
struct EpiQ { static constexpr bool PERM = true, AFTER_DRAIN = false; const float* ss; bf16_t* qb;
    __device__ __forceinline__ void operator()(const f32x4 (&acc)[2][2][4][2], const Unit& u, int wr, int wc, int fr, int fq) const {
        const int row0 = u.pm * BM + wr * 64 + fr, col0 = u.pn * BM + wc * 32 + 8 * fq;
#pragma unroll
        for (int ai = 0; ai < 2; ++ai)
#pragma unroll
            for (int m = 0; m < 4; ++m) { const int row = row0 + ai * HALF + m * 16; const float r = rstd_row(ss, row) * QSCALE;
#pragma unroll
                for (int bj = 0; bj < 2; ++bj) *(u32x4*)(qb + (size_t)row * D + col0 + bj * HALF) = pack8(acc[ai][bj][m][0] * r, acc[ai][bj][m][1] * r); }
    }
};
}

#define GAS __attribute__((address_space(1)))
#define LAS __attribute__((address_space(3)))
typedef unsigned v4u __attribute__((ext_vector_type(4)));
typedef float f32x4 __attribute__((ext_vector_type(4)));
typedef short bf16x8 __attribute__((ext_vector_type(8)));
typedef GAS unsigned gu32;
typedef GAS unsigned long long gu64;
#define RLX_AGENT __ATOMIC_RELAXED, __HIP_MEMORY_SCOPE_AGENT
#define LDS_WAIT() asm volatile("s_waitcnt lgkmcnt(0)" ::: "memory")
#define VM_WAIT() asm volatile("s_waitcnt vmcnt(0)" ::: "memory")
__device__ __forceinline__ unsigned long long rt() { return __builtin_amdgcn_s_memrealtime(); }
__device__ __forceinline__ unsigned pk2(float lo, float hi) { return f2bf(lo) | (f2bf(hi) << 16); }

#define XB_TMO      128
#define XB_XCNT(j)  (256  + 64 * (j))
#define XB_XSUB(j)  (1280 + 64 * (j))
#define XB_XGEN(j)  (2304 + 64 * (j))
#define XB_TOP      3328
#define XB_TOPGEN   3392
#define XCD_BAR_WORDS 3456
#define XB_SPIN_CAP (1u << 18)

__device__ __forceinline__ unsigned xb_ld(unsigned* p)              { return __hip_atomic_load(p, __ATOMIC_RELAXED, __HIP_MEMORY_SCOPE_AGENT); }
__device__ __forceinline__ unsigned xb_add(unsigned* p, unsigned v) { return __hip_atomic_fetch_add(p, v, __ATOMIC_RELAXED, __HIP_MEMORY_SCOPE_AGENT); }
__device__ __forceinline__ unsigned xb_xcc_id() { return (unsigned)__builtin_amdgcn_s_getreg((3 << 11) | 20) & 0xFu; }
#define XB_SPIN(cond, bar) do { unsigned _sp = 0; while (cond) { __builtin_amdgcn_s_sleep(1); \
    if ((++_sp & 255u) == 0u) { if (xb_ld(&(bar)[XB_TMO])) break; if (_sp > XB_SPIN_CAP) { atomicAdd(&(bar)[XB_TMO], 1u); break; } } } } while (0)

struct XcdBarrier {
    unsigned* bar; unsigned x;
    volatile LAS unsigned* st;
};

__device__ __forceinline__ XcdBarrier xcd_barrier_post(unsigned* bar, volatile LAS unsigned* st) {
    XcdBarrier b; b.bar = bar; b.x = xb_xcc_id(); b.st = st;
    if (threadIdx.x == 0) (void)xb_add(&bar[XB_XCNT(b.x)], 1u);
    return b;
}
__device__ __forceinline__ void xcd_barrier_complete(unsigned* bar, unsigned x, unsigned& nloc, unsigned& nx) {
    const unsigned G = gridDim.x * gridDim.y * gridDim.z;
    unsigned sum, cnt, mine, sp = 0u;
    for (;;) {
        sum = 0u; cnt = 0u; mine = 0u;
#pragma unroll
        for (unsigned j = 0; j < 16; ++j) { const unsigned c = xb_ld(&bar[XB_XCNT(j)]); sum += c; cnt += (c > 0u) ? 1u : 0u; mine = (j == x) ? c : mine; }
        if (sum == G) break;
        __builtin_amdgcn_s_sleep(1);
        if ((++sp & 255u) == 0u) { if (xb_ld(&bar[XB_TMO])) break; if (sp > XB_SPIN_CAP) { atomicAdd(&bar[XB_TMO], 1u); break; } }
    }
    nloc = mine > 0u ? mine : 1u; nx = cnt > 0u ? cnt : 1u;
}

__device__ __forceinline__ void xcd_barrier(const XcdBarrier& b) {
    asm volatile("s_waitcnt vmcnt(0)" ::: "memory");
    __syncthreads();
    if (threadIdx.x == 0) {
        unsigned* bar = b.bar;
        __builtin_amdgcn_s_waitcnt(0);
        unsigned nloc = b.st[0], nx = b.st[1];
        if (nloc == 0u) { xcd_barrier_complete(bar, b.x, nloc, nx); b.st[0] = nloc; b.st[1] = nx; }
        const unsigned old = xb_add(&bar[XB_XSUB(b.x)], 1u);
        const unsigned gen = old / nloc;
        if (old + 1u == (gen + 1u) * nloc) {
            __builtin_amdgcn_fence(__ATOMIC_RELEASE, "agent");
            asm volatile("s_waitcnt vmcnt(0)" ::: "memory");
            const unsigned og = xb_add(&bar[XB_TOP], 1u);
            const unsigned tg = og / nx;
            if (og + 1u == (tg + 1u) * nx) xb_add(&bar[XB_TOPGEN], 1u);
            else XB_SPIN(xb_ld(&bar[XB_TOPGEN]) == tg, bar);
            __builtin_amdgcn_fence(__ATOMIC_ACQUIRE, "agent");
            xb_add(&bar[XB_XGEN(b.x)], 1u);
            asm volatile("s_waitcnt vmcnt(0)" ::: "memory");
        } else {
            XB_SPIN(xb_ld(&bar[XB_XGEN(b.x)]) == gen, bar);
            __builtin_amdgcn_fence(__ATOMIC_ACQUIRE, "agent");
            asm volatile("s_waitcnt vmcnt(0)" ::: "memory");
        }
    }
    __syncthreads();
}

namespace sb {
__device__ __forceinline__ void transpose_item(const float* W, int ldw, int c0, const float* gain, bf16_t* WT, int K, int n0, int k0, LAS float* scr, int lane) {
#pragma unroll 8
    for (int i = 0; i < 32; ++i) { const int kk = 2 * i + (lane >> 5); float v = W[(size_t)(k0 + kk) * ldw + c0 + (lane & 31)]; if (gain) v *= gain[k0 + kk]; scr[kk * 33 + (lane & 31)] = v; }
    LDS_WAIT(); asm volatile("" ::: "memory");
    const int c = lane & 7;
#pragma unroll
    for (int j = 0; j < 4; ++j) { const int n = (lane >> 3) + 8 * j; const LAS float* s = scr + (8 * c) * 33 + n;
        v4u o; o.x = pk2(s[0 * 33], s[1 * 33]); o.y = pk2(s[2 * 33], s[3 * 33]); o.z = pk2(s[4 * 33], s[5 * 33]); o.w = pk2(s[6 * 33], s[7 * 33]);
        *(GAS v4u*)(WT + (size_t)(n0 + n) * K + k0 + 8 * c) = o; }
    LDS_WAIT(); asm volatile("" ::: "memory");
}
template <int MAP>
__device__ __forceinline__ void transpose_job_item(const float* W0, const float* W1, const float* gain, bf16_t* WT, int K, int N, int ldw, int item, LAS float* scr, int lane) {
    const int nblk = N / 32, kb = item / nblk, nb = item % nblk, n0 = 32 * nb, k0 = 64 * kb;
    const float* W = W0; int c0 = n0;
    if (MAP == 1) { const int pn = n0 / 256, half = (n0 % 256) / 128, jj = n0 % 128; W = half ? W1 : W0; c0 = pn * 128 + jj; }
    if (MAP == 2) { if (n0 >= 512) { const int m = n0 - 512, pc = m / 256, half = (m % 256) / 128, jj = m % 128; c0 = 512 + half * 512 + pc * 128 + jj; } }
    if (MAP == 3) { if (n0 >= 1024) { W = W1; c0 = n0 - 1024; } }
    transpose_item(W, ldw, c0, gain, WT, K, n0, k0, scr, lane);
}
__device__ __forceinline__ void row_bf16_ss(const float* xr, bf16_t* orow, float* ssrow, float* rstd1, int lane) {
    float s = 0.f;
#pragma unroll
    for (int j = 0; j < 4; ++j) { const f32x4 v = *(const f32x4*)(xr + j * 256 + lane * 4); s += (v.x * v.x + v.y * v.y) + (v.z * v.z + v.w * v.w);
        uint2 o; o.x = pk2(v.x, v.y); o.y = pk2(v.z, v.w); *(uint2*)(orow + j * 256 + lane * 4) = o; }
    s = wave_sum(s);
    if (lane < 16) ssrow[lane] = lane == 0 ? s : 0.f;
    if (rstd1 && lane == 0) *rstd1 = rsqrtf(s * (1.f / D) + EPS);
}

__device__ __forceinline__ void s5_task(int task, const bf16_t* ug, const float* h0re, const float* h0im, const float* a_re, const float* a_im, const float* log_dt,
                                        const float* b_re, const float* b_im, const float* c_re, const float* c_im, const float* dskip, bf16_t* gb, float* out, int n) {
    const int g = task % NG, sq = task / NG;
    const bool prompt = sq < NBATCH; const int b = prompt ? sq : sq - NBATCH, T = prompt ? SEQ : DECS, row0 = prompt ? b * SEQ : MP + b * DECS;
    const float dt = expf(log_dt[g]), lr = a_re[g * NST + n], li = a_im[g * NST + n];
    const float mag = expf(lr * dt), abr = mag * cosf(li * dt), abi = mag * sinf(li * dt);
    const float den = lr * lr + li * li, nr = abr - 1.f, ni = abi, cr = (nr * lr + ni * li) / den, ci = (ni * lr - nr * li) / den;
    float Br[16], Bi[16], Cr[16], Ci[16];
#pragma unroll
    for (int c = 0; c < 16; ++c) { const float br = b_re[((size_t)g * NST + n) * 16 + c], bi = b_im[((size_t)g * NST + n) * 16 + c];
        Br[c] = cr * br - ci * bi; Bi[c] = cr * bi + ci * br; Cr[c] = c_re[((size_t)g * 16 + c) * NST + n]; Ci[c] = c_im[((size_t)g * 16 + c) * NST + n]; }
    float hr = 0.f, hi = 0.f;
    if (!prompt) { hr = h0re[((size_t)b * NG + g) * NST + n]; hi = h0im[((size_t)b * NG + g) * NST + n]; }
    const float dsk = dskip[g * 16 + (n & 15)];
    for (int t = 0; t < T; ++t) {
        const bf16_t* up = ug + ((size_t)g * M + row0 + t) * 16;
        const v4u w0 = *(const v4u*)up, w1 = *(const v4u*)(up + 8);
        float u[16];
        u[0] = __builtin_bit_cast(float, w0.x << 16); u[1] = __builtin_bit_cast(float, w0.x & 0xffff0000u); u[2] = __builtin_bit_cast(float, w0.y << 16); u[3] = __builtin_bit_cast(float, w0.y & 0xffff0000u);
        u[4] = __builtin_bit_cast(float, w0.z << 16); u[5] = __builtin_bit_cast(float, w0.z & 0xffff0000u); u[6] = __builtin_bit_cast(float, w0.w << 16); u[7] = __builtin_bit_cast(float, w0.w & 0xffff0000u);
        u[8] = __builtin_bit_cast(float, w1.x << 16); u[9] = __builtin_bit_cast(float, w1.x & 0xffff0000u); u[10] = __builtin_bit_cast(float, w1.y << 16); u[11] = __builtin_bit_cast(float, w1.y & 0xffff0000u);
        u[12] = __builtin_bit_cast(float, w1.z << 16); u[13] = __builtin_bit_cast(float, w1.z & 0xffff0000u); u[14] = __builtin_bit_cast(float, w1.w << 16); u[15] = __builtin_bit_cast(float, w1.w & 0xffff0000u);
        float xr = 0.f, xi = 0.f;
#pragma unroll
        for (int c = 0; c < 16; ++c) { xr += Br[c] * u[c]; xi += Bi[c] * u[c]; }
        const float nhr = abr * hr - abi * hi + xr, nhi = abr * hi + abi * hr + xi; hr = nhr; hi = nhi;
        float ymine = 0.f;
#pragma unroll
        for (int c = 0; c < 16; ++c) { const float y = wave_sum(Cr[c] * hr - Ci[c] * hi); if ((n & 15) == c) ymine = y + dsk * u[c]; }
        if (n < 16) gb[(size_t)(row0 + t) * SSM + g * 16 + n] = (bf16_t)f2bf(gelu_tanh(ymine));
    }
    if (prompt) { out[O_SRP + ((size_t)b * NG + g) * NST + n] = hr; out[O_SIP + ((size_t)b * NG + g) * NST + n] = hi; }
    else { out[O_SRS + ((size_t)b * NG + g) * NST + n] = hr; out[O_SIS + ((size_t)b * NG + g) * NST + n] = hi; }
}

__device__ __forceinline__ void conv_row(int row, const bf16_t* vb, const float* cache, const float* w, const float* bias, const float* lg, const float* lb, bf16_t* mixb, float* out, LAS float* red, int c) {
    float y = bias[c];
    if (row < MP) { const int t = row % SEQ;
        for (int k = 0; k < CWID; ++k) { const int tt = t - 30 + k; if (tt >= 0) y += w[k * CONVD + c] * bf2f(vb[(size_t)(row - 30 + k) * CONVD + c]); }
    } else { const int rs = row - MP, b = rs / DECS, t = rs % DECS;
        for (int k = 0; k < CWID; ++k) { const int idx = t + k; const float xv = idx < 30 ? cache[((size_t)b * 30 + idx) * CONVD + c] : bf2f(vb[(size_t)(MP + b * DECS + idx - 30) * CONVD + c]); y += w[k * CONVD + c] * xv; }
        if (t == 0) for (int j = 0; j < 22; ++j) out[O_CVS + ((size_t)b * 30 + j) * CONVD + c] = cache[((size_t)b * 30 + j + 8) * CONVD + c];
    }
    float s = wave_sum(y); if ((c & 63) == 0) red[c >> 6] = s; __syncthreads();
    float mu = 0.f;
#pragma unroll
    for (int i = 0; i < 8; ++i) mu += red[i];
    mu *= (1.f / CONVD);
    const float d = y - mu; float q = wave_sum(d * d); if ((c & 63) == 0) red[8 + (c >> 6)] = q; __syncthreads();
    float var = 0.f;
#pragma unroll
    for (int i = 0; i < 8; ++i) var += red[8 + i];
    var *= (1.f / CONVD);
    const float z = d * rsqrtf(var + EPS) * lg[c] + lb[c];
    mixb[(size_t)row * D + SSM + c] = (bf16_t)f2bf(siluf_(z));
}

__device__ __forceinline__ void attn_task(int task, const bf16_t* qb, const bf16_t* kb, const bf16_t* vb2, const float* ck, const float* cv, bf16_t* ob, LAS float* scr, int t256) {
    LAS float* q = scr; LAS float* p = scr + 2048; LAS float* red = scr + 4096;
    const int rg = task >> 2, h = task & 3, row0 = rg * 8; const bool prompt = row0 < MP; const int b = prompt ? row0 / SEQ : (row0 - MP) / DECS;
#pragma unroll
    for (int r = 0; r < 8; ++r) q[r * 256 + t256] = bf2f(qb[(size_t)(row0 + r) * D + h * HD + t256]);
    __syncthreads();
    float s[8];
#pragma unroll
    for (int r = 0; r < 8; ++r) s[r] = 0.f;
    if (prompt) { const bf16_t* kr = kb + ((size_t)b * NMEM + t256) * D + h * HD;
        for (int d = 0; d < HD; d += 8) { const v4u w = *(const v4u*)(kr + d); float kv[8];
            kv[0] = __builtin_bit_cast(float, w.x << 16); kv[1] = __builtin_bit_cast(float, w.x & 0xffff0000u); kv[2] = __builtin_bit_cast(float, w.y << 16); kv[3] = __builtin_bit_cast(float, w.y & 0xffff0000u);
            kv[4] = __builtin_bit_cast(float, w.z << 16); kv[5] = __builtin_bit_cast(float, w.z & 0xffff0000u); kv[6] = __builtin_bit_cast(float, w.w << 16); kv[7] = __builtin_bit_cast(float, w.w & 0xffff0000u);
#pragma unroll
            for (int r = 0; r < 8; ++r)
#pragma unroll
                for (int j = 0; j < 8; ++j) s[r] += q[r * 256 + d + j] * kv[j]; }
    } else { const float* kr = ck + ((size_t)b * NMEM + t256) * D + h * HD;
        for (int d = 0; d < HD; d += 4) { const f32x4 kv = *(const f32x4*)(kr + d);
#pragma unroll
            for (int r = 0; r < 8; ++r) s[r] += (q[r * 256 + d] * kv.x + q[r * 256 + d + 1] * kv.y) + (q[r * 256 + d + 2] * kv.z + q[r * 256 + d + 3] * kv.w); }
    }
    const int w4 = t256 >> 6;
#pragma unroll
    for (int r = 0; r < 8; ++r) { float mx = s[r];
#pragma unroll
        for (int o = 1; o < 64; o <<= 1) mx = fmaxf(mx, __shfl_xor(mx, o));
        if ((t256 & 63) == 0) red[r * 4 + w4] = mx; }
    __syncthreads();
    float e[8];
#pragma unroll
    for (int r = 0; r < 8; ++r) { const float mx = fmaxf(fmaxf(red[r * 4], red[r * 4 + 1]), fmaxf(red[r * 4 + 2], red[r * 4 + 3])); e[r] = exp2f(s[r] - mx); }
    __syncthreads();
#pragma unroll
    for (int r = 0; r < 8; ++r) { const float sm = wave_sum(e[r]); if ((t256 & 63) == 0) red[r * 4 + w4] = sm; }
    __syncthreads();
#pragma unroll
    for (int r = 0; r < 8; ++r) { const float sm = (red[r * 4] + red[r * 4 + 1]) + (red[r * 4 + 2] + red[r * 4 + 3]); p[r * 256 + t256] = e[r] / sm; }
    __syncthreads();
    float o[8];
#pragma unroll
    for (int r = 0; r < 8; ++r) o[r] = 0.f;
    if (prompt) { const bf16_t* vr = vb2 + (size_t)b * NMEM * D + h * HD + t256;
        for (int m = 0; m < NMEM; ++m) { const float vv = bf2f(vr[(size_t)m * D]);
#pragma unroll
            for (int r = 0; r < 8; ++r) o[r] += p[r * 256 + m] * vv; }
    } else { const float* vr = cv + (size_t)b * NMEM * D + h * HD + t256;
        for (int m = 0; m < NMEM; ++m) { const float vv = vr[(size_t)m * D];
#pragma unroll
            for (int r = 0; r < 8; ++r) o[r] += p[r * 256 + m] * vv; }
    }
#pragma unroll
    for (int r = 0; r < 8; ++r) ob[(size_t)(row0 + r) * D + h * HD + t256] = (bf16_t)f2bf(o[r]);
    __syncthreads();
}
}

namespace s5f {
typedef short bf16x8 __attribute__((ext_vector_type(8)));
constexpr int KT_OFF = 0, KT_BYTES = 65 * 256 * 2, U_OFF = 33792, U_CSTR = 2064, S_OFF = U_OFF + 32 * U_CSTR, H_OFF = S_OFF + 32 * 128 * 4, H_RSTR = 272, END_OFF = H_OFF + 32 * H_RSTR;
static_assert(KT_BYTES <= U_OFF && END_OFF <= 131072, "S5 LDS map");
constexpr size_t TAB_KT = 0, TAB_P = 2 * MiB, TAB_Q = 10 * MiB, TAB_AL = 18 * MiB;
struct cf { float re, im; };
typedef float f32x2v __attribute__((ext_vector_type(2)));
typedef unsigned u32x2v __attribute__((ext_vector_type(2)));
__device__ __forceinline__ f32x2v tov(cf a) { return (f32x2v){a.re, a.im}; }
__device__ __forceinline__ cf toc(f32x2v a) { return cf{a.x, a.y}; }
__device__ __forceinline__ cf cmul(cf a, cf b) { return cf{a.re * b.re - a.im * b.im, a.re * b.im + a.im * b.re}; }
__device__ __forceinline__ cf cpow_a(float lr, float li, float dt, float p) { const float mag = expf(lr * dt * p); float s, c; sincosf(li * dt * p, &s, &c); return cf{mag * c, mag * s}; }
__device__ __forceinline__ cf coef_of(float lr, float li, float dt) { const cf a = cpow_a(lr, li, dt, 1.f); const float den = lr * lr + li * li, nr = a.re - 1.f, ni = a.im; return cf{(nr * lr + ni * li) / den, (ni * lr - nr * li) / den}; }

__device__ __forceinline__ void kt_task(int task, const float* a_re, const float* a_im, const float* log_dt, const float* b_re, const float* b_im, const float* c_re, const float* c_im,
                                        bf16_t* Ktab, LAS unsigned char* scr, int tid) {
    const int g = task >> 3, tb = task & 7;
    LAS f32x2v* Wb = (LAS f32x2v*)scr; LAS f32x2v* Bb = (LAS f32x2v*)(scr + 4096); LAS f32x2v* Cc = (LAS f32x2v*)(scr + 4096 + 8192);
    const float dt = expf(log_dt[g]);
    { const int tl = tid >> 6, n = tid & 63; Wb[tl * 64 + n] = tov(cpow_a(a_re[g * NST + n], a_im[g * NST + n], dt, (float)(8 * tb + tl))); }
#pragma unroll
    for (int e = tid; e < 1024; e += 512) { const int n = e >> 4, c = e & 15; const cf co = coef_of(a_re[g * NST + n], a_im[g * NST + n], dt);
        Bb[e] = tov(cmul(co, cf{b_re[((size_t)g * NST + n) * 16 + c], b_im[((size_t)g * NST + n) * 16 + c]})); }
#pragma unroll
    for (int e = tid; e < 1024; e += 512) Cc[e] = (f32x2v){c_re[(size_t)g * 1024 + e], c_im[(size_t)g * 1024 + e]};
    __syncthreads();
    { const int tl = tid >> 6, cc = tid & 63, c = cc >> 2, c0 = 4 * (cc & 3); float acc[4] = {0.f, 0.f, 0.f, 0.f};
        for (int n = 0; n < 64; ++n) { const cf T = cmul(toc(Cc[c * 64 + n]), toc(Wb[tl * 64 + n]));
#pragma unroll
            for (int k = 0; k < 4; ++k) { const cf E = toc(Bb[n * 16 + c0 + k]); acc[k] += T.re * E.re - T.im * E.im; } }
        uint2 o; o.x = pk2(acc[0], acc[1]); o.y = pk2(acc[2], acc[3]);
        *(uint2*)(Ktab + (((size_t)g * 65 + 8 * tb + tl + 1) * 16 + c) * 16 + c0) = o; }
    if (tb == 0 && tid < 32) *(v4u*)(Ktab + (size_t)g * 65 * 256 + tid * 8) = (v4u){0u, 0u, 0u, 0u};
    __syncthreads();
}
__device__ __forceinline__ void pq_entry(int e, const float* a_re, const float* a_im, const float* log_dt, const float* b_re, const float* b_im, const float* c_re, const float* c_im,
                                         bf16_t* Ptab, bf16_t* Qtab, float* ALtab) {
    {
        const int n = e & 63, j = (e >> 6) & 63, g = e >> 12; const float dt = expf(log_dt[g]);
        const cf W = cpow_a(a_re[g * NST + n], a_im[g * NST + n], dt, (float)(j + 1));
#pragma unroll
        for (int c = 0; c < 16; ++c) { const cf w = cmul(cf{c_re[((size_t)g * 16 + c) * NST + n], c_im[((size_t)g * 16 + c) * NST + n]}, W);
            bf16_t* p = Ptab + (((size_t)g * 64 + j) * 16 + c) * 128; p[n] = (bf16_t)f2bf(w.re); p[64 + n] = (bf16_t)f2bf(-w.im); }
        if (j == 0) { const cf al = cpow_a(a_re[g * NST + n], a_im[g * NST + n], dt, 64.f); ALtab[(g * NST + n) * 2] = al.re; ALtab[(g * NST + n) * 2 + 1] = al.im;
            const cf a8 = cpow_a(a_re[g * NST + n], a_im[g * NST + n], dt, 8.f); ALtab[NG * NST * 2 + (g * NST + n) * 2] = a8.re; ALtab[NG * NST * 2 + (g * NST + n) * 2 + 1] = a8.im; }
    }
    {
        const int i = e & 63, n = (e >> 6) & 63, g = e >> 12; const float dt = expf(log_dt[g]);
        const float lr = a_re[g * NST + n], li = a_im[g * NST + n];
        const cf V = cmul(cpow_a(lr, li, dt, (float)(63 - i)), coef_of(lr, li, dt));
        unsigned wr[8], wi[8];
#pragma unroll
        for (int c = 0; c < 16; c += 2) { const cf v0 = cmul(V, cf{b_re[((size_t)g * NST + n) * 16 + c], b_im[((size_t)g * NST + n) * 16 + c]}), v1 = cmul(V, cf{b_re[((size_t)g * NST + n) * 16 + c + 1], b_im[((size_t)g * NST + n) * 16 + c + 1]});
            wr[c >> 1] = pk2(v0.re, v1.re); wi[c >> 1] = pk2(v0.im, v1.im); }
        v4u* qr = (v4u*)(Qtab + ((size_t)g * 128 + n) * 1024 + i * 16); v4u* qi = (v4u*)(Qtab + ((size_t)g * 128 + 64 + n) * 1024 + i * 16);
        qr[0] = (v4u){wr[0], wr[1], wr[2], wr[3]}; qr[1] = (v4u){wr[4], wr[5], wr[6], wr[7]}; qi[0] = (v4u){wi[0], wi[1], wi[2], wi[3]}; qi[1] = (v4u){wi[4], wi[5], wi[6], wi[7]};
    }
}
__device__ __forceinline__ float gelu_fast(float x) { const float u = 1.5957691216057308f * (x + 0.044715f * x * x * x); return x * __builtin_amdgcn_rcpf(1.f + __builtin_amdgcn_exp2f(-1.4426950408889634f * u)); }

__device__ __forceinline__ void prompt_unit(int b, int g, const bf16_t* ug, const bf16_t* Ktab, const bf16_t* Ptab, const bf16_t* Qtab, const float* ALtab, const float* dskip, bf16_t* gb, float* out,
                                            LAS unsigned char* L, int tid, int wave, int lane) {
    {
        const v4u* src = (const v4u*)(Ktab + (size_t)g * 65 * 256);
#pragma unroll
        for (int p = 0; p < 5; ++p) { const int q = p * 512 + tid; if (q < KT_BYTES / 16) *(LAS v4u*)(L + KT_OFF + q * 16) = src[q]; }
        const v4u* us = (const v4u*)(ug + ((size_t)g * M + (size_t)b * SEQ) * 16);
#pragma unroll
        for (int p = 0; p < 8; ++p) { const int q = p * 512 + tid; *(LAS v4u*)(L + U_OFF + (q >> 7) * U_CSTR + (q & 127) * 16) = us[q]; }
    }
    __syncthreads();
    const int fr = lane & 15, kq = lane >> 4;
    const LAS unsigned char* ub0 = L + U_OFF + fr * U_CSTR + kq * 16; const LAS unsigned char* ub1 = ub0 + 16 * U_CSTR;
    {
        f32x4 a0 = {0.f, 0.f, 0.f, 0.f}, a1 = {0.f, 0.f, 0.f, 0.f};
        const bf16_t* qrow = Qtab + ((size_t)g * 128 + wave * 16 + fr) * 1024 + kq * 8;
        bf16x8 af[32];
#pragma unroll
        for (int s = 0; s < 32; ++s) af[s] = *(const bf16x8*)(qrow + s * 32);
#pragma unroll
        for (int s = 0; s < 32; ++s) {
            a0 = __builtin_amdgcn_mfma_f32_16x16x32_bf16(af[s], *(const LAS bf16x8*)(ub0 + s * 64), a0, 0, 0, 0);
            a1 = __builtin_amdgcn_mfma_f32_16x16x32_bf16(af[s], *(const LAS bf16x8*)(ub1 + s * 64), a1, 0, 0, 0); }
        *(LAS f32x4*)(L + S_OFF + (fr * 128 + wave * 16 + kq * 4) * 4) = a0;
        *(LAS f32x4*)(L + S_OFF + ((16 + fr) * 128 + wave * 16 + kq * 4) * 4) = a1;
    }
    __syncthreads();
    if (tid < 64) {
        const int n = tid; const float alr = ALtab[(g * NST + n) * 2], ali = ALtab[(g * NST + n) * 2 + 1]; float hr = 0.f, hi = 0.f;
        const LAS float* Sb = (const LAS float*)(L + S_OFF);
        for (int c = 0; c < 32; ++c) { LAS bf16_t* hb = (LAS bf16_t*)(L + H_OFF + c * H_RSTR); hb[n] = (bf16_t)f2bf(hr); hb[64 + n] = (bf16_t)f2bf(hi);
            const float sr = Sb[c * 128 + n], si = Sb[c * 128 + 64 + n]; const float nhr = alr * hr - ali * hi + sr, nhi = alr * hi + ali * hr + si; hr = nhr; hi = nhi; }
        out[O_SRP + ((size_t)b * NG + g) * NST + n] = hr; out[O_SIP + ((size_t)b * NG + g) * NST + n] = hi;
    }
    __syncthreads();
    f32x4 acc[8][2];
#pragma unroll
    for (int q = 0; q < 8; ++q) { acc[q][0] = (f32x4){0.f, 0.f, 0.f, 0.f}; acc[q][1] = (f32x4){0.f, 0.f, 0.f, 0.f}; }
    {
        const LAS unsigned char* kt = L + KT_OFF + (fr * 16 + (kq & 1) * 8) * 2 + (wave + 1 - (kq >> 1)) * 512;
        const int smax = (wave + 56) >> 1;
        for (int s = 0; s <= smax; ++s) {
            const bf16x8 b0 = *(const LAS bf16x8*)(ub0 + s * 64), b1 = *(const LAS bf16x8*)(ub1 + s * 64);
#pragma unroll
            for (int q = 0; q < 8; ++q) if (wave + 8 * q >= 2 * s) { const bf16x8 a = *(const LAS bf16x8*)(kt + (8 * q - 2 * s) * 512);
                acc[q][0] = __builtin_amdgcn_mfma_f32_16x16x32_bf16(a, b0, acc[q][0], 0, 0, 0); acc[q][1] = __builtin_amdgcn_mfma_f32_16x16x32_bf16(a, b1, acc[q][1], 0, 0, 0); }
        }
    }
    {
        const LAS unsigned char* hb0 = L + H_OFF + fr * H_RSTR + kq * 16; const LAS unsigned char* hb1 = hb0 + 16 * H_RSTR;
        const bf16_t* prow = Ptab + (((size_t)g * 64 + wave) * 16 + fr) * 128 + kq * 8;
#pragma unroll
        for (int s2 = 0; s2 < 4; ++s2) { const bf16x8 b0 = *(const LAS bf16x8*)(hb0 + s2 * 64), b1 = *(const LAS bf16x8*)(hb1 + s2 * 64);
#pragma unroll
            for (int q = 0; q < 8; ++q) { const bf16x8 a = *(const bf16x8*)(prow + (size_t)q * 8 * 16 * 128 + s2 * 32);
                acc[q][0] = __builtin_amdgcn_mfma_f32_16x16x32_bf16(a, b0, acc[q][0], 0, 0, 0); acc[q][1] = __builtin_amdgcn_mfma_f32_16x16x32_bf16(a, b1, acc[q][1], 0, 0, 0); } }
    }
    {
        const f32x4 dsk = *(const f32x4*)(dskip + g * 16 + kq * 4);
#pragma unroll
        for (int q = 0; q < 8; ++q)
#pragma unroll
            for (int nb = 0; nb < 2; ++nb) { const int chunk = nb * 16 + fr, j = wave + 8 * q;
                const u32x2v uw = *(const LAS u32x2v*)(L + U_OFF + chunk * U_CSTR + (j * 16 + kq * 4) * 2);
                const f32x4 u4 = {__builtin_bit_cast(float, uw.x << 16), __builtin_bit_cast(float, uw.x & 0xffff0000u), __builtin_bit_cast(float, uw.y << 16), __builtin_bit_cast(float, uw.y & 0xffff0000u)};
                const f32x4 y = acc[q][nb] + dsk * u4;
                uint2 o; o.x = pk2(gelu_fast(y[0]), gelu_fast(y[1])); o.y = pk2(gelu_fast(y[2]), gelu_fast(y[3]));
                *(uint2*)(gb + ((size_t)b * SEQ + chunk * 64 + j) * SSM + g * 16 + kq * 4) = o; }
    }
    __syncthreads();
}
__device__ __forceinline__ void sample_unit(int g, int bblk, const bf16_t* ug, const float* h0re, const float* h0im, const bf16_t* Ktab, const bf16_t* Ptab, const bf16_t* Qtab, const float* ALtab, const float* dskip,
                                            bf16_t* gb, float* out, int wave, int lane) {
    const int fr = lane & 15, kq = lane >> 4, b = bblk * 16 + fr;
    const bf16_t* ub = ug + ((size_t)g * M + MP + (size_t)b * DECS) * 16;
    const size_t hbase = ((size_t)b * NG + g) * NST;
    bf16x8 uf[4], hf[4];
#pragma unroll
    for (int s = 0; s < 4; ++s) uf[s] = *(const bf16x8*)(ub + (2 * s + (kq >> 1)) * 16 + (kq & 1) * 8);
#pragma unroll
    for (int s2 = 0; s2 < 4; ++s2) { const float* hp = (s2 < 2 ? h0re : h0im) + hbase + (s2 & 1) * 32 + kq * 8; const f32x4 x0 = *(const f32x4*)hp, x1 = *(const f32x4*)(hp + 4);
        hf[s2] = __builtin_bit_cast(bf16x8, (v4u){pk2(x0.x, x0.y), pk2(x0.z, x0.w), pk2(x1.x, x1.y), pk2(x1.z, x1.w)}); }
    {   const int j = wave; f32x4 acc = {0.f, 0.f, 0.f, 0.f};
#pragma unroll
        for (int s = 0; s < 4; ++s) if (2 * s <= j) { const int tau1 = j - 2 * s - (kq >> 1) + 1;
            acc = __builtin_amdgcn_mfma_f32_16x16x32_bf16(*(const bf16x8*)(Ktab + ((size_t)g * 65 + tau1) * 256 + fr * 16 + (kq & 1) * 8), uf[s], acc, 0, 0, 0); }
#pragma unroll
        for (int s2 = 0; s2 < 4; ++s2) acc = __builtin_amdgcn_mfma_f32_16x16x32_bf16(*(const bf16x8*)(Ptab + (((size_t)g * 64 + j) * 16 + fr) * 128 + s2 * 32 + kq * 8), hf[s2], acc, 0, 0, 0);
        const f32x4 dsk = *(const f32x4*)(dskip + g * 16 + kq * 4);
        const u32x2v uw = *(const u32x2v*)(ub + j * 16 + kq * 4);
        const f32x4 u4 = {__builtin_bit_cast(float, uw.x << 16), __builtin_bit_cast(float, uw.x & 0xffff0000u), __builtin_bit_cast(float, uw.y << 16), __builtin_bit_cast(float, uw.y & 0xffff0000u)};
        const f32x4 y = acc + dsk * u4;
        *(u32x2v*)(gb + ((size_t)MP + b * DECS + j) * SSM + g * 16 + kq * 4) = (u32x2v){pk2(gelu_fast(y[0]), gelu_fast(y[1])), pk2(gelu_fast(y[2]), gelu_fast(y[3]))};
    }
    {   f32x4 acc = {0.f, 0.f, 0.f, 0.f};
        const bf16_t* qrow = Qtab + ((size_t)g * 128 + wave * 16 + fr) * 1024 + 56 * 16 + (kq >> 1) * 16 + (kq & 1) * 8;
#pragma unroll
        for (int s = 0; s < 4; ++s) acc = __builtin_amdgcn_mfma_f32_16x16x32_bf16(*(const bf16x8*)(qrow + s * 32), uf[s], acc, 0, 0, 0);
        const float* al8 = ALtab + NG * NST * 2 + (size_t)g * NST * 2;
#pragma unroll
        for (int r = 0; r < 4; ++r) { const int n = (16 * wave + 4 * kq + r) & 63; const float h0r = h0re[hbase + n], h0i = h0im[hbase + n], ar = al8[2 * n], ai = al8[2 * n + 1];
            if (wave < 4) out[O_SRS + hbase + n] = ar * h0r - ai * h0i + acc[r]; else out[O_SIS + hbase + n] = ar * h0i + ai * h0r + acc[r]; }
    }
}
}


namespace att {
typedef short bf16x8 __attribute__((ext_vector_type(8)));
typedef float f32x16 __attribute__((ext_vector_type(16)));
typedef float f32x2v __attribute__((ext_vector_type(2)));
typedef unsigned u32x2v __attribute__((ext_vector_type(2)));
__device__ __forceinline__ int crow(int r, int hi) { return (r & 3) + 8 * (r >> 2) + 4 * hi; }
__device__ __forceinline__ unsigned cvtpk(float lo, float hi) { return pg8::cvt_pk_bf16(lo, hi); }

__device__ __forceinline__ void prompt_unit(int b, int h, int qblk, const bf16_t* qb, const bf16_t* kb, const bf16_t* vT, bf16_t* ob, LAS unsigned char* L, LAS float* wsf, int tid, int wave, int lane) {
    const int r32 = lane & 31, hh = lane >> 5, x = r32 & 15;
    const bf16_t* Kg = kb + (size_t)b * NMEM * D + h * HD;
    for (int half = 0; half < 2; ++half)
#pragma unroll 4
        for (int p = 0; p < 8; ++p) { const int q = p * 512 + tid, mem = q >> 4, c16 = q & 15;
            *(LAS v4u*)(L + half * 65536 + mem * 256 + ((c16 ^ (mem & 15)) << 4)) = *(const v4u*)(Kg + (size_t)mem * D + half * 128 + c16 * 8); }
    const size_t qrow = (size_t)b * SEQ + qblk * 256 + wave * 32 + r32;
    const bf16_t* Qg = qb + qrow * D + h * HD + hh * 8;
    unsigned koff[8];
#pragma unroll
    for (int ks = 0; ks < 8; ++ks) koff[ks] = (unsigned)(((2 * ks + hh) ^ x) << 4);
    __syncthreads();
    f32x16 S[8];
#pragma unroll
    for (int mb = 0; mb < 8; ++mb)
#pragma unroll
        for (int r = 0; r < 16; ++r) S[mb][r] = 0.f;
#pragma unroll
    for (int half = 0; half < 2; ++half) {
        bf16x8 qf[8];
#pragma unroll
        for (int ks = 0; ks < 8; ++ks) qf[ks] = *(const bf16x8*)(Qg + half * 128 + ks * 16);
        const LAS unsigned char* kbase = L + half * 65536 + r32 * 256;
#pragma unroll
        for (int mb = 0; mb < 8; ++mb) {
#pragma unroll
            for (int ks = 0; ks < 8; ++ks) S[mb] = __builtin_amdgcn_mfma_f32_32x32x16_bf16(*(const LAS bf16x8*)(kbase + mb * 8192 + koff[ks]), qf[ks], S[mb], 0, 0, 0);
            asm volatile("" : "+v"(S[mb])); __builtin_amdgcn_sched_barrier(0); }
    }
    __syncthreads();
    const bf16_t* Vg = vT + (size_t)h * HD * MMEM + (size_t)b * NMEM;
    for (int dh = 0; dh < 2; ++dh)
#pragma unroll 4
        for (int p = 0; p < 8; ++p) { const int q = p * 512 + tid, dd = q >> 5, c32 = q & 31;
            *(LAS v4u*)(L + dh * 65536 + dd * 512 + ((c32 ^ (dd & 15)) << 4)) = *(const v4u*)(Vg + (size_t)(dh * 128 + dd) * MMEM + c32 * 8); }
    float mx = S[0][0];
#pragma unroll
    for (int mb = 0; mb < 8; ++mb)
#pragma unroll
        for (int r = 0; r < 16; ++r) mx = fmaxf(mx, S[mb][r]);
    mx = fmaxf(mx, __shfl_xor(mx, 32));
    float lsum = 0.f;
    v4u pa[8][2];
#pragma unroll
    for (int mb = 0; mb < 8; ++mb) {
#pragma unroll
        for (int r = 0; r < 16; ++r) { const float e = __builtin_amdgcn_exp2f(S[mb][r] - mx); S[mb][r] = e; lsum += e; }
#pragma unroll
        for (int s = 0; s < 2; ++s) pa[mb][s] = (v4u){cvtpk(S[mb][8 * s], S[mb][8 * s + 1]), cvtpk(S[mb][8 * s + 2], S[mb][8 * s + 3]), cvtpk(S[mb][8 * s + 4], S[mb][8 * s + 5]), cvtpk(S[mb][8 * s + 6], S[mb][8 * s + 7])};
    }
    lsum += __shfl_xor(lsum, 32);
    if (hh == 0) wsf[r32] = lsum;
    __syncthreads();
    unsigned voff[2][4];
#pragma unroll
    for (int s = 0; s < 2; ++s)
#pragma unroll
        for (int ml = 0; ml < 4; ++ml) voff[s][ml] = (unsigned)(((4 * ml + 2 * s) ^ (hh ^ x)) << 4);
    bf16_t* Og = ob + ((size_t)b * SEQ + qblk * 256 + wave * 32 + 4 * hh) * D + h * HD + r32;
#pragma unroll
    for (int dh = 0; dh < 2; ++dh) {
        f32x16 O[4];
#pragma unroll
        for (int db = 0; db < 4; ++db)
#pragma unroll
            for (int r = 0; r < 16; ++r) O[db][r] = 0.f;
        const LAS unsigned char* vbase = L + dh * 65536 + r32 * 512;
#pragma unroll
        for (int mb = 0; mb < 8; ++mb)
#pragma unroll
            for (int s = 0; s < 2; ++s) { const bf16x8 a = __builtin_bit_cast(bf16x8, pa[mb][s]);
#pragma unroll
                for (int db = 0; db < 4; ++db)
                    O[db] = __builtin_amdgcn_mfma_f32_32x32x16_bf16(a, *(const LAS bf16x8*)(vbase + db * 16384 + (mb >> 2) * 256 + voff[s][mb & 3]), O[db], 0, 0, 0);
                asm volatile("" : "+v"(O[0]), "+v"(O[1]), "+v"(O[2]), "+v"(O[3])); __builtin_amdgcn_sched_barrier(0); }
#pragma unroll
        for (int r = 0; r < 16; ++r) { const float rl = __builtin_amdgcn_rcpf(wsf[crow(r, hh)]);
#pragma unroll
            for (int db = 0; db < 4; ++db) Og[(size_t)((r & 3) + 8 * (r >> 2)) * D + dh * 128 + db * 32] = (bf16_t)f2bf(O[db][r] * rl);
            __builtin_amdgcn_sched_barrier(0); }
    }
    __syncthreads();
}

__device__ __forceinline__ void sample_unit(int b, int hp, const bf16_t* qb, const float* ck, const float* cv, bf16_t* ob, LAS unsigned char* L, int tid, int wave, int lane) {
    const int hsel = wave >> 2, mq = wave & 3, head = 2 * hp + hsel;
    LAS float* sbuf = (LAS float*)L; LAS float* pT = (LAS float*)(L + 16384); LAS float* obuf = (LAS float*)(L + 32768);
    float q[8][4];
#pragma unroll
    for (int t = 0; t < 8; ++t) { const u32x2v w = *(const u32x2v*)(qb + ((size_t)MP + b * DECS + t) * D + head * HD + lane * 4);
        q[t][0] = __builtin_bit_cast(float, w.x << 16); q[t][1] = __builtin_bit_cast(float, w.x & 0xffff0000u); q[t][2] = __builtin_bit_cast(float, w.y << 16); q[t][3] = __builtin_bit_cast(float, w.y & 0xffff0000u); }
    const float* Kr = ck + (((size_t)b * NMEM + mq * 64) * NH + head) * HD + lane * 4;
    for (int m0 = 0; m0 < 64; m0 += 4) {
        f32x4 k4[4];
#pragma unroll
        for (int i = 0; i < 4; ++i) k4[i] = *(const f32x4*)(Kr + (size_t)(m0 + i) * NH * HD);
#pragma unroll
        for (int i = 0; i < 4; ++i) {
            float v[8];
#pragma unroll
            for (int t = 0; t < 8; ++t) v[t] = (q[t][0] * k4[i].x + q[t][1] * k4[i].y) + (q[t][2] * k4[i].z + q[t][3] * k4[i].w);
            float r4[4], r2[2], r1;
#pragma unroll
            for (int j = 0; j < 4; ++j) { const bool up = lane & 32; const float send = up ? v[j] : v[j + 4], keep = up ? v[j + 4] : v[j]; r4[j] = keep + __shfl_xor(send, 32); }
#pragma unroll
            for (int j = 0; j < 2; ++j) { const bool up = lane & 16; const float send = up ? r4[j] : r4[j + 2], keep = up ? r4[j + 2] : r4[j]; r2[j] = keep + __shfl_xor(send, 16); }
            { const bool up = lane & 8; const float send = up ? r2[0] : r2[1], keep = up ? r2[1] : r2[0]; r1 = keep + __shfl_xor(send, 8); }
            r1 += __shfl_xor(r1, 4); r1 += __shfl_xor(r1, 2); r1 += __shfl_xor(r1, 1);
            const int t = ((lane >> 5) & 1) * 4 + ((lane >> 4) & 1) * 2 + ((lane >> 3) & 1);
            if ((lane & 7) == 0) sbuf[(hsel * 8 + t) * 256 + mq * 64 + m0 + i] = r1;
        }
    }
    __syncthreads();
#pragma unroll
    for (int rr = 0; rr < 2; ++rr) { const int row = wave * 2 + rr;
        const f32x4 s4 = *(const LAS f32x4*)(sbuf + row * 256 + lane * 4);
        float mx = fmaxf(fmaxf(s4.x, s4.y), fmaxf(s4.z, s4.w));
#pragma unroll
        for (int o = 1; o < 64; o <<= 1) mx = fmaxf(mx, __shfl_xor(mx, o));
        const float e0 = exp2f(s4.x - mx), e1 = exp2f(s4.y - mx), e2 = exp2f(s4.z - mx), e3 = exp2f(s4.w - mx);
        const float inv = 1.f / wave_sum((e0 + e1) + (e2 + e3));
        LAS float* pp = pT + ((row >> 3) * 256 + lane * 4) * 8 + (row & 7);
        pp[0] = e0 * inv; pp[8] = e1 * inv; pp[16] = e2 * inv; pp[24] = e3 * inv; }
    __syncthreads();
    float o[8][4];
#pragma unroll
    for (int t = 0; t < 8; ++t) { o[t][0] = 0.f; o[t][1] = 0.f; o[t][2] = 0.f; o[t][3] = 0.f; }
    const float* Vr = cv + (((size_t)b * NMEM + mq * 64) * NH + head) * HD + lane * 4;
    for (int m0 = 0; m0 < 64; m0 += 4) {
        f32x4 v4[4];
#pragma unroll
        for (int i = 0; i < 4; ++i) v4[i] = *(const f32x4*)(Vr + (size_t)(m0 + i) * NH * HD);
#pragma unroll
        for (int i = 0; i < 4; ++i) { const LAS f32x4* pp = (const LAS f32x4*)(pT + (hsel * 256 + mq * 64 + m0 + i) * 8); const f32x4 pa = pp[0], pb = pp[1];
            const float pv[8] = {pa.x, pa.y, pa.z, pa.w, pb.x, pb.y, pb.z, pb.w};
#pragma unroll
            for (int t = 0; t < 8; ++t) { o[t][0] += pv[t] * v4[i].x; o[t][1] += pv[t] * v4[i].y; o[t][2] += pv[t] * v4[i].z; o[t][3] += pv[t] * v4[i].w; } }
    }
#pragma unroll
    for (int t = 0; t < 8; ++t) *(LAS f32x4*)(obuf + ((hsel * 4 + mq) * 8 + t) * 256 + lane * 4) = (f32x4){o[t][0], o[t][1], o[t][2], o[t][3]};
    __syncthreads();
    { const int hs = tid >> 8, t = (tid >> 5) & 7, d8 = tid & 31;
        f32x4 a0 = {0.f, 0.f, 0.f, 0.f}, a1 = {0.f, 0.f, 0.f, 0.f};
#pragma unroll
        for (int m = 0; m < 4; ++m) { const LAS f32x4* pp = (const LAS f32x4*)(obuf + ((hs * 4 + m) * 8 + t) * 256 + d8 * 8); a0 = a0 + pp[0]; a1 = a1 + pp[1]; }
        *(v4u*)(ob + ((size_t)MP + b * DECS + t) * D + (2 * hp + hs) * HD + d8 * 8) = (v4u){pk2(a0.x, a0.y), pk2(a0.z, a0.w), pk2(a1.x, a1.y), pk2(a1.z, a1.w)};
    }
    __syncthreads();
}
}

namespace cvx {
template <int NT>
__device__ __forceinline__ void ln_swish_rows(const LAS float* ybuf, int row0, const float* lg, const float* lb, bf16_t* mixb, int wave, int lane) {
    const f32x4 g0 = *(const f32x4*)(lg + lane * 4), g1 = *(const f32x4*)(lg + 256 + lane * 4), b0 = *(const f32x4*)(lb + lane * 4), b1 = *(const f32x4*)(lb + 256 + lane * 4);
    for (int j = wave; j < NT; j += 8) {
        const f32x4 a = *(const LAS f32x4*)(ybuf + j * 512 + lane * 4), b = *(const LAS f32x4*)(ybuf + j * 512 + 256 + lane * 4);
        const float s = wave_sum(((a.x + a.y) + (a.z + a.w)) + ((b.x + b.y) + (b.z + b.w)));
        const float mu = s * (1.f / CONVD); const f32x4 da = a - mu, db = b - mu;
        const float q = wave_sum(((da.x * da.x + da.y * da.y) + (da.z * da.z + da.w * da.w)) + ((db.x * db.x + db.y * db.y) + (db.z * db.z + db.w * db.w)));
        const float rs = rsqrtf(q * (1.f / CONVD) + EPS);
        const f32x4 za = da * rs * g0 + b0, zb = db * rs * g1 + b1;
        typedef unsigned u32x2 __attribute__((ext_vector_type(2)));
        bf16_t* o = mixb + (size_t)(row0 + j) * D + SSM + lane * 4;
        *(u32x2*)o = (u32x2){pk2(za.x * fx::fsig(za.x), za.y * fx::fsig(za.y)), pk2(za.z * fx::fsig(za.z), za.w * fx::fsig(za.w))};
        *(u32x2*)(o + 256) = (u32x2){pk2(zb.x * fx::fsig(zb.x), zb.y * fx::fsig(zb.y)), pk2(zb.z * fx::fsig(zb.z), zb.w * fx::fsig(zb.w))};
    }
}
__device__ __forceinline__ void prompt_tile(int b, int t0, const bf16_t* vb, const float* w, const float* bias, const float* lg, const float* lb, bf16_t* mixb, LAS float* ybuf, int tid, int wave, int lane) {
    const int c = tid;
    float wk[31];
#pragma unroll
    for (int k = 0; k < 31; ++k) wk[k] = w[k * CONVD + c];
    const float bs = bias[c];
    const bf16_t* vp = vb + (size_t)b * SEQ * CONVD + c;
#pragma unroll 1
    for (int pass = 0; pass < 4; ++pass) {
        const int tb = t0 + pass * 16;
        float xin[46];
#pragma unroll
        for (int ii = 0; ii < 46; ++ii) { const int tt = tb - 30 + ii; const int tc = tt < 0 ? 0 : tt; const float v = bf2f(vp[(size_t)tc * CONVD]); xin[ii] = tt < 0 ? 0.f : v; }
#pragma unroll
        for (int j = 0; j < 16; ++j) { float y = bs;
#pragma unroll
            for (int k = 0; k < 31; ++k) y += wk[k] * xin[j + k];
            ybuf[(pass * 16 + j) * 512 + c] = y; }
    }
    __syncthreads();
    ln_swish_rows<64>(ybuf, b * SEQ + t0, lg, lb, mixb, wave, lane);
    __syncthreads();
}
__device__ __forceinline__ void sample_batch(int b, const bf16_t* vb, const float* cache, const float* w, const float* bias, const float* lg, const float* lb, bf16_t* mixb, float* out, LAS float* ybuf, int tid, int wave, int lane) {
    const int c = tid;
    float xp[38];
#pragma unroll
    for (int i = 0; i < 30; ++i) xp[i] = cache[((size_t)b * 30 + i) * CONVD + c];
#pragma unroll
    for (int i = 0; i < 8; ++i) xp[30 + i] = bf2f(vb[((size_t)MP + b * DECS + i) * CONVD + c]);
#pragma unroll
    for (int j = 0; j < 22; ++j) out[O_CVS + ((size_t)b * 30 + j) * CONVD + c] = xp[j + 8];
    float y[8];
    const float bs = bias[c];
#pragma unroll
    for (int j = 0; j < 8; ++j) y[j] = bs;
#pragma unroll
    for (int k = 0; k < 31; ++k) { const float wv = w[k * CONVD + c];
#pragma unroll
        for (int j = 0; j < 8; ++j) y[j] += wv * xp[j + k]; }
#pragma unroll
    for (int j = 0; j < 8; ++j) ybuf[j * 512 + c] = y[j];
    __syncthreads();
    ln_swish_rows<8>(ybuf, MP + b * DECS, lg, lb, mixb, wave, lane);
    __syncthreads();
}
}

namespace sg {
typedef short bf16x8 __attribute__((ext_vector_type(8)));
constexpr int PSTR = 68, PBYTES = 64 * PSTR * 4;
template <class Epi>
__device__ __forceinline__ void tile(const bf16_t* A, const bf16_t* Bt, int K, int tm, int tn, const Epi& E, LAS unsigned char* L, int tid, int wave, int lane) {
    const int fr = lane & 15, kq = lane >> 4, kw = K >> 3, ns = kw >> 5;
    const bf16_t* a0 = A + (size_t)(tm * 64 + fr) * K + wave * kw + kq * 8;
    const bf16_t* b0 = Bt + (size_t)(tn * 64 + fr) * K + wave * kw + kq * 8;
    f32x4 acc[4][4];
#pragma unroll
    for (int i = 0; i < 4; ++i)
#pragma unroll
        for (int j = 0; j < 4; ++j) acc[i][j] = (f32x4){0.f, 0.f, 0.f, 0.f};
#pragma unroll 2
    for (int s = 0; s < ns; ++s) {
        bf16x8 af[4], bf[4];
#pragma unroll
        for (int i = 0; i < 4; ++i) { af[i] = *(const bf16x8*)(a0 + (size_t)i * 16 * K + s * 32); bf[i] = *(const bf16x8*)(b0 + (size_t)i * 16 * K + s * 32); }
#pragma unroll
        for (int i = 0; i < 4; ++i)
#pragma unroll
            for (int j = 0; j < 4; ++j) acc[i][j] = __builtin_amdgcn_mfma_f32_16x16x32_bf16(af[i], bf[j], acc[i][j], 0, 0, 0);
    }
    LAS float* P = (LAS float*)(L + (wave & 3) * PBYTES) + (4 * kq) * PSTR + fr;
    if (wave >= 4) {
#pragma unroll
        for (int i = 0; i < 4; ++i)
#pragma unroll
            for (int j = 0; j < 4; ++j)
#pragma unroll
                for (int r = 0; r < 4; ++r) P[(16 * i + r) * PSTR + 16 * j] = acc[i][j][r];
    }
    __syncthreads();
    if (wave < 4) {
#pragma unroll
        for (int i = 0; i < 4; ++i)
#pragma unroll
            for (int j = 0; j < 4; ++j)
#pragma unroll
                for (int r = 0; r < 4; ++r) acc[i][j][r] += P[(16 * i + r) * PSTR + 16 * j];
    }
    __syncthreads();
    if (wave < 4) {
#pragma unroll
        for (int i = 0; i < 4; ++i)
#pragma unroll
            for (int j = 0; j < 4; ++j)
#pragma unroll
                for (int r = 0; r < 4; ++r) P[(16 * i + r) * PSTR + 16 * j] = acc[i][j][r];
    }
    __syncthreads();
    { const int row = tid >> 3, c8 = (tid & 7) * 8; f32x4 v0 = {0.f, 0.f, 0.f, 0.f}, v1 = {0.f, 0.f, 0.f, 0.f};
#pragma unroll
        for (int w = 0; w < 4; ++w) { const LAS f32x4* p = (const LAS f32x4*)(L + w * PBYTES + (row * PSTR + c8) * 4); v0 = v0 + p[0]; v1 = v1 + p[1]; }
        E(tm * 64 + row, tn * 64 + c8, tn, v0, v1, lane); }
    __syncthreads();
}
struct SRes { const float* rin; float* rout; bf16_t* xb; float* ss; float alpha;
    __device__ __forceinline__ void operator()(int row, int col0, int slot, f32x4 a0, f32x4 a1, int lane) const {
        const size_t o = (size_t)row * D + col0;
        const f32x4 v0 = *(const f32x4*)(rin + o) + a0 * alpha, v1 = *(const f32x4*)(rin + o + 4) + a1 * alpha;
        *(f32x4*)(rout + o) = v0; *(f32x4*)(rout + o + 4) = v1; if (xb) *(fx::u32x4*)(xb + o) = fx::pack8(v0, v1);
        float sq = ((v0[0] * v0[0] + v0[1] * v0[1]) + (v0[2] * v0[2] + v0[3] * v0[3])) + ((v1[0] * v1[0] + v1[1] * v1[1]) + (v1[2] * v1[2] + v1[3] * v1[3]));
        sq += __shfl_xor(sq, 1); sq += __shfl_xor(sq, 2); sq += __shfl_xor(sq, 4);
        if ((lane & 7) == 0) ss[(size_t)row * 16 + slot] = sq;
    }
};
struct SQ { const float* ss; bf16_t* qb;
    __device__ __forceinline__ void operator()(int row, int col0, int slot, f32x4 a0, f32x4 a1, int lane) const {
        const float r = fx::rstd_row(ss, row) * QSCALE; *(fx::u32x4*)(qb + (size_t)row * D + col0) = fx::pack8(a0 * r, a1 * r);
    }
};
}

namespace pro {
using s5f::cf; using s5f::cmul; using s5f::cpow_a; using s5f::coef_of;
__device__ __forceinline__ void transpose_item(const float* W, int ldw, int c0, const float* gain, bf16_t* WT, int K, int n0, int k0, LAS float* scr, int lane) {
    const int r8 = lane >> 3, c4 = (lane & 7) * 4;
    f32x4 v[8];
#pragma unroll
    for (int i = 0; i < 8; ++i) v[i] = *(const f32x4*)(W + (size_t)(k0 + 8 * i + r8) * ldw + c0 + c4);
    if (gain) {
#pragma unroll
        for (int i = 0; i < 8; ++i) v[i] = v[i] * gain[k0 + 8 * i + r8]; }
#pragma unroll
    for (int i = 0; i < 8; ++i) *(LAS f32x4*)(scr + (8 * i + r8) * 36 + c4) = v[i];
    LDS_WAIT(); asm volatile("" ::: "memory");
    const int c = lane & 7;
#pragma unroll
    for (int j = 0; j < 4; ++j) { const int n = (lane >> 3) + 8 * j; const LAS float* s = scr + (8 * c) * 36 + n;
        v4u o; o.x = pk2(s[0 * 36], s[1 * 36]); o.y = pk2(s[2 * 36], s[3 * 36]); o.z = pk2(s[4 * 36], s[5 * 36]); o.w = pk2(s[6 * 36], s[7 * 36]);
        *(GAS v4u*)(WT + (size_t)(n0 + n) * K + k0 + 8 * c) = o; }
    LDS_WAIT(); asm volatile("" ::: "memory");
}
template <int MAP>
__device__ __forceinline__ void transpose_job_item(const float* W0, const float* W1, const float* gain, bf16_t* WT, int K, int N, int ldw, int item, LAS float* scr, int lane) {
    const int nblk = N / 32, kb = item / nblk, nb = item % nblk, n0 = 32 * nb, k0 = 64 * kb;
    const float* W = W0; int c0 = n0;
    if (MAP == 1) { const int pn = n0 / 256, half = (n0 % 256) / 128, jj = n0 % 128; W = half ? W1 : W0; c0 = pn * 128 + jj; }
    if (MAP == 2) { if (n0 >= 512) { const int m = n0 - 512, pc = m / 256, half = (m % 256) / 128, jj = m % 128; c0 = 512 + half * 512 + pc * 128 + jj; } }
    if (MAP == 3) { if (n0 >= 1024) { W = W1; c0 = n0 - 1024; } }
    transpose_item(W, ldw, c0, gain, WT, K, n0, k0, scr, lane);
}
__device__ __forceinline__ void rows2_bf16_ss(const float* xa, const float* xb_, bf16_t* oa, bf16_t* ob_, float* ssa, float* ssb, float* ra, float* rb, int lane) {
    f32x4 va[4], vb[4];
#pragma unroll
    for (int j = 0; j < 4; ++j) { va[j] = *(const f32x4*)(xa + j * 256 + lane * 4); vb[j] = *(const f32x4*)(xb_ + j * 256 + lane * 4); }
    float sa = 0.f, sb_ = 0.f;
#pragma unroll
    for (int j = 0; j < 4; ++j) { sa += (va[j].x * va[j].x + va[j].y * va[j].y) + (va[j].z * va[j].z + va[j].w * va[j].w); sb_ += (vb[j].x * vb[j].x + vb[j].y * vb[j].y) + (vb[j].z * vb[j].z + vb[j].w * vb[j].w);
        uint2 o; o.x = pk2(va[j].x, va[j].y); o.y = pk2(va[j].z, va[j].w); *(uint2*)(oa + j * 256 + lane * 4) = o;
        uint2 p; p.x = pk2(vb[j].x, vb[j].y); p.y = pk2(vb[j].z, vb[j].w); *(uint2*)(ob_ + j * 256 + lane * 4) = p; }
    sa = wave_sum(sa); sb_ = wave_sum(sb_);
    if (lane < 16) { ssa[lane] = lane == 0 ? sa : 0.f; ssb[lane] = lane == 0 ? sb_ : 0.f; }
    if (ra && lane == 0) { *ra = rsqrtf(sa * (1.f / D) + EPS); *rb = rsqrtf(sb_ * (1.f / D) + EPS); }
}
__device__ __forceinline__ void kt_wave_task(int task, const float* a_re, const float* a_im, const float* log_dt, const float* b_re, const float* b_im, const float* c_re, const float* c_im,
                                             bf16_t* Ktab, LAS float* scr, int lane) {
    const int g = task >> 6, tau = task & 63, n = lane;
    const float dt = expf(log_dt[g]), lr = a_re[g * NST + n], li = a_im[g * NST + n];
    const cf W = cpow_a(lr, li, dt, (float)tau), co = coef_of(lr, li, dt);
    LAS float* T = scr; LAS float* E = scr + 64 * 32;
#pragma unroll
    for (int c = 0; c < 16; ++c) { const cf t = cmul(cf{c_re[((size_t)g * 16 + c) * NST + n], c_im[((size_t)g * 16 + c) * NST + n]}, W); T[n * 32 + 2 * c] = t.re; T[n * 32 + 2 * c + 1] = t.im;
        const cf e = cmul(co, cf{b_re[((size_t)g * NST + n) * 16 + c], b_im[((size_t)g * NST + n) * 16 + c]}); E[n * 32 + 2 * c] = e.re; E[n * 32 + 2 * c + 1] = e.im; }
    LDS_WAIT(); asm volatile("" ::: "memory");
    const int c = lane >> 2, c0 = 4 * (lane & 3); float acc[4] = {0.f, 0.f, 0.f, 0.f};
    for (int m = 0; m < 64; ++m) { const float tr = T[m * 32 + 2 * c], ti = T[m * 32 + 2 * c + 1];
#pragma unroll
        for (int k = 0; k < 4; ++k) acc[k] += tr * E[m * 32 + 2 * (c0 + k)] - ti * E[m * 32 + 2 * (c0 + k) + 1]; }
    uint2 o; o.x = pk2(acc[0], acc[1]); o.y = pk2(acc[2], acc[3]);
    *(uint2*)(Ktab + (((size_t)g * 65 + tau + 1) * 16 + c) * 16 + c0) = o;
    if (tau == 0 && lane < 32) *(v4u*)(Ktab + (size_t)g * 65 * 256 + lane * 8) = (v4u){0u, 0u, 0u, 0u};
    LDS_WAIT(); asm volatile("" ::: "memory");
}
}

#ifndef DBL_MASK
#define DBL_MASK 0
#endif
constexpr int NWAVES = 8;
constexpr int RING_OFF = 0, RING_BYTES = 131072;
constexpr int LDSCTL_OFF = RING_BYTES, MISC_OFF = LDSCTL_OFF + 320, XTRA_OFF = RING_BYTES + 1024;
constexpr int LDS_BYTES = 147456;
constexpr size_t CTL_ZERO_BYTES = 1 * MiB;
constexpr int CW_TMO = 0, CW_CODE = 1, CW_BAR = 4096;
constexpr int MAX_LAUNCHES = 8;
static_assert((CW_BAR + MAX_LAUNCHES * XCD_BAR_WORDS) * 4 <= (int)CTL_ZERO_BYTES, "barrier words inside the memset region");

enum Phase { PH_PRO = 0, PH_GU1 = 1, PH_D1 = 2, PH_IN = 3, PH_MIX = 4, PH_GLU = 5, PH_OUT = 6, PH_Q = 7, PH_ATT = 8, PH_O = 9, PH_GU2 = 10, PH_D2 = 11, PH_FIN = 12, PH_N = 13 };

struct Args { const float* in[39]; float* out; unsigned char* ws; int ph_lo, ph_hi, li, pad; };

__global__ void __launch_bounds__(NWAVES * 64, 2) mk_fwd(Args args) {
    extern __shared__ __attribute__((aligned(16))) unsigned char lds[];
    LAS unsigned char* L = (LAS unsigned char*)lds;
    volatile LAS unsigned* MISC = (volatile LAS unsigned*)(L + MISC_OFF);
    const int tid = threadIdx.x;
    const int G = gridDim.x, bx = blockIdx.x;
    unsigned char* ws = args.ws; float* out = args.out;
    gu32* ctl = (gu32*)(ws + WS_CTL);
    for (int u = tid; u < (LDS_BYTES - LDSCTL_OFF) / 4; u += NWAVES * 64) ((LAS unsigned*)(L + LDSCTL_OFF))[u] = 0u;
    __syncthreads();
    XcdBarrier bar = xcd_barrier_post((unsigned*)(ctl + CW_BAR) + args.li * XCD_BAR_WORDS, MISC + 8);
    const int lo = args.ph_lo, hi = args.ph_hi;
#define IN(k) (lo <= (k) && (k) < hi)
#define BOTH(k) (IN(k) && IN((k) + 1))
#define GRID_BAR() xcd_barrier(bar)
    bf16_t *Wgu1 = (bf16_t*)(ws + WS_WGU1), *Wgu2 = (bf16_t*)(ws + WS_WGU2), *Wd1 = (bf16_t*)(ws + WS_WD1), *Wd2 = (bf16_t*)(ws + WS_WD2), *Win = (bf16_t*)(ws + WS_WIN), *Wglu = (bf16_t*)(ws + WS_WGLU),
           *Wout = (bf16_t*)(ws + WS_WOUT), *Wq = (bf16_t*)(ws + WS_WQ), *Wo = (bf16_t*)(ws + WS_WO), *Wkv = (bf16_t*)(ws + WS_WKV);
    bf16_t *xb = (bf16_t*)(ws + WS_XB), *memb = (bf16_t*)(ws + WS_MEMB), *kb = (bf16_t*)(ws + WS_KB), *vb2 = (bf16_t*)(ws + WS_VB2), *hb = (bf16_t*)(ws + WS_H), *ug = (bf16_t*)(ws + WS_UG),
           *vb = (bf16_t*)(ws + WS_VB), *gb = (bf16_t*)(ws + WS_GB), *mixb = (bf16_t*)(ws + WS_MIXB), *qb = (bf16_t*)(ws + WS_QB), *ob = (bf16_t*)(ws + WS_OB);
    bf16_t *Ktab = (bf16_t*)(ws + WS_TAB + s5f::TAB_KT), *Ptab = (bf16_t*)(ws + WS_TAB + s5f::TAB_P), *Qtab = (bf16_t*)(ws + WS_TAB + s5f::TAB_Q); float* ALtab = (float*)(ws + WS_TAB + s5f::TAB_AL);
    float *ss0 = (float*)(ws + WS_SS0), *ss1 = (float*)(ws + WS_SS1), *ss2 = (float*)(ws + WS_SS2), *ss3 = (float*)(ws + WS_SS3), *ss4 = (float*)(ws + WS_SS4), *ssm = (float*)(ws + WS_SSM), *xres = (float*)(ws + WS_XRES);
    float* rstdm = ssm + (size_t)MMEM * 16; bf16_t* vT = vb2;

    const int wave = __builtin_amdgcn_readfirstlane(tid >> 6), lane = tid & 63;
    const float* const* in = args.in;
    if (IN(PH_PRO)) {
      for (int rep_ = 0; rep_ <= ((DBL_MASK >> PH_PRO) & 1); ++rep_) {
        {
            LAS float* scr = (LAS float*)(L + RING_OFF + wave * 16384);
            const int NGW = G * NWAVES;
            constexpr int I_GU = (D / 64) * (2 * FF / 32), I_D = (FF / 64) * (D / 32), I_IN = (D / 64) * (1536 / 32), I_GLU = (SSM / 64) * (SSM / 32), I_SQ = (D / 64) * (D / 32), I_KV = (D / 64) * (2048 / 32);
            constexpr int NITEMS = 2 * I_GU + 2 * I_D + I_IN + I_GLU + 3 * I_SQ + I_KV;
            constexpr int T_KT = NG * 64, T_PQ = 131072 / 64, T_ROW = M / 2, T_MEM = MMEM / 2, NTASK = T_KT + T_PQ + NITEMS + T_ROW + T_MEM;
            const bool rev = wave & 1; constexpr int NEV = (NTASK + 1) / 2, NOD = NTASK / 2;
            for (int ti = (wave >> 1) * G + bx; ti < (rev ? NOD : NEV); ti += NGW / 2) {
                int r = rev ? 2 * (NOD - 1 - ti) + 1 : 2 * ti;
                if (r < T_KT) { pro::kt_wave_task(r, in[17], in[18], in[19], in[20], in[21], in[22], in[23], Ktab, scr, lane); continue; } r -= T_KT;
                if (r < T_PQ) { s5f::pq_entry(r * 64 + lane, in[17], in[18], in[19], in[20], in[21], in[22], in[23], Ptab, Qtab, ALtab); continue; } r -= T_PQ;
                if (r < NITEMS) {
                    if (r < I_GU) { pro::transpose_job_item<1>(in[12], in[13], in[11], Wgu1, D, 2 * FF, FF, r, scr, lane); continue; } r -= I_GU;
                    if (r < I_GU) { pro::transpose_job_item<1>(in[35], in[36], in[34], Wgu2, D, 2 * FF, FF, r, scr, lane); continue; } r -= I_GU;
                    if (r < I_D) { pro::transpose_job_item<0>(in[14], nullptr, nullptr, Wd1, FF, D, D, r, scr, lane); continue; } r -= I_D;
                    if (r < I_D) { pro::transpose_job_item<0>(in[37], nullptr, nullptr, Wd2, FF, D, D, r, scr, lane); continue; } r -= I_D;
                    if (r < I_IN) { pro::transpose_job_item<2>(in[16], nullptr, in[15], Win, D, 1536, 1536, r, scr, lane); continue; } r -= I_IN;
                    if (r < I_GLU) { pro::transpose_job_item<0>(in[25], nullptr, nullptr, Wglu, SSM, SSM, SSM, r, scr, lane); continue; } r -= I_GLU;
                    if (r < I_SQ) { pro::transpose_job_item<0>(in[30], nullptr, nullptr, Wout, D, D, D, r, scr, lane); continue; } r -= I_SQ;
                    if (r < I_SQ) { pro::transpose_job_item<0>(in[32], nullptr, in[31], Wq, D, D, D, r, scr, lane); continue; } r -= I_SQ;
                    if (r < I_SQ) { pro::transpose_job_item<0>(in[33], nullptr, nullptr, Wo, D, D, D, r, scr, lane); continue; } r -= I_SQ;
                    pro::transpose_job_item<3>(in[9], in[10], in[8], Wkv, D, 2048, D, r, scr, lane); continue;
                }
                r -= NITEMS;
                if (r < T_ROW) { const int m0 = 2 * r, m1 = m0 + 1;
                    pro::rows2_bf16_ss(m0 < MP ? in[0] + (size_t)m0 * D : in[1] + (size_t)(m0 - MP) * D, m1 < MP ? in[0] + (size_t)m1 * D : in[1] + (size_t)(m1 - MP) * D,
                                       xb + (size_t)m0 * D, xb + (size_t)m1 * D, ss0 + (size_t)m0 * 16, ss0 + (size_t)m1 * 16, nullptr, nullptr, lane); continue; }
                r -= T_ROW;
                { const int m0 = 2 * r, m1 = m0 + 1; pro::rows2_bf16_ss(in[7] + (size_t)m0 * D, in[7] + (size_t)m1 * D, memb + (size_t)m0 * D, memb + (size_t)m1 * D, ssm + (size_t)m0 * 16, ssm + (size_t)m1 * 16, rstdm + m0, rstdm + m1, lane); }
            }
        }
        if (rep_ < ((DBL_MASK >> PH_PRO) & 1)) GRID_BAR();
      }
        if (BOTH(PH_PRO)) GRID_BAR();
    }

    if (IN(PH_GU1)) {
      for (int rep_ = 0; rep_ <= ((DBL_MASK >> PH_GU1) & 1); ++rep_) {
        { pg8::Gemm g{memb, Wkv, MMEM, D, D}; pg8::StaticOrder S; S.init(MMEM, D, G, (bx + G - 216 % G) % G); fx::EpiK E{rstdm, kb, out};
          pg8::gemm_phase<fx::EpiK, pg8::StaticOrder, true, true>(L + RING_OFF, g, S, E); }
        { pg8::Gemm g{xb, Wgu1, M, 2 * FF, D}; pg8::StaticOrder S; S.init(M, 2 * FF, G, bx); fx::EpiSwiglu E{ss0, hb};
          pg8::gemm_phase<fx::EpiSwiglu, pg8::StaticOrder, true, true>(L + RING_OFF, g, S, E); }
        if (rep_ < ((DBL_MASK >> PH_GU1) & 1)) GRID_BAR();
      }
        if (BOTH(PH_GU1)) GRID_BAR();
    }
    if (IN(PH_D1)) {
      for (int rep_ = 0; rep_ <= ((DBL_MASK >> PH_D1) & 1); ++rep_) {
        pg8::Gemm g{hb, Wd1, MP, D, FF}; pg8::StaticOrder S; S.init(MP, D, G, bx); fx::EpiRes E{args.in[0], args.in[0], xres, xb, ss1, 0.5f};
        pg8::gemm_phase<fx::EpiRes, pg8::StaticOrder, true, true>(L + RING_OFF, g, S, E);
        { sg::SRes Es{args.in[1], xres + (size_t)MP * D, xb + (size_t)MP * D, ss1 + (size_t)MP * 16, 0.5f};
          for (int t = bx; t < 256; t += G) sg::tile(hb + (size_t)MP * FF, Wd1, FF, t >> 4, t & 15, Es, L + RING_OFF, tid, wave, lane); }
        if (rep_ < ((DBL_MASK >> PH_D1) & 1)) GRID_BAR();
      }
        if (BOTH(PH_D1)) GRID_BAR();
    }
    if (IN(PH_IN)) {
      for (int rep_ = 0; rep_ <= ((DBL_MASK >> PH_IN) & 1); ++rep_) {
        { pg8::Gemm g{xb, Win, M, 1536, D}; pg8::StaticOrder S; S.init(M, 1536, G, bx); fx::EpiIn E{ss1, ug, vb, out};
          pg8::gemm_phase<fx::EpiIn, pg8::StaticOrder, true, true>(L + RING_OFF, g, S, E); }
        { pg8::Gemm g{Wkv + (size_t)D * D, memb, D, MMEM, D}; pg8::StaticOrder S; S.init(D, MMEM, G, (bx + G - 152 % G) % G); fx::EpiVT E{rstdm, vT, out};
          pg8::gemm_phase<fx::EpiVT, pg8::StaticOrder, true, true>(L + RING_OFF, g, S, E); }
        if (rep_ < ((DBL_MASK >> PH_IN) & 1)) GRID_BAR();
      }
        if (BOTH(PH_IN)) GRID_BAR();
    }
    if (IN(PH_MIX)) {
      for (int rep_ = 0; rep_ <= ((DBL_MASK >> PH_MIX) & 1); ++rep_) {
        for (int unit = bx; unit < NBATCH * NG; unit += G) s5f::prompt_unit(unit >> 5, unit & 31, ug, Ktab, Ptab, Qtab, ALtab, in[24], gb, out, L + RING_OFF, tid, wave, lane);
        for (int unit = bx; unit < NG * (DECB / 16); unit += G) s5f::sample_unit(unit & 31, unit >> 5, ug, in[2], in[3], Ktab, Ptab, Qtab, ALtab, in[24], gb, out, wave, lane);
        __syncthreads();
        LAS float* ybuf = (LAS float*)(L + RING_OFF);
        for (int tile = bx; tile < NBATCH * (SEQ / 64); tile += G) cvx::prompt_tile(tile >> 5, (tile & 31) * 64, vb, in[26], in[27], in[28], in[29], mixb, ybuf, tid, wave, lane);
        for (int b = bx; b < DECB; b += G) cvx::sample_batch(b, vb, in[4], in[26], in[27], in[28], in[29], mixb, out, ybuf, tid, wave, lane);
        if (rep_ < ((DBL_MASK >> PH_MIX) & 1)) GRID_BAR();
      }
        if (BOTH(PH_MIX)) GRID_BAR();
    }

    if (IN(PH_GLU)) {
      for (int rep_ = 0; rep_ <= ((DBL_MASK >> PH_GLU) & 1); ++rep_) {
        pg8::Gemm g{gb, Wglu, M, SSM, SSM}; pg8::StaticOrder S; S.init(M, SSM, G, bx); fx::EpiGlu E{gb, mixb};
        pg8::gemm_phase<fx::EpiGlu, pg8::StaticOrder, true, true>(L + RING_OFF, g, S, E);
        if (rep_ < ((DBL_MASK >> PH_GLU) & 1)) GRID_BAR();
      }
        if (BOTH(PH_GLU)) GRID_BAR();
    }
    if (IN(PH_OUT)) {
      for (int rep_ = 0; rep_ <= ((DBL_MASK >> PH_OUT) & 1); ++rep_) {
        pg8::Gemm g{mixb, Wout, MP, D, D}; pg8::StaticOrder S; S.init(MP, D, G, bx); fx::EpiRes E{xres, xres, xres, xb, ss2, 1.f};
        pg8::gemm_phase<fx::EpiRes, pg8::StaticOrder, true, true>(L + RING_OFF, g, S, E);
        { sg::SRes Es{xres + (size_t)MP * D, xres + (size_t)MP * D, xb + (size_t)MP * D, ss2 + (size_t)MP * 16, 1.f};
          for (int t = bx; t < 256; t += G) sg::tile(mixb + (size_t)MP * D, Wout, D, t >> 4, t & 15, Es, L + RING_OFF, tid, wave, lane); }
        if (rep_ < ((DBL_MASK >> PH_OUT) & 1)) GRID_BAR();
      }
        if (BOTH(PH_OUT)) GRID_BAR();
    }
    if (IN(PH_Q)) {
      for (int rep_ = 0; rep_ <= ((DBL_MASK >> PH_Q) & 1); ++rep_) {
        pg8::Gemm g{xb, Wq, MP, D, D}; pg8::StaticOrder S; S.init(MP, D, G, bx); fx::EpiQ E{ss2, qb};
        pg8::gemm_phase<fx::EpiQ, pg8::StaticOrder, true, true>(L + RING_OFF, g, S, E);
        { sg::SQ Es{ss2 + (size_t)MP * 16, qb + (size_t)MP * D};
          for (int t = bx; t < 256; t += G) sg::tile(xb + (size_t)MP * D, Wq, D, t >> 4, t & 15, Es, L + RING_OFF, tid, wave, lane); }
        if (rep_ < ((DBL_MASK >> PH_Q) & 1)) GRID_BAR();
      }
        if (BOTH(PH_Q)) GRID_BAR();
    }
    if (IN(PH_ATT)) {
      for (int rep_ = 0; rep_ <= ((DBL_MASK >> PH_ATT) & 1); ++rep_) {
        LAS float* wsf = (LAS float*)(L + XTRA_OFF) + wave * 32;
        const int vcu = (G % 8 == 0) ? (bx % 8) * (G / 8) + bx / 8 : bx;
        for (int unit = vcu; unit < NBATCH * NH * 8; unit += G) att::prompt_unit(unit >> 5, (unit >> 3) & 3, unit & 7, qb, kb, vT, ob, L + RING_OFF, wsf, tid, wave, lane);
        for (int unit = bx; unit < DECB * 2; unit += G) att::sample_unit(unit >> 1, unit & 1, qb, in[5], in[6], ob, L + RING_OFF, tid, wave, lane);
        if (rep_ < ((DBL_MASK >> PH_ATT) & 1)) GRID_BAR();
      }
        if (BOTH(PH_ATT)) GRID_BAR();
    }

    if (IN(PH_O)) {
      for (int rep_ = 0; rep_ <= ((DBL_MASK >> PH_O) & 1); ++rep_) {
        pg8::Gemm g{ob, Wo, MP, D, D}; pg8::StaticOrder S; S.init(MP, D, G, bx); fx::EpiRes E{xres, xres, xres, xb, ss3, 1.f};
        pg8::gemm_phase<fx::EpiRes, pg8::StaticOrder, true, true>(L + RING_OFF, g, S, E);
        { sg::SRes Es{xres + (size_t)MP * D, xres + (size_t)MP * D, xb + (size_t)MP * D, ss3 + (size_t)MP * 16, 1.f};
          for (int t = bx; t < 256; t += G) sg::tile(ob + (size_t)MP * D, Wo, D, t >> 4, t & 15, Es, L + RING_OFF, tid, wave, lane); }
        if (rep_ < ((DBL_MASK >> PH_O) & 1)) GRID_BAR();
      }
        if (BOTH(PH_O)) GRID_BAR();
    }
    if (IN(PH_GU2)) {
      for (int rep_ = 0; rep_ <= ((DBL_MASK >> PH_GU2) & 1); ++rep_) {
        pg8::Gemm g{xb, Wgu2, M, 2 * FF, D}; pg8::StaticOrder S; S.init(M, 2 * FF, G, bx); fx::EpiSwiglu E{ss3, hb};
        pg8::gemm_phase<fx::EpiSwiglu, pg8::StaticOrder, true, true>(L + RING_OFF, g, S, E);
        if (rep_ < ((DBL_MASK >> PH_GU2) & 1)) GRID_BAR();
      }
        if (BOTH(PH_GU2)) GRID_BAR();
    }
    if (IN(PH_D2)) {
      for (int rep_ = 0; rep_ <= ((DBL_MASK >> PH_D2) & 1); ++rep_) {
        pg8::Gemm g{hb, Wd2, MP, D, FF}; pg8::StaticOrder S; S.init(MP, D, G, bx); fx::EpiRes E{xres, xres, out + O_Y, nullptr, ss4, 0.5f};
        pg8::gemm_phase<fx::EpiRes, pg8::StaticOrder, true, true>(L + RING_OFF, g, S, E);
        { sg::SRes Es{xres + (size_t)MP * D, out + O_Y + (size_t)MP * D, nullptr, ss4 + (size_t)MP * 16, 0.5f};
          for (int t = bx; t < 256; t += G) sg::tile(hb + (size_t)MP * FF, Wd2, FF, t >> 4, t & 15, Es, L + RING_OFF, tid, wave, lane); }
        if (rep_ < ((DBL_MASK >> PH_D2) & 1)) GRID_BAR();
      }
        if (BOTH(PH_D2)) GRID_BAR();
    }

    if (IN(PH_FIN)) {
        float* y = out + O_Y; const float* gfin = in[38];
        for (int m = bx * NWAVES + wave; m < M; m += G * NWAVES) { const float r = rstd_from_ss(ss4, m);
#pragma unroll
            for (int j = 0; j < 4; ++j) { f32x4* p = (f32x4*)(y + (size_t)m * D + j * 256 + lane * 4); const f32x4 gg = *(const f32x4*)(gfin + j * 256 + lane * 4); f32x4 v = *p; v = v * r * gg; *p = v; } }
    }
    if (IN(13)) { for (int unit = bx; unit < NBATCH * NG; unit += G) s5f::prompt_unit(unit >> 5, unit & 31, ug, Ktab, Ptab, Qtab, ALtab, in[24], gb, out, L + RING_OFF, tid, wave, lane); }
    if (IN(14)) { for (int unit = bx; unit < NG * (DECB / 16); unit += G) s5f::sample_unit(unit & 31, unit >> 5, ug, in[2], in[3], Ktab, Ptab, Qtab, ALtab, in[24], gb, out, wave, lane); }
    if (IN(15)) { LAS float* ybuf = (LAS float*)(L + RING_OFF);
        for (int tile = bx; tile < NBATCH * (SEQ / 64); tile += G) cvx::prompt_tile(tile >> 5, (tile & 31) * 64, vb, in[26], in[27], in[28], in[29], mixb, ybuf, tid, wave, lane);
        for (int b = bx; b < DECB; b += G) cvx::sample_batch(b, vb, in[4], in[26], in[27], in[28], in[29], mixb, out, ybuf, tid, wave, lane); }
#undef IN
#undef BOTH
#undef GRID_BAR
}

#ifndef FAST_MERGE
#define FAST_MERGE 1
#endif
extern "C" void kernel_launch(void* const* d_in, const int* in_sizes, int n_in, void* d_out, int out_size, void* d_ws, size_t ws_size, hipStream_t stream) {
    if (n_in != 39 || out_size != (int)O_END || ws_size < WS_END) { fprintf(stderr, "kernel_launch: unexpected shapes n_in %d out %d ws %zu\n", n_in, out_size, ws_size); return; }
    static int grid = 0;
    if (grid == 0) {
        int dev = 0, cus = 0;
        if (hipGetDevice(&dev) != hipSuccess || hipDeviceGetAttribute(&cus, hipDeviceAttributeMultiprocessorCount, dev) != hipSuccess) { grid = -1; return; }
        if (hipFuncSetAttribute((const void*)mk_fwd, hipFuncAttributeMaxDynamicSharedMemorySize, LDS_BYTES) != hipSuccess) { fprintf(stderr, "kernel_launch: hipFuncSetAttribute failed\n"); grid = -1; return; }
        int per_cu = 0;
        if (hipOccupancyMaxActiveBlocksPerMultiprocessor(&per_cu, (const void*)mk_fwd, NWAVES * 64, LDS_BYTES) != hipSuccess || per_cu < 1) { fprintf(stderr, "kernel_launch: occupancy query says %d\n", per_cu); }
        (void)hipGetLastError();
        grid = cus;
    }
    if (grid < 0) return;
    const float* const* in = (const float* const*)d_in;
    const float *x_p = in[0], *x_s = in[1], *st_re = in[2], *st_im = in[3], *cconv = in[4], *cmk = in[5], *cmv = in[6], *memp = in[7], *g_mem = in[8], *w_k = in[9], *w_v = in[10],
                *g_ffn1 = in[11], *w1g = in[12], *w1u = in[13], *w1d = in[14], *g_mix = in[15], *w_in = in[16], *a_re = in[17], *a_im = in[18], *log_dt = in[19], *b_re = in[20], *b_im = in[21],
                *c_re = in[22], *c_im = in[23], *ssm_d = in[24], *w_glu = in[25], *conv_w = in[26], *conv_b = in[27], *ln_g = in[28], *ln_b = in[29], *w_out = in[30], *g_xattn = in[31],
                *w_q = in[32], *w_o = in[33], *g_ffn2 = in[34], *w2g = in[35], *w2u = in[36], *w2d = in[37], *g_final = in[38];
    (void)x_p; (void)x_s;
    unsigned char* ws = (unsigned char*)d_ws; float* out = (float*)d_out;
    bf16_t *Wgu1 = (bf16_t*)(ws + WS_WGU1), *Wgu2 = (bf16_t*)(ws + WS_WGU2), *Wd1 = (bf16_t*)(ws + WS_WD1), *Wd2 = (bf16_t*)(ws + WS_WD2), *Win = (bf16_t*)(ws + WS_WIN), *Wglu = (bf16_t*)(ws + WS_WGLU),
           *Wout = (bf16_t*)(ws + WS_WOUT), *Wq = (bf16_t*)(ws + WS_WQ), *Wo = (bf16_t*)(ws + WS_WO), *Wkv = (bf16_t*)(ws + WS_WKV);
    bf16_t *xb = (bf16_t*)(ws + WS_XB), *memb = (bf16_t*)(ws + WS_MEMB), *kb = (bf16_t*)(ws + WS_KB), *vb2 = (bf16_t*)(ws + WS_VB2), *ug = (bf16_t*)(ws + WS_UG),
           *vb = (bf16_t*)(ws + WS_VB), *gb = (bf16_t*)(ws + WS_GB), *mixb = (bf16_t*)(ws + WS_MIXB), *qb = (bf16_t*)(ws + WS_QB), *ob = (bf16_t*)(ws + WS_OB);
    float *ss0 = (float*)(ws + WS_SS0), *ss4 = (float*)(ws + WS_SS4), *ssm = (float*)(ws + WS_SSM);

    if (hipMemsetAsync(ws + WS_CTL, 0, CTL_ZERO_BYTES, stream) != hipSuccess) return;
    Args a{};
    for (int i = 0; i < 39; ++i) a.in[i] = in[i];
    a.out = out; a.ws = ws;
    int li = 0;
    auto run = [&](int lo, int hi) {
        if (FAST_MERGE) { a.ph_lo = lo; a.ph_hi = hi; a.li = li++; hipLaunchKernelGGL(mk_fwd, dim3(grid), dim3(NWAVES * 64), LDS_BYTES, stream, a); }
        else for (int p = lo; p < hi; ++p) { a.ph_lo = p; a.ph_hi = p + 1; a.li = li; hipLaunchKernelGGL(mk_fwd, dim3(grid), dim3(NWAVES * 64), LDS_BYTES, stream, a); }
    };

    run(PH_PRO, PH_N);
#ifdef PROBE_PHASE
    run(PROBE_PHASE, PROBE_PHASE + 1);
#endif
}
```

```cpp
#include <hip/hip_runtime.h>
#include <cstdint>
#include <cstdio>

typedef unsigned short bf16_t;
typedef float f32x4 __attribute__((ext_vector_type(4)));

constexpr int D = 1024, FF = 2816, MP = 16384, MS = 1024, M = MP + MS;
constexpr int SEQ = 2048, DECB = 128, DECS = 8, NBATCH = 8;
constexpr int SSM = 512, CONVD = 512, NG = 32, GC = 16, NST = 64, CWID = 31, NMEM = 256, NH = 4, HD = 256;
constexpr int MMEM = NBATCH * NMEM;
constexpr float EPS = 1e-6f;
constexpr float QSCALE = 0.0625f * 1.4426950408889634f;

constexpr size_t O_Y = 0;
constexpr size_t O_SRP = (size_t)M * D;
constexpr size_t O_SIP = O_SRP + 16384;
constexpr size_t O_CVP = O_SIP + 16384;
constexpr size_t O_MKP = O_CVP + 122880;
constexpr size_t O_MVP = O_MKP + 2097152;
constexpr size_t O_SRS = O_MVP + 2097152;
constexpr size_t O_SIS = O_SRS + 262144;
constexpr size_t O_CVS = O_SIS + 262144;
constexpr size_t O_END = O_CVS + 1966080;

constexpr size_t MiB = 1u << 20;
constexpr size_t WS_CTL = 0;
constexpr size_t WS_WGU1 = 2 * MiB, WS_WGU2 = 13 * MiB, WS_WD1 = 24 * MiB, WS_WD2 = 30 * MiB, WS_WIN = 36 * MiB, WS_WGLU = 39 * MiB,
                 WS_WOUT = 40 * MiB, WS_WQ = 42 * MiB, WS_WO = 44 * MiB, WS_WKV = 46 * MiB;
constexpr size_t WS_TAB = 50 * MiB;
constexpr size_t WS_XB = 72 * MiB, WS_MEMB = 106 * MiB, WS_KB = 110 * MiB, WS_VB2 = 114 * MiB;
constexpr size_t WS_SS0 = 118 * MiB, WS_SS1 = 120 * MiB, WS_SS2 = 122 * MiB, WS_SS3 = 124 * MiB, WS_SS4 = 126 * MiB, WS_SSM = 127 * MiB + 512 * 1024;
constexpr size_t WS_XRES = 128 * MiB, WS_H = 196 * MiB, WS_UG = 290 * MiB, WS_VB = 307 * MiB, WS_GB = 324 * MiB, WS_MIXB = 342 * MiB,
                 WS_QB = 376 * MiB, WS_OB = 410 * MiB, WS_END = 444 * MiB;

__device__ __forceinline__ unsigned f2bf(float f) { unsigned u = __builtin_bit_cast(unsigned, f); return (u + 0x7fffu + ((u >> 16) & 1u)) >> 16; }
__device__ __forceinline__ float bf2f(bf16_t b) { return __builtin_bit_cast(float, (unsigned)b << 16); }
__device__ __forceinline__ float sigmoidf_(float x) { return 1.f / (1.f + __expf(-x)); }
__device__ __forceinline__ float siluf_(float x) { return x * sigmoidf_(x); }
__device__ __forceinline__ float gelu_tanh(float x) { const float u = 0.7978845608028654f * (x + 0.044715f * x * x * x); return 0.5f * x * (1.f + tanhf(u)); }
__device__ __forceinline__ float wave_sum(float v) {
#pragma unroll
    for (int o = 1; o < 64; o <<= 1) v += __shfl_xor(v, o);
    return v;
}
__device__ __forceinline__ float rstd_from_ss(const float* ss, int row) {
    float s = 0.f;
#pragma unroll
    for (int i = 0; i < 16; ++i) s += ss[(size_t)row * 16 + i];
    return rsqrtf(s * (1.f / D) + EPS);
}

template <int MAP>
__global__ void k_wt(const float* W0, const float* W1, const float* gain, bf16_t* WT, int K, int N, int ldw) {
    __shared__ float tile[32][33];
    const int n0 = blockIdx.x * 32, k0 = blockIdx.y * 32, tx = threadIdx.x & 31, ty = threadIdx.x >> 5;
    const float* W = W0; int c0 = n0;
    if (MAP == 1) { const int pn = n0 / 256, half = (n0 % 256) / 128, jj = n0 % 128; W = half ? W1 : W0; c0 = pn * 128 + jj; }
    if (MAP == 2) { if (n0 >= 512) { const int m = n0 - 512, pc = m / 256, half = (m % 256) / 128, jj = m % 128; c0 = 512 + half * 512 + pc * 128 + jj; } }
    if (MAP == 3) { if (n0 >= 1024) { W = W1; c0 = n0 - 1024; } }
    for (int i = ty; i < 32; i += 8) { const int k = k0 + i; tile[i][tx] = W[(size_t)k * ldw + c0 + tx] * (gain ? gain[k] : 1.f); }
    __syncthreads();
    for (int i = ty; i < 32; i += 8) WT[(size_t)(n0 + i) * K + k0 + tx] = (bf16_t)f2bf(tile[tx][i]);
}
__global__ void k_rows_bf16_ss(const float* x0, int rows0, const float* x1, int rows1, bf16_t* xb, float* ss) {
    const int row = blockIdx.x * 4 + (threadIdx.x >> 6), lane = threadIdx.x & 63;
    if (row >= rows0 + rows1) return;
    const float* xr = row < rows0 ? x0 + (size_t)row * D : x1 + (size_t)(row - rows0) * D;
    float s = 0.f;
    for (int j = 0; j < 4; ++j) { const f32x4 v = *(const f32x4*)(xr + j * 256 + lane * 4); s += v.x * v.x + v.y * v.y + v.z * v.z + v.w * v.w;
        uint2 o; o.x = f2bf(v.x) | (f2bf(v.y) << 16); o.y = f2bf(v.z) | (f2bf(v.w) << 16); *(uint2*)(xb + (size_t)row * D + j * 256 + lane * 4) = o; }
    s = wave_sum(s);
    if (lane < 16) ss[(size_t)row * 16 + lane] = lane == 0 ? s : 0.f;
}
__global__ void k_rows_ss(const float* x, int rows, float* ss) {
    const int row = blockIdx.x * 4 + (threadIdx.x >> 6), lane = threadIdx.x & 63;
    if (row >= rows) return;
    float s = 0.f;
    for (int j = 0; j < 4; ++j) { const f32x4 v = *(const f32x4*)(x + (size_t)row * D + j * 256 + lane * 4); s += v.x * v.x + v.y * v.y + v.z * v.z + v.w * v.w; }
    s = wave_sum(s);
    if (lane < 16) ss[(size_t)row * 16 + lane] = lane == 0 ? s : 0.f;
}

enum { E_KV = 1, E_SWIGLU = 2, E_RES = 3, E_U = 4, E_V = 5, E_GLU = 6, E_Q = 7 };
struct EpiP {
    const float* ss;
    const float* resin;
    float* resout;
    bf16_t* ob;
    bf16_t* ob2;
    const bf16_t* gb;
    float* out;
    float alpha;
    int pad;
};
template <int MODE>
__device__ __forceinline__ void epi_elem(const EpiP& P, int row, int c, float a0, float a1, float rstd) {
    if (MODE == E_KV) {
        const float v = a0 * rstd;
        if (c < 1024) { P.out[O_MKP + (size_t)row * 1024 + c] = v; P.ob[(size_t)row * 1024 + c] = (bf16_t)f2bf(v); }
        else { P.out[O_MVP + (size_t)row * 1024 + c - 1024] = v; P.ob2[(size_t)row * 1024 + c - 1024] = (bf16_t)f2bf(v); }
    } else if (MODE == E_SWIGLU) {
        const float g = a0 * rstd, u = a1 * rstd; P.ob[(size_t)row * FF + c] = (bf16_t)f2bf(siluf_(g) * u);
    } else if (MODE == E_RES) {
        const float v = P.resin[(size_t)row * D + c] + P.alpha * a0; P.resout[(size_t)row * D + c] = v; if (P.ob) P.ob[(size_t)row * D + c] = (bf16_t)f2bf(v);
    } else if (MODE == E_U) {
        P.ob[((size_t)(c >> 4) * M + row) * 16 + (c & 15)] = (bf16_t)f2bf(a0 * rstd);
    } else if (MODE == E_V) {
        const float v = (a0 * rstd) * sigmoidf_(a1 * rstd); P.ob[(size_t)row * CONVD + c] = (bf16_t)f2bf(v);
        if (row < MP) { const int b = row / SEQ, t = row % SEQ; if (t >= SEQ - 30) P.out[O_CVP + ((size_t)b * 30 + (t - (SEQ - 30))) * CONVD + c] = v; }
        else { const int rs = row - MP, b = rs / DECS, t = rs % DECS; P.out[O_CVS + ((size_t)b * 30 + 22 + t) * CONVD + c] = v; }
    } else if (MODE == E_GLU) {
        const float g = bf2f(P.gb[(size_t)row * SSM + c]); P.ob[(size_t)row * D + c] = (bf16_t)f2bf(g * sigmoidf_(a0));
    } else if (MODE == E_Q) {
        P.ob[(size_t)row * D + c] = (bf16_t)f2bf(a0 * rstd * QSCALE);
    }
}
template <int MODE> struct ModeTraits { static constexpr bool PAIRED = (MODE == E_SWIGLU || MODE == E_V); static constexpr bool RSTD = (MODE == E_KV || MODE == E_SWIGLU || MODE == E_U || MODE == E_V || MODE == E_Q); };

template <int MODE>
__global__ void __launch_bounds__(256) k_ref_gemm(const bf16_t* A, const bf16_t* BT, int K, EpiP P) {
    constexpr bool PAIRED = ModeTraits<MODE>::PAIRED;
    __shared__ float As[32][65], B0[32][65], B1[PAIRED ? 32 : 1][65];
    const int tid = threadIdx.x, tx = tid & 15, ty = tid >> 4;
    const int m0 = blockIdx.y * 64, p0 = blockIdx.x * 64;
    const int cb0 = PAIRED ? (p0 / 128) * 256 + (p0 % 128) : p0;
    float acc0[4][4], acc1[4][4];
    for (int i = 0; i < 4; ++i) for (int j = 0; j < 4; ++j) { acc0[i][j] = 0.f; acc1[i][j] = 0.f; }
    for (int k0 = 0; k0 < K; k0 += 32) {
        for (int e = tid; e < 64 * 32; e += 256) { const int r = e >> 5, k = e & 31;
            As[k][r] = bf2f(A[(size_t)(m0 + r) * K + k0 + k]); B0[k][r] = bf2f(BT[(size_t)(cb0 + r) * K + k0 + k]);
            if (PAIRED) B1[k][r] = bf2f(BT[(size_t)(cb0 + 128 + r) * K + k0 + k]); }
        __syncthreads();
        for (int k = 0; k < 32; ++k) {
            float a[4], b0[4], b1[4];
            for (int i = 0; i < 4; ++i) a[i] = As[k][ty * 4 + i];
            for (int j = 0; j < 4; ++j) { b0[j] = B0[k][tx * 4 + j]; b1[j] = PAIRED ? B1[k][tx * 4 + j] : 0.f; }
            for (int i = 0; i < 4; ++i) for (int j = 0; j < 4; ++j) { acc0[i][j] += a[i] * b0[j]; if (PAIRED) acc1[i][j] += a[i] * b1[j]; }
        }
        __syncthreads();
    }
    for (int i = 0; i < 4; ++i) { const int row = m0 + ty * 4 + i; const float rstd = ModeTraits<MODE>::RSTD ? rstd_from_ss(P.ss, row) : 1.f;
        for (int j = 0; j < 4; ++j) epi_elem<MODE>(P, row, p0 + tx * 4 + j, acc0[i][j], acc1[i][j], rstd); }
}

__global__ void __launch_bounds__(64) k_ref_s5(const bf16_t* ug, const float* h0re, const float* h0im, const float* a_re, const float* a_im, const float* log_dt,
                                               const float* b_re, const float* b_im, const float* c_re, const float* c_im, const float* dskip, bf16_t* gb, float* out) {
    const int g = blockIdx.x % NG, sq = blockIdx.x / NG, n = threadIdx.x;
    const bool prompt = sq < NBATCH; const int b = prompt ? sq : sq - NBATCH, T = prompt ? SEQ : DECS, row0 = prompt ? b * SEQ : MP + b * DECS;
    const float dt = expf(log_dt[g]), lr = a_re[g * NST + n], li = a_im[g * NST + n];
    const float mag = expf(lr * dt), abr = mag * cosf(li * dt), abi = mag * sinf(li * dt);
    const float den = lr * lr + li * li, nr = abr - 1.f, ni = abi, cr = (nr * lr + ni * li) / den, ci = (ni * lr - nr * li) / den;
    float Br[16], Bi[16], Cr[16], Ci[16];
    for (int c = 0; c < 16; ++c) { const float br = b_re[((size_t)g * NST + n) * 16 + c], bi = b_im[((size_t)g * NST + n) * 16 + c];
        Br[c] = cr * br - ci * bi; Bi[c] = cr * bi + ci * br; Cr[c] = c_re[((size_t)g * 16 + c) * NST + n]; Ci[c] = c_im[((size_t)g * 16 + c) * NST + n]; }
    float hr = 0.f, hi = 0.f;
    if (!prompt) { hr = h0re[((size_t)b * NG + g) * NST + n]; hi = h0im[((size_t)b * NG + g) * NST + n]; }
    const float dsk = dskip[g * 16 + (n & 15)];
    for (int t = 0; t < T; ++t) {
        const bf16_t* up = ug + ((size_t)g * M + row0 + t) * 16;
        float u[16], xr = 0.f, xi = 0.f;
#pragma unroll
        for (int c = 0; c < 16; ++c) { u[c] = bf2f(up[c]); xr += Br[c] * u[c]; xi += Bi[c] * u[c]; }
        const float nhr = abr * hr - abi * hi + xr, nhi = abr * hi + abi * hr + xi; hr = nhr; hi = nhi;
        float ymine = 0.f;
#pragma unroll
        for (int c = 0; c < 16; ++c) { const float y = wave_sum(Cr[c] * hr - Ci[c] * hi); if ((n & 15) == c) ymine = y + dsk * u[c]; }
        if (n < 16) gb[(size_t)(row0 + t) * SSM + g * 16 + n] = (bf16_t)f2bf(gelu_tanh(ymine));
    }
    if (prompt) { out[O_SRP + ((size_t)b * NG + g) * NST + n] = hr; out[O_SIP + ((size_t)b * NG + g) * NST + n] = hi; }
    else { out[O_SRS + ((size_t)b * NG + g) * NST + n] = hr; out[O_SIS + ((size_t)b * NG + g) * NST + n] = hi; }
}

__global__ void __launch_bounds__(512) k_ref_conv(const bf16_t* vb, const float* cache, const float* w, const float* bias, const float* lg, const float* lb, bf16_t* mixb, float* out) {
    __shared__ float red[2][8];
    const int row = blockIdx.x, c = threadIdx.x;
    float y = bias[c];
    if (row < MP) { const int t = row % SEQ;
        for (int k = 0; k < CWID; ++k) { const int tt = t - 30 + k; if (tt >= 0) y += w[k * CONVD + c] * bf2f(vb[(size_t)(row - 30 + k) * CONVD + c]); }
    } else { const int rs = row - MP, b = rs / DECS, t = rs % DECS;
        for (int k = 0; k < CWID; ++k) { const int idx = t + k; const float xv = idx < 30 ? cache[((size_t)b * 30 + idx) * CONVD + c] : bf2f(vb[(size_t)(MP + b * DECS + idx - 30) * CONVD + c]); y += w[k * CONVD + c] * xv; }
        if (t == 0) for (int j = 0; j < 22; ++j) out[O_CVS + ((size_t)b * 30 + j) * CONVD + c] = cache[((size_t)b * 30 + j + 8) * CONVD + c];
    }
    float s = wave_sum(y); if ((c & 63) == 0) red[0][c >> 6] = s; __syncthreads();
    float mu = 0.f; for (int i = 0; i < 8; ++i) mu += red[0][i]; mu *= (1.f / CONVD);
    const float d = y - mu; float q = wave_sum(d * d); if ((c & 63) == 0) red[1][c >> 6] = q; __syncthreads();
    float var = 0.f; for (int i = 0; i < 8; ++i) var += red[1][i]; var *= (1.f / CONVD);
    const float z = d * rsqrtf(var + EPS) * lg[c] + lb[c];
    mixb[(size_t)row * D + SSM + c] = (bf16_t)f2bf(siluf_(z));
}

__global__ void __launch_bounds__(256) k_ref_attn(const bf16_t* qb, const bf16_t* kb, const bf16_t* vb2, const float* ck, const float* cv, bf16_t* ob) {
    __shared__ float q[256], p[256], red[4];
    const int row = blockIdx.x >> 2, h = blockIdx.x & 3, tid = threadIdx.x;
    q[tid] = bf2f(qb[(size_t)row * D + h * HD + tid]);
    __syncthreads();
    float s = 0.f;
    if (row < MP) { const int b = row / SEQ; const bf16_t* kr = kb + ((size_t)b * NMEM + tid) * D + h * HD; for (int d = 0; d < HD; ++d) s += q[d] * bf2f(kr[d]); }
    else { const int b = (row - MP) / DECS; const float* kr = ck + ((size_t)b * NMEM + tid) * D + h * HD; for (int d = 0; d < HD; ++d) s += q[d] * kr[d]; }
    float mx = s; for (int o = 1; o < 64; o <<= 1) mx = fmaxf(mx, __shfl_xor(mx, o));
    if ((tid & 63) == 0) red[tid >> 6] = mx; __syncthreads();
    mx = fmaxf(fmaxf(red[0], red[1]), fmaxf(red[2], red[3])); __syncthreads();
    const float e = exp2f(s - mx); float sm = wave_sum(e);
    if ((tid & 63) == 0) red[tid >> 6] = sm; __syncthreads();
    sm = red[0] + red[1] + red[2] + red[3];
    p[tid] = e / sm; __syncthreads();
    float o = 0.f;
    if (row < MP) { const int b = row / SEQ; const bf16_t* vr = vb2 + (size_t)b * NMEM * D + h * HD + tid; for (int m = 0; m < NMEM; ++m) o += p[m] * bf2f(vr[(size_t)m * D]); }
    else { const int b = (row - MP) / DECS; const float* vr = cv + (size_t)b * NMEM * D + h * HD + tid; for (int m = 0; m < NMEM; ++m) o += p[m] * vr[(size_t)m * D]; }
    ob[(size_t)row * D + h * HD + tid] = (bf16_t)f2bf(o);
}

__global__ void k_final(float* y, const float* ss, const float* g) {
    const int row = blockIdx.x * 4 + (threadIdx.x >> 6), lane = threadIdx.x & 63;
    const float r = rstd_from_ss(ss, row);
    for (int j = 0; j < 4; ++j) { f32x4* p = (f32x4*)(y + (size_t)row * D + j * 256 + lane * 4); const f32x4 gg = *(const f32x4*)(g + j * 256 + lane * 4); f32x4 v = *p; v = v * r * gg; *p = v; }
}


namespace pg8 {
#define PG8_LAS __attribute__((address_space(3)))
typedef unsigned short bf16_t;
typedef short bf16x8 __attribute__((ext_vector_type(8)));
typedef float f32x4 __attribute__((ext_vector_type(4)));
typedef unsigned u32x4 __attribute__((ext_vector_type(4)));
constexpr int BM = 256, BK = 64, HALF = 128, HTB = HALF * BK * 2  , STAGE_BYTES = 8 * HTB, NXCD = 8, WGM = 8;

__host__ __device__ __forceinline__ int lds_byte(int r, int c) { const int st = (r >> 4) * 2 + (c >> 5), rr = r & 15, cc = c & 31, ob = rr * 64 + cc * 2; return st * 1024 + (ob ^ (((ob >> 9) & 1) << 5)); }
__host__ __device__ __forceinline__ void stage_rc(int b, int& R, int& C) { const int st = b / 1024, sb = b % 1024, swz = sb ^ (((sb >> 9) & 1) << 5); R = (st >> 1) * 16 + swz / 64; C = (st & 1) * 32 + (swz % 64) / 2; }
__host__ __device__ __forceinline__ int perm32(int rho) { const int n = rho >> 4, i = rho & 15; return 8 * (i >> 2) + 4 * n + (i & 3); }

struct Unit { int pm, pn; };
struct Gemm { const bf16_t* A; const bf16_t* Bt; int M, N, K; };

struct StaticOrder {
    int nM, nN, nwg, G, c;
    __host__ __device__ void init(int M, int N, int G_, int c_) { nM = M / BM; nN = N / BM; nwg = nM * nN; G = G_; c = c_; }
    __host__ __device__ bool next(int i, Unit& u) const {
        const long L = (long)i * G + c; if (L >= nwg) return false;
        int wgid = (int)L; { const int q = nwg / NXCD, r = nwg % NXCD, xcd = wgid % NXCD, off = wgid / NXCD; wgid = (xcd < r ? xcd * (q + 1) : r * (q + 1) + (xcd - r) * q) + off; }
        const int nig = WGM * nN, gid = wgid / nig, fm = gid * WGM, gsz = (nM - fm) < WGM ? (nM - fm) : WGM;
        u.pm = fm + ((wgid % nig) % gsz); u.pn = (wgid % nig) / gsz; return true;
    }
    __device__ __forceinline__ void a_ready(const Unit&) const {}
    __device__ __forceinline__ void done(const Unit&) const {}
};
__device__ __forceinline__ unsigned cvt_pk_bf16(float lo, float hi) { unsigned r; asm volatile("v_cvt_pk_bf16_f32 %0, %1, %2" : "=v"(r) : "v"(lo), "v"(hi)); return r; }
typedef float f32x2 __attribute__((ext_vector_type(2)));
template <class Epi, class Sched, bool ALIGN_EPI = false, bool SP2 = false>
__device__ __forceinline__ void gemm_phase(PG8_LAS unsigned char* lds, const Gemm g, const Sched& S, const Epi& E) {
    const int tid = threadIdx.x, wid = __builtin_amdgcn_readfirstlane(tid >> 6), lane = tid & 63, wr = wid >> 2, wc = wid & 3, fr = lane & 15, fq = lane >> 4;
    const int K = g.K, nt = K / BK;
    unsigned voffA[2], voffB[2];
#pragma unroll
    for (int i = 0; i < 2; ++i) { int R, C; stage_rc(tid * 16 + i * 8192, R, C); const int Rb = Epi::PERM ? ((R & ~31) + perm32(R & 31)) : R;
        voffA[i] = (unsigned)(R * K + C) * 2u; voffB[i] = (unsigned)(Rb * K + C) * 2u; }
    const size_t kstep = (size_t)(BK * 2);
    const size_t hstep = (size_t)HALF * K * 2;
    const size_t tstep = 2 * hstep;
    const unsigned ldsw = (unsigned)wid * 1024u;
    const int aoff = lds_byte(wr * 64 + fr, fq * 8), boff = lds_byte(wc * 32 + fr, fq * 8);
#define PG8_SA(b, h) (((b) * 2 + (h)) * HTB)
#define PG8_SB(b, h) ((4 + (b) * 2 + (h)) * HTB)
#define PG8_STAGE(bufoff, gbase, voff) do { _Pragma("unroll") for (int _i = 0; _i < 2; ++_i) \
        __builtin_amdgcn_global_load_lds((const unsigned*)((const char*)(gbase) + (voff)[_i]), (PG8_LAS unsigned*)(lds + (bufoff) + ldsw + _i * 8192), 16, 0, 0); } while (0)
#define PG8_LDA(dst, b, h) do { _Pragma("unroll") for (int m = 0; m < 4; ++m) _Pragma("unroll") for (int k = 0; k < 2; ++k) dst[m][k] = *(const PG8_LAS bf16x8*)(lds + PG8_SA(b, h) + aoff + m * 2048 + k * 1024); } while (0)
#define PG8_LDB(dst, b, h) do { _Pragma("unroll") for (int n = 0; n < 2; ++n) _Pragma("unroll") for (int k = 0; k < 2; ++k) dst[n][k] = *(const PG8_LAS bf16x8*)(lds + PG8_SB(b, h) + boff + n * 2048 + k * 1024); } while (0)
#define PG8_MMA(ai, bj, At, Bt) do { __builtin_amdgcn_s_setprio(1); _Pragma("unroll") for (int m = 0; m < 4; ++m) _Pragma("unroll") for (int n = 0; n < 2; ++n) _Pragma("unroll") for (int k = 0; k < 2; ++k) \
        acc[ai][bj][m][n] = __builtin_amdgcn_mfma_f32_16x16x32_bf16(Bt[n][k], At[m][k], acc[ai][bj][m][n], 0, 0, 0); __builtin_amdgcn_s_setprio(0); } while (0)
#define PG8_WAIT_V(n) asm volatile("s_waitcnt vmcnt(" #n ")" ::: "memory")
#define PG8_WAIT_L(n) asm volatile("s_waitcnt lgkmcnt(" #n ")" ::: "memory")
#define PG8_BAR __builtin_amdgcn_s_barrier()
#define PG8_SCHED __builtin_amdgcn_sched_barrier(0)
    Unit cur, nxt; int ui = 0;
    if (!S.next(0, cur)) return;
    f32x4 acc[2][2][4][2];
#pragma unroll
    for (int a = 0; a < 2; ++a)
#pragma unroll
        for (int b = 0; b < 2; ++b)
#pragma unroll
            for (int m = 0; m < 4; ++m)
#pragma unroll
                for (int n = 0; n < 2; ++n) acc[a][b][m][n] = (f32x4){0.f, 0.f, 0.f, 0.f};
    bf16x8 At[4][2], B0[2][2], B1[2][2];
    const char* cA = (const char*)g.A + (size_t)cur.pm * tstep; const char* cB = (const char*)g.Bt + (size_t)cur.pn * tstep;
    S.a_ready(cur);
    if constexpr (SP2) {
        PG8_STAGE(PG8_SB(0, 0), cB, voffB); PG8_STAGE(PG8_SB(0, 1), cB + hstep, voffB); PG8_STAGE(PG8_SA(0, 0), cA, voffA); PG8_STAGE(PG8_SA(0, 1), cA + hstep, voffA);
        if (wr == 1) PG8_BAR;
        PG8_WAIT_V(2); PG8_BAR;
        PG8_STAGE(PG8_SB(1, 0), cB + kstep, voffB); PG8_STAGE(PG8_SA(1, 0), cA + kstep, voffA); PG8_STAGE(PG8_SB(1, 1), cB + hstep + kstep, voffB);
        PG8_WAIT_V(6); PG8_BAR;
    } else {
        PG8_STAGE(PG8_SB(0, 0), cB, voffB); PG8_STAGE(PG8_SA(0, 0), cA, voffA); PG8_STAGE(PG8_SB(0, 1), cB + hstep, voffB); PG8_STAGE(PG8_SA(0, 1), cA + hstep, voffA);
        if (wr == 1) PG8_BAR;
        PG8_WAIT_V(4); PG8_BAR;
        PG8_STAGE(PG8_SB(1, 0), cB + kstep, voffB); PG8_STAGE(PG8_SA(1, 0), cA + kstep, voffA); PG8_STAGE(PG8_SB(1, 1), cB + hstep + kstep, voffB);
        PG8_WAIT_V(6); PG8_BAR;
    }
    for (;;) {
        const bool has_next = S.next(ui + 1, nxt);
        const char* nA = has_next ? (const char*)g.A + (size_t)nxt.pm * tstep : cA; const char* nB = has_next ? (const char*)g.Bt + (size_t)nxt.pn * tstep : cB;
        for (int t = 0; t < nt; t += 2) {
            const bool last = (t == nt - 2);
            const char* a1 = cA + (size_t)(t + 1) * kstep;
            const char* a2 = last ? nA : cA + (size_t)(t + 2) * kstep; const char* b2 = last ? nB : cB + (size_t)(t + 2) * kstep;
            const char* a3 = a2 + kstep; const char* b3 = b2 + kstep;
            if (last && has_next) S.a_ready(nxt);
            if constexpr (SP2) {
            PG8_LDB(B0, 0, 0); PG8_LDB(B1, 0, 1); PG8_SCHED; PG8_LDA(At, 0, 0); PG8_STAGE(PG8_SA(1, 1), a1 + hstep, voffA);
            PG8_WAIT_V(8); PG8_WAIT_L(0); PG8_BAR; PG8_MMA(0, 0, At, B0); PG8_MMA(0, 1, At, B1); PG8_BAR; PG8_SCHED;
            PG8_LDA(At, 0, 1); PG8_STAGE(PG8_SB(0, 0), b2, voffB); PG8_STAGE(PG8_SB(0, 1), b2 + hstep, voffB); PG8_STAGE(PG8_SA(0, 0), a2, voffA);
            PG8_WAIT_V(8); PG8_WAIT_L(0); PG8_BAR; PG8_MMA(1, 0, At, B0); PG8_MMA(1, 1, At, B1); PG8_BAR; PG8_SCHED;
            PG8_LDB(B0, 1, 0); PG8_LDB(B1, 1, 1); PG8_SCHED; PG8_LDA(At, 1, 0); PG8_STAGE(PG8_SA(0, 1), a2 + hstep, voffA);
            PG8_WAIT_V(8); PG8_WAIT_L(0); PG8_BAR; PG8_MMA(0, 0, At, B0); PG8_MMA(0, 1, At, B1); PG8_BAR; PG8_SCHED;
            PG8_LDA(At, 1, 1); PG8_STAGE(PG8_SB(1, 0), b3, voffB); PG8_STAGE(PG8_SB(1, 1), b3 + hstep, voffB); PG8_STAGE(PG8_SA(1, 0), a3, voffA);
            PG8_WAIT_V(8); PG8_WAIT_L(0); PG8_BAR; PG8_MMA(1, 0, At, B0); PG8_MMA(1, 1, At, B1); PG8_BAR; PG8_SCHED;
            } else {
            PG8_LDB(B0, 0, 0); PG8_SCHED; PG8_LDA(At, 0, 0); PG8_STAGE(PG8_SA(1, 1), a1 + hstep, voffA);
            PG8_WAIT_L(8); PG8_BAR; PG8_WAIT_L(0); PG8_MMA(0, 0, At, B0); PG8_BAR; PG8_SCHED;
            PG8_LDB(B1, 0, 1); PG8_STAGE(PG8_SB(0, 0), b2, voffB);
            PG8_BAR; PG8_WAIT_L(0); PG8_MMA(0, 1, At, B1); PG8_BAR;
            PG8_LDA(At, 0, 1); PG8_STAGE(PG8_SA(0, 0), a2, voffA);
            PG8_BAR; PG8_WAIT_L(0); PG8_MMA(1, 0, At, B0); PG8_BAR; PG8_SCHED;
            PG8_STAGE(PG8_SB(0, 1), b2 + hstep, voffB);
            PG8_WAIT_V(6); PG8_BAR; PG8_MMA(1, 1, At, B1); PG8_BAR;
            PG8_LDB(B0, 1, 0); PG8_SCHED; PG8_LDA(At, 1, 0); PG8_STAGE(PG8_SA(0, 1), a2 + hstep, voffA);
            PG8_WAIT_L(8); PG8_BAR; PG8_WAIT_L(0); PG8_MMA(0, 0, At, B0); PG8_BAR; PG8_SCHED;
            PG8_LDB(B1, 1, 1); PG8_STAGE(PG8_SB(1, 0), b3, voffB);
            PG8_BAR; PG8_WAIT_L(0); PG8_MMA(0, 1, At, B1); PG8_BAR;
            PG8_LDA(At, 1, 1); PG8_STAGE(PG8_SA(1, 0), a3, voffA);
            PG8_BAR; PG8_WAIT_L(0); PG8_MMA(1, 0, At, B0); PG8_BAR; PG8_SCHED;
            PG8_STAGE(PG8_SB(1, 1), b3 + hstep, voffB);
            PG8_WAIT_V(6); PG8_BAR; PG8_MMA(1, 1, At, B1); PG8_BAR;
            }
        }
        if constexpr (ALIGN_EPI) { if (wr == 0) PG8_BAR; }
        if constexpr (!Epi::AFTER_DRAIN) { E(acc, cur, wr, wc, fr, fq); S.done(cur); }
        if (!has_next) break;
#pragma unroll
        for (int a = 0; a < 2; ++a)
#pragma unroll
            for (int b = 0; b < 2; ++b)
#pragma unroll
                for (int m = 0; m < 4; ++m)
#pragma unroll
                    for (int n = 0; n < 2; ++n) acc[a][b][m][n] = (f32x4){0.f, 0.f, 0.f, 0.f};
        cur = nxt; cA = nA; cB = nB; ++ui;
        if constexpr (ALIGN_EPI) { if (wr == 1) PG8_BAR; }
    }
    PG8_WAIT_V(0);
    if constexpr (!ALIGN_EPI) { if (wr == 0) PG8_BAR; }
    PG8_BAR;
    if constexpr (Epi::AFTER_DRAIN) { E.fused(acc, cur, wr, wc, fr, fq, lds, wid, lane); S.done(cur); }
#undef PG8_SA
#undef PG8_SB
#undef PG8_STAGE
#undef PG8_LDA
#undef PG8_LDB
#undef PG8_MMA
#undef PG8_WAIT_V
#undef PG8_WAIT_L
#undef PG8_BAR
#undef PG8_SCHED
}
}

namespace fx {
using pg8::f32x4; using pg8::u32x4; using pg8::Unit; using pg8::HALF; using pg8::BM; using pg8::cvt_pk_bf16;
__device__ __forceinline__ float rstd_row(const float* ss, int row) {
    const f32x4* p = (const f32x4*)(ss + (size_t)row * 16); const f32x4 a = p[0], b = p[1], c = p[2], d = p[3];
    const float s = ((a.x + a.y) + (a.z + a.w)) + ((b.x + b.y) + (b.z + b.w)) + ((c.x + c.y) + (c.z + c.w)) + ((d.x + d.y) + (d.z + d.w));
    return rsqrtf(s * (1.f / D) + EPS);
}
__device__ __forceinline__ float fsig(float x) { return __builtin_amdgcn_rcpf(1.f + __builtin_amdgcn_exp2f(-1.4426950408889634f * x)); }
__device__ __forceinline__ u32x4 pack8(const f32x4 a, const f32x4 b) { u32x4 w; w.x = cvt_pk_bf16(a[0], a[1]); w.y = cvt_pk_bf16(a[2], a[3]); w.z = cvt_pk_bf16(b[0], b[1]); w.w = cvt_pk_bf16(b[2], b[3]); return w; }
__device__ __forceinline__ f32x4 sig4(const f32x4 x) { return (f32x4){fsig(x[0]), fsig(x[1]), fsig(x[2]), fsig(x[3])}; }

struct EpiKV { static constexpr bool PERM = true, AFTER_DRAIN = false; const float* ss; bf16_t* kb; bf16_t* vb2; float* out;
    __device__ __forceinline__ void operator()(const f32x4 (&acc)[2][2][4][2], const Unit& u, int wr, int wc, int fr, int fq) const {
        const int row0 = u.pm * BM + wr * 64 + fr; const bool isv = u.pn >= 4; const int colt = (isv ? u.pn - 4 : u.pn) * BM + wc * 32 + 8 * fq;
        float* of = out + (isv ? O_MVP : O_MKP); bf16_t* ob = isv ? vb2 : kb;
#pragma unroll
        for (int ai = 0; ai < 2; ++ai)
#pragma unroll
            for (int m = 0; m < 4; ++m) { const int row = row0 + ai * HALF + m * 16; const float r = rstd_row(ss, row);
#pragma unroll
                for (int bj = 0; bj < 2; ++bj) { const f32x4 v0 = acc[ai][bj][m][0] * r, v1 = acc[ai][bj][m][1] * r; const size_t o = (size_t)row * D + colt + bj * HALF;
                    *(f32x4*)(of + o) = v0; *(f32x4*)(of + o + 4) = v1; *(u32x4*)(ob + o) = pack8(v0, v1); } }
    }
};

struct EpiK { static constexpr bool PERM = true, AFTER_DRAIN = false; const float* rstdm; bf16_t* kb; float* out;
    __device__ __forceinline__ void operator()(const f32x4 (&acc)[2][2][4][2], const Unit& u, int wr, int wc, int fr, int fq) const {
        const int row0 = u.pm * BM + wr * 64 + fr, colt = u.pn * BM + wc * 32 + 8 * fq;
#pragma unroll
        for (int ai = 0; ai < 2; ++ai)
#pragma unroll
            for (int m = 0; m < 4; ++m) { const int row = row0 + ai * HALF + m * 16; const float r = rstdm[row];
#pragma unroll
                for (int bj = 0; bj < 2; ++bj) { const f32x4 v0 = acc[ai][bj][m][0] * r, v1 = acc[ai][bj][m][1] * r; const size_t o = (size_t)row * D + colt + bj * HALF;
                    *(f32x4*)(out + O_MKP + o) = v0; *(f32x4*)(out + O_MKP + o + 4) = v1; *(u32x4*)(kb + o) = pack8(v0, v1); } }
    }
};
struct EpiVT { static constexpr bool PERM = true, AFTER_DRAIN = false; const float* rstdm; bf16_t* vT; float* out;
    __device__ __forceinline__ void operator()(const f32x4 (&acc)[2][2][4][2], const Unit& u, int wr, int wc, int fr, int fq) const {
        const int row0 = u.pm * BM + wr * 64 + fr;
#pragma unroll
        for (int bj = 0; bj < 2; ++bj) { const int cl = bj * HALF + wc * 32 + 8 * fq, c0 = u.pn * BM + cl;
            const f32x4 r0 = *(const f32x4*)(rstdm + c0), r1 = *(const f32x4*)(rstdm + c0 + 4);
            const int pos0 = (cl & ~15) + 4 * ((cl >> 3) & 1);
#pragma unroll
            for (int ai = 0; ai < 2; ++ai)
#pragma unroll
                for (int m = 0; m < 4; ++m) { const int row = row0 + ai * HALF + m * 16; const f32x4 v0 = acc[ai][bj][m][0] * r0, v1 = acc[ai][bj][m][1] * r1;
                    bf16_t* vp = vT + (size_t)row * MMEM + u.pn * BM;
                    typedef unsigned u32x2 __attribute__((ext_vector_type(2)));
                    *(u32x2*)(vp + pos0) = (u32x2){cvt_pk_bf16(v0[0], v0[1]), cvt_pk_bf16(v0[2], v0[3])}; *(u32x2*)(vp + pos0 + 8) = (u32x2){cvt_pk_bf16(v1[0], v1[1]), cvt_pk_bf16(v1[2], v1[3])};
                    float* op = out + O_MVP + (size_t)c0 * D + row;
                    op[0] = v0[0]; op[D] = v0[1]; op[2 * D] = v0[2]; op[3 * D] = v0[3]; op[4 * D] = v1[0]; op[5 * D] = v1[1]; op[6 * D] = v1[2]; op[7 * D] = v1[3]; } }
    }
};
struct EpiSwiglu { static constexpr bool PERM = true, AFTER_DRAIN = false; const float* ss; bf16_t* H;
    __device__ __forceinline__ void operator()(const f32x4 (&acc)[2][2][4][2], const Unit& u, int wr, int wc, int fr, int fq) const {
        const int row0 = u.pm * BM + wr * 64 + fr, col0 = u.pn * HALF + wc * 32 + 8 * fq;
#pragma unroll
        for (int ai = 0; ai < 2; ++ai)
#pragma unroll
            for (int m = 0; m < 4; ++m) { const int row = row0 + ai * HALF + m * 16; const float r = rstd_row(ss, row);
                const f32x4 g0 = acc[ai][0][m][0] * r, g1 = acc[ai][0][m][1] * r, u0 = acc[ai][1][m][0] * r, u1 = acc[ai][1][m][1] * r;
                *(u32x4*)(H + (size_t)row * FF + col0) = pack8(g0 * sig4(g0) * u0, g1 * sig4(g1) * u1); }
    }
};
struct EpiRes { static constexpr bool PERM = true, AFTER_DRAIN = false; const float* rin0; const float* rin1; float* rout; bf16_t* xb; float* ss; float alpha;
    __device__ __forceinline__ void operator()(const f32x4 (&acc)[2][2][4][2], const Unit& u, int wr, int wc, int fr, int fq) const {
        const int row0 = u.pm * BM + wr * 64 + fr, col0 = u.pn * BM + wc * 32 + 8 * fq; const float* rin = u.pm >= MP / BM ? rin1 : rin0;
#pragma unroll
        for (int ai = 0; ai < 2; ++ai)
#pragma unroll
            for (int m = 0; m < 4; ++m) { const int row = row0 + ai * HALF + m * 16; float sq = 0.f;
#pragma unroll
                for (int bj = 0; bj < 2; ++bj) { const size_t o = (size_t)row * D + col0 + bj * HALF;
                    const f32x4 v0 = *(const f32x4*)(rin + o) + acc[ai][bj][m][0] * alpha, v1 = *(const f32x4*)(rin + o + 4) + acc[ai][bj][m][1] * alpha;
                    *(f32x4*)(rout + o) = v0; *(f32x4*)(rout + o + 4) = v1; if (xb) *(u32x4*)(xb + o) = pack8(v0, v1);
                    sq += (v0[0] * v0[0] + v0[1] * v0[1]) + (v0[2] * v0[2] + v0[3] * v0[3]) + (v1[0] * v1[0] + v1[1] * v1[1]) + (v1[2] * v1[2] + v1[3] * v1[3]); }
                sq += __shfl_xor(sq, 16); sq += __shfl_xor(sq, 32);
                if (fq == 0) ss[(size_t)row * 16 + u.pn * 4 + wc] = sq;
                if (m & 1) asm volatile("" ::: "memory"); }
    }
};
struct EpiIn { static constexpr bool PERM = true, AFTER_DRAIN = false; const float* ss; bf16_t* ug; bf16_t* vb; float* out;
    __device__ __forceinline__ void operator()(const f32x4 (&acc)[2][2][4][2], const Unit& u, int wr, int wc, int fr, int fq) const {
        const int row0 = u.pm * BM + wr * 64 + fr;
        if (u.pn < 2) {
#pragma unroll
            for (int ai = 0; ai < 2; ++ai)
#pragma unroll
                for (int m = 0; m < 4; ++m) { const int row = row0 + ai * HALF + m * 16; const float r = rstd_row(ss, row);
#pragma unroll
                    for (int bj = 0; bj < 2; ++bj) { const int c0 = u.pn * BM + bj * HALF + wc * 32 + 8 * fq;
                        *(u32x4*)(ug + ((size_t)(c0 >> 4) * M + row) * 16 + (c0 & 15)) = pack8(acc[ai][bj][m][0] * r, acc[ai][bj][m][1] * r); } }
        } else {
            const int p0 = (u.pn - 2) * HALF + wc * 32 + 8 * fq;
#pragma unroll
            for (int ai = 0; ai < 2; ++ai)
#pragma unroll
                for (int m = 0; m < 4; ++m) { const int row = row0 + ai * HALF + m * 16; const float r = rstd_row(ss, row);
                    const f32x4 a0 = acc[ai][0][m][0] * r, a1 = acc[ai][0][m][1] * r, g0 = acc[ai][1][m][0] * r, g1 = acc[ai][1][m][1] * r;
                    const f32x4 v0 = a0 * sig4(g0), v1 = a1 * sig4(g1);
                    *(u32x4*)(vb + (size_t)row * CONVD + p0) = pack8(v0, v1);
                    float* o = nullptr;
                    if (row >= MP) { const int rs = row - MP; o = out + O_CVS + ((size_t)(rs >> 3) * 30 + 22 + (rs & 7)) * CONVD + p0; }
                    else { const int t = row & (SEQ - 1); if (t >= SEQ - 30) o = out + O_CVP + ((size_t)(row >> 11) * 30 + (t - (SEQ - 30))) * CONVD + p0; }
                    if (o) { *(f32x4*)o = v0; *(f32x4*)(o + 4) = v1; } }
        }
    }
};
struct EpiGlu { static constexpr bool PERM = true, AFTER_DRAIN = false; const bf16_t* gb; bf16_t* mixb;
    __device__ __forceinline__ void operator()(const f32x4 (&acc)[2][2][4][2], const Unit& u, int wr, int wc, int fr, int fq) const {
        const int row0 = u.pm * BM + wr * 64 + fr, col0 = u.pn * BM + wc * 32 + 8 * fq;
#pragma unroll
        for (int ai = 0; ai < 2; ++ai)
#pragma unroll
            for (int m = 0; m < 4; ++m) { const int row = row0 + ai * HALF + m * 16;
#pragma unroll
                for (int bj = 0; bj < 2; ++bj) { const int c0 = col0 + bj * HALF; const u32x4 gw = *(const u32x4*)(gb + (size_t)row * SSM + c0);
                    const f32x4 ga = {__builtin_bit_cast(float, gw.x << 16), __builtin_bit_cast(float, gw.x & 0xffff0000u), __builtin_bit_cast(float, gw.y << 16), __builtin_bit_cast(float, gw.y & 0xffff0000u)};
                    const f32x4 gc = {__builtin_bit_cast(float, gw.z << 16), __builtin_bit_cast(float, gw.z & 0xffff0000u), __builtin_bit_cast(float, gw.w << 16), __builtin_bit_cast(float, gw.w & 0xffff0000u)};
                    *(u32x4*)(mixb + (size_t)row * D + c0) = pack8(ga * sig4(acc[ai][bj][m][0]), gc * sig4(acc[ai][bj][m][1])); } }
    }
};
struct EpiQ { static constexpr bool PERM = true, AFTER_DRAIN = false; const float* ss; bf16_t* qb;
    __device__ __forceinline__ void operator()(const f32x4 (&acc)[2][2][4][2], const Unit& u, int wr, int wc, int fr, int fq) const {
        const int row0 = u.pm * BM + wr * 64 + fr, col0 = u.pn * BM + wc * 32 + 8 * fq;
#pragma unroll
        for (int ai = 0; ai < 2; ++ai)
#pragma unroll
            for (int m = 0; m < 4; ++m) { const int row = row0 + ai * HALF + m * 16; const float r = rstd_row(ss, row) * QSCALE;
#pragma unroll
                for (int bj = 0; bj < 2; ++bj) *(u32x4*)(qb + (size_t)row * D + col0 + bj * HALF) = pack8(acc[ai][bj][m][0] * r, acc[ai][bj][m][1] * r); }
    }
};
}

#define GAS __attribute__((address_space(1)))
#define LAS __attribute__((address_space(3)))
typedef unsigned v4u __attribute__((ext_vector_type(4)));
typedef float f32x4 __attribute__((ext_vector_type(4)));
typedef short bf16x8 __attribute__((ext_vector_type(8)));
typedef GAS unsigned gu32;
typedef GAS unsigned long long gu64;
#define RLX_AGENT __ATOMIC_RELAXED, __HIP_MEMORY_SCOPE_AGENT
#define LDS_WAIT() asm volatile("s_waitcnt lgkmcnt(0)" ::: "memory")
#define VM_WAIT() asm volatile("s_waitcnt vmcnt(0)" ::: "memory")
__device__ __forceinline__ unsigned long long rt() { return __builtin_amdgcn_s_memrealtime(); }
__device__ __forceinline__ unsigned pk2(float lo, float hi) { return f2bf(lo) | (f2bf(hi) << 16); }

#define XB_TMO      128
#define XB_XCNT(j)  (256  + 64 * (j))
#define XB_XSUB(j)  (1280 + 64 * (j))
#define XB_XGEN(j)  (2304 + 64 * (j))
#define XB_TOP      3328
#define XB_TOPGEN   3392
#define XCD_BAR_WORDS 3456
#define XB_SPIN_CAP (1u << 18)

__device__ __forceinline__ unsigned xb_ld(unsigned* p)              { return __hip_atomic_load(p, __ATOMIC_RELAXED, __HIP_MEMORY_SCOPE_AGENT); }
__device__ __forceinline__ unsigned xb_add(unsigned* p, unsigned v) { return __hip_atomic_fetch_add(p, v, __ATOMIC_RELAXED, __HIP_MEMORY_SCOPE_AGENT); }
__device__ __forceinline__ unsigned xb_xcc_id() { return (unsigned)__builtin_amdgcn_s_getreg((3 << 11) | 20) & 0xFu; }
#define XB_SPIN(cond, bar) do { unsigned _sp = 0; while (cond) { __builtin_amdgcn_s_sleep(1); \
    if ((++_sp & 255u) == 0u) { if (xb_ld(&(bar)[XB_TMO])) break; if (_sp > XB_SPIN_CAP) { atomicAdd(&(bar)[XB_TMO], 1u); break; } } } } while (0)

struct XcdBarrier {
    unsigned* bar; unsigned x;
    volatile LAS unsigned* st;
};

__device__ __forceinline__ XcdBarrier xcd_barrier_post(unsigned* bar, volatile LAS unsigned* st) {
    XcdBarrier b; b.bar = bar; b.x = xb_xcc_id(); b.st = st;
    if (threadIdx.x == 0) (void)xb_add(&bar[XB_XCNT(b.x)], 1u);
    return b;
}
__device__ __forceinline__ void xcd_barrier_complete(unsigned* bar, unsigned x, unsigned& nloc, unsigned& nx) {
    const unsigned G = gridDim.x * gridDim.y * gridDim.z;
    unsigned sum, cnt, mine, sp = 0u;
    for (;;) {
        sum = 0u; cnt = 0u; mine = 0u;
#pragma unroll
        for (unsigned j = 0; j < 16; ++j) { const unsigned c = xb_ld(&bar[XB_XCNT(j)]); sum += c; cnt += (c > 0u) ? 1u : 0u; mine = (j == x) ? c : mine; }
        if (sum == G) break;
        __builtin_amdgcn_s_sleep(1);
        if ((++sp & 255u) == 0u) { if (xb_ld(&bar[XB_TMO])) break; if (sp > XB_SPIN_CAP) { atomicAdd(&bar[XB_TMO], 1u); break; } }
    }
    nloc = mine > 0u ? mine : 1u; nx = cnt > 0u ? cnt : 1u;
}

__device__ __forceinline__ void xcd_barrier(const XcdBarrier& b) {
    asm volatile("s_waitcnt vmcnt(0)" ::: "memory");
    __syncthreads();
    if (threadIdx.x == 0) {
        unsigned* bar = b.bar;
        __builtin_amdgcn_s_waitcnt(0);
        unsigned nloc = b.st[0], nx = b.st[1];
        if (nloc == 0u) { xcd_barrier_complete(bar, b.x, nloc, nx); b.st[0] = nloc; b.st[1] = nx; }
        const unsigned old = xb_add(&bar[XB_XSUB(b.x)], 1u);
        const unsigned gen = old / nloc;
        if (old + 1u == (gen + 1u) * nloc) {
            __builtin_amdgcn_fence(__ATOMIC_RELEASE, "agent");
            asm volatile("s_waitcnt vmcnt(0)" ::: "memory");
            const unsigned og = xb_add(&bar[XB_TOP], 1u);
            const unsigned tg = og / nx;
            if (og + 1u == (tg + 1u) * nx) xb_add(&bar[XB_TOPGEN], 1u);
            else XB_SPIN(xb_ld(&bar[XB_TOPGEN]) == tg, bar);
            __builtin_amdgcn_fence(__ATOMIC_ACQUIRE, "agent");
            xb_add(&bar[XB_XGEN(b.x)], 1u);
            asm volatile("s_waitcnt vmcnt(0)" ::: "memory");
        } else {
            XB_SPIN(xb_ld(&bar[XB_XGEN(b.x)]) == gen, bar);
            __builtin_amdgcn_fence(__ATOMIC_ACQUIRE, "agent");
            asm volatile("s_waitcnt vmcnt(0)" ::: "memory");
        }
    }
    __syncthreads();
}

namespace sb {
__device__ __forceinline__ void transpose_item(const float* W, int ldw, int c0, const float* gain, bf16_t* WT, int K, int n0, int k0, LAS float* scr, int lane) {
#pragma unroll 8
    for (int i = 0; i < 32; ++i) { const int kk = 2 * i + (lane >> 5); float v = W[(size_t)(k0 + kk) * ldw + c0 + (lane & 31)]; if (gain) v *= gain[k0 + kk]; scr[kk * 33 + (lane & 31)] = v; }
    LDS_WAIT(); asm volatile("" ::: "memory");
    const int c = lane & 7;
#pragma unroll
    for (int j = 0; j < 4; ++j) { const int n = (lane >> 3) + 8 * j; const LAS float* s = scr + (8 * c) * 33 + n;
        v4u o; o.x = pk2(s[0 * 33], s[1 * 33]); o.y = pk2(s[2 * 33], s[3 * 33]); o.z = pk2(s[4 * 33], s[5 * 33]); o.w = pk2(s[6 * 33], s[7 * 33]);
        *(GAS v4u*)(WT + (size_t)(n0 + n) * K + k0 + 8 * c) = o; }
    LDS_WAIT(); asm volatile("" ::: "memory");
}
template <int MAP>
__device__ __forceinline__ void transpose_job_item(const float* W0, const float* W1, const float* gain, bf16_t* WT, int K, int N, int ldw, int item, LAS float* scr, int lane) {
    const int nblk = N / 32, kb = item / nblk, nb = item % nblk, n0 = 32 * nb, k0 = 64 * kb;
    const float* W = W0; int c0 = n0;
    if (MAP == 1) { const int pn = n0 / 256, half = (n0 % 256) / 128, jj = n0 % 128; W = half ? W1 : W0; c0 = pn * 128 + jj; }
    if (MAP == 2) { if (n0 >= 512) { const int m = n0 - 512, pc = m / 256, half = (m % 256) / 128, jj = m % 128; c0 = 512 + half * 512 + pc * 128 + jj; } }
    if (MAP == 3) { if (n0 >= 1024) { W = W1; c0 = n0 - 1024; } }
    transpose_item(W, ldw, c0, gain, WT, K, n0, k0, scr, lane);
}
__device__ __forceinline__ void row_bf16_ss(const float* xr, bf16_t* orow, float* ssrow, float* rstd1, int lane) {
    float s = 0.f;
#pragma unroll
    for (int j = 0; j < 4; ++j) { const f32x4 v = *(const f32x4*)(xr + j * 256 + lane * 4); s += (v.x * v.x + v.y * v.y) + (v.z * v.z + v.w * v.w);
        uint2 o; o.x = pk2(v.x, v.y); o.y = pk2(v.z, v.w); *(uint2*)(orow + j * 256 + lane * 4) = o; }
    s = wave_sum(s);
    if (lane < 16) ssrow[lane] = lane == 0 ? s : 0.f;
    if (rstd1 && lane == 0) *rstd1 = rsqrtf(s * (1.f / D) + EPS);
}

__device__ __forceinline__ void s5_task(int task, const bf16_t* ug, const float* h0re, const float* h0im, const float* a_re, const float* a_im, const float* log_dt,
                                        const float* b_re, const float* b_im, const float* c_re, const float* c_im, const float* dskip, bf16_t* gb, float* out, int n) {
    const int g = task % NG, sq = task / NG;
    const bool prompt = sq < NBATCH; const int b = prompt ? sq : sq - NBATCH, T = prompt ? SEQ : DECS, row0 = prompt ? b * SEQ : MP + b * DECS;
    const float dt = expf(log_dt[g]), lr = a_re[g * NST + n], li = a_im[g * NST + n];
    const float mag = expf(lr * dt), abr = mag * cosf(li * dt), abi = mag * sinf(li * dt);
    const float den = lr * lr + li * li, nr = abr - 1.f, ni = abi, cr = (nr * lr + ni * li) / den, ci = (ni * lr - nr * li) / den;
    float Br[16], Bi[16], Cr[16], Ci[16];
#pragma unroll
    for (int c = 0; c < 16; ++c) { const float br = b_re[((size_t)g * NST + n) * 16 + c], bi = b_im[((size_t)g * NST + n) * 16 + c];
        Br[c] = cr * br - ci * bi; Bi[c] = cr * bi + ci * br; Cr[c] = c_re[((size_t)g * 16 + c) * NST + n]; Ci[c] = c_im[((size_t)g * 16 + c) * NST + n]; }
    float hr = 0.f, hi = 0.f;
    if (!prompt) { hr = h0re[((size_t)b * NG + g) * NST + n]; hi = h0im[((size_t)b * NG + g) * NST + n]; }
    const float dsk = dskip[g * 16 + (n & 15)];
    for (int t = 0; t < T; ++t) {
        const bf16_t* up = ug + ((size_t)g * M + row0 + t) * 16;
        const v4u w0 = *(const v4u*)up, w1 = *(const v4u*)(up + 8);
        float u[16];
        u[0] = __builtin_bit_cast(float, w0.x << 16); u[1] = __builtin_bit_cast(float, w0.x & 0xffff0000u); u[2] = __builtin_bit_cast(float, w0.y << 16); u[3] = __builtin_bit_cast(float, w0.y & 0xffff0000u);
        u[4] = __builtin_bit_cast(float, w0.z << 16); u[5] = __builtin_bit_cast(float, w0.z & 0xffff0000u); u[6] = __builtin_bit_cast(float, w0.w << 16); u[7] = __builtin_bit_cast(float, w0.w & 0xffff0000u);
        u[8] = __builtin_bit_cast(float, w1.x << 16); u[9] = __builtin_bit_cast(float, w1.x & 0xffff0000u); u[10] = __builtin_bit_cast(float, w1.y << 16); u[11] = __builtin_bit_cast(float, w1.y & 0xffff0000u);
        u[12] = __builtin_bit_cast(float, w1.z << 16); u[13] = __builtin_bit_cast(float, w1.z & 0xffff0000u); u[14] = __builtin_bit_cast(float, w1.w << 16); u[15] = __builtin_bit_cast(float, w1.w & 0xffff0000u);
        float xr = 0.f, xi = 0.f;
#pragma unroll
        for (int c = 0; c < 16; ++c) { xr += Br[c] * u[c]; xi += Bi[c] * u[c]; }
        const float nhr = abr * hr - abi * hi + xr, nhi = abr * hi + abi * hr + xi; hr = nhr; hi = nhi;
        float ymine = 0.f;
#pragma unroll
        for (int c = 0; c < 16; ++c) { const float y = wave_sum(Cr[c] * hr - Ci[c] * hi); if ((n & 15) == c) ymine = y + dsk * u[c]; }
        if (n < 16) gb[(size_t)(row0 + t) * SSM + g * 16 + n] = (bf16_t)f2bf(gelu_tanh(ymine));
    }
    if (prompt) { out[O_SRP + ((size_t)b * NG + g) * NST + n] = hr; out[O_SIP + ((size_t)b * NG + g) * NST + n] = hi; }
    else { out[O_SRS + ((size_t)b * NG + g) * NST + n] = hr; out[O_SIS + ((size_t)b * NG + g) * NST + n] = hi; }
}

__device__ __forceinline__ void conv_row(int row, const bf16_t* vb, const float* cache, const float* w, const float* bias, const float* lg, const float* lb, bf16_t* mixb, float* out, LAS float* red, int c) {
    float y = bias[c];
    if (row < MP) { const int t = row % SEQ;
        for (int k = 0; k < CWID; ++k) { const int tt = t - 30 + k; if (tt >= 0) y += w[k * CONVD + c] * bf2f(vb[(size_t)(row - 30 + k) * CONVD + c]); }
    } else { const int rs = row - MP, b = rs / DECS, t = rs % DECS;
        for (int k = 0; k < CWID; ++k) { const int idx = t + k; const float xv = idx < 30 ? cache[((size_t)b * 30 + idx) * CONVD + c] : bf2f(vb[(size_t)(MP + b * DECS + idx - 30) * CONVD + c]); y += w[k * CONVD + c] * xv; }
        if (t == 0) for (int j = 0; j < 22; ++j) out[O_CVS + ((size_t)b * 30 + j) * CONVD + c] = cache[((size_t)b * 30 + j + 8) * CONVD + c];
    }
    float s = wave_sum(y); if ((c & 63) == 0) red[c >> 6] = s; __syncthreads();
    float mu = 0.f;
#pragma unroll
    for (int i = 0; i < 8; ++i) mu += red[i];
    mu *= (1.f / CONVD);
    const float d = y - mu; float q = wave_sum(d * d); if ((c & 63) == 0) red[8 + (c >> 6)] = q; __syncthreads();
    float var = 0.f;
#pragma unroll
    for (int i = 0; i < 8; ++i) var += red[8 + i];
    var *= (1.f / CONVD);
    const float z = d * rsqrtf(var + EPS) * lg[c] + lb[c];
    mixb[(size_t)row * D + SSM + c] = (bf16_t)f2bf(siluf_(z));
}

__device__ __forceinline__ void attn_task(int task, const bf16_t* qb, const bf16_t* kb, const bf16_t* vb2, const float* ck, const float* cv, bf16_t* ob, LAS float* scr, int t256) {
    LAS float* q = scr; LAS float* p = scr + 2048; LAS float* red = scr + 4096;
    const int rg = task >> 2, h = task & 3, row0 = rg * 8; const bool prompt = row0 < MP; const int b = prompt ? row0 / SEQ : (row0 - MP) / DECS;
#pragma unroll
    for (int r = 0; r < 8; ++r) q[r * 256 + t256] = bf2f(qb[(size_t)(row0 + r) * D + h * HD + t256]);
    __syncthreads();
    float s[8];
#pragma unroll
    for (int r = 0; r < 8; ++r) s[r] = 0.f;
    if (prompt) { const bf16_t* kr = kb + ((size_t)b * NMEM + t256) * D + h * HD;
        for (int d = 0; d < HD; d += 8) { const v4u w = *(const v4u*)(kr + d); float kv[8];
            kv[0] = __builtin_bit_cast(float, w.x << 16); kv[1] = __builtin_bit_cast(float, w.x & 0xffff0000u); kv[2] = __builtin_bit_cast(float, w.y << 16); kv[3] = __builtin_bit_cast(float, w.y & 0xffff0000u);
            kv[4] = __builtin_bit_cast(float, w.z << 16); kv[5] = __builtin_bit_cast(float, w.z & 0xffff0000u); kv[6] = __builtin_bit_cast(float, w.w << 16); kv[7] = __builtin_bit_cast(float, w.w & 0xffff0000u);
#pragma unroll
            for (int r = 0; r < 8; ++r)
#pragma unroll
                for (int j = 0; j < 8; ++j) s[r] += q[r * 256 + d + j] * kv[j]; }
    } else { const float* kr = ck + ((size_t)b * NMEM + t256) * D + h * HD;
        for (int d = 0; d < HD; d += 4) { const f32x4 kv = *(const f32x4*)(kr + d);
#pragma unroll
            for (int r = 0; r < 8; ++r) s[r] += (q[r * 256 + d] * kv.x + q[r * 256 + d + 1] * kv.y) + (q[r * 256 + d + 2] * kv.z + q[r * 256 + d + 3] * kv.w); }
    }
    const int w4 = t256 >> 6;
#pragma unroll
    for (int r = 0; r < 8; ++r) { float mx = s[r];
#pragma unroll
        for (int o = 1; o < 64; o <<= 1) mx = fmaxf(mx, __shfl_xor(mx, o));
        if ((t256 & 63) == 0) red[r * 4 + w4] = mx; }
    __syncthreads();
    float e[8];
#pragma unroll
    for (int r = 0; r < 8; ++r) { const float mx = fmaxf(fmaxf(red[r * 4], red[r * 4 + 1]), fmaxf(red[r * 4 + 2], red[r * 4 + 3])); e[r] = exp2f(s[r] - mx); }
    __syncthreads();
#pragma unroll
    for (int r = 0; r < 8; ++r) { const float sm = wave_sum(e[r]); if ((t256 & 63) == 0) red[r * 4 + w4] = sm; }
    __syncthreads();
#pragma unroll
    for (int r = 0; r < 8; ++r) { const float sm = (red[r * 4] + red[r * 4 + 1]) + (red[r * 4 + 2] + red[r * 4 + 3]); p[r * 256 + t256] = e[r] / sm; }
    __syncthreads();
    float o[8];
#pragma unroll
    for (int r = 0; r < 8; ++r) o[r] = 0.f;
    if (prompt) { const bf16_t* vr = vb2 + (size_t)b * NMEM * D + h * HD + t256;
        for (int m = 0; m < NMEM; ++m) { const float vv = bf2f(vr[(size_t)m * D]);
#pragma unroll
            for (int r = 0; r < 8; ++r) o[r] += p[r * 256 + m] * vv; }
    } else { const float* vr = cv + (size_t)b * NMEM * D + h * HD + t256;
        for (int m = 0; m < NMEM; ++m) { const float vv = vr[(size_t)m * D];
#pragma unroll
            for (int r = 0; r < 8; ++r) o[r] += p[r * 256 + m] * vv; }
    }
#pragma unroll
    for (int r = 0; r < 8; ++r) ob[(size_t)(row0 + r) * D + h * HD + t256] = (bf16_t)f2bf(o[r]);
    __syncthreads();
}
}

namespace s5f {
typedef short bf16x8 __attribute__((ext_vector_type(8)));
constexpr int KT_OFF = 0, KT_BYTES = 65 * 256 * 2, U_OFF = 33792, U_CSTR = 2064, S_OFF = U_OFF + 32 * U_CSTR, H_OFF = S_OFF + 32 * 128 * 4, H_RSTR = 272, END_OFF = H_OFF + 32 * H_RSTR;
static_assert(KT_BYTES <= U_OFF && END_OFF <= 131072, "S5 LDS map");
constexpr size_t TAB_KT = 0, TAB_P = 2 * MiB, TAB_Q = 10 * MiB, TAB_AL = 18 * MiB;
struct cf { float re, im; };
typedef float f32x2v __attribute__((ext_vector_type(2)));
typedef unsigned u32x2v __attribute__((ext_vector_type(2)));
__device__ __forceinline__ f32x2v tov(cf a) { return (f32x2v){a.re, a.im}; }
__device__ __forceinline__ cf toc(f32x2v a) { return cf{a.x, a.y}; }
__device__ __forceinline__ cf cmul(cf a, cf b) { return cf{a.re * b.re - a.im * b.im, a.re * b.im + a.im * b.re}; }
__device__ __forceinline__ cf cpow_a(float lr, float li, float dt, float p) { const float mag = expf(lr * dt * p); float s, c; sincosf(li * dt * p, &s, &c); return cf{mag * c, mag * s}; }
__device__ __forceinline__ cf coef_of(float lr, float li, float dt) { const cf a = cpow_a(lr, li, dt, 1.f); const float den = lr * lr + li * li, nr = a.re - 1.f, ni = a.im; return cf{(nr * lr + ni * li) / den, (ni * lr - nr * li) / den}; }

__device__ __forceinline__ void kt_task(int task, const float* a_re, const float* a_im, const float* log_dt, const float* b_re, const float* b_im, const float* c_re, const float* c_im,
                                        bf16_t* Ktab, LAS unsigned char* scr, int tid) {
    const int g = task >> 3, tb = task & 7;
    LAS f32x2v* Wb = (LAS f32x2v*)scr; LAS f32x2v* Bb = (LAS f32x2v*)(scr + 4096); LAS f32x2v* Cc = (LAS f32x2v*)(scr + 4096 + 8192);
    const float dt = expf(log_dt[g]);
    { const int tl = tid >> 6, n = tid & 63; Wb[tl * 64 + n] = tov(cpow_a(a_re[g * NST + n], a_im[g * NST + n], dt, (float)(8 * tb + tl))); }
#pragma unroll
    for (int e = tid; e < 1024; e += 512) { const int n = e >> 4, c = e & 15; const cf co = coef_of(a_re[g * NST + n], a_im[g * NST + n], dt);
        Bb[e] = tov(cmul(co, cf{b_re[((size_t)g * NST + n) * 16 + c], b_im[((size_t)g * NST + n) * 16 + c]})); }
#pragma unroll
    for (int e = tid; e < 1024; e += 512) Cc[e] = (f32x2v){c_re[(size_t)g * 1024 + e], c_im[(size_t)g * 1024 + e]};
    __syncthreads();
    { const int tl = tid >> 6, cc = tid & 63, c = cc >> 2, c0 = 4 * (cc & 3); float acc[4] = {0.f, 0.f, 0.f, 0.f};
        for (int n = 0; n < 64; ++n) { const cf T = cmul(toc(Cc[c * 64 + n]), toc(Wb[tl * 64 + n]));
#pragma unroll
            for (int k = 0; k < 4; ++k) { const cf E = toc(Bb[n * 16 + c0 + k]); acc[k] += T.re * E.re - T.im * E.im; } }
        uint2 o; o.x = pk2(acc[0], acc[1]); o.y = pk2(acc[2], acc[3]);
        *(uint2*)(Ktab + (((size_t)g * 65 + 8 * tb + tl + 1) * 16 + c) * 16 + c0) = o; }
    if (tb == 0 && tid < 32) *(v4u*)(Ktab + (size_t)g * 65 * 256 + tid * 8) = (v4u){0u, 0u, 0u, 0u};
    __syncthreads();
}
__device__ __forceinline__ void pq_entry(int e, const float* a_re, const float* a_im, const float* log_dt, const float* b_re, const float* b_im, const float* c_re, const float* c_im,
                                         bf16_t* Ptab, bf16_t* Qtab, float* ALtab) {
    {
        const int n = e & 63, j = (e >> 6) & 63, g = e >> 12; const float dt = expf(log_dt[g]);
        const cf W = cpow_a(a_re[g * NST + n], a_im[g * NST + n], dt, (float)(j + 1));
#pragma unroll
        for (int c = 0; c < 16; ++c) { const cf w = cmul(cf{c_re[((size_t)g * 16 + c) * NST + n], c_im[((size_t)g * 16 + c) * NST + n]}, W);
            bf16_t* p = Ptab + (((size_t)g * 64 + j) * 16 + c) * 128; p[n] = (bf16_t)f2bf(w.re); p[64 + n] = (bf16_t)f2bf(-w.im); }
        if (j == 0) { const cf al = cpow_a(a_re[g * NST + n], a_im[g * NST + n], dt, 64.f); ALtab[(g * NST + n) * 2] = al.re; ALtab[(g * NST + n) * 2 + 1] = al.im;
            const cf a8 = cpow_a(a_re[g * NST + n], a_im[g * NST + n], dt, 8.f); ALtab[NG * NST * 2 + (g * NST + n) * 2] = a8.re; ALtab[NG * NST * 2 + (g * NST + n) * 2 + 1] = a8.im; }
    }
    {
        const int i = e & 63, n = (e >> 6) & 63, g = e >> 12; const float dt = expf(log_dt[g]);
        const float lr = a_re[g * NST + n], li = a_im[g * NST + n];
        const cf V = cmul(cpow_a(lr, li, dt, (float)(63 - i)), coef_of(lr, li, dt));
        unsigned wr[8], wi[8];
#pragma unroll
        for (int c = 0; c < 16; c += 2) { const cf v0 = cmul(V, cf{b_re[((size_t)g * NST + n) * 16 + c], b_im[((size_t)g * NST + n) * 16 + c]}), v1 = cmul(V, cf{b_re[((size_t)g * NST + n) * 16 + c + 1], b_im[((size_t)g * NST + n) * 16 + c + 1]});
            wr[c >> 1] = pk2(v0.re, v1.re); wi[c >> 1] = pk2(v0.im, v1.im); }
        v4u* qr = (v4u*)(Qtab + ((size_t)g * 128 + n) * 1024 + i * 16); v4u* qi = (v4u*)(Qtab + ((size_t)g * 128 + 64 + n) * 1024 + i * 16);
        qr[0] = (v4u){wr[0], wr[1], wr[2], wr[3]}; qr[1] = (v4u){wr[4], wr[5], wr[6], wr[7]}; qi[0] = (v4u){wi[0], wi[1], wi[2], wi[3]}; qi[1] = (v4u){wi[4], wi[5], wi[6], wi[7]};
    }
}
__device__ __forceinline__ float gelu_fast(float x) { const float u = 1.5957691216057308f * (x + 0.044715f * x * x * x); return x * __builtin_amdgcn_rcpf(1.f + __builtin_amdgcn_exp2f(-1.4426950408889634f * u)); }

__device__ __forceinline__ void prompt_unit(int b, int g, const bf16_t* ug, const bf16_t* Ktab, const bf16_t* Ptab, const bf16_t* Qtab, const float* ALtab, const float* dskip, bf16_t* gb, float* out,
                                            LAS unsigned char* L, int tid, int wave, int lane) {
    {
        const v4u* src = (const v4u*)(Ktab + (size_t)g * 65 * 256);
#pragma unroll
        for (int p = 0; p < 5; ++p) { const int q = p * 512 + tid; if (q < KT_BYTES / 16) *(LAS v4u*)(L + KT_OFF + q * 16) = src[q]; }
        const v4u* us = (const v4u*)(ug + ((size_t)g * M + (size_t)b * SEQ) * 16);
#pragma unroll
        for (int p = 0; p < 8; ++p) { const int q = p * 512 + tid; *(LAS v4u*)(L + U_OFF + (q >> 7) * U_CSTR + (q & 127) * 16) = us[q]; }
    }
    __syncthreads();
    const int fr = lane & 15, kq = lane >> 4;
    const LAS unsigned char* ub0 = L + U_OFF + fr * U_CSTR + kq * 16; const LAS unsigned char* ub1 = ub0 + 16 * U_CSTR;
    {
        f32x4 a0 = {0.f, 0.f, 0.f, 0.f}, a1 = {0.f, 0.f, 0.f, 0.f};
        const bf16_t* qrow = Qtab + ((size_t)g * 128 + wave * 16 + fr) * 1024 + kq * 8;
        bf16x8 af[32];
#pragma unroll
        for (int s = 0; s < 32; ++s) af[s] = *(const bf16x8*)(qrow + s * 32);
#pragma unroll
        for (int s = 0; s < 32; ++s) {
            a0 = __builtin_amdgcn_mfma_f32_16x16x32_bf16(af[s], *(const LAS bf16x8*)(ub0 + s * 64), a0, 0, 0, 0);
            a1 = __builtin_amdgcn_mfma_f32_16x16x32_bf16(af[s], *(const LAS bf16x8*)(ub1 + s * 64), a1, 0, 0, 0); }
        *(LAS f32x4*)(L + S_OFF + (fr * 128 + wave * 16 + kq * 4) * 4) = a0;
        *(LAS f32x4*)(L + S_OFF + ((16 + fr) * 128 + wave * 16 + kq * 4) * 4) = a1;
    }
    __syncthreads();
    if (tid < 64) {
        const int n = tid; const float alr = ALtab[(g * NST + n) * 2], ali = ALtab[(g * NST + n) * 2 + 1]; float hr = 0.f, hi = 0.f;
        const LAS float* Sb = (const LAS float*)(L + S_OFF);
        for (int c = 0; c < 32; ++c) { LAS bf16_t* hb = (LAS bf16_t*)(L + H_OFF + c * H_RSTR); hb[n] = (bf16_t)f2bf(hr); hb[64 + n] = (bf16_t)f2bf(hi);
            const float sr = Sb[c * 128 + n], si = Sb[c * 128 + 64 + n]; const float nhr = alr * hr - ali * hi + sr, nhi = alr * hi + ali * hr + si; hr = nhr; hi = nhi; }
        out[O_SRP + ((size_t)b * NG + g) * NST + n] = hr; out[O_SIP + ((size_t)b * NG + g) * NST + n] = hi;
    }
    __syncthreads();
    f32x4 acc[8][2];
#pragma unroll
    for (int q = 0; q < 8; ++q) { acc[q][0] = (f32x4){0.f, 0.f, 0.f, 0.f}; acc[q][1] = (f32x4){0.f, 0.f, 0.f, 0.f}; }
    {
        const LAS unsigned char* kt = L + KT_OFF + (fr * 16 + (kq & 1) * 8) * 2 + (wave + 1 - (kq >> 1)) * 512;
        const int smax = (wave + 56) >> 1;
        for (int s = 0; s <= smax; ++s) {
            const bf16x8 b0 = *(const LAS bf16x8*)(ub0 + s * 64), b1 = *(const LAS bf16x8*)(ub1 + s * 64);
#pragma unroll
            for (int q = 0; q < 8; ++q) if (wave + 8 * q >= 2 * s) { const bf16x8 a = *(const LAS bf16x8*)(kt + (8 * q - 2 * s) * 512);
                acc[q][0] = __builtin_amdgcn_mfma_f32_16x16x32_bf16(a, b0, acc[q][0], 0, 0, 0); acc[q][1] = __builtin_amdgcn_mfma_f32_16x16x32_bf16(a, b1, acc[q][1], 0, 0, 0); }
        }
    }
    {
        const LAS unsigned char* hb0 = L + H_OFF + fr * H_RSTR + kq * 16; const LAS unsigned char* hb1 = hb0 + 16 * H_RSTR;
        const bf16_t* prow = Ptab + (((size_t)g * 64 + wave) * 16 + fr) * 128 + kq * 8;
#pragma unroll
        for (int s2 = 0; s2 < 4; ++s2) { const bf16x8 b0 = *(const LAS bf16x8*)(hb0 + s2 * 64), b1 = *(const LAS bf16x8*)(hb1 + s2 * 64);
#pragma unroll
            for (int q = 0; q < 8; ++q) { const bf16x8 a = *(const bf16x8*)(prow + (size_t)q * 8 * 16 * 128 + s2 * 32);
                acc[q][0] = __builtin_amdgcn_mfma_f32_16x16x32_bf16(a, b0, acc[q][0], 0, 0, 0); acc[q][1] = __builtin_amdgcn_mfma_f32_16x16x32_bf16(a, b1, acc[q][1], 0, 0, 0); } }
    }
    {
        const f32x4 dsk = *(const f32x4*)(dskip + g * 16 + kq * 4);
#pragma unroll
        for (int q = 0; q < 8; ++q)
#pragma unroll
            for (int nb = 0; nb < 2; ++nb) { const int chunk = nb * 16 + fr, j = wave + 8 * q;
                const u32x2v uw = *(const LAS u32x2v*)(L + U_OFF + chunk * U_CSTR + (j * 16 + kq * 4) * 2);
                const f32x4 u4 = {__builtin_bit_cast(float, uw.x << 16), __builtin_bit_cast(float, uw.x & 0xffff0000u), __builtin_bit_cast(float, uw.y << 16), __builtin_bit_cast(float, uw.y & 0xffff0000u)};
                const f32x4 y = acc[q][nb] + dsk * u4;
                uint2 o; o.x = pk2(gelu_fast(y[0]), gelu_fast(y[1])); o.y = pk2(gelu_fast(y[2]), gelu_fast(y[3]));
                *(uint2*)(gb + ((size_t)b * SEQ + chunk * 64 + j) * SSM + g * 16 + kq * 4) = o; }
    }
    __syncthreads();
}
__device__ __forceinline__ void sample_unit(int g, int bblk, const bf16_t* ug, const float* h0re, const float* h0im, const bf16_t* Ktab, const bf16_t* Ptab, const bf16_t* Qtab, const float* ALtab, const float* dskip,
                                            bf16_t* gb, float* out, int wave, int lane) {
    const int fr = lane & 15, kq = lane >> 4, b = bblk * 16 + fr;
    const bf16_t* ub = ug + ((size_t)g * M + MP + (size_t)b * DECS) * 16;
    const size_t hbase = ((size_t)b * NG + g) * NST;
    bf16x8 uf[4], hf[4];
#pragma unroll
    for (int s = 0; s < 4; ++s) uf[s] = *(const bf16x8*)(ub + (2 * s + (kq >> 1)) * 16 + (kq & 1) * 8);
#pragma unroll
    for (int s2 = 0; s2 < 4; ++s2) { const float* hp = (s2 < 2 ? h0re : h0im) + hbase + (s2 & 1) * 32 + kq * 8; const f32x4 x0 = *(const f32x4*)hp, x1 = *(const f32x4*)(hp + 4);
        hf[s2] = __builtin_bit_cast(bf16x8, (v4u){pk2(x0.x, x0.y), pk2(x0.z, x0.w), pk2(x1.x, x1.y), pk2(x1.z, x1.w)}); }
    {   const int j = wave; f32x4 acc = {0.f, 0.f, 0.f, 0.f};
#pragma unroll
        for (int s = 0; s < 4; ++s) if (2 * s <= j) { const int tau1 = j - 2 * s - (kq >> 1) + 1;
            acc = __builtin_amdgcn_mfma_f32_16x16x32_bf16(*(const bf16x8*)(Ktab + ((size_t)g * 65 + tau1) * 256 + fr * 16 + (kq & 1) * 8), uf[s], acc, 0, 0, 0); }
#pragma unroll
        for (int s2 = 0; s2 < 4; ++s2) acc = __builtin_amdgcn_mfma_f32_16x16x32_bf16(*(const bf16x8*)(Ptab + (((size_t)g * 64 + j) * 16 + fr) * 128 + s2 * 32 + kq * 8), hf[s2], acc, 0, 0, 0);
        const f32x4 dsk = *(const f32x4*)(dskip + g * 16 + kq * 4);
        const u32x2v uw = *(const u32x2v*)(ub + j * 16 + kq * 4);
        const f32x4 u4 = {__builtin_bit_cast(float, uw.x << 16), __builtin_bit_cast(float, uw.x & 0xffff0000u), __builtin_bit_cast(float, uw.y << 16), __builtin_bit_cast(float, uw.y & 0xffff0000u)};
        const f32x4 y = acc + dsk * u4;
        *(u32x2v*)(gb + ((size_t)MP + b * DECS + j) * SSM + g * 16 + kq * 4) = (u32x2v){pk2(gelu_fast(y[0]), gelu_fast(y[1])), pk2(gelu_fast(y[2]), gelu_fast(y[3]))};
    }
    {   f32x4 acc = {0.f, 0.f, 0.f, 0.f};
        const bf16_t* qrow = Qtab + ((size_t)g * 128 + wave * 16 + fr) * 1024 + 56 * 16 + (kq >> 1) * 16 + (kq & 1) * 8;
#pragma unroll
        for (int s = 0; s < 4; ++s) acc = __builtin_amdgcn_mfma_f32_16x16x32_bf16(*(const bf16x8*)(qrow + s * 32), uf[s], acc, 0, 0, 0);
        const float* al8 = ALtab + NG * NST * 2 + (size_t)g * NST * 2;
#pragma unroll
        for (int r = 0; r < 4; ++r) { const int n = (16 * wave + 4 * kq + r) & 63; const float h0r = h0re[hbase + n], h0i = h0im[hbase + n], ar = al8[2 * n], ai = al8[2 * n + 1];
            if (wave < 4) out[O_SRS + hbase + n] = ar * h0r - ai * h0i + acc[r]; else out[O_SIS + hbase + n] = ar * h0i + ai * h0r + acc[r]; }
    }
}
}


namespace att {
typedef short bf16x8 __attribute__((ext_vector_type(8)));
typedef float f32x16 __attribute__((ext_vector_type(16)));
typedef float f32x2v __attribute__((ext_vector_type(2)));
typedef unsigned u32x2v __attribute__((ext_vector_type(2)));
__device__ __forceinline__ int crow(int r, int hi) { return (r & 3) + 8 * (r >> 2) + 4 * hi; }
__device__ __forceinline__ unsigned cvtpk(float lo, float hi) { return pg8::cvt_pk_bf16(lo, hi); }

__device__ __forceinline__ void prompt_unit(int b, int h, int qblk, const bf16_t* qb, const bf16_t* kb, const bf16_t* vT, bf16_t* ob, LAS unsigned char* L, LAS float* wsf, int tid, int wave, int lane) {
    const int r32 = lane & 31, hh = lane >> 5, x = r32 & 15;
    const bf16_t* Kg = kb + (size_t)b * NMEM * D + h * HD;
#pragma unroll 1
    for (int half = 0; half < 2; ++half) {   v4u st[8];
#pragma unroll
        for (int i = 0; i < 8; ++i) { const int q = i * 512 + tid, mem = q >> 4, c16 = q & 15; st[i] = *(const v4u*)(Kg + (size_t)mem * D + half * 128 + c16 * 8); }
#pragma unroll
        for (int i = 0; i < 8; ++i) { const int q = i * 512 + tid, mem = q >> 4, c16 = q & 15; *(LAS v4u*)(L + half * 65536 + mem * 256 + ((c16 ^ (mem & 15)) << 4)) = st[i]; } }
    const size_t qrow = (size_t)b * SEQ + qblk * 256 + wave * 32 + r32;
    const bf16_t* Qg = qb + qrow * D + h * HD + hh * 8;
    unsigned koff[8];
#pragma unroll
    for (int ks = 0; ks < 8; ++ks) koff[ks] = (unsigned)(((2 * ks + hh) ^ x) << 4);
    __syncthreads();
    f32x16 S[8];
#pragma unroll
    for (int mb = 0; mb < 8; ++mb)
#pragma unroll
        for (int r = 0; r < 16; ++r) S[mb][r] = 0.f;
#pragma unroll
    for (int half = 0; half < 2; ++half) {
        bf16x8 qf[8];
#pragma unroll
        for (int ks = 0; ks < 8; ++ks) qf[ks] = *(const bf16x8*)(Qg + half * 128 + ks * 16);
        const LAS unsigned char* kbase = L + half * 65536 + r32 * 256;
#pragma unroll
        for (int mb = 0; mb < 8; ++mb) {
#pragma unroll
            for (int ks = 0; ks < 8; ++ks) S[mb] = __builtin_amdgcn_mfma_f32_32x32x16_bf16(*(const LAS bf16x8*)(kbase + mb * 8192 + koff[ks]), qf[ks], S[mb], 0, 0, 0);
            asm volatile("" : "+v"(S[mb])); __builtin_amdgcn_sched_barrier(0); }
    }
    __syncthreads();
    const bf16_t* Vg = vT + (size_t)h * HD * MMEM + (size_t)b * NMEM;
#pragma unroll 1
    for (int pb = 0; pb < 4; ++pb) { v4u st[4];
#pragma unroll
        for (int p = 0; p < 4; ++p) { const int q = (pb * 4 + p) * 512 + tid, dd = (q >> 5) & 127, dh = q >> 12, c32 = q & 31; st[p] = *(const v4u*)(Vg + (size_t)(dh * 128 + dd) * MMEM + c32 * 8); }
#pragma unroll
        for (int p = 0; p < 4; ++p) { const int q = (pb * 4 + p) * 512 + tid, dd = (q >> 5) & 127, dh = q >> 12, c32 = q & 31; *(LAS v4u*)(L + dh * 65536 + dd * 512 + ((c32 ^ (dd & 15)) << 4)) = st[p]; } }
    float mx = S[0][0];
#pragma unroll
    for (int mb = 0; mb < 8; ++mb)
#pragma unroll
        for (int r = 0; r < 16; ++r) mx = fmaxf(mx, S[mb][r]);
    mx = fmaxf(mx, __shfl_xor(mx, 32));
    float lsum = 0.f;
    v4u pa[8][2];
#pragma unroll
    for (int mb = 0; mb < 8; ++mb) {
#pragma unroll
        for (int r = 0; r < 16; ++r) { const float e = __builtin_amdgcn_exp2f(S[mb][r] - mx); S[mb][r] = e; lsum += e; }
#pragma unroll
        for (int s = 0; s < 2; ++s) pa[mb][s] = (v4u){cvtpk(S[mb][8 * s], S[mb][8 * s + 1]), cvtpk(S[mb][8 * s + 2], S[mb][8 * s + 3]), cvtpk(S[mb][8 * s + 4], S[mb][8 * s + 5]), cvtpk(S[mb][8 * s + 6], S[mb][8 * s + 7])};
    }
    lsum += __shfl_xor(lsum, 32);
    if (hh == 0) wsf[r32] = lsum;
    __syncthreads();
    unsigned voff[2][4];
#pragma unroll
    for (int s = 0; s < 2; ++s)
#pragma unroll
        for (int ml = 0; ml < 4; ++ml) voff[s][ml] = (unsigned)(((4 * ml + 2 * s) ^ (hh ^ x)) << 4);
    bf16_t* Og = ob + ((size_t)b * SEQ + qblk * 256 + wave * 32 + 4 * hh) * D + h * HD + r32;
#pragma unroll
    for (int dh = 0; dh < 2; ++dh) {
        f32x16 O[4];
#pragma unroll
        for (int db = 0; db < 4; ++db)
#pragma unroll
            for (int r = 0; r < 16; ++r) O[db][r] = 0.f;
        const LAS unsigned char* vbase = L + dh * 65536 + r32 * 512;
#pragma unroll
        for (int mb = 0; mb < 8; ++mb)
#pragma unroll
            for (int s = 0; s < 2; ++s) { const bf16x8 a = __builtin_bit_cast(bf16x8, pa[mb][s]);
#pragma unroll
                for (int db = 0; db < 4; ++db)
                    O[db] = __builtin_amdgcn_mfma_f32_32x32x16_bf16(a, *(const LAS bf16x8*)(vbase + db * 16384 + (mb >> 2) * 256 + voff[s][mb & 3]), O[db], 0, 0, 0);
                asm volatile("" : "+v"(O[0]), "+v"(O[1]), "+v"(O[2]), "+v"(O[3])); __builtin_amdgcn_sched_barrier(0); }
#pragma unroll
        for (int r = 0; r < 16; ++r) { const float rl = __builtin_amdgcn_rcpf(wsf[crow(r, hh)]);
#pragma unroll
            for (int db = 0; db < 4; ++db) Og[(size_t)((r & 3) + 8 * (r >> 2)) * D + dh * 128 + db * 32] = (bf16_t)f2bf(O[db][r] * rl);
            __builtin_amdgcn_sched_barrier(0); }
    }
    __syncthreads();
}

__device__ __forceinline__ void sample_unit(int b, int hp, const bf16_t* qb, const float* ck, const float* cv, bf16_t* ob, LAS unsigned char* L, int tid, int wave, int lane) {
    const int hsel = wave >> 2, mq = wave & 3, head = 2 * hp + hsel;
    LAS float* sbuf = (LAS float*)L; LAS float* pT = (LAS float*)(L + 16384); LAS float* obuf = (LAS float*)(L + 32768);
    float q[8][4];
#pragma unroll
    for (int t = 0; t < 8; ++t) { const u32x2v w = *(const u32x2v*)(qb + ((size_t)MP + b * DECS + t) * D + head * HD + lane * 4);
        q[t][0] = __builtin_bit_cast(float, w.x << 16); q[t][1] = __builtin_bit_cast(float, w.x & 0xffff0000u); q[t][2] = __builtin_bit_cast(float, w.y << 16); q[t][3] = __builtin_bit_cast(float, w.y & 0xffff0000u); }
    const float* Kr = ck + (((size_t)b * NMEM + mq * 64) * NH + head) * HD + lane * 4;
    f32x4 kn[8];
#pragma unroll
    for (int i = 0; i < 8; ++i) kn[i] = *(const f32x4*)(Kr + (size_t)i * NH * HD);
    for (int m0 = 0; m0 < 64; m0 += 8) {
        f32x4 k4[8];
#pragma unroll
        for (int i = 0; i < 8; ++i) k4[i] = kn[i];
        if (m0 + 8 < 64) {
#pragma unroll
            for (int i = 0; i < 8; ++i) kn[i] = *(const f32x4*)(Kr + (size_t)(m0 + 8 + i) * NH * HD); }
#pragma unroll
        for (int i = 0; i < 8; ++i) {
            float v[8];
#pragma unroll
            for (int t = 0; t < 8; ++t) v[t] = (q[t][0] * k4[i].x + q[t][1] * k4[i].y) + (q[t][2] * k4[i].z + q[t][3] * k4[i].w);
            float r4[4], r2[2], r1;
#pragma unroll
            for (int j = 0; j < 4; ++j) { const bool up = lane & 32; const float send = up ? v[j] : v[j + 4], keep = up ? v[j + 4] : v[j]; r4[j] = keep + __shfl_xor(send, 32); }
#pragma unroll
            for (int j = 0; j < 2; ++j) { const bool up = lane & 16; const float send = up ? r4[j] : r4[j + 2], keep = up ? r4[j + 2] : r4[j]; r2[j] = keep + __shfl_xor(send, 16); }
            { const bool up = lane & 8; const float send = up ? r2[0] : r2[1], keep = up ? r2[1] : r2[0]; r1 = keep + __shfl_xor(send, 8); }
            r1 += __shfl_xor(r1, 4); r1 += __shfl_xor(r1, 2); r1 += __shfl_xor(r1, 1);
            const int t = ((lane >> 5) & 1) * 4 + ((lane >> 4) & 1) * 2 + ((lane >> 3) & 1);
            if ((lane & 7) == 0) sbuf[(hsel * 8 + t) * 256 + mq * 64 + m0 + i] = r1;
        }
    }
    const float* Vr = cv + (((size_t)b * NMEM + mq * 64) * NH + head) * HD + lane * 4;
    f32x4 vn[8];
#pragma unroll
    for (int i = 0; i < 8; ++i) vn[i] = *(const f32x4*)(Vr + (size_t)i * NH * HD);
    __syncthreads();
#pragma unroll
    for (int rr = 0; rr < 2; ++rr) { const int row = wave * 2 + rr;
        const f32x4 s4 = *(const LAS f32x4*)(sbuf + row * 256 + lane * 4);
        float mx = fmaxf(fmaxf(s4.x, s4.y), fmaxf(s4.z, s4.w));
#pragma unroll
        for (int o = 1; o < 64; o <<= 1) mx = fmaxf(mx, __shfl_xor(mx, o));
        const float e0 = exp2f(s4.x - mx), e1 = exp2f(s4.y - mx), e2 = exp2f(s4.z - mx), e3 = exp2f(s4.w - mx);
        const float inv = 1.f / wave_sum((e0 + e1) + (e2 + e3));
        LAS float* pp = pT + ((row >> 3) * 256 + lane * 4) * 8 + (row & 7);
        pp[0] = e0 * inv; pp[8] = e1 * inv; pp[16] = e2 * inv; pp[24] = e3 * inv; }
    __syncthreads();
    float o[8][4];
#pragma unroll
    for (int t = 0; t < 8; ++t) { o[t][0] = 0.f; o[t][1] = 0.f; o[t][2] = 0.f; o[t][3] = 0.f; }
    for (int m0 = 0; m0 < 64; m0 += 8) {
        f32x4 v4[8];
#pragma unroll
        for (int i = 0; i < 8; ++i) v4[i] = vn[i];
        if (m0 + 8 < 64) {
#pragma unroll
            for (int i = 0; i < 8; ++i) vn[i] = *(const f32x4*)(Vr + (size_t)(m0 + 8 + i) * NH * HD); }
#pragma unroll
        for (int i = 0; i < 8; ++i) { const LAS f32x4* pp = (const LAS f32x4*)(pT + (hsel * 256 + mq * 64 + m0 + i) * 8); const f32x4 pa = pp[0], pb = pp[1];
            const float pv[8] = {pa.x, pa.y, pa.z, pa.w, pb.x, pb.y, pb.z, pb.w};
#pragma unroll
            for (int t = 0; t < 8; ++t) { o[t][0] += pv[t] * v4[i].x; o[t][1] += pv[t] * v4[i].y; o[t][2] += pv[t] * v4[i].z; o[t][3] += pv[t] * v4[i].w; } }
    }
#pragma unroll
    for (int t = 0; t < 8; ++t) *(LAS f32x4*)(obuf + ((hsel * 4 + mq) * 8 + t) * 256 + lane * 4) = (f32x4){o[t][0], o[t][1], o[t][2], o[t][3]};
    __syncthreads();
    { const int hs = tid >> 8, t = (tid >> 5) & 7, d8 = tid & 31;
        f32x4 a0 = {0.f, 0.f, 0.f, 0.f}, a1 = {0.f, 0.f, 0.f, 0.f};
#pragma unroll
        for (int m = 0; m < 4; ++m) { const LAS f32x4* pp = (const LAS f32x4*)(obuf + ((hs * 4 + m) * 8 + t) * 256 + d8 * 8); a0 = a0 + pp[0]; a1 = a1 + pp[1]; }
        *(v4u*)(ob + ((size_t)MP + b * DECS + t) * D + (2 * hp + hs) * HD + d8 * 8) = (v4u){pk2(a0.x, a0.y), pk2(a0.z, a0.w), pk2(a1.x, a1.y), pk2(a1.z, a1.w)};
    }
    __syncthreads();
}
}

namespace cvx {
template <int NT>
__device__ __forceinline__ void ln_swish_rows(const LAS float* ybuf, int row0, const float* lg, const float* lb, bf16_t* mixb, int wave, int lane) {
    const f32x4 g0 = *(const f32x4*)(lg + lane * 4), g1 = *(const f32x4*)(lg + 256 + lane * 4), b0 = *(const f32x4*)(lb + lane * 4), b1 = *(const f32x4*)(lb + 256 + lane * 4);
    for (int j = wave; j < NT; j += 8) {
        const f32x4 a = *(const LAS f32x4*)(ybuf + j * 512 + lane * 4), b = *(const LAS f32x4*)(ybuf + j * 512 + 256 + lane * 4);
        const float s = wave_sum(((a.x + a.y) + (a.z + a.w)) + ((b.x + b.y) + (b.z + b.w)));
        const float mu = s * (1.f / CONVD); const f32x4 da = a - mu, db = b - mu;
        const float q = wave_sum(((da.x * da.x + da.y * da.y) + (da.z * da.z + da.w * da.w)) + ((db.x * db.x + db.y * db.y) + (db.z * db.z + db.w * db.w)));
        const float rs = rsqrtf(q * (1.f / CONVD) + EPS);
        const f32x4 za = da * rs * g0 + b0, zb = db * rs * g1 + b1;
        typedef unsigned u32x2 __attribute__((ext_vector_type(2)));
        bf16_t* o = mixb + (size_t)(row0 + j) * D + SSM + lane * 4;
        *(u32x2*)o = (u32x2){pk2(za.x * fx::fsig(za.x), za.y * fx::fsig(za.y)), pk2(za.z * fx::fsig(za.z), za.w * fx::fsig(za.w))};
        *(u32x2*)(o + 256) = (u32x2){pk2(zb.x * fx::fsig(zb.x), zb.y * fx::fsig(zb.y)), pk2(zb.z * fx::fsig(zb.z), zb.w * fx::fsig(zb.w))};
    }
}
__device__ __forceinline__ void prompt_tile(int b, int t0, const bf16_t* vb, const float* w, const float* bias, const float* lg, const float* lb, bf16_t* mixb, LAS float* ybuf, int tid, int wave, int lane) {
    const int c = tid;
    float wk[31];
#pragma unroll
    for (int k = 0; k < 31; ++k) wk[k] = w[k * CONVD + c];
    const float bs = bias[c];
    const bf16_t* vp = vb + (size_t)b * SEQ * CONVD + c;
#pragma unroll 1
    for (int pass = 0; pass < 4; ++pass) {
        const int tb = t0 + pass * 16;
        float xin[46];
#pragma unroll
        for (int ii = 0; ii < 46; ++ii) { const int tt = tb - 30 + ii; const int tc = tt < 0 ? 0 : tt; const float v = bf2f(vp[(size_t)tc * CONVD]); xin[ii] = tt < 0 ? 0.f : v; }
#pragma unroll
        for (int j = 0; j < 16; ++j) { float y = bs;
#pragma unroll
            for (int k = 0; k < 31; ++k) y += wk[k] * xin[j + k];
            ybuf[(pass * 16 + j) * 512 + c] = y; }
    }
    __syncthreads();
    ln_swish_rows<64>(ybuf, b * SEQ + t0, lg, lb, mixb, wave, lane);
    __syncthreads();
}
__device__ __forceinline__ void sample_batch(int b, const bf16_t* vb, const float* cache, const float* w, const float* bias, const float* lg, const float* lb, bf16_t* mixb, float* out, LAS float* ybuf, int tid, int wave, int lane) {
    const int c = tid;
    float xp[38];
#pragma unroll
    for (int i = 0; i < 30; ++i) xp[i] = cache[((size_t)b * 30 + i) * CONVD + c];
#pragma unroll
    for (int i = 0; i < 8; ++i) xp[30 + i] = bf2f(vb[((size_t)MP + b * DECS + i) * CONVD + c]);
#pragma unroll
    for (int j = 0; j < 22; ++j) out[O_CVS + ((size_t)b * 30 + j) * CONVD + c] = xp[j + 8];
    float y[8];
    const float bs = bias[c];
#pragma unroll
    for (int j = 0; j < 8; ++j) y[j] = bs;
#pragma unroll
    for (int k = 0; k < 31; ++k) { const float wv = w[k * CONVD + c];
#pragma unroll
        for (int j = 0; j < 8; ++j) y[j] += wv * xp[j + k]; }
#pragma unroll
    for (int j = 0; j < 8; ++j) ybuf[j * 512 + c] = y[j];
    __syncthreads();
    ln_swish_rows<8>(ybuf, MP + b * DECS, lg, lb, mixb, wave, lane);
    __syncthreads();
}
}

namespace sg {
typedef short bf16x8 __attribute__((ext_vector_type(8)));
constexpr int PSTR = 68, PBYTES = 64 * PSTR * 4;
template <class Epi>
__device__ __forceinline__ void tile(const bf16_t* A, const bf16_t* Bt, int K, int tm, int tn, const Epi& E, LAS unsigned char* L, int tid, int wave, int lane) {
    const int fr = lane & 15, kq = lane >> 4, kw = K >> 3, ns = kw >> 5;
    const bf16_t* a0 = A + (size_t)(tm * 64 + fr) * K + wave * kw + kq * 8;
    const bf16_t* b0 = Bt + (size_t)(tn * 64 + fr) * K + wave * kw + kq * 8;
    f32x4 acc[4][4];
#pragma unroll
    for (int i = 0; i < 4; ++i)
#pragma unroll
        for (int j = 0; j < 4; ++j) acc[i][j] = (f32x4){0.f, 0.f, 0.f, 0.f};
#pragma unroll 2
    for (int s = 0; s < ns; ++s) {
        bf16x8 af[4], bf[4];
#pragma unroll
        for (int i = 0; i < 4; ++i) { af[i] = *(const bf16x8*)(a0 + (size_t)i * 16 * K + s * 32); bf[i] = *(const bf16x8*)(b0 + (size_t)i * 16 * K + s * 32); }
#pragma unroll
        for (int i = 0; i < 4; ++i)
#pragma unroll
            for (int j = 0; j < 4; ++j) acc[i][j] = __builtin_amdgcn_mfma_f32_16x16x32_bf16(af[i], bf[j], acc[i][j], 0, 0, 0);
    }
    LAS float* P = (LAS float*)(L + (wave & 3) * PBYTES) + (4 * kq) * PSTR + fr;
    if (wave >= 4) {
#pragma unroll
        for (int i = 0; i < 4; ++i)
#pragma unroll
            for (int j = 0; j < 4; ++j)
#pragma unroll
                for (int r = 0; r < 4; ++r) P[(16 * i + r) * PSTR + 16 * j] = acc[i][j][r];
    }
    __syncthreads();
    if (wave < 4) {
#pragma unroll
        for (int i = 0; i < 4; ++i)
#pragma unroll
            for (int j = 0; j < 4; ++j)
#pragma unroll
                for (int r = 0; r < 4; ++r) acc[i][j][r] += P[(16 * i + r) * PSTR + 16 * j];
    }
    __syncthreads();
    if (wave < 4) {
#pragma unroll
        for (int i = 0; i < 4; ++i)
#pragma unroll
            for (int j = 0; j < 4; ++j)
#pragma unroll
                for (int r = 0; r < 4; ++r) P[(16 * i + r) * PSTR + 16 * j] = acc[i][j][r];
    }
    __syncthreads();
    { const int row = tid >> 3, c8 = (tid & 7) * 8; f32x4 v0 = {0.f, 0.f, 0.f, 0.f}, v1 = {0.f, 0.f, 0.f, 0.f};
#pragma unroll
        for (int w = 0; w < 4; ++w) { const LAS f32x4* p = (const LAS f32x4*)(L + w * PBYTES + (row * PSTR + c8) * 4); v0 = v0 + p[0]; v1 = v1 + p[1]; }
        E(tm * 64 + row, tn * 64 + c8, tn, v0, v1, lane); }
    __syncthreads();
}
struct SRes { const float* rin; float* rout; bf16_t* xb; float* ss; float alpha;
    __device__ __forceinline__ void operator()(int row, int col0, int slot, f32x4 a0, f32x4 a1, int lane) const {
        const size_t o = (size_t)row * D + col0;
        const f32x4 v0 = *(const f32x4*)(rin + o) + a0 * alpha, v1 = *(const f32x4*)(rin + o + 4) + a1 * alpha;
        *(f32x4*)(rout + o) = v0; *(f32x4*)(rout + o + 4) = v1; if (xb) *(fx::u32x4*)(xb + o) = fx::pack8(v0, v1);
        float sq = ((v0[0] * v0[0] + v0[1] * v0[1]) + (v0[2] * v0[2] + v0[3] * v0[3])) + ((v1[0] * v1[0] + v1[1] * v1[1]) + (v1[2] * v1[2] + v1[3] * v1[3]));
        sq += __shfl_xor(sq, 1); sq += __shfl_xor(sq, 2); sq += __shfl_xor(sq, 4);
        if ((lane & 7) == 0) ss[(size_t)row * 16 + slot] = sq;
    }
};
struct SQ { const float* ss; bf16_t* qb;
    __device__ __forceinline__ void operator()(int row, int col0, int slot, f32x4 a0, f32x4 a1, int lane) const {
        const float r = fx::rstd_row(ss, row) * QSCALE; *(fx::u32x4*)(qb + (size_t)row * D + col0) = fx::pack8(a0 * r, a1 * r);
    }
};
}

namespace pro {
using s5f::cf; using s5f::cmul; using s5f::cpow_a; using s5f::coef_of;
__device__ __forceinline__ void transpose_item(const float* W, int ldw, int c0, const float* gain, bf16_t* WT, int K, int n0, int k0, LAS float* scr, int lane) {
    const int r8 = lane >> 3, c4 = (lane & 7) * 4;
    f32x4 v[8];
#pragma unroll
    for (int i = 0; i < 8; ++i) v[i] = *(const f32x4*)(W + (size_t)(k0 + 8 * i + r8) * ldw + c0 + c4);
    if (gain) {
#pragma unroll
        for (int i = 0; i < 8; ++i) v[i] = v[i] * gain[k0 + 8 * i + r8]; }
#pragma unroll
    for (int i = 0; i < 8; ++i) *(LAS f32x4*)(scr + (8 * i + r8) * 36 + c4) = v[i];
    LDS_WAIT(); asm volatile("" ::: "memory");
    const int c = lane & 7;
#pragma unroll
    for (int j = 0; j < 4; ++j) { const int n = (lane >> 3) + 8 * j; const LAS float* s = scr + (8 * c) * 36 + n;
        v4u o; o.x = pk2(s[0 * 36], s[1 * 36]); o.y = pk2(s[2 * 36], s[3 * 36]); o.z = pk2(s[4 * 36], s[5 * 36]); o.w = pk2(s[6 * 36], s[7 * 36]);
        *(GAS v4u*)(WT + (size_t)(n0 + n) * K + k0 + 8 * c) = o; }
    LDS_WAIT(); asm volatile("" ::: "memory");
}
template <int MAP>
__device__ __forceinline__ void transpose_job_item(const float* W0, const float* W1, const float* gain, bf16_t* WT, int K, int N, int ldw, int item, LAS float* scr, int lane) {
    const int nblk = N / 32, kb = item / nblk, nb = item % nblk, n0 = 32 * nb, k0 = 64 * kb;
    const float* W = W0; int c0 = n0;
    if (MAP == 1) { const int pn = n0 / 256, half = (n0 % 256) / 128, jj = n0 % 128; W = half ? W1 : W0; c0 = pn * 128 + jj; }
    if (MAP == 2) { if (n0 >= 512) { const int m = n0 - 512, pc = m / 256, half = (m % 256) / 128, jj = m % 128; c0 = 512 + half * 512 + pc * 128 + jj; } }
    if (MAP == 3) { if (n0 >= 1024) { W = W1; c0 = n0 - 1024; } }
    transpose_item(W, ldw, c0, gain, WT, K, n0, k0, scr, lane);
}
__device__ __forceinline__ void rows2_bf16_ss(const float* xa, const float* xb_, bf16_t* oa, bf16_t* ob_, float* ssa, float* ssb, float* ra, float* rb, int lane) {
    f32x4 va[4], vb[4];
#pragma unroll
    for (int j = 0; j < 4; ++j) { va[j] = *(const f32x4*)(xa + j * 256 + lane * 4); vb[j] = *(const f32x4*)(xb_ + j * 256 + lane * 4); }
    float sa = 0.f, sb_ = 0.f;
#pragma unroll
    for (int j = 0; j < 4; ++j) { sa += (va[j].x * va[j].x + va[j].y * va[j].y) + (va[j].z * va[j].z + va[j].w * va[j].w); sb_ += (vb[j].x * vb[j].x + vb[j].y * vb[j].y) + (vb[j].z * vb[j].z + vb[j].w * vb[j].w);
        uint2 o; o.x = pk2(va[j].x, va[j].y); o.y = pk2(va[j].z, va[j].w); *(uint2*)(oa + j * 256 + lane * 4) = o;
        uint2 p; p.x = pk2(vb[j].x, vb[j].y); p.y = pk2(vb[j].z, vb[j].w); *(uint2*)(ob_ + j * 256 + lane * 4) = p; }
    sa = wave_sum(sa); sb_ = wave_sum(sb_);
    if (lane < 16) { ssa[lane] = lane == 0 ? sa : 0.f; ssb[lane] = lane == 0 ? sb_ : 0.f; }
    if (ra && lane == 0) { *ra = rsqrtf(sa * (1.f / D) + EPS); *rb = rsqrtf(sb_ * (1.f / D) + EPS); }
}
__device__ __forceinline__ void kt_wave_task(int task, const float* a_re, const float* a_im, const float* log_dt, const float* b_re, const float* b_im, const float* c_re, const float* c_im,
                                             bf16_t* Ktab, LAS float* scr, int lane) {
    const int g = task >> 6, tau = task & 63, n = lane;
    const float dt = expf(log_dt[g]), lr = a_re[g * NST + n], li = a_im[g * NST + n];
    const cf W = cpow_a(lr, li, dt, (float)tau), co = coef_of(lr, li, dt);
    LAS float* T = scr; LAS float* E = scr + 64 * 32;
#pragma unroll
    for (int c = 0; c < 16; ++c) { const cf t = cmul(cf{c_re[((size_t)g * 16 + c) * NST + n], c_im[((size_t)g * 16 + c) * NST + n]}, W); T[n * 32 + 2 * c] = t.re; T[n * 32 + 2 * c + 1] = t.im;
        const cf e = cmul(co, cf{b_re[((size_t)g * NST + n) * 16 + c], b_im[((size_t)g * NST + n) * 16 + c]}); E[n * 32 + 2 * c] = e.re; E[n * 32 + 2 * c + 1] = e.im; }
    LDS_WAIT(); asm volatile("" ::: "memory");
    const int c = lane >> 2, c0 = 4 * (lane & 3); float acc[4] = {0.f, 0.f, 0.f, 0.f};
    for (int m = 0; m < 64; ++m) { const float tr = T[m * 32 + 2 * c], ti = T[m * 32 + 2 * c + 1];
#pragma unroll
        for (int k = 0; k < 4; ++k) acc[k] += tr * E[m * 32 + 2 * (c0 + k)] - ti * E[m * 32 + 2 * (c0 + k) + 1]; }
    uint2 o; o.x = pk2(acc[0], acc[1]); o.y = pk2(acc[2], acc[3]);
    *(uint2*)(Ktab + (((size_t)g * 65 + tau + 1) * 16 + c) * 16 + c0) = o;
    if (tau == 0 && lane < 32) *(v4u*)(Ktab + (size_t)g * 65 * 256 + lane * 8) = (v4u){0u, 0u, 0u, 0u};
    LDS_WAIT(); asm volatile("" ::: "memory");
}
}

#ifndef DBL_MASK
#define DBL_MASK 0
#endif
constexpr int NWAVES = 8;
constexpr int RING_OFF = 0, RING_BYTES = 131072;
constexpr int LDSCTL_OFF = RING_BYTES, MISC_OFF = LDSCTL_OFF + 320, XTRA_OFF = RING_BYTES + 1024;
constexpr int LDS_BYTES = 147456;
constexpr size_t CTL_ZERO_BYTES = 1 * MiB;
constexpr int CW_TMO = 0, CW_CODE = 1, CW_BAR = 4096;
constexpr int MAX_LAUNCHES = 8;
static_assert((CW_BAR + MAX_LAUNCHES * XCD_BAR_WORDS) * 4 <= (int)CTL_ZERO_BYTES, "barrier words inside the memset region");

enum Phase { PH_PRO = 0, PH_GU1 = 1, PH_D1 = 2, PH_IN = 3, PH_MIX = 4, PH_GLU = 5, PH_OUT = 6, PH_Q = 7, PH_ATT = 8, PH_O = 9, PH_GU2 = 10, PH_D2 = 11, PH_FIN = 12, PH_N = 13 };

struct Args { const float* in[39]; float* out; unsigned char* ws; int ph_lo, ph_hi, li, pad; };

__global__ void __launch_bounds__(NWAVES * 64, 2) mk_fwd(Args args) {
    extern __shared__ __attribute__((aligned(16))) unsigned char lds[];
    LAS unsigned char* L = (LAS unsigned char*)lds;
    volatile LAS unsigned* MISC = (volatile LAS unsigned*)(L + MISC_OFF);
    const int tid = threadIdx.x;
    const int G = gridDim.x, bx = blockIdx.x;
    unsigned char* ws = args.ws; float* out = args.out;
    gu32* ctl = (gu32*)(ws + WS_CTL);
    for (int u = tid; u < (LDS_BYTES - LDSCTL_OFF) / 4; u += NWAVES * 64) ((LAS unsigned*)(L + LDSCTL_OFF))[u] = 0u;
    __syncthreads();
    XcdBarrier bar = xcd_barrier_post((unsigned*)(ctl + CW_BAR) + args.li * XCD_BAR_WORDS, MISC + 8);
    const int lo = args.ph_lo, hi = args.ph_hi;
#define IN(k) (lo <= (k) && (k) < hi)
#define BOTH(k) (IN(k) && IN((k) + 1))
#define GRID_BAR() xcd_barrier(bar)
    bf16_t *Wgu1 = (bf16_t*)(ws + WS_WGU1), *Wgu2 = (bf16_t*)(ws + WS_WGU2), *Wd1 = (bf16_t*)(ws + WS_WD1), *Wd2 = (bf16_t*)(ws + WS_WD2), *Win = (bf16_t*)(ws + WS_WIN), *Wglu = (bf16_t*)(ws + WS_WGLU),
           *Wout = (bf16_t*)(ws + WS_WOUT), *Wq = (bf16_t*)(ws + WS_WQ), *Wo = (bf16_t*)(ws + WS_WO), *Wkv = (bf16_t*)(ws + WS_WKV);
    bf16_t *xb = (bf16_t*)(ws + WS_XB), *memb = (bf16_t*)(ws + WS_MEMB), *kb = (bf16_t*)(ws + WS_KB), *vb2 = (bf16_t*)(ws + WS_VB2), *hb = (bf16_t*)(ws + WS_H), *ug = (bf16_t*)(ws + WS_UG),
           *vb = (bf16_t*)(ws + WS_VB), *gb = (bf16_t*)(ws + WS_GB), *mixb = (bf16_t*)(ws + WS_MIXB), *qb = (bf16_t*)(ws + WS_QB), *ob = (bf16_t*)(ws + WS_OB);
    bf16_t *Ktab = (bf16_t*)(ws + WS_TAB + s5f::TAB_KT), *Ptab = (bf16_t*)(ws + WS_TAB + s5f::TAB_P), *Qtab = (bf16_t*)(ws + WS_TAB + s5f::TAB_Q); float* ALtab = (float*)(ws + WS_TAB + s5f::TAB_AL);
    float *ss0 = (float*)(ws + WS_SS0), *ss1 = (float*)(ws + WS_SS1), *ss2 = (float*)(ws + WS_SS2), *ss3 = (float*)(ws + WS_SS3), *ss4 = (float*)(ws + WS_SS4), *ssm = (float*)(ws + WS_SSM), *xres = (float*)(ws + WS_XRES);
    float* rstdm = ssm + (size_t)MMEM * 16; bf16_t* vT = vb2;

    const int wave = __builtin_amdgcn_readfirstlane(tid >> 6), lane = tid & 63;
    const float* const* in = args.in;
    if (IN(PH_PRO)) {
      for (int rep_ = 0; rep_ <= ((DBL_MASK >> PH_PRO) & 1); ++rep_) {
        {
            LAS float* scr = (LAS float*)(L + RING_OFF + wave * 16384);
            const int NGW = G * NWAVES;
            constexpr int I_GU = (D / 64) * (2 * FF / 32), I_D = (FF / 64) * (D / 32), I_IN = (D / 64) * (1536 / 32), I_GLU = (SSM / 64) * (SSM / 32), I_SQ = (D / 64) * (D / 32), I_KV = (D / 64) * (2048 / 32);
            constexpr int NITEMS = 2 * I_GU + 2 * I_D + I_IN + I_GLU + 3 * I_SQ + I_KV;
            constexpr int T_KT = NG * 64, T_PQ = 131072 / 64, T_ROW = M / 2, T_MEM = MMEM / 2, NTASK = T_KT + T_PQ + NITEMS + T_ROW + T_MEM;
            const bool rev = wave & 1; constexpr int NEV = (NTASK + 1) / 2, NOD = NTASK / 2;
            for (int ti = (wave >> 1) * G + bx; ti < (rev ? NOD : NEV); ti += NGW / 2) {
                int r = rev ? 2 * (NOD - 1 - ti) + 1 : 2 * ti;
                if (r < T_KT) { pro::kt_wave_task(r, in[17], in[18], in[19], in[20], in[21], in[22], in[23], Ktab, scr, lane); continue; } r -= T_KT;
                if (r < T_PQ) { s5f::pq_entry(r * 64 + lane, in[17], in[18], in[19], in[20], in[21], in[22], in[23], Ptab, Qtab, ALtab); continue; } r -= T_PQ;
                if (r < NITEMS) {
                    if (r < I_GU) { pro::transpose_job_item<1>(in[12], in[13], in[11], Wgu1, D, 2 * FF, FF, r, scr, lane); continue; } r -= I_GU;
                    if (r < I_GU) { pro::transpose_job_item<1>(in[35], in[36], in[34], Wgu2, D, 2 * FF, FF, r, scr, lane); continue; } r -= I_GU;
                    if (r < I_D) { pro::transpose_job_item<0>(in[14], nullptr, nullptr, Wd1, FF, D, D, r, scr, lane); continue; } r -= I_D;
                    if (r < I_D) { pro::transpose_job_item<0>(in[37], nullptr, nullptr, Wd2, FF, D, D, r, scr, lane); continue; } r -= I_D;
                    if (r < I_IN) { pro::transpose_job_item<2>(in[16], nullptr, in[15], Win, D, 1536, 1536, r, scr, lane); continue; } r -= I_IN;
                    if (r < I_GLU) { pro::transpose_job_item<0>(in[25], nullptr, nullptr, Wglu, SSM, SSM, SSM, r, scr, lane); continue; } r -= I_GLU;
                    if (r < I_SQ) { pro::transpose_job_item<0>(in[30], nullptr, nullptr, Wout, D, D, D, r, scr, lane); continue; } r -= I_SQ;
                    if (r < I_SQ) { pro::transpose_job_item<0>(in[32], nullptr, in[31], Wq, D, D, D, r, scr, lane); continue; } r -= I_SQ;
                    if (r < I_SQ) { pro::transpose_job_item<0>(in[33], nullptr, nullptr, Wo, D, D, D, r, scr, lane); continue; } r -= I_SQ;
                    pro::transpose_job_item<3>(in[9], in[10], in[8], Wkv, D, 2048, D, r, scr, lane); continue;
                }
                r -= NITEMS;
                if (r < T_ROW) { const int m0 = 2 * r, m1 = m0 + 1;
                    pro::rows2_bf16_ss(m0 < MP ? in[0] + (size_t)m0 * D : in[1] + (size_t)(m0 - MP) * D, m1 < MP ? in[0] + (size_t)m1 * D : in[1] + (size_t)(m1 - MP) * D,
                                       xb + (size_t)m0 * D, xb + (size_t)m1 * D, ss0 + (size_t)m0 * 16, ss0 + (size_t)m1 * 16, nullptr, nullptr, lane); continue; }
                r -= T_ROW;
                { const int m0 = 2 * r, m1 = m0 + 1; pro::rows2_bf16_ss(in[7] + (size_t)m0 * D, in[7] + (size_t)m1 * D, memb + (size_t)m0 * D, memb + (size_t)m1 * D, ssm + (size_t)m0 * 16, ssm + (size_t)m1 * 16, rstdm + m0, rstdm + m1, lane); }
            }
        }
        if (rep_ < ((DBL_MASK >> PH_PRO) & 1)) GRID_BAR();
      }
        if (BOTH(PH_PRO)) GRID_BAR();
    }

    if (IN(PH_GU1)) {
      for (int rep_ = 0; rep_ <= ((DBL_MASK >> PH_GU1) & 1); ++rep_) {
        { pg8::Gemm g{memb, Wkv, MMEM, D, D}; pg8::StaticOrder S; S.init(MMEM, D, G, (bx + G - 216 % G) % G); fx::EpiK E{rstdm, kb, out};
          pg8::gemm_phase<fx::EpiK, pg8::StaticOrder, true, true>(L + RING_OFF, g, S, E); }
        { pg8::Gemm g{xb, Wgu1, M, 2 * FF, D}; pg8::StaticOrder S; S.init(M, 2 * FF, G, bx); fx::EpiSwiglu E{ss0, hb};
          pg8::gemm_phase<fx::EpiSwiglu, pg8::StaticOrder, true, true>(L + RING_OFF, g, S, E); }
        if (rep_ < ((DBL_MASK >> PH_GU1) & 1)) GRID_BAR();
      }
        if (BOTH(PH_GU1)) GRID_BAR();
    }
    if (IN(PH_D1)) {
      for (int rep_ = 0; rep_ <= ((DBL_MASK >> PH_D1) & 1); ++rep_) {
        pg8::Gemm g{hb, Wd1, MP, D, FF}; pg8::StaticOrder S; S.init(MP, D, G, bx); fx::EpiRes E{args.in[0], args.in[0], xres, xb, ss1, 0.5f};
        pg8::gemm_phase<fx::EpiRes, pg8::StaticOrder, true, true>(L + RING_OFF, g, S, E);
        { sg::SRes Es{args.in[1], xres + (size_t)MP * D, xb + (size_t)MP * D, ss1 + (size_t)MP * 16, 0.5f};
          for (int t = bx; t < 256; t += G) sg::tile(hb + (size_t)MP * FF, Wd1, FF, t >> 4, t & 15, Es, L + RING_OFF, tid, wave, lane); }
        if (rep_ < ((DBL_MASK >> PH_D1) & 1)) GRID_BAR();
      }
        if (BOTH(PH_D1)) GRID_BAR();
    }
    if (IN(PH_IN)) {
      for (int rep_ = 0; rep_ <= ((DBL_MASK >> PH_IN) & 1); ++rep_) {
        { pg8::Gemm g{xb, Win, M, 1536, D}; pg8::StaticOrder S; S.init(M, 1536, G, bx); fx::EpiIn E{ss1, ug, vb, out};
          pg8::gemm_phase<fx::EpiIn, pg8::StaticOrder, true, true>(L + RING_OFF, g, S, E); }
        { pg8::Gemm g{Wkv + (size_t)D * D, memb, D, MMEM, D}; pg8::StaticOrder S; S.init(D, MMEM, G, (bx + G - 152 % G) % G); fx::EpiVT E{rstdm, vT, out};
          pg8::gemm_phase<fx::EpiVT, pg8::StaticOrder, true, true>(L + RING_OFF, g, S, E); }
        if (rep_ < ((DBL_MASK >> PH_IN) & 1)) GRID_BAR();
      }
        if (BOTH(PH_IN)) GRID_BAR();
    }
    if (IN(PH_MIX)) {
      for (int rep_ = 0; rep_ <= ((DBL_MASK >> PH_MIX) & 1); ++rep_) {
        for (int unit = bx; unit < NBATCH * NG; unit += G) s5f::prompt_unit(unit >> 5, unit & 31, ug, Ktab, Ptab, Qtab, ALtab, in[24], gb, out, L + RING_OFF, tid, wave, lane);
        for (int unit = bx; unit < NG * (DECB / 16); unit += G) s5f::sample_unit(unit & 31, unit >> 5, ug, in[2], in[3], Ktab, Ptab, Qtab, ALtab, in[24], gb, out, wave, lane);
        __syncthreads();
        LAS float* ybuf = (LAS float*)(L + RING_OFF);
        for (int tile = bx; tile < NBATCH * (SEQ / 64); tile += G) cvx::prompt_tile(tile >> 5, (tile & 31) * 64, vb, in[26], in[27], in[28], in[29], mixb, ybuf, tid, wave, lane);
        for (int b = bx; b < DECB; b += G) cvx::sample_batch(b, vb, in[4], in[26], in[27], in[28], in[29], mixb, out, ybuf, tid, wave, lane);
        if (rep_ < ((DBL_MASK >> PH_MIX) & 1)) GRID_BAR();
      }
        if (BOTH(PH_MIX)) GRID_BAR();
    }

    if (IN(PH_GLU)) {
      for (int rep_ = 0; rep_ <= ((DBL_MASK >> PH_GLU) & 1); ++rep_) {
        pg8::Gemm g{gb, Wglu, M, SSM, SSM}; pg8::StaticOrder S; S.init(M, SSM, G, bx); fx::EpiGlu E{gb, mixb};
        pg8::gemm_phase<fx::EpiGlu, pg8::StaticOrder, true, true>(L + RING_OFF, g, S, E);
        if (rep_ < ((DBL_MASK >> PH_GLU) & 1)) GRID_BAR();
      }
        if (BOTH(PH_GLU)) GRID_BAR();
    }
    if (IN(PH_OUT)) {
      for (int rep_ = 0; rep_ <= ((DBL_MASK >> PH_OUT) & 1); ++rep_) {
        pg8::Gemm g{mixb, Wout, MP, D, D}; pg8::StaticOrder S; S.init(MP, D, G, bx); fx::EpiRes E{xres, xres, xres, xb, ss2, 1.f};
        pg8::gemm_phase<fx::EpiRes, pg8::StaticOrder, true, true>(L + RING_OFF, g, S, E);
        { sg::SRes Es{xres + (size_t)MP * D, xres + (size_t)MP * D, xb + (size_t)MP * D, ss2 + (size_t)MP * 16, 1.f};
          for (int t = bx; t < 256; t += G) sg::tile(mixb + (size_t)MP * D, Wout, D, t >> 4, t & 15, Es, L + RING_OFF, tid, wave, lane); }
        if (rep_ < ((DBL_MASK >> PH_OUT) & 1)) GRID_BAR();
      }
        if (BOTH(PH_OUT)) GRID_BAR();
    }
    if (IN(PH_Q)) {
      for (int rep_ = 0; rep_ <= ((DBL_MASK >> PH_Q) & 1); ++rep_) {
        pg8::Gemm g{xb, Wq, MP, D, D}; pg8::StaticOrder S; S.init(MP, D, G, bx); fx::EpiQ E{ss2, qb};
        pg8::gemm_phase<fx::EpiQ, pg8::StaticOrder, true, true>(L + RING_OFF, g, S, E);
        { sg::SQ Es{ss2 + (size_t)MP * 16, qb + (size_t)MP * D};
          for (int t = bx; t < 256; t += G) sg::tile(xb + (size_t)MP * D, Wq, D, t >> 4, t & 15, Es, L + RING_OFF, tid, wave, lane); }
        if (rep_ < ((DBL_MASK >> PH_Q) & 1)) GRID_BAR();
      }
        if (BOTH(PH_Q)) GRID_BAR();
    }
    if (IN(PH_ATT)) {
      for (int rep_ = 0; rep_ <= ((DBL_MASK >> PH_ATT) & 1); ++rep_) {
        LAS float* wsf = (LAS float*)(L + XTRA_OFF) + wave * 32;
        const int vcu = (G % 8 == 0) ? (bx % 8) * (G / 8) + bx / 8 : bx;
        for (int unit = vcu; unit < NBATCH * NH * 8; unit += G) att::prompt_unit(unit >> 5, (unit >> 3) & 3, unit & 7, qb, kb, vT, ob, L + RING_OFF, wsf, tid, wave, lane);
        for (int unit = bx; unit < DECB * 2; unit += G) att::sample_unit(unit >> 1, unit & 1, qb, in[5], in[6], ob, L + RING_OFF, tid, wave, lane);
        if (rep_ < ((DBL_MASK >> PH_ATT) & 1)) GRID_BAR();
      }
        if (BOTH(PH_ATT)) GRID_BAR();
    }

    if (IN(PH_O)) {
      for (int rep_ = 0; rep_ <= ((DBL_MASK >> PH_O) & 1); ++rep_) {
        pg8::Gemm g{ob, Wo, MP, D, D}; pg8::StaticOrder S; S.init(MP, D, G, bx); fx::EpiRes E{xres, xres, xres, xb, ss3, 1.f};
        pg8::gemm_phase<fx::EpiRes, pg8::StaticOrder, true, true>(L + RING_OFF, g, S, E);
        { sg::SRes Es{xres + (size_t)MP * D, xres + (size_t)MP * D, xb + (size_t)MP * D, ss3 + (size_t)MP * 16, 1.f};
          for (int t = bx; t < 256; t += G) sg::tile(ob + (size_t)MP * D, Wo, D, t >> 4, t & 15, Es, L + RING_OFF, tid, wave, lane); }
        if (rep_ < ((DBL_MASK >> PH_O) & 1)) GRID_BAR();
      }
        if (BOTH(PH_O)) GRID_BAR();
    }
    if (IN(PH_GU2)) {
      for (int rep_ = 0; rep_ <= ((DBL_MASK >> PH_GU2) & 1); ++rep_) {
        pg8::Gemm g{xb, Wgu2, M, 2 * FF, D}; pg8::StaticOrder S; S.init(M, 2 * FF, G, bx); fx::EpiSwiglu E{ss3, hb};
        pg8::gemm_phase<fx::EpiSwiglu, pg8::StaticOrder, true, true>(L + RING_OFF, g, S, E);
        if (rep_ < ((DBL_MASK >> PH_GU2) & 1)) GRID_BAR();
      }
        if (BOTH(PH_GU2)) GRID_BAR();
    }
    if (IN(PH_D2)) {
      for (int rep_ = 0; rep_ <= ((DBL_MASK >> PH_D2) & 1); ++rep_) {
        pg8::Gemm g{hb, Wd2, MP, D, FF}; pg8::StaticOrder S; S.init(MP, D, G, bx); fx::EpiRes E{xres, xres, out + O_Y, nullptr, ss4, 0.5f};
        pg8::gemm_phase<fx::EpiRes, pg8::StaticOrder, true, true>(L + RING_OFF, g, S, E);
        { sg::SRes Es{xres + (size_t)MP * D, out + O_Y + (size_t)MP * D, nullptr, ss4 + (size_t)MP * 16, 0.5f};
          for (int t = bx; t < 256; t += G) sg::tile(hb + (size_t)MP * FF, Wd2, FF, t >> 4, t & 15, Es, L + RING_OFF, tid, wave, lane); }
        if (rep_ < ((DBL_MASK >> PH_D2) & 1)) GRID_BAR();
      }
        if (BOTH(PH_D2)) GRID_BAR();
    }

    if (IN(PH_FIN)) {
        float* y = out + O_Y; const float* gfin = in[38];
        for (int m = bx * NWAVES + wave; m < M; m += G * NWAVES) { const float r = rstd_from_ss(ss4, m);
#pragma unroll
            for (int j = 0; j < 4; ++j) { f32x4* p = (f32x4*)(y + (size_t)m * D + j * 256 + lane * 4); const f32x4 gg = *(const f32x4*)(gfin + j * 256 + lane * 4); f32x4 v = *p; v = v * r * gg; *p = v; } }
    }
    if (IN(13)) { for (int unit = bx; unit < NBATCH * NG; unit += G) s5f::prompt_unit(unit >> 5, unit & 31, ug, Ktab, Ptab, Qtab, ALtab, in[24], gb, out, L + RING_OFF, tid, wave, lane); }
    if (IN(14)) { for (int unit = bx; unit < NG * (DECB / 16); unit += G) s5f::sample_unit(unit & 31, unit >> 5, ug, in[2], in[3], Ktab, Ptab, Qtab, ALtab, in[24], gb, out, wave, lane); }
    if (IN(15)) { LAS float* ybuf = (LAS float*)(L + RING_OFF);
        for (int tile = bx; tile < NBATCH * (SEQ / 64); tile += G) cvx::prompt_tile(tile >> 5, (tile & 31) * 64, vb, in[26], in[27], in[28], in[29], mixb, ybuf, tid, wave, lane);
        for (int b = bx; b < DECB; b += G) cvx::sample_batch(b, vb, in[4], in[26], in[27], in[28], in[29], mixb, out, ybuf, tid, wave, lane); }
#undef IN
#undef BOTH
#undef GRID_BAR
}

#ifndef FAST_MERGE
#define FAST_MERGE 1
#endif
extern "C" void kernel_launch(void* const* d_in, const int* in_sizes, int n_in, void* d_out, int out_size, void* d_ws, size_t ws_size, hipStream_t stream) {
    if (n_in != 39 || out_size != (int)O_END || ws_size < WS_END) { fprintf(stderr, "kernel_launch: unexpected shapes n_in %d out %d ws %zu\n", n_in, out_size, ws_size); return; }
    static int grid = 0;
    if (grid == 0) {
        int dev = 0, cus = 0;
        if (hipGetDevice(&dev) != hipSuccess || hipDeviceGetAttribute(&cus, hipDeviceAttributeMultiprocessorCount, dev) != hipSuccess) { grid = -1; return; }
        if (hipFuncSetAttribute((const void*)mk_fwd, hipFuncAttributeMaxDynamicSharedMemorySize, LDS_BYTES) != hipSuccess) { fprintf(stderr, "kernel_launch: hipFuncSetAttribute failed\n"); grid = -1; return; }
        int per_cu = 0;
        if (hipOccupancyMaxActiveBlocksPerMultiprocessor(&per_cu, (const void*)mk_fwd, NWAVES * 64, LDS_BYTES) != hipSuccess || per_cu < 1) { fprintf(stderr, "kernel_launch: occupancy query says %d\n", per_cu); }
        (void)hipGetLastError();
        grid = cus;
    }
    if (grid < 0) return;
    const float* const* in = (const float* const*)d_in;
    const float *x_p = in[0], *x_s = in[1], *st_re = in[2], *st_im = in[3], *cconv = in[4], *cmk = in[5], *cmv = in[6], *memp = in[7], *g_mem = in[8], *w_k = in[9], *w_v = in[10],
                *g_ffn1 = in[11], *w1g = in[12], *w1u = in[13], *w1d = in[14], *g_mix = in[15], *w_in = in[16], *a_re = in[17], *a_im = in[18], *log_dt = in[19], *b_re = in[20], *b_im = in[21],
                *c_re = in[22], *c_im = in[23], *ssm_d = in[24], *w_glu = in[25], *conv_w = in[26], *conv_b = in[27], *ln_g = in[28], *ln_b = in[29], *w_out = in[30], *g_xattn = in[31],
                *w_q = in[32], *w_o = in[33], *g_ffn2 = in[34], *w2g = in[35], *w2u = in[36], *w2d = in[37], *g_final = in[38];
    (void)x_p; (void)x_s;
    unsigned char* ws = (unsigned char*)d_ws; float* out = (float*)d_out;
    bf16_t *Wgu1 = (bf16_t*)(ws + WS_WGU1), *Wgu2 = (bf16_t*)(ws + WS_WGU2), *Wd1 = (bf16_t*)(ws + WS_WD1), *Wd2 = (bf16_t*)(ws + WS_WD2), *Win = (bf16_t*)(ws + WS_WIN), *Wglu = (bf16_t*)(ws + WS_WGLU),
           *Wout = (bf16_t*)(ws + WS_WOUT), *Wq = (bf16_t*)(ws + WS_WQ), *Wo = (bf16_t*)(ws + WS_WO), *Wkv = (bf16_t*)(ws + WS_WKV);
    bf16_t *xb = (bf16_t*)(ws + WS_XB), *memb = (bf16_t*)(ws + WS_MEMB), *kb = (bf16_t*)(ws + WS_KB), *vb2 = (bf16_t*)(ws + WS_VB2), *ug = (bf16_t*)(ws + WS_UG),
           *vb = (bf16_t*)(ws + WS_VB), *gb = (bf16_t*)(ws + WS_GB), *mixb = (bf16_t*)(ws + WS_MIXB), *qb = (bf16_t*)(ws + WS_QB), *ob = (bf16_t*)(ws + WS_OB);
    float *ss0 = (float*)(ws + WS_SS0), *ss4 = (float*)(ws + WS_SS4), *ssm = (float*)(ws + WS_SSM);

    if (hipMemsetAsync(ws + WS_CTL, 0, CTL_ZERO_BYTES, stream) != hipSuccess) return;
    Args a{};
    for (int i = 0; i < 39; ++i) a.in[i] = in[i];
    a.out = out; a.ws = ws;
    int li = 0;
    auto run = [&](int lo, int hi) {
        if (FAST_MERGE) { a.ph_lo = lo; a.ph_hi = hi; a.li = li++; hipLaunchKernelGGL(mk_fwd, dim3(grid), dim3(NWAVES * 64), LDS_BYTES, stream, a); }
        else for (int p = lo; p < hi; ++p) { a.ph_lo = p; a.ph_hi = p + 1; a.li = li; hipLaunchKernelGGL(mk_fwd, dim3(grid), dim3(NWAVES * 64), LDS_BYTES, stream, a); }
    };

    run(PH_PRO, PH_N);
#ifdef PROBE_PHASE
    run(PROBE_PHASE, PROBE_PHASE + 1);
#endif
}
```
